# Optimizing an MI355X kernel written in HIP

```python
import math
import jax, jax.numpy as jnp
from jax import lax
import numpy as np

D_MODEL = 2048
BATCH = 1
SEQ = 16384
DEPTH = 2

GRID_W = 64
CTX_LEN = 256
EPS = 1e-6
N_MOD = 6

GROUP_W = D_MODEL // 4
D_MIX = 4 * GROUP_W

GDN_HEADS = 4
GDN_DK = GROUP_W // GDN_HEADS
GDN_DV = GROUP_W // GDN_HEADS
GDN_CONV = 3
GDN_CHUNK = 64
MLA_HEADS = 4
MLA_NOPE = 128
MLA_ROPE = 64
MLA_V = GROUP_W // MLA_HEADS
MLA_Q_RANK = 448
MLA_KV_RANK = 128
ATTN_BLOCK = 128
ROPE_BASE = 10000.0
HY_CH = GROUP_W
HY_CONV = 3
HY_EMB = 33
HY_FFN = 64
HY_FAST = 0.3
HY_SLOW = 1.5
HY_TARGET = 1e-2
RET_HEADS = 4
RET_DK = GROUP_W // RET_HEADS
RET_DV = GROUP_W // RET_HEADS
RET_CHUNK = 128
RET_DECAY_F = (5.0, 7.0, 9.0, 11.0)
RET_DECAY_B = (6.0, 8.0, 10.0, 12.0)
D_FF = 5632
N_EXPERTS = 8
TOP_K = 2

IN_SIZES = (3 * GDN_HEADS * GDN_DK, GDN_HEADS * GDN_DV, 2 * GDN_HEADS, 2 * GDN_HEADS,
            MLA_Q_RANK, MLA_KV_RANK, MLA_ROPE,
            3 * HY_CH,
            3 * RET_HEADS * RET_DK, RET_HEADS * RET_DV)
D_IN = sum(IN_SIZES)

kernel_name = "hybrid_flow_backbone_block"

f32 = jnp.float32


def rms_norm(x, w=None):
    xf = x.astype(f32)
    y = (xf * lax.rsqrt(jnp.mean(xf * xf, axis=-1, keepdims=True) + EPS)).astype(x.dtype)
    return y if w is None else y * w


def l2_norm(x):
    xf = x.astype(f32)
    return (xf * lax.rsqrt(jnp.sum(xf * xf, axis=-1, keepdims=True) + EPS)).astype(x.dtype)


def split_in(p):
    offs = [int(o) for o in np.cumsum(IN_SIZES)[:-1]]
    return jnp.split(p, offs, axis=-1)


def depthwise_conv_centred(x, w):
    K = w.shape[0]
    return lax.conv_general_dilated(x, w[:, None, :].astype(x.dtype), window_strides=(1,),
                                    padding=[(K // 2, K // 2)],
                                    dimension_numbers=('NWC', 'WIO', 'NWC'),
                                    feature_group_count=x.shape[-1])


def rotate_half(x):
    x1, x2 = jnp.split(x, 2, axis=-1)
    return jnp.concatenate([-x2, x1], axis=-1)


def rope_angles(pos, dim):
    inv = ROPE_BASE ** (-jnp.arange(0, dim, 2, dtype=f32) / dim)
    ang = pos.astype(f32)[:, None] * inv[None, :]
    ang = jnp.concatenate([ang, ang], axis=-1)
    return jnp.cos(ang), jnp.sin(ang)


def apply_rope(x, pos):
    cos, sin = rope_angles(pos, x.shape[-1])
    shp = (pos.shape[0],) + (1,) * (x.ndim - 3) + (x.shape[-1],)
    cos, sin = cos.reshape(shp).astype(x.dtype), sin.reshape(shp).astype(x.dtype)
    return x * cos + rotate_half(x) * sin


def axial_rope(x, rows, cols):
    half = x.shape[-1] // 2
    return jnp.concatenate([apply_rope(x[..., :half], rows), apply_rope(x[..., half:], cols)], axis=-1)


def bidirectional(scan_f, scan_b, ctx_f, lat_f, ctx_b, lat_b, S0):
    flip = lambda seq: tuple(jnp.flip(a, axis=2) for a in seq)
    oc_f, sc_f = scan_f(*ctx_f, S0)
    ol_f, _ = scan_f(*lat_f, sc_f)
    oc_b, sc_b = scan_b(*flip(ctx_b), S0)
    ol_b, _ = scan_b(*flip(lat_b), sc_b)
    return oc_f + jnp.flip(oc_b, axis=2), ol_f + jnp.flip(ol_b, axis=2)


def unit_lower_inverse(A):
    C = A.shape[-1]
    Nm = -A
    T = jnp.eye(C, dtype=A.dtype) + Nm
    P = Nm
    for _ in range(int(math.log2(C)) - 1):
        P = P @ P
        T = T + T @ P
    return T


def gated_delta_scan(q, k, v, g, beta, S0):
    out_dtype = v.dtype
    q, k, v, g, beta = (t.astype(f32) for t in (q, k, v, g, beta))
    B, H, L, dk = q.shape
    dv = v.shape[-1]
    C = GDN_CHUNK
    N = L // C
    q = q * (dk ** -0.5)
    chunk = lambda t: jnp.moveaxis(t.reshape((B, H, N, C) + t.shape[3:]), 2, 0)
    q, k, v, g, beta = (chunk(t) for t in (q, k, v, g, beta))
    gc = jnp.cumsum(g, axis=-1)
    causal = jnp.tril(jnp.ones((C, C), bool))
    strict = jnp.tril(jnp.ones((C, C), bool), -1)
    decay = jnp.exp(jnp.where(causal, gc[..., :, None] - gc[..., None, :], -jnp.inf))
    kb = k * beta[..., None]
    A = jnp.where(strict, jnp.einsum('nbhcd,nbhsd->nbhcs', kb, k) * decay, 0.0)
    T = unit_lower_inverse(A)
    u = T @ (v * beta[..., None])
    w = T @ (kb * jnp.exp(gc)[..., None])

    def step(S, inp):
        qi, ki, ui, wi, gi, di = inp
        v_new = ui - wi @ S
        attn = (qi @ jnp.swapaxes(ki, -1, -2)) * di
        o = (qi * jnp.exp(gi)[..., None]) @ S + attn @ v_new
        g_last = gi[..., -1:]
        S = S * jnp.exp(g_last)[..., None] + jnp.swapaxes(ki * jnp.exp(g_last - gi)[..., None], -1, -2) @ v_new
        return S, o

    S, o = lax.scan(step, S0.astype(f32), (q, k, u, w, gc, decay))
    o = jnp.moveaxis(o, 0, 2).reshape(B, H, L, dv)
    return o.astype(out_dtype), S


def retention_scan(q, k, v, S0, log_gamma):
    out_dtype = v.dtype
    q, k, v = (t.astype(f32) for t in (q, k, v))
    B, H, L, dk = q.shape
    dv = v.shape[-1]
    C = RET_CHUNK
    N = L // C
    idx = jnp.arange(C, dtype=f32)
    rel = idx[:, None] - idx[None, :]
    D = jnp.where(rel >= 0, jnp.exp(jnp.maximum(rel, 0.0)[None] * log_gamma[:, None, None]), 0.0)
    q_dec = jnp.exp((idx + 1.0)[None, :] * log_gamma[:, None])[None, :, :, None]
    k_dec = jnp.exp((C - 1.0 - idx)[None, :] * log_gamma[:, None])[None, :, :, None]
    c_dec = jnp.exp(C * log_gamma)[None, :, None, None]
    chunk = lambda t: jnp.moveaxis(t.reshape(B, H, N, C, t.shape[-1]), 2, 0)

    def step(S, inp):
        qi, ki, vi = inp
        inner = (qi @ jnp.swapaxes(ki, -1, -2)) * D[None]
        o = (qi @ S) * q_dec + inner @ vi
        S = S * c_dec + jnp.swapaxes(ki * k_dec, -1, -2) @ vi
        return S, o

    S, o = lax.scan(step, S0.astype(f32), (chunk(q), chunk(k), chunk(v)))
    o = jnp.moveaxis(o, 0, 2).reshape(B, H, L, dv)
    return o.astype(out_dtype), S


def gdn_prepare(qkv, a, b, conv_w, A_log, dt_bias):
    B, L, _ = qkv.shape
    qkv = jax.nn.silu(depthwise_conv_centred(qkv, conv_w))
    q, k, v = jnp.split(qkv, 3, axis=-1)
    heads = lambda t: t.reshape(B, L, GDN_HEADS, -1).transpose(0, 2, 1, 3)
    q, k, v = l2_norm(heads(q)), l2_norm(heads(k)), heads(v)
    a = a.astype(f32).reshape(B, L, 2, GDN_HEADS)
    b = b.astype(f32).reshape(B, L, 2, GDN_HEADS)
    g = -jnp.exp(A_log.astype(f32)) * jax.nn.softplus(a + dt_bias.astype(f32))
    beta = jax.nn.sigmoid(b)
    g, beta = g.transpose(2, 0, 3, 1), beta.transpose(2, 0, 3, 1)
    return (q, k, v, g[0], beta[0]), (q, k, v, g[1], beta[1])


def gdn_output(o, z, norm_w):
    B, H, L, dv = o.shape
    o = rms_norm(o.transpose(0, 2, 1, 3), norm_w) * jax.nn.silu(z.reshape(B, L, H, dv))
    return o.reshape(B, L, H * dv)


def ret_prepare(qkv, pos):
    B, L, _ = qkv.shape
    q, k, v = (t.reshape(B, L, RET_HEADS, -1) for t in jnp.split(qkv, 3, axis=-1))
    if pos is not None:
        q, k = apply_rope(q, pos), apply_rope(k, pos)
    k = k * (RET_DK ** -0.5)
    return tuple(t.transpose(0, 2, 1, 3) for t in (q, k, v))


def ret_output(o, gate):
    B, H, L, dv = o.shape
    o = rms_norm(o.transpose(0, 2, 1, 3)).reshape(B, L, H * dv)
    return o * jax.nn.silu(gate)


def mla_project(cq, ckv, kr, q_norm_w, w_uq, kv_norm_w, w_ukv, rows, cols):
    B, L, _ = cq.shape
    q = (rms_norm(cq, q_norm_w) @ w_uq).reshape(B, L, MLA_HEADS, MLA_NOPE + MLA_ROPE)
    kv = (rms_norm(ckv, kv_norm_w) @ w_ukv).reshape(B, L, MLA_HEADS, MLA_NOPE + MLA_V)
    q_nope, q_rope = q[..., :MLA_NOPE], q[..., MLA_NOPE:]
    k_nope, v = kv[..., :MLA_NOPE], kv[..., MLA_NOPE:]
    if rows is not None:
        q_rope = axial_rope(q_rope, rows, cols)
        kr = axial_rope(kr, rows, cols)
    k_rope = jnp.broadcast_to(kr[:, :, None, :], (B, L, MLA_HEADS, MLA_ROPE))
    return jnp.concatenate([q_nope, q_rope], -1), jnp.concatenate([k_nope, k_rope], -1), v


def block_attention(q, k, v):
    B, Lq, H, Dk = q.shape
    nb = Lq // ATTN_BLOCK
    qb = jnp.moveaxis(q.reshape(B, nb, ATTN_BLOCK, H, Dk), 1, 0)
    scale = Dk ** -0.5

    def one(qi):
        s = jnp.einsum('bqhd,bkhd->bhqk', qi, k).astype(f32) * scale
        p = jax.nn.softmax(s, axis=-1).astype(v.dtype)
        return jnp.einsum('bhqk,bkhd->bqhd', p, v)

    o = lax.map(one, qb)
    return jnp.moveaxis(o, 0, 1).reshape(B, Lq, H * v.shape[-1])


def hyena_filters(L, w1, b1, w2, b2, w3, b3, w4, freq):
    w1, b1, w2, b2, w3, b3, w4, freq = (t.astype(f32) for t in (w1, b1, w2, b2, w3, b3, w4, freq))
    p = jnp.arange(L, dtype=f32)
    bands = (HY_EMB - 1) // 2
    fr = jnp.linspace(1e-4, bands - 1, bands, dtype=f32)
    ang = (2.0 * math.pi / L) * p[:, None] * fr[None, :]
    z = jnp.concatenate([(p / (L - 1))[:, None], jnp.cos(ang), -jnp.sin(ang)], axis=-1)
    hdn = jnp.sin(freq * (z @ w1 + b1))
    hdn = jnp.sin(freq * (hdn @ w2 + b2))
    hdn = jnp.sin(freq * (hdn @ w3 + b3))
    h = hdn @ w4
    deltas = jnp.abs(jnp.linspace(math.log(HY_FAST) / HY_TARGET, math.log(HY_SLOW) / HY_TARGET, 2 * HY_CH, dtype=f32))
    dist = jnp.abs(p - L // 2) / L
    h = h * jnp.exp(-dist[:, None] * deltas[None, :])
    return h / (jnp.sum(jnp.abs(h), axis=0, keepdims=True) + EPS)


def fft_conv_centred(u, h):
    L = u.shape[1]
    n = 2 * L
    U = jnp.fft.rfft(u.astype(f32), n=n, axis=1)
    Hf = jnp.fft.rfft(h, n=n, axis=0)
    y = jnp.fft.irfft(U * Hf[None], n=n, axis=1)
    return y[:, L // 2: L // 2 + L].astype(u.dtype)


def hyena_mixer(u, conv_w, w1, b1, w2, b2, w3, b3, w4, freq, bias):
    L = u.shape[1]
    u = depthwise_conv_centred(u, conv_w)
    v, x1, x2 = jnp.split(u, 3, axis=-1)
    h = hyena_filters(L, w1, b1, w2, b2, w3, b3, w4, freq)
    z1 = x1 * (fft_conv_centred(v, h[:, :HY_CH]) + bias[0] * v)
    return x2 * (fft_conv_centred(z1, h[:, HY_CH:]) + bias[1] * z1)


def token_mixers(h_c, h_l, w_in, gdn_conv_w, gdn_A_log, gdn_dt_bias, gdn_norm_w,
                 mla_q_norm_w, mla_w_uq, mla_kv_norm_w, mla_w_ukv,
                 hy_conv_w, hy_w1, hy_b1, hy_w2, hy_b2, hy_w3, hy_b3, hy_w4, hy_freq, hy_bias,
                 rows, cols, pos, want_ctx):
    B, Lc, _ = h_c.shape
    P = jnp.concatenate([h_c, h_l], axis=1) @ w_in
    pc, pl = split_in(P[:, :Lc]), split_in(P[:, Lc:])

    cf, cb = gdn_prepare(pc[0], pc[2], pc[3], gdn_conv_w, gdn_A_log, gdn_dt_bias)
    lf, lb = gdn_prepare(pl[0], pl[2], pl[3], gdn_conv_w, gdn_A_log, gdn_dt_bias)
    S0 = jnp.zeros((B, GDN_HEADS, GDN_DK, GDN_DV), f32)
    gdn_c, gdn_l = bidirectional(gated_delta_scan, gated_delta_scan, cf, lf, cb, lb, S0)

    qc, kc, vc = mla_project(pc[4], pc[5], pc[6], mla_q_norm_w, mla_w_uq, mla_kv_norm_w, mla_w_ukv, None, None)
    ql, kl, vl = mla_project(pl[4], pl[5], pl[6], mla_q_norm_w, mla_w_uq, mla_kv_norm_w, mla_w_ukv, rows, cols)
    mla_l = block_attention(ql, jnp.concatenate([kc, kl], axis=1), jnp.concatenate([vc, vl], axis=1))

    hy_l = hyena_mixer(pl[7], hy_conv_w, hy_w1, hy_b1, hy_w2, hy_b2, hy_w3, hy_b3, hy_w4, hy_freq, hy_bias)

    lg_f = jnp.log1p(-jnp.exp2(-jnp.asarray(RET_DECAY_F, f32)))
    lg_b = jnp.log1p(-jnp.exp2(-jnp.asarray(RET_DECAY_B, f32)))
    rc = ret_prepare(pc[8], None)
    rl = ret_prepare(pl[8], pos)
    R0 = jnp.zeros((B, RET_HEADS, RET_DK, RET_DV), f32)
    ret_c, ret_l = bidirectional(lambda q, k, v, s: retention_scan(q, k, v, s, lg_f),
                                 lambda q, k, v, s: retention_scan(q, k, v, s, lg_b),
                                 rc, rl, rc, rl, R0)

    o_l = jnp.concatenate([gdn_output(gdn_l, pl[1], gdn_norm_w), mla_l, hy_l, ret_output(ret_l, pl[9])], axis=-1)
    if not want_ctx:
        return None, o_l
    mla_c = block_attention(qc, kc, vc)
    hy_c = hyena_mixer(pc[7], hy_conv_w, hy_w1, hy_b1, hy_w2, hy_b2, hy_w3, hy_b3, hy_w4, hy_freq, hy_bias)
    o_c = jnp.concatenate([gdn_output(gdn_c, pc[1], gdn_norm_w), mla_c, hy_c, ret_output(ret_c, pc[9])], axis=-1)
    return o_c, o_l


def swiglu(h, w1, w3, w2):
    return (jax.nn.silu(h @ w1) * (h @ w3)) @ w2


def moe_swiglu(h, router, w1, w3, w2):
    logits = (h @ router).astype(f32)
    top_v, top_i = lax.top_k(logits, TOP_K)
    wts = jax.nn.softmax(top_v, axis=-1)
    gates = jnp.sum(jax.nn.one_hot(top_i, N_EXPERTS, dtype=f32) * wts[..., None], axis=-2)
    y = jnp.zeros_like(h)
    for e in range(N_EXPERTS):
        y = y + gates[..., e:e + 1].astype(h.dtype) * swiglu(h, w1[e], w3[e], w2[e])
    return y


def setup_inputs(seed: int = 0) -> dict:
    key = jax.random.key(seed)
    ks = list(jax.random.split(key, 64))
    nrm = lambda shape, scale: jax.random.normal(ks.pop(), shape, f32) * scale
    gain = lambda shape: 1.0 + 0.05 * jax.random.normal(ks.pop(), shape, f32)
    n_dense = (DEPTH + 1) // 2
    n_moe = DEPTH // 2
    dt = jnp.exp(jax.random.uniform(ks.pop(), (DEPTH, 2, GDN_HEADS), f32, math.log(1e-3), math.log(1e-1)))
    a_log = jnp.log(jax.random.uniform(ks.pop(), (DEPTH, 2, GDN_HEADS), f32, 1.0, 16.0))
    return {
        "x": nrm((BATCH, SEQ, D_MODEL), 1.0),
        "c": nrm((BATCH, D_MODEL), 1.0),
        "ctx": nrm((BATCH, CTX_LEN, D_MODEL), 1.0),
        "c_ctx": nrm((D_MODEL,), 1.0),
        "norm1_w": gain((DEPTH, D_MODEL)),
        "norm2_w": gain((DEPTH, D_MODEL)),
        "mod_w": nrm((DEPTH, D_MODEL, N_MOD * D_MODEL), 0.5 * D_MODEL ** -0.5),
        "mod_b": nrm((DEPTH, N_MOD * D_MODEL), 0.02),
        "w_in": nrm((DEPTH, D_MODEL, D_IN), D_MODEL ** -0.5),
        "w_out": nrm((DEPTH, D_MIX, D_MODEL), D_MIX ** -0.5),
        "gdn_conv_w": nrm((DEPTH, GDN_CONV, 3 * GDN_HEADS * GDN_DK), GDN_CONV ** -0.5),
        "gdn_A_log": a_log,
        "gdn_dt_bias": dt + jnp.log(-jnp.expm1(-dt)),
        "gdn_norm_w": gain((DEPTH, GDN_DV)),
        "mla_q_norm_w": gain((DEPTH, MLA_Q_RANK)),
        "mla_w_uq": nrm((DEPTH, MLA_Q_RANK, MLA_HEADS * (MLA_NOPE + MLA_ROPE)), MLA_Q_RANK ** -0.5),
        "mla_kv_norm_w": gain((DEPTH, MLA_KV_RANK)),
        "mla_w_ukv": nrm((DEPTH, MLA_KV_RANK, MLA_HEADS * (MLA_NOPE + MLA_V)), MLA_KV_RANK ** -0.5),
        "hy_conv_w": nrm((DEPTH, HY_CONV, 3 * HY_CH), HY_CONV ** -0.5),
        "hy_w1": nrm((DEPTH, HY_EMB, HY_FFN), HY_EMB ** -0.5),
        "hy_b1": nrm((DEPTH, HY_FFN), 0.1),
        "hy_w2": nrm((DEPTH, HY_FFN, HY_FFN), HY_FFN ** -0.5),
        "hy_b2": nrm((DEPTH, HY_FFN), 0.1),
        "hy_w3": nrm((DEPTH, HY_FFN, HY_FFN), HY_FFN ** -0.5),
        "hy_b3": nrm((DEPTH, HY_FFN), 0.1),
        "hy_w4": nrm((DEPTH, HY_FFN, 2 * HY_CH), HY_FFN ** -0.5),
        "hy_freq": gain((DEPTH, HY_FFN)),
        "hy_bias": nrm((DEPTH, 2, HY_CH), 1.0),
        "ffn_w1": nrm((n_dense, D_MODEL, D_FF), D_MODEL ** -0.5),
        "ffn_w3": nrm((n_dense, D_MODEL, D_FF), D_MODEL ** -0.5),
        "ffn_w2": nrm((n_dense, D_FF, D_MODEL), D_FF ** -0.5),
        "moe_router": nrm((n_moe, D_MODEL, N_EXPERTS), D_MODEL ** -0.5),
        "moe_w1": nrm((n_moe, N_EXPERTS, D_MODEL, D_FF), D_MODEL ** -0.5),
        "moe_w3": nrm((n_moe, N_EXPERTS, D_MODEL, D_FF), D_MODEL ** -0.5),
        "moe_w2": nrm((n_moe, N_EXPERTS, D_FF, D_MODEL), D_FF ** -0.5),
        "final_norm_w": gain((D_MODEL,)),
    }


def reference(x, c, ctx, c_ctx, norm1_w, norm2_w, mod_w, mod_b, w_in, w_out,
              gdn_conv_w, gdn_A_log, gdn_dt_bias, gdn_norm_w,
              mla_q_norm_w, mla_w_uq, mla_kv_norm_w, mla_w_ukv,
              hy_conv_w, hy_w1, hy_b1, hy_w2, hy_b2, hy_w3, hy_b3, hy_w4, hy_freq, hy_bias,
              ffn_w1, ffn_w3, ffn_w2, moe_router, moe_w1, moe_w3, moe_w2, final_norm_w):
    B, L, _ = x.shape
    Lc = ctx.shape[1]
    ROWS = L // GRID_W
    rows = jnp.repeat(jnp.arange(ROWS, dtype=jnp.int32), GRID_W)
    cols = jnp.tile(jnp.arange(GRID_W, dtype=jnp.int32), ROWS)
    pos = jnp.arange(L, dtype=jnp.int32)
    xc = ctx
    for l in range(DEPTH):
        want_ctx = l < DEPTH - 1
        mod_lat = (jax.nn.silu(c) @ mod_w[l] + mod_b[l])[:, None, :]
        mod_ctx = (jax.nn.silu(c_ctx) @ mod_w[l] + mod_b[l])[None, None, :]
        sh1, sc1, g1, sh2, sc2, g2 = jnp.split(mod_lat, N_MOD, axis=-1)
        csh1, csc1, cg1, csh2, csc2, cg2 = jnp.split(mod_ctx, N_MOD, axis=-1)

        h_l = rms_norm(x, norm1_w[l]) * (1 + sc1) + sh1
        h_c = rms_norm(xc, norm1_w[l]) * (1 + csc1) + csh1
        o_c, o_l = token_mixers(h_c, h_l, w_in[l], gdn_conv_w[l], gdn_A_log[l], gdn_dt_bias[l], gdn_norm_w[l],
                                mla_q_norm_w[l], mla_w_uq[l], mla_kv_norm_w[l], mla_w_ukv[l],
                                hy_conv_w[l], hy_w1[l], hy_b1[l], hy_w2[l], hy_b2[l], hy_w3[l], hy_b3[l],
                                hy_w4[l], hy_freq[l], hy_bias[l], rows, cols, pos, want_ctx)
        x = x + g1 * (o_l @ w_out[l])
        h_l = rms_norm(x, norm2_w[l]) * (1 + sc2) + sh2
        if want_ctx:
            xc = xc + cg1 * (o_c @ w_out[l])
            h_c = rms_norm(xc, norm2_w[l]) * (1 + csc2) + csh2
            h_all = jnp.concatenate([h_c, h_l], axis=1)
        else:
            h_all = h_l
        if l % 2 == 0:
            f = swiglu(h_all, ffn_w1[l // 2], ffn_w3[l // 2], ffn_w2[l // 2])
        else:
            f = moe_swiglu(h_all, moe_router[l // 2], moe_w1[l // 2], moe_w3[l // 2], moe_w2[l // 2])
        x = x + g2 * f[:, f.shape[1] - L:]
        if want_ctx:
            xc = xc + cg2 * f[:, :Lc]
    return rms_norm(x, final_norm_w)
```

```cpp
#include <hip/hip_runtime.h>
#include <stdint.h>
#include <math.h>
#include <stdio.h>

#define LAS __attribute__((address_space(3)))
typedef unsigned short bf16_t;
typedef short bf16x8 __attribute__((ext_vector_type(8)));
typedef short s16x4 __attribute__((ext_vector_type(4)));
typedef float f32x4 __attribute__((ext_vector_type(4)));
typedef float f32x2 __attribute__((ext_vector_type(2)));
typedef float f32x16 __attribute__((ext_vector_type(16)));
typedef unsigned u32x4 __attribute__((ext_vector_type(4)));
typedef unsigned u32x2 __attribute__((ext_vector_type(2)));

constexpr int D_ = 2048, SEQ = 16384, LC = 256, MT = 16640, NP = 6400, DFF = 5632, NEXP = 8, DIN = 6288;
constexpr int PC_GQKV = 0, PC_GZ = 1536, PC_HY = 2048, PC_RQKV = 3584, PC_RG = 5120, PC_CQ = 5632, PC_CKV = 6144, PC_KR = 6272, PC_A = 6336, PC_B = 6344;
constexpr int MLAK = 640, MLAN = 1792;
constexpr float EPS = 1e-6f;
constexpr int MAXROWS_MOE = 2 * SEQ + NEXP * 256;
enum { I_X, I_C, I_CTX, I_CCTX, I_N1W, I_N2W, I_MODW, I_MODB, I_WIN, I_WOUT, I_GCONV, I_GALOG, I_GDT, I_GNW, I_MQN, I_MUQ, I_MKVN, I_MUKV,
       I_HCONV, I_HW1, I_HB1, I_HW2, I_HB2, I_HW3, I_HB3, I_HW4, I_HFREQ, I_HBIAS, I_FW1, I_FW3, I_FW2, I_ROUTER, I_MW1, I_MW3, I_MW2, I_FNW, N_IN };

struct Params {
    const float* in[N_IN];
    float* out;
    unsigned* bar; unsigned* cnt;
    float* modv;
    bf16_t *wb_in, *wb_out, *wb_mla, *wb_f13, *wb_f2, *wb_m13, *wb_m2;
    float *hfilt, *hsum, *hfc, *hsc;
    float* xcur; bf16_t* hbuf;
    bf16_t* Pp; bf16_t* gqkv; float* ggb; bf16_t* rqk; float* mrs; bf16_t* krr; bf16_t* qkvup;
    float *go, *ro; float* hys; bf16_t* ocat; bf16_t* act;
    bf16_t* hg; bf16_t* yb; int* tok_r; float* tok_w; int* tok_e; int* tok_p;
};

__device__ __forceinline__ unsigned cvt_pk_bf16(float lo, float hi) { unsigned r; asm volatile("v_cvt_pk_bf16_f32 %0, %1, %2" : "=v"(r) : "v"(lo), "v"(hi)); return r; }
__device__ __forceinline__ bf16_t f2bf(float x) { return (bf16_t)(cvt_pk_bf16(x, 0.f) & 0xffffu); }
__device__ __forceinline__ float bf2f(bf16_t b) { return __uint_as_float(((unsigned)b) << 16); }
__device__ __forceinline__ float bflo(unsigned w) { return __uint_as_float(w << 16); }
__device__ __forceinline__ float bfhi(unsigned w) { return __uint_as_float(w & 0xffff0000u); }
__device__ __forceinline__ float silu_f(float x) { return x / (1.f + __expf(-x)); }
__device__ __forceinline__ float sigmoid_f(float x) { return 1.f / (1.f + __expf(-x)); }
__device__ __forceinline__ float softplus_f(float x) { return fmaxf(x, 0.f) + log1pf(__expf(-fabsf(x))); }
__device__ __forceinline__ float wave_sum(float v) {
#pragma unroll
    for (int o = 32; o >= 1; o >>= 1) v += __shfl_xor(v, o);
    return v;
}
__device__ __forceinline__ float sum16(float v) {
#pragma unroll
    for (int o = 8; o >= 1; o >>= 1) v += __shfl_xor(v, o);
    return v;
}
__device__ __forceinline__ void unpack8(u32x4 w, float (&f)[8]) {
    f[0] = bflo(w.x); f[1] = bfhi(w.x); f[2] = bflo(w.y); f[3] = bfhi(w.y); f[4] = bflo(w.z); f[5] = bfhi(w.z); f[6] = bflo(w.w); f[7] = bfhi(w.w);
}
__device__ __forceinline__ u32x4 pack8(const float (&f)[8]) {
    u32x4 w; w.x = cvt_pk_bf16(f[0], f[1]); w.y = cvt_pk_bf16(f[2], f[3]); w.z = cvt_pk_bf16(f[4], f[5]); w.w = cvt_pk_bf16(f[6], f[7]); return w;
}

namespace pg8 {
constexpr int BM = 256, BK = 64, HALF = 128, HTB = HALF * BK * 2, STAGE_BYTES = 8 * HTB, NXCD = 8, WGM = 8;
__host__ __device__ __forceinline__ int lds_byte(int r, int c) { const int st = (r >> 4) * 2 + (c >> 5), rr = r & 15, cc = c & 31, ob = rr * 64 + cc * 2; return st * 1024 + (ob ^ (((ob >> 9) & 1) << 5)); }
__host__ __device__ __forceinline__ void stage_rc(int b, int& R, int& C) { const int st = b / 1024, sb = b % 1024, swz = sb ^ (((sb >> 9) & 1) << 5); R = (st >> 1) * 16 + swz / 64; C = (st & 1) * 32 + (swz % 64) / 2; }
__host__ __device__ __forceinline__ int perm32(int rho) { const int n = rho >> 4, i = rho & 15; return 8 * (i >> 2) + 4 * n + (i & 3); }
struct Unit { int pm, pn, e; };
struct Gemm { const bf16_t* A; const bf16_t* Bt; int K, lda, ldb; size_t estride; };

struct StaticOrder {
    int nM, nN, nwg, G, c;
    __device__ void init(int M, int N, int G_, int c_) { nM = M / BM; nN = N / BM; nwg = nM * nN; G = G_; c = c_; }
    __device__ bool next(int i, Unit& u) const {
        const long L = (long)i * G + c; if (L >= nwg) return false;
        int wgid = (int)L; { const int q = nwg / NXCD, r = nwg % NXCD, xcd = wgid % NXCD, off = wgid / NXCD; wgid = (xcd < r ? xcd * (q + 1) : r * (q + 1) + (xcd - r) * q) + off; }
        const int nig = WGM * nN, gid = wgid / nig, fm = gid * WGM, gsz = (nM - fm) < WGM ? (nM - fm) : WGM;
        u.pm = fm + ((wgid % nig) % gsz); u.pn = (wgid % nig) / gsz; u.e = 0; return true;
    }
    __device__ __forceinline__ void a_ready(const Unit&) const {}
    __device__ __forceinline__ void done(const Unit&) const {}
};
struct GroupedOrder {
    int pb[NEXP + 1]; int nN, nwg, G, c;
    __device__ void init(const unsigned* cnt, int N, int G_, int c_) {
        int acc = 0;
#pragma unroll
        for (int e = 0; e < NEXP; ++e) { pb[e] = acc; acc += ((int)cnt[e] + 255) >> 8; }
        pb[NEXP] = acc; nN = N / BM; nwg = acc * nN; G = G_; c = c_;
    }
    __device__ bool next(int i, Unit& u) const {
        const long L = (long)i * G + c; if (L >= nwg) return false;
        const int np = pb[NEXP]; u.pn = (int)(L / np); u.pm = (int)(L % np);
        int e = 0;
#pragma unroll
        for (int k = 1; k < NEXP; ++k) e += (u.pm >= pb[k]) ? 1 : 0;
        u.e = e; return true;
    }
    __device__ __forceinline__ void a_ready(const Unit&) const {}
    __device__ __forceinline__ void done(const Unit&) const {}
};

template <class Epi, class Sched>
__device__ __forceinline__ void gemm_phase(LAS unsigned char* lds, const Gemm g, const Sched& S, const Epi& E) {
    const int tid = threadIdx.x, wid = __builtin_amdgcn_readfirstlane(tid >> 6), lane = tid & 63, wr = wid >> 2, wc = wid & 3, fr = lane & 15, fq = lane >> 4;
    const int K = g.K, nt = K / BK;
    unsigned voffA[2], voffB[2];
#pragma unroll
    for (int i = 0; i < 2; ++i) { int R, C; stage_rc(tid * 16 + i * 8192, R, C); const int Rb = Epi::PERM ? ((R & ~31) + perm32(R & 31)) : R;
        voffA[i] = (unsigned)(R * g.lda + C) * 2u; voffB[i] = (unsigned)(Rb * g.ldb + C) * 2u; }
    const size_t kstep = (size_t)(BK * 2);
    const size_t hstepA = (size_t)HALF * g.lda * 2, hstepB = (size_t)HALF * g.ldb * 2;
    const size_t tstepA = 2 * hstepA, tstepB = 2 * hstepB;
    const unsigned ldsw = (unsigned)wid * 1024u;
    const int aoff = lds_byte(wr * 64 + fr, fq * 8), boff = lds_byte(wc * 32 + fr, fq * 8);
#define PG8_SA(b, h) (((b) * 2 + (h)) * HTB)
#define PG8_SB(b, h) ((4 + (b) * 2 + (h)) * HTB)
#define PG8_STAGE(bufoff, gbase, voff) do { _Pragma("unroll") for (int _i = 0; _i < 2; ++_i) \
        __builtin_amdgcn_global_load_lds((const unsigned*)((const char*)(gbase) + (voff)[_i]), (LAS unsigned*)(lds + (bufoff) + ldsw + _i * 8192), 16, 0, 0); } while (0)
#define PG8_LDA(dst, b, h) do { _Pragma("unroll") for (int m = 0; m < 4; ++m) _Pragma("unroll") for (int k = 0; k < 2; ++k) dst[m][k] = *(const LAS bf16x8*)(lds + PG8_SA(b, h) + aoff + m * 2048 + k * 1024); } while (0)
#define PG8_LDB(dst, b, h) do { _Pragma("unroll") for (int n = 0; n < 2; ++n) _Pragma("unroll") for (int k = 0; k < 2; ++k) dst[n][k] = *(const LAS bf16x8*)(lds + PG8_SB(b, h) + boff + n * 2048 + k * 1024); } while (0)
#define PG8_MMA(ai, bj, At, Bt) do { __builtin_amdgcn_s_setprio(1); _Pragma("unroll") for (int m = 0; m < 4; ++m) _Pragma("unroll") for (int n = 0; n < 2; ++n) _Pragma("unroll") for (int k = 0; k < 2; ++k) \
        acc[ai][bj][m][n] = __builtin_amdgcn_mfma_f32_16x16x32_bf16(Bt[n][k], At[m][k], acc[ai][bj][m][n], 0, 0, 0); __builtin_amdgcn_s_setprio(0); } while (0)
#define PG8_WAIT_V(n) asm volatile("s_waitcnt vmcnt(" #n ")" ::: "memory")
#define PG8_WAIT_L(n) asm volatile("s_waitcnt lgkmcnt(" #n ")" ::: "memory")
#define PG8_BAR __builtin_amdgcn_s_barrier()
#define PG8_SCHED __builtin_amdgcn_sched_barrier(0)
    Unit cur, nxt; int ui = 0;
    if (!S.next(0, cur)) return;
    f32x4 acc[2][2][4][2];
#pragma unroll
    for (int a = 0; a < 2; ++a)
#pragma unroll
        for (int b = 0; b < 2; ++b)
#pragma unroll
            for (int m = 0; m < 4; ++m)
#pragma unroll
                for (int n = 0; n < 2; ++n) acc[a][b][m][n] = (f32x4){0.f, 0.f, 0.f, 0.f};
    bf16x8 At[4][2], B0[2][2], B1[2][2];
    const char* cA = (const char*)g.A + (size_t)cur.pm * tstepA; const char* cB = (const char*)g.Bt + (size_t)cur.pn * tstepB + (size_t)cur.e * g.estride * 2;
    S.a_ready(cur);
    PG8_STAGE(PG8_SB(0, 0), cB, voffB); PG8_STAGE(PG8_SA(0, 0), cA, voffA); PG8_STAGE(PG8_SB(0, 1), cB + hstepB, voffB); PG8_STAGE(PG8_SA(0, 1), cA + hstepA, voffA);
    if (wr == 1) PG8_BAR;
    PG8_WAIT_V(4); PG8_BAR;
    PG8_STAGE(PG8_SB(1, 0), cB + kstep, voffB); PG8_STAGE(PG8_SA(1, 0), cA + kstep, voffA); PG8_STAGE(PG8_SB(1, 1), cB + hstepB + kstep, voffB);
    PG8_WAIT_V(6); PG8_BAR;
    for (;;) {
        const bool has_next = S.next(ui + 1, nxt);
        const char* nA = has_next ? (const char*)g.A + (size_t)nxt.pm * tstepA : cA;
        const char* nB = has_next ? (const char*)g.Bt + (size_t)nxt.pn * tstepB + (size_t)nxt.e * g.estride * 2 : cB;
        for (int t = 0; t < nt; t += 2) {
            const bool last = (t == nt - 2);
            const char* a1 = cA + (size_t)(t + 1) * kstep;
            const char* a2 = last ? nA : cA + (size_t)(t + 2) * kstep; const char* b2 = last ? nB : cB + (size_t)(t + 2) * kstep;
            const char* a3 = a2 + kstep; const char* b3 = b2 + kstep;
            if (last && has_next) S.a_ready(nxt);
            PG8_LDB(B0, 0, 0); PG8_SCHED; PG8_LDA(At, 0, 0); PG8_STAGE(PG8_SA(1, 1), a1 + hstepA, voffA);
            PG8_WAIT_L(8); PG8_BAR; PG8_WAIT_L(0); PG8_MMA(0, 0, At, B0); PG8_BAR; PG8_SCHED;
            PG8_LDB(B1, 0, 1); PG8_STAGE(PG8_SB(0, 0), b2, voffB);
            PG8_BAR; PG8_WAIT_L(0); PG8_MMA(0, 1, At, B1); PG8_BAR;
            PG8_LDA(At, 0, 1); PG8_STAGE(PG8_SA(0, 0), a2, voffA);
            PG8_BAR; PG8_WAIT_L(0); PG8_MMA(1, 0, At, B0); PG8_BAR; PG8_SCHED;
            PG8_STAGE(PG8_SB(0, 1), b2 + hstepB, voffB);
            PG8_WAIT_V(6); PG8_BAR; PG8_MMA(1, 1, At, B1); PG8_BAR;
            PG8_LDB(B0, 1, 0); PG8_SCHED; PG8_LDA(At, 1, 0); PG8_STAGE(PG8_SA(0, 1), a2 + hstepA, voffA);
            PG8_WAIT_L(8); PG8_BAR; PG8_WAIT_L(0); PG8_MMA(0, 0, At, B0); PG8_BAR; PG8_SCHED;
            PG8_LDB(B1, 1, 1); PG8_STAGE(PG8_SB(1, 0), b3, voffB);
            PG8_BAR; PG8_WAIT_L(0); PG8_MMA(0, 1, At, B1); PG8_BAR;
            PG8_LDA(At, 1, 1); PG8_STAGE(PG8_SA(1, 0), a3, voffA);
            PG8_BAR; PG8_WAIT_L(0); PG8_MMA(1, 0, At, B0); PG8_BAR; PG8_SCHED;
            PG8_STAGE(PG8_SB(1, 1), b3 + hstepB, voffB);
            PG8_WAIT_V(6); PG8_BAR; PG8_MMA(1, 1, At, B1); PG8_BAR;
        }
        E(acc, cur, wr, wc, fr, fq); S.done(cur);
        if (!has_next) break;
#pragma unroll
        for (int a = 0; a < 2; ++a)
#pragma unroll
            for (int b = 0; b < 2; ++b)
#pragma unroll
                for (int m = 0; m < 4; ++m)
#pragma unroll
                    for (int n = 0; n < 2; ++n) acc[a][b][m][n] = (f32x4){0.f, 0.f, 0.f, 0.f};
        cur = nxt; cA = nA; cB = nB; ++ui;
    }
    PG8_WAIT_V(0);
    if (wr == 0) PG8_BAR;
    PG8_BAR;
#undef PG8_SA
#undef PG8_SB
#undef PG8_STAGE
#undef PG8_LDA
#undef PG8_LDB
#undef PG8_MMA
#undef PG8_WAIT_V
#undef PG8_WAIT_L
#undef PG8_BAR
#undef PG8_SCHED
}

struct EpiStoreBf16 {
    static constexpr bool PERM = true;
    bf16_t* O; int ldc; const float* rs; int rs_split;
    __device__ __forceinline__ void operator()(const f32x4 (&acc)[2][2][4][2], const Unit& u, int wr, int wc, int fr, int fq) const {
        const int row0 = u.pm * BM + wr * 64 + fr, col0 = u.pn * BM + wc * 32 + 8 * fq;
        const int sel = (u.pn >= rs_split) ? 1 : 0;
#pragma unroll
        for (int ai = 0; ai < 2; ++ai)
#pragma unroll
            for (int m = 0; m < 4; ++m) { const int row = row0 + ai * HALF + m * 16; bf16_t* rowp = O + (size_t)row * ldc + col0;
                const float sc = rs ? rs[row * 2 + sel] : 1.f;
#pragma unroll
                for (int bj = 0; bj < 2; ++bj) { const f32x4 v0 = acc[ai][bj][m][0] * sc, v1 = acc[ai][bj][m][1] * sc;
                    u32x4 w; w.x = cvt_pk_bf16(v0[0], v0[1]); w.y = cvt_pk_bf16(v0[2], v0[3]); w.z = cvt_pk_bf16(v1[0], v1[1]); w.w = cvt_pk_bf16(v1[2], v1[3]);
                    *(u32x4*)(rowp + bj * HALF) = w; } }
    }
};
struct EpiResGate {
    static constexpr bool PERM = false;
    float* out; const float* res_ctx; const float* res_lat; const float* gate_ctx; const float* gate_lat; int rowbase;
    __device__ __forceinline__ void operator()(const f32x4 (&acc)[2][2][4][2], const Unit& u, int wr, int wc, int fr, int fq) const {
        const int row0 = rowbase + u.pm * BM + wr * 64 + fr, col0 = u.pn * BM + wc * 32 + 4 * fq;
#pragma unroll
        for (int ai = 0; ai < 2; ++ai)
#pragma unroll
            for (int m = 0; m < 4; ++m) { const int row = row0 + ai * HALF + m * 16; const bool isc = row < LC;
                const float* rp = isc ? res_ctx + (size_t)row * D_ : res_lat + (size_t)(row - LC) * D_; const float* gp = isc ? gate_ctx : gate_lat;
                float* op = out + (size_t)row * D_;
#pragma unroll
                for (int bj = 0; bj < 2; ++bj)
#pragma unroll
                    for (int n = 0; n < 2; ++n) { const int c = col0 + bj * HALF + n * 16; const f32x4 r4 = *(const f32x4*)(rp + c), g4 = *(const f32x4*)(gp + c);
                        *(f32x4*)(op + c) = r4 + g4 * acc[ai][bj][m][n]; } }
    }
};
struct EpiSwiGLU {
    static constexpr bool PERM = true;
    bf16_t* O; int ldc;
    __device__ __forceinline__ void operator()(const f32x4 (&acc)[2][2][4][2], const Unit& u, int wr, int wc, int fr, int fq) const {
        const int row0 = u.pm * BM + wr * 64 + fr, col0 = u.pn * HALF + wc * 32 + 8 * fq;
#pragma unroll
        for (int ai = 0; ai < 2; ++ai)
#pragma unroll
            for (int m = 0; m < 4; ++m) { bf16_t* rowp = O + (size_t)(row0 + ai * HALF + m * 16) * ldc + col0;
                float o[8];
#pragma unroll
                for (int n = 0; n < 2; ++n)
#pragma unroll
                    for (int j = 0; j < 4; ++j) { const float gte = acc[ai][0][m][n][j], up = acc[ai][1][m][n][j]; o[n * 4 + j] = silu_f(gte) * up; }
                *(u32x4*)rowp = pack8(o); }
    }
};
}
#ifndef FFT_DEV_H
#define FFT_DEV_H
#ifndef FFT_HOST
#define FFT_FN __device__ __forceinline__
struct cpx { float x, y; };
FFT_FN void tw(float frac, float& c, float& s) { c = __builtin_amdgcn_cosf(frac); s = __builtin_amdgcn_sinf(frac); }
#else
#include <cmath>
#define FFT_FN static inline
struct cpx { float x, y; };
FFT_FN void tw(float frac, float& c, float& s) { c = (float)cos(6.283185307179586 * (double)frac); s = (float)sin(6.283185307179586 * (double)frac); }
#endif
#define ZP(i) ((i) + (((i) >> 6) << 2))
constexpr int FFT_N = 16384;
constexpr int FFT_ZN = FFT_N + 4 * (FFT_N / 64);

FFT_FN void bf_dif(cpx& a, cpx& b, float c, float s) {
    const float dx = a.x - b.x, dy = a.y - b.y;
    a.x += b.x; a.y += b.y;
    b.x = dx * c + dy * s; b.y = dy * c - dx * s;
}
FFT_FN void bf_dit(cpx& a, cpx& b, float c, float s) {
    const float tx = b.x * c - b.y * s, ty = b.x * s + b.y * c;
    b.x = a.x - tx; b.y = a.y - ty; a.x += tx; a.y += ty;
}
template <int K16> FFT_FN void rot16(float c0, float s0, float& c, float& s) {
    constexpr float CR[16] = {1.f, 0.9238795325112867f, 0.7071067811865476f, 0.3826834323650898f, 0.f, -0.3826834323650898f, -0.7071067811865476f, -0.9238795325112867f,
                              -1.f, -0.9238795325112867f, -0.7071067811865476f, -0.3826834323650898f, 0.f, 0.3826834323650898f, 0.7071067811865476f, 0.9238795325112867f};
    constexpr float SR[16] = {0.f, 0.3826834323650898f, 0.7071067811865476f, 0.9238795325112867f, 1.f, 0.9238795325112867f, 0.7071067811865476f, 0.3826834323650898f,
                              0.f, -0.3826834323650898f, -0.7071067811865476f, -0.9238795325112867f, -1.f, -0.9238795325112867f, -0.7071067811865476f, -0.3826834323650898f};
    constexpr float cr = CR[K16 & 15], sr = SR[K16 & 15];
    c = c0 * cr - s0 * sr; s = s0 * cr + c0 * sr;
}
#define FFT_BF(DIFDIT, ra, rb, K16, cb, sb) do { float _c, _s; rot16<K16>(cb, sb, _c, _s); DIFDIT(v[ra], v[rb], _c, _s); } while (0)
template <bool INV> FFT_FN void fft_pass16(cpx* Z, int g, int lm) {
    const int mp = 1 << lm, ilo = g & (mp - 1), ihi = g >> lm, base = (ihi << (lm + 4)) + ilo;
    cpx v[16];
#pragma unroll
    for (int r = 0; r < 16; ++r) v[r] = Z[ZP(base + r * mp)];
    const float th = (float)ilo / (float)(16 * mp);
    float cA, sA, cB, sB, cC, sC, cD, sD;
    tw(th, cA, sA); tw(2.f * th, cB, sB); tw(4.f * th, cC, sC); tw(8.f * th, cD, sD);
    if (!INV) {
        FFT_BF(bf_dif, 0, 8, 0, cA, sA); FFT_BF(bf_dif, 1, 9, 1, cA, sA); FFT_BF(bf_dif, 2, 10, 2, cA, sA); FFT_BF(bf_dif, 3, 11, 3, cA, sA);
        FFT_BF(bf_dif, 4, 12, 4, cA, sA); FFT_BF(bf_dif, 5, 13, 5, cA, sA); FFT_BF(bf_dif, 6, 14, 6, cA, sA); FFT_BF(bf_dif, 7, 15, 7, cA, sA);
        FFT_BF(bf_dif, 0, 4, 0, cB, sB); FFT_BF(bf_dif, 1, 5, 2, cB, sB); FFT_BF(bf_dif, 2, 6, 4, cB, sB); FFT_BF(bf_dif, 3, 7, 6, cB, sB);
        FFT_BF(bf_dif, 8, 12, 0, cB, sB); FFT_BF(bf_dif, 9, 13, 2, cB, sB); FFT_BF(bf_dif, 10, 14, 4, cB, sB); FFT_BF(bf_dif, 11, 15, 6, cB, sB);
        FFT_BF(bf_dif, 0, 2, 0, cC, sC); FFT_BF(bf_dif, 1, 3, 4, cC, sC); FFT_BF(bf_dif, 4, 6, 0, cC, sC); FFT_BF(bf_dif, 5, 7, 4, cC, sC);
        FFT_BF(bf_dif, 8, 10, 0, cC, sC); FFT_BF(bf_dif, 9, 11, 4, cC, sC); FFT_BF(bf_dif, 12, 14, 0, cC, sC); FFT_BF(bf_dif, 13, 15, 4, cC, sC);
#pragma unroll
        for (int r = 0; r < 16; r += 2) bf_dif(v[r], v[r + 1], cD, sD);
    } else {
#pragma unroll
        for (int r = 0; r < 16; r += 2) bf_dit(v[r], v[r + 1], cD, sD);
        FFT_BF(bf_dit, 0, 2, 0, cC, sC); FFT_BF(bf_dit, 1, 3, 4, cC, sC); FFT_BF(bf_dit, 4, 6, 0, cC, sC); FFT_BF(bf_dit, 5, 7, 4, cC, sC);
        FFT_BF(bf_dit, 8, 10, 0, cC, sC); FFT_BF(bf_dit, 9, 11, 4, cC, sC); FFT_BF(bf_dit, 12, 14, 0, cC, sC); FFT_BF(bf_dit, 13, 15, 4, cC, sC);
        FFT_BF(bf_dit, 0, 4, 0, cB, sB); FFT_BF(bf_dit, 1, 5, 2, cB, sB); FFT_BF(bf_dit, 2, 6, 4, cB, sB); FFT_BF(bf_dit, 3, 7, 6, cB, sB);
        FFT_BF(bf_dit, 8, 12, 0, cB, sB); FFT_BF(bf_dit, 9, 13, 2, cB, sB); FFT_BF(bf_dit, 10, 14, 4, cB, sB); FFT_BF(bf_dit, 11, 15, 6, cB, sB);
        FFT_BF(bf_dit, 0, 8, 0, cA, sA); FFT_BF(bf_dit, 1, 9, 1, cA, sA); FFT_BF(bf_dit, 2, 10, 2, cA, sA); FFT_BF(bf_dit, 3, 11, 3, cA, sA);
        FFT_BF(bf_dit, 4, 12, 4, cA, sA); FFT_BF(bf_dit, 5, 13, 5, cA, sA); FFT_BF(bf_dit, 6, 14, 6, cA, sA); FFT_BF(bf_dit, 7, 15, 7, cA, sA);
    }
#pragma unroll
    for (int r = 0; r < 16; ++r) Z[ZP(base + r * mp)] = v[r];
}
template <bool INV> FFT_FN void fft_pass4(cpx* Z, int g) {
    const int base = 4 * g;
    cpx a = Z[ZP(base)], b = Z[ZP(base + 1)], c = Z[ZP(base + 2)], d = Z[ZP(base + 3)];
    if (!INV) {
        cpx a2 = {a.x + c.x, a.y + c.y}, c2 = {a.x - c.x, a.y - c.y};
        cpx b2 = {b.x + d.x, b.y + d.y}, t = {b.x - d.x, b.y - d.y}; cpx d2 = {t.y, -t.x};
        a = {a2.x + b2.x, a2.y + b2.y}; b = {a2.x - b2.x, a2.y - b2.y};
        c = {c2.x + d2.x, c2.y + d2.y}; d = {c2.x - d2.x, c2.y - d2.y};
    } else {
        cpx a2 = {a.x + b.x, a.y + b.y}, b2 = {a.x - b.x, a.y - b.y};
        cpx c2 = {c.x + d.x, c.y + d.y}, d2 = {c.x - d.x, c.y - d.y};
        a = {a2.x + c2.x, a2.y + c2.y}; c = {a2.x - c2.x, a2.y - c2.y};
        cpx t = {-d2.y, d2.x};
        b = {b2.x + t.x, b2.y + t.y}; d = {b2.x - t.x, b2.y - t.y};
    }
    Z[ZP(base)] = a; Z[ZP(base + 1)] = b; Z[ZP(base + 2)] = c; Z[ZP(base + 3)] = d;
}
FFT_FN int rev14(int p) {
#ifndef FFT_HOST
    return (int)(__builtin_bitreverse32((unsigned)p) >> 18);
#else
    int r = 0; for (int b = 0; b < 14; ++b) r |= ((p >> b) & 1) << (13 - b); return r;
#endif
}
FFT_FN int ilog2(int q) {
#ifndef FFT_HOST
    return 31 - __builtin_clz((unsigned)q);
#else
    int b = 0; while ((1 << (b + 1)) <= q) ++b; return b;
#endif
}
FFT_FN void fft_pointwise(cpx* Z, const cpx* Zh, int q) {
    if (q == 0) {
#pragma unroll
        for (int p0 = 0; p0 < 2; ++p0) {
            const cpx a = Z[ZP(p0)], h = Zh[p0];
            const float ue = a.x, uo = a.y, he = h.x, ho = h.y, sg = p0 ? -1.f : 1.f;
            cpx o = {ue * he + sg * uo * ho, ue * ho + uo * he};
            Z[ZP(p0)] = o;
        }
        return;
    }
    const int b = ilog2(q), pp = (2 << b) + (q - (1 << b)), pq = 3 * (2 << b) - 1 - pp;
    const int kk = rev14(pp);
    float wc, ws; tw((float)kk * (1.0f / (float)FFT_N), wc, ws);
    const cpx A = Z[ZP(pp)], B = Z[ZP(pq)], HA = Zh[pp], HB = Zh[pq];
    const cpx Ue = {0.5f * (A.x + B.x), 0.5f * (A.y - B.y)};
    const cpx dU = {A.x - B.x, A.y + B.y};
    const cpx Uo = {0.5f * dU.y, -0.5f * dU.x};
    const cpx He = {0.5f * (HA.x + HB.x), 0.5f * (HA.y - HB.y)};
    const cpx dH = {HA.x - HB.x, HA.y + HB.y};
    const cpx Ho = {0.5f * dH.y, -0.5f * dH.x};
    const cpx UoHo = {Uo.x * Ho.x - Uo.y * Ho.y, Uo.x * Ho.y + Uo.y * Ho.x};
    const cpx wUH = {wc * UoHo.x + ws * UoHo.y, wc * UoHo.y - ws * UoHo.x};
    const cpx Ye = {Ue.x * He.x - Ue.y * He.y + wUH.x, Ue.x * He.y + Ue.y * He.x + wUH.y};
    const cpx Yo = {Ue.x * Ho.x - Ue.y * Ho.y + Uo.x * He.x - Uo.y * He.y, Ue.x * Ho.y + Ue.y * Ho.x + Uo.x * He.y + Uo.y * He.x};
    cpx o1 = {Ye.x - Yo.y, Ye.y + Yo.x};
    cpx o2 = {Ye.x + Yo.y, -Ye.y + Yo.x};
    Z[ZP(pp)] = o1; Z[ZP(pq)] = o2;
}
#endif
template <class F> __device__ __forceinline__ void tconv_tile(const F& f, bf16_t* dst, int K, int k0, int n0, float* tile  ) {
    const int tid = threadIdx.x;
    { const int n = tid & 63, kb = tid >> 6;
#pragma unroll
      for (int i = 0; i < 8; ++i) { const int k = kb + 8 * i; tile[k * 65 + n] = f(k0 + k, n0 + n); } }
    __syncthreads();
    { const int nn = tid >> 3, kq = (tid & 7) * 8; float v[8];
#pragma unroll
      for (int e = 0; e < 8; ++e) v[e] = tile[(kq + e) * 65 + nn];
      *(u32x4*)(dst + (size_t)(n0 + nn) * K + k0 + kq) = pack8(v); }
    __syncthreads();
}
__device__ __forceinline__ int in_src_col(int n) {
    if (n < 2048) return n;
    if (n < 3584) return 2704 + (n - 2048);
    if (n < 5120) return 4240 + (n - 3584);
    if (n < 5632) return 5776 + (n - 5120);
    if (n < 6080) return 2064 + (n - 5632);
    if (n < 6144) return -1;
    if (n < 6272) return 2512 + (n - 6144);
    if (n < 6336) return 2640 + (n - 6272);
    if (n < 6344) return 2048 + (n - 6336);
    if (n < 6352) return 2056 + (n - 6344);
    return -1;
}
struct FWin { const float* src; __device__ __forceinline__ float operator()(int k, int n) const { const int c = in_src_col(n); return c < 0 ? 0.f : src[(size_t)k * DIN + c]; } };
struct FPlain { const float* src; int ld; __device__ __forceinline__ float operator()(int k, int n) const { return src[(size_t)k * ld + n]; } };
struct FMla { const float *uq, *ukv, *qn, *kvn;
    __device__ __forceinline__ float operator()(int k, int n) const {
        if (n < 768) return k < 448 ? uq[(size_t)k * 768 + n] * qn[k] : 0.f;
        return k >= 512 ? ukv[(size_t)(k - 512) * 1024 + (n - 768)] * kvn[k - 512] : 0.f; } };
struct FW13 { const float *w1, *w3;
    __device__ __forceinline__ float operator()(int k, int n) const { const int col = (n >> 8) * 128 + (n & 127);
        const uintptr_t d = (uintptr_t)w3 - (uintptr_t)w1; const float* b = (const float*)((uintptr_t)w1 + (((n >> 7) & 1) ? d : (uintptr_t)0));
        return b[(size_t)k * DFF + col]; } };

constexpr int T_WIN = (NP / 64) * (D_ / 64), T_WOUT = 32 * 32, T_MLA = (MLAN / 64) * (MLAK / 64), T_F13 = (2 * DFF / 64) * 32, T_F2 = 32 * (DFF / 64);
constexpr int U_MOD = 96, U_HF = 516, U_TR = 2 * T_WIN + 2 * T_WOUT + 2 * T_MLA + T_F13 + T_F2;
constexpr int U_PRO = U_MOD + U_HF + U_TR;

__device__ __forceinline__ void pro_mod_unit(const Params& p, int u, float* lds) {
    const int tid = threadIdx.x, wid = tid >> 6, lane = tid & 63;
    const int l = u / 48, cb = u % 48, col = cb * 256 + lane * 4;
    const float* W = p.in[I_MODW] + (size_t)l * D_ * (6 * D_) + col;
    const float* c = p.in[I_C]; const float* cc = p.in[I_CCTX];
    f32x4 al = {0, 0, 0, 0}, ac = {0, 0, 0, 0};
    const int k0 = wid * 256;
#pragma unroll 4
    for (int k = k0; k < k0 + 256; ++k) {
        const f32x4 w4 = *(const f32x4*)(W + (size_t)k * (6 * D_));
        const float sl = silu_f(c[k]), sc = silu_f(cc[k]);
        al += w4 * sl; ac += w4 * sc;
    }
    f32x4* red = (f32x4*)lds;
    red[(wid * 64 + lane) * 2] = al; red[(wid * 64 + lane) * 2 + 1] = ac;
    __syncthreads();
    if (wid == 0) {
        f32x4 sl = {0, 0, 0, 0}, sc = {0, 0, 0, 0};
#pragma unroll
        for (int w = 0; w < 8; ++w) { sl += red[(w * 64 + lane) * 2]; sc += red[(w * 64 + lane) * 2 + 1]; }
        const f32x4 b4 = *(const f32x4*)(p.in[I_MODB] + (size_t)l * 6 * D_ + col);
        *(f32x4*)(p.modv + ((size_t)l * 2 + 0) * 6 * D_ + col) = sl + b4;
        *(f32x4*)(p.modv + ((size_t)l * 2 + 1) * 6 * D_ + col) = sc + b4;
    }
    __syncthreads();
}

__device__ __forceinline__ void pro_hfilt_unit(const Params& p, int l, int Lf, int tb, float* hout, float* hsumo, float* lds) {
    const int tid = threadIdx.x, wid = tid >> 6, lane = tid & 63;
    float* zb = lds;
    float* H1 = lds + 64 * 36;
    float* H2 = H1 + 64 * 65;
    const int t0 = tb * 64;
    const float* w1 = p.in[I_HW1] + (size_t)l * 33 * 64; const float* b1 = p.in[I_HB1] + l * 64;
    const float* w2 = p.in[I_HW2] + (size_t)l * 64 * 64; const float* b2 = p.in[I_HB2] + l * 64;
    const float* w3 = p.in[I_HW3] + (size_t)l * 64 * 64; const float* b3 = p.in[I_HB3] + l * 64;
    const float* w4 = p.in[I_HW4] + (size_t)l * 64 * 1024; const float* fq = p.in[I_HFREQ] + l * 64;
    {
        const int tp = lane, part = wid; const float pf = (float)(t0 + tp);
        const float c0 = (float)(6.283185307179586 / (double)Lf);
#pragma unroll 1
        for (int e = part; e < 33; e += 8) {
            float v;
            if (e == 0) v = pf / (float)(Lf - 1);
            else { const int b = (e - 1) & 15; const float fr = 1e-4f + (float)b * ((15.0f - 1e-4f) / 15.0f); const float ang = (c0 * pf) * fr; v = (e <= 16) ? cosf(ang) : -sinf(ang); }
            zb[tp * 36 + e] = v;
        }
    }
    __syncthreads();
    {   const int tp = lane, j0 = wid * 8;
#pragma unroll 1
        for (int jj = 0; jj < 8; ++jj) { const int j = j0 + jj; float s = b1[j];
            for (int e = 0; e < 33; ++e) s += zb[tp * 36 + e] * w1[e * 64 + j];
            H1[tp * 65 + j] = sinf(fq[j] * s); }
    }
    __syncthreads();
    {   const int tp = lane, j0 = wid * 8;
#pragma unroll 1
        for (int jj = 0; jj < 8; ++jj) { const int j = j0 + jj; float s = b2[j];
            for (int i = 0; i < 64; ++i) s += H1[tp * 65 + i] * w2[i * 64 + j];
            H2[tp * 65 + j] = sinf(fq[j] * s); }
    }
    __syncthreads();
    {   const int tp = lane, j0 = wid * 8;
#pragma unroll 1
        for (int jj = 0; jj < 8; ++jj) { const int j = j0 + jj; float s = b3[j];
            for (int i = 0; i < 64; ++i) s += H2[tp * 65 + i] * w3[i * 64 + j];
            H1[tp * 65 + j] = sinf(fq[j] * s); }
    }
    __syncthreads();
    const int nblk = Lf / 64;
#pragma unroll 1
    for (int i = 0; i < 2; ++i) {
        const int c = (wid + 8 * i) * 64 + lane;
        float wreg[64];
#pragma unroll
        for (int j = 0; j < 64; ++j) wreg[j] = w4[j * 1024 + c];
        const float a0 = -120.39728043259361f, a1 = 40.546510810816436f;
        const float delta = fabsf(a0 + (float)c * ((a1 - a0) / 1023.0f));
        float asum = 0.f;
#pragma unroll 1
        for (int tp = 0; tp < 64; ++tp) {
            float s = 0.f;
#pragma unroll
            for (int j = 0; j < 64; ++j) s += H1[tp * 65 + j] * wreg[j];
            const float pf = (float)(t0 + tp), dist = fabsf(pf - (float)(Lf / 2)) / (float)Lf;
            const float val = s * expf(-dist * delta);
            hout[(size_t)c * Lf + t0 + tp] = val; asum += fabsf(val);
        }
        hsumo[(size_t)c * nblk + tb] = asum;
    }
    __syncthreads();
}

__device__ __forceinline__ void phase_prologue(const Params& p, float* lds) {
    if (blockIdx.x == 0 && threadIdx.x < 16) p.cnt[threadIdx.x] = 0u;
#pragma unroll 1
    for (int u = blockIdx.x; u < U_PRO; u += gridDim.x) {
        if (u < U_MOD) { pro_mod_unit(p, u, lds); continue; }
        int v = u - U_MOD;
        if (v < U_HF) {
            if (v < 512) { const int l = v >> 8, tb = v & 255; pro_hfilt_unit(p, l, SEQ, tb, p.hfilt + (size_t)l * 1024 * SEQ, p.hsum + (size_t)l * 1024 * 256, lds); }
            else pro_hfilt_unit(p, 0, LC, v - 512, p.hfc, p.hsc, lds);
            continue;
        }
        v -= U_HF;
        if (v < 2 * T_WIN) { const int l = v / T_WIN, t = v % T_WIN, nt = t / 32, kt = t % 32;
            FWin f{p.in[I_WIN] + (size_t)l * D_ * DIN}; tconv_tile(f, p.wb_in + (size_t)l * NP * D_, D_, kt * 64, nt * 64, lds); continue; }
        v -= 2 * T_WIN;
        if (v < 2 * T_WOUT) { const int l = v / T_WOUT, t = v % T_WOUT, nt = t / 32, kt = t % 32;
            FPlain f{p.in[I_WOUT] + (size_t)l * D_ * D_, D_}; tconv_tile(f, p.wb_out + (size_t)l * D_ * D_, D_, kt * 64, nt * 64, lds); continue; }
        v -= 2 * T_WOUT;
        if (v < 2 * T_MLA) { const int l = v / T_MLA, t = v % T_MLA, nt = t / 10, kt = t % 10;
            FMla f{p.in[I_MUQ] + (size_t)l * 448 * 768, p.in[I_MUKV] + (size_t)l * 128 * 1024, p.in[I_MQN] + l * 448, p.in[I_MKVN] + l * 128};
            tconv_tile(f, p.wb_mla + (size_t)l * MLAN * MLAK, MLAK, kt * 64, nt * 64, lds); continue; }
        v -= 2 * T_MLA;
        if (v < T_F13) { const int nt = v / 32, kt = v % 32; FW13 f{p.in[I_FW1], p.in[I_FW3]}; tconv_tile(f, p.wb_f13, D_, kt * 64, nt * 64, lds); continue; }
        v -= T_F13;
        { const int nt = v / 88, kt = v % 88; FPlain f{p.in[I_FW2], D_}; tconv_tile(f, p.wb_f2, DFF, kt * 64, nt * 64, lds); }
    }
}
constexpr int T_M13 = NEXP * T_F13, T_M2 = NEXP * T_F2, U_MOEW = T_M13 + T_M2;
__device__ __forceinline__ void moe_w_unit(const Params& p, int v, float* lds) {
    if (v < T_M13) { const int e = v / T_F13, t = v % T_F13, nt = t / 32, kt = t % 32;
        FW13 f{p.in[I_MW1] + (size_t)e * D_ * DFF, p.in[I_MW3] + (size_t)e * D_ * DFF}; tconv_tile(f, p.wb_m13 + (size_t)e * 2 * DFF * D_, D_, kt * 64, nt * 64, lds); return; }
    v -= T_M13;
    { const int e = v / T_F2, t = v % T_F2, nt = t / 88, kt = t % 88;
      FPlain f{p.in[I_MW2] + (size_t)e * DFF * D_, D_}; tconv_tile(f, p.wb_m2 + (size_t)e * D_ * DFF, DFF, kt * 64, nt * 64, lds); }
}

__device__ __forceinline__ void phase_norm(const Params& p, int layer, int which, int row_lo) {
    const int tid = threadIdx.x, wid = tid >> 6, lane = tid & 63;
    const float* nw = p.in[which == 1 ? I_N1W : I_N2W] + (size_t)layer * D_;
    const int csh = (which == 1 ? 0 : 3) * D_, csc = (which == 1 ? 1 : 4) * D_;
    const bool route = (layer == 1 && which == 2);
    for (int r = row_lo + blockIdx.x * 8 + wid; r < MT; r += gridDim.x * 8) {
        const bool isc = r < LC;
        const float* src = (layer == 0 && which == 1) ? (isc ? p.in[I_CTX] + (size_t)r * D_ : p.in[I_X] + (size_t)(r - LC) * D_) : p.xcur + (size_t)r * D_;
        const float* mv = p.modv + ((size_t)layer * 2 + (isc ? 1 : 0)) * 6 * D_;
        f32x4 xv[8]; float ss = 0.f;
#pragma unroll
        for (int i = 0; i < 8; ++i) { xv[i] = *(const f32x4*)(src + (i * 64 + lane) * 4); ss += xv[i][0] * xv[i][0] + xv[i][1] * xv[i][1] + xv[i][2] * xv[i][2] + xv[i][3] * xv[i][3]; }
        ss = wave_sum(ss);
        const float rstd = rsqrtf(ss * (1.0f / D_) + EPS);
        float lg[NEXP];
#pragma unroll
        for (int e = 0; e < NEXP; ++e) lg[e] = 0.f;
#pragma unroll
        for (int i = 0; i < 8; ++i) { const int col = (i * 64 + lane) * 4;
            const f32x4 w4 = *(const f32x4*)(nw + col), sh = *(const f32x4*)(mv + csh + col), sc = *(const f32x4*)(mv + csc + col);
            const f32x4 hv = (xv[i] * rstd) * w4 * (sc + 1.0f) + sh;
            u32x2 o; o.x = cvt_pk_bf16(hv[0], hv[1]); o.y = cvt_pk_bf16(hv[2], hv[3]);
            *(u32x2*)(p.hbuf + (size_t)r * D_ + col) = o;
            if (route) { const float* rt = p.in[I_ROUTER] + (size_t)col * NEXP;
#pragma unroll
                for (int j = 0; j < 4; ++j) { const f32x4 r0 = *(const f32x4*)(rt + j * NEXP), r1 = *(const f32x4*)(rt + j * NEXP + 4);
                    lg[0] += hv[j] * r0[0]; lg[1] += hv[j] * r0[1]; lg[2] += hv[j] * r0[2]; lg[3] += hv[j] * r0[3];
                    lg[4] += hv[j] * r1[0]; lg[5] += hv[j] * r1[1]; lg[6] += hv[j] * r1[2]; lg[7] += hv[j] * r1[3]; } }
        }
        if (route && !isc) {
#pragma unroll
            for (int e = 0; e < NEXP; ++e) lg[e] = wave_sum(lg[e]);
            if (lane == 0) {
                int e0 = 0; float v0 = lg[0];
#pragma unroll
                for (int e = 1; e < NEXP; ++e) if (lg[e] > v0) { v0 = lg[e]; e0 = e; }
                int e1 = -1; float v1 = -3.0e38f;
#pragma unroll
                for (int e = 0; e < NEXP; ++e) if (e != e0 && lg[e] > v1) { v1 = lg[e]; e1 = e; }
                const float w0 = 1.f / (1.f + expf(v1 - v0)), w1 = 1.f - w0;
                const int t = r - LC;
                const int p0 = (int)atomicAdd(&p.cnt[e0], 1u), p1 = (int)atomicAdd(&p.cnt[e1], 1u);
                p.tok_e[t * 2] = e0; p.tok_e[t * 2 + 1] = e1; p.tok_p[t * 2] = p0; p.tok_p[t * 2 + 1] = p1; p.tok_w[t * 2] = w0; p.tok_w[t * 2 + 1] = w1;
            }
        }
    }
}

__device__ __forceinline__ void phase_prep(const Params& p, int layer) {
    const int tid = threadIdx.x, wid = tid >> 6, lane = tid & 63;
    const float* gcw = p.in[I_GCONV] + (size_t)layer * 3 * 1536;
    const float LN1E4 = 9.210340371976184f;
    for (int r = blockIdx.x * 8 + wid; r < MT; r += gridDim.x * 8) {
        const bool isc = r < LC; const int t = r - LC;
        const bool hasp = isc ? (r > 0) : (r > LC), hasn = isc ? (r < LC - 1) : (r < MT - 1);
        const bf16_t* P0 = p.Pp + (size_t)r * NP;
#pragma unroll
        for (int i = 0; i < 3; ++i) {
            const int ch = i * 512 + lane * 8;
            float x0[8], xm[8], xn[8], y[8];
            unpack8(*(const u32x4*)(P0 + PC_GQKV + ch), x0);
            if (hasp) unpack8(*(const u32x4*)(P0 - NP + PC_GQKV + ch), xm); else { for (int e = 0; e < 8; ++e) xm[e] = 0.f; }
            if (hasn) unpack8(*(const u32x4*)(P0 + NP + PC_GQKV + ch), xn); else { for (int e = 0; e < 8; ++e) xn[e] = 0.f; }
            float ss = 0.f;
#pragma unroll
            for (int e = 0; e < 8; ++e) { const float v = gcw[ch + e] * xm[e] + gcw[1536 + ch + e] * x0[e] + gcw[3072 + ch + e] * xn[e]; y[e] = silu_f(v); ss += y[e] * y[e]; }
            if (i < 2) { ss = sum16(ss); const float rn = rsqrtf(ss + EPS) * (i == 0 ? 0.08838834764831845f : 1.f);
#pragma unroll
                for (int e = 0; e < 8; ++e) y[e] *= rn; }
            *(u32x4*)(p.gqkv + (size_t)r * 1536 + ch) = pack8(y);
        }
        if (lane < 8) {
            const float a = bf2f(P0[PC_A + lane]), b = bf2f(P0[PC_B + lane]);
            const float g = -expf(p.in[I_GALOG][layer * 8 + lane]) * softplus_f(a + p.in[I_GDT][layer * 8 + lane]);
            p.ggb[(size_t)r * 16 + lane] = g; p.ggb[(size_t)r * 16 + 8 + lane] = sigmoid_f(b);
        }
        {   float sq = 0.f, sk = 0.f;
            if (lane < 56) { float f[8]; unpack8(*(const u32x4*)(P0 + PC_CQ + lane * 8), f);
#pragma unroll
                for (int e = 0; e < 8; ++e) sq += f[e] * f[e]; }
            if (lane < 16) { float f[8]; unpack8(*(const u32x4*)(P0 + PC_CKV + lane * 8), f);
#pragma unroll
                for (int e = 0; e < 8; ++e) sk += f[e] * f[e]; }
            sq = wave_sum(sq); sk = wave_sum(sk);
            if (lane == 0) { p.mrs[(size_t)r * 2] = rsqrtf(sq * (1.0f / 448.f) + EPS); p.mrs[(size_t)r * 2 + 1] = rsqrtf(sk * (1.0f / 128.f) + EPS); }
        }
        if (lane < 32) {
            const int i = lane & 15, half = lane >> 4;
            const float x1 = bf2f(P0[PC_KR + half * 32 + i]), x2 = bf2f(P0[PC_KR + half * 32 + i + 16]);
            float o1 = x1, o2 = x2;
            if (!isc) { const float pos = (float)(half ? (t & 63) : (t >> 6)); const float inv = expf(-(float)i * (LN1E4 / 16.f)); float s, c; sincosf(pos * inv, &s, &c);
                o1 = x1 * c - x2 * s; o2 = x2 * c + x1 * s; }
            p.krr[(size_t)r * 64 + half * 32 + i] = f2bf(o1); p.krr[(size_t)r * 64 + half * 32 + i + 16] = f2bf(o2);
        }
        {   float s = 0.f, c = 1.f;
            if (!isc) { const float inv = expf(-(float)lane * (LN1E4 / 64.f)); sincosf((float)t * inv, &s, &c); }
#pragma unroll
            for (int it = 0; it < 8; ++it) { const int which = it >> 2, hd = it & 3; const int o = which * 512 + hd * 128 + lane;
                const float x1 = bf2f(P0[PC_RQKV + o]), x2 = bf2f(P0[PC_RQKV + o + 64]); const float sc = which ? 0.08838834764831845f : 1.f;
                p.rqk[(size_t)r * 1024 + o] = f2bf((x1 * c - x2 * s) * sc); p.rqk[(size_t)r * 1024 + o + 64] = f2bf((x2 * c + x1 * s) * sc); }
        }
    }
}
namespace att {
constexpr int NW = 8, QBLK = 32, KVBLK = 64, DK = 192, DV = 128;
constexpr float SCALE = 0.07216878364870322f;
constexpr float THR = 8.f;
constexpr int LDQ = MLAN, LDKN = MLAN, LDKR = 64, LDV = MLAN, LDO = D_;
constexpr int SHM_V = KVBLK * DV * 2, SHM_K = KVBLK * DK * 2, SHM_ATTN = 2 * SHM_V + 2 * SHM_K + NW * 64 * 4;
#define KSWZ(row, colB) ((row) * 384 + ((colB) ^ ((((row) >> 1) & 7) << 4)))
#define SBAR() __builtin_amdgcn_sched_barrier(0)
__device__ __forceinline__ int crow(int r, int hi) { return (r & 3) + 8 * (r >> 2) + 4 * hi; }
__device__ __forceinline__ void partialSM(f32x16& p0, f32x16& p1, float& m_reg, float& mn, float& alpha) {
    constexpr float C = SCALE * 1.4426950408889634f;
    float pmax = p0[0];
#pragma unroll
    for (int r = 1; r < 16; ++r) pmax = fmaxf(pmax, p0[r]);
#pragma unroll
    for (int r = 0; r < 16; ++r) pmax = fmaxf(pmax, p1[r]);
    { auto rr = __builtin_amdgcn_permlane32_swap(__float_as_uint(pmax), __float_as_uint(pmax), false, false);
      pmax = fmaxf(__uint_as_float(rr[0]), __uint_as_float(rr[1])); }
    if (__builtin_expect(__all(pmax - m_reg <= THR / SCALE), 1)) { mn = m_reg; alpha = 1.f; }
    else { mn = fmaxf(m_reg, pmax); alpha = __builtin_amdgcn_exp2f((m_reg - mn) * C); m_reg = mn; }
    const float mnC = -mn * C;
#pragma unroll
    for (int r = 0; r < 16; ++r) p0[r] = fmaf(p0[r], C, mnC);
#pragma unroll
    for (int r = 0; r < 16; ++r) p1[r] = fmaf(p1[r], C, mnC);
#pragma unroll
    for (int r = 0; r < 16; ++r) p0[r] = __builtin_amdgcn_exp2f(p0[r]);
}
__device__ __forceinline__ void finishSM(f32x16& p0, f32x16& p1, float alpha, float& l_reg, bf16x8& pa0, bf16x8& pa1, bf16x8& pa2, bf16x8& pa3) {
#pragma unroll
    for (int r = 0; r < 16; ++r) p1[r] = __builtin_amdgcn_exp2f(p1[r]);
    float ps = 0;
#pragma unroll
    for (int r = 0; r < 16; ++r) ps += p0[r];
#pragma unroll
    for (int r = 0; r < 16; ++r) ps += p1[r];
    { auto rr = __builtin_amdgcn_permlane32_swap(__float_as_uint(ps), __float_as_uint(ps), false, false);
      ps = __uint_as_float(rr[0]) + __uint_as_float(rr[1]); }
    l_reg = l_reg * alpha + ps;
#define PK4(P, BASE, OUT) do { unsigned a0 = cvt_pk_bf16(P[BASE + 0], P[BASE + 1]), a1 = cvt_pk_bf16(P[BASE + 2], P[BASE + 3]);   \
    unsigned b0 = cvt_pk_bf16(P[BASE + 4], P[BASE + 5]), b1 = cvt_pk_bf16(P[BASE + 6], P[BASE + 7]);                              \
    auto r0 = __builtin_amdgcn_permlane32_swap(a0, b0, false, false); auto r1 = __builtin_amdgcn_permlane32_swap(a1, b1, false, false); \
    u32x4 w = {r0[0], r1[0], r0[1], r1[1]}; OUT = *reinterpret_cast<bf16x8*>(&w); } while (0)
    PK4(p0, 0, pa0); PK4(p0, 8, pa1); PK4(p1, 0, pa2); PK4(p1, 8, pa3);
#undef PK4
}
__device__ __forceinline__ void qkt(f32x16& p0, f32x16& p1, const int (&ka)[4], int boff, const bf16x8* qr) {
    p0 = f32x16{}; p1 = f32x16{};
#pragma unroll
    for (int d0 = 0; d0 < 12; ++d0) { const int dl = d0 & 3, dh = d0 >> 2;
        const bf16x8 b0 = *(const LAS bf16x8*)(unsigned)(ka[dl] + (boff + dh * 128));
        const bf16x8 b1 = *(const LAS bf16x8*)(unsigned)(ka[dl] + (boff + dh * 128 + 32 * 384));
        p0 = __builtin_amdgcn_mfma_f32_32x32x16_bf16(b0, qr[d0], p0, 0, 0, 0);
        p1 = __builtin_amdgcn_mfma_f32_32x32x16_bf16(b1, qr[d0], p1, 0, 0, 0); }
}
__device__ __forceinline__ int v_st(int k, int c) { const int kk = (k & ~0xC) | ((k & 4) << 1) | ((k & 8) >> 1); return ((kk >> 3) * 4 + (c >> 5)) * 512 + ((kk & 7) * 32 + (c & 31)) * 2; }
__device__ __forceinline__ int v_rd_base(int lane) { return ((lane & 3) << 3) | (((lane >> 2) & 3) << 6) | (((lane >> 4) & 1) << 5) | (((lane >> 5) & 1) << 8); }
constexpr int v_rd_off(int d0, int ks, int half) { return d0 * 512 + ks * 4096 + half * 2048; }
template <int OFF> __device__ __forceinline__ s16x4 tr_read(int vb) {
    s16x4 r; asm volatile("ds_read_b64_tr_b16 %0, %1 offset:%2" : "=&v"(r) : "v"(vb), "i"(OFF) : "memory"); return r;
}
template <int D0> __device__ __forceinline__ void pv_one(f32x16& od, int vb, bf16x8 pa0, bf16x8 pa1, bf16x8 pa2, bf16x8 pa3) {
    const s16x4 l0 = tr_read<v_rd_off(D0, 0, 0)>(vb), h0 = tr_read<v_rd_off(D0, 0, 1)>(vb), l1 = tr_read<v_rd_off(D0, 1, 0)>(vb), h1 = tr_read<v_rd_off(D0, 1, 1)>(vb);
    const s16x4 l2 = tr_read<v_rd_off(D0, 2, 0)>(vb), h2 = tr_read<v_rd_off(D0, 2, 1)>(vb), l3 = tr_read<v_rd_off(D0, 3, 0)>(vb), h3 = tr_read<v_rd_off(D0, 3, 1)>(vb);
    asm volatile("s_waitcnt lgkmcnt(0)" ::: "memory"); SBAR();
#define PK(L, H) (bf16x8){L[0], L[1], L[2], L[3], H[0], H[1], H[2], H[3]}
    od = __builtin_amdgcn_mfma_f32_32x32x16_bf16(pa0, PK(l0, h0), od, 0, 0, 0);
    od = __builtin_amdgcn_mfma_f32_32x32x16_bf16(pa1, PK(l1, h1), od, 0, 0, 0);
    od = __builtin_amdgcn_mfma_f32_32x32x16_bf16(pa2, PK(l2, h2), od, 0, 0, 0);
    od = __builtin_amdgcn_mfma_f32_32x32x16_bf16(pa3, PK(l3, h3), od, 0, 0, 0);
#undef PK
}
__device__ __forceinline__ void pv_d0(f32x16* o, int vb, bf16x8 pa0, bf16x8 pa1, bf16x8 pa2, bf16x8 pa3) {
    pv_one<0>(o[0], vb, pa0, pa1, pa2, pa3); pv_one<1>(o[1], vb, pa0, pa1, pa2, pa3); pv_one<2>(o[2], vb, pa0, pa1, pa2, pa3); pv_one<3>(o[3], vb, pa0, pa1, pa2, pa3);
}
__device__ __forceinline__ void attn_body(const bf16_t* __restrict__ Qb, const bf16_t* __restrict__ Kn, const bf16_t* __restrict__ Kr, const bf16_t* __restrict__ Vh,
                                          bf16_t* __restrict__ Ob, int seq, int rope_t0, char* lds) {
    const int tid = threadIdx.x, wid = tid >> 6, lane = tid & 63, r32 = lane & 31, hi = lane >> 5;
    char* V_lds = lds; char* K_lds = lds + 2 * SHM_V;
    float* ws = (float*)(lds + 2 * SHM_V + 2 * SHM_K) + wid * 64; float* li_l = ws; float* al_l = ws + 32;
    float m_reg = -1e30f, l_reg = 0; f32x16 o[4] = {}; bf16x8 qr[12];
    const bf16_t* Qw = Qb + (long)(wid * QBLK + r32) * LDQ + hi * 8;
#pragma unroll
    for (int d0 = 0; d0 < 8; ++d0) qr[d0] = *reinterpret_cast<const bf16x8*>(Qw + d0 * 16);
    {
        bf16_t* Qr = (bf16_t*)(lds + SHM_ATTN);
#pragma unroll 1
        for (int it = 0; it < 16; ++it) { const int item = tid + it * 512, row = item >> 5, pr = item & 31, half = pr >> 4, i = pr & 15;
            const bf16_t* qp = Qb + (long)row * LDQ + 128 + half * 32 + i;
            const float x1 = bf2f(qp[0]), x2 = bf2f(qp[16]); float o1 = x1, o2 = x2;
            if (rope_t0 >= 0) { const int t = rope_t0 + row; const float pos = (float)(half ? (t & 63) : (t >> 6));
                const float inv = expf(-(float)i * (9.210340371976184f / 16.f)); float s, c; sincosf(pos * inv, &s, &c);
                o1 = x1 * c - x2 * s; o2 = x2 * c + x1 * s; }
            Qr[row * 64 + half * 32 + i] = f2bf(o1); Qr[row * 64 + half * 32 + i + 16] = f2bf(o2); }
        __syncthreads();
#pragma unroll
        for (int dd = 0; dd < 4; ++dd) qr[8 + dd] = *reinterpret_cast<const bf16x8*>(Qr + (wid * QBLK + r32) * 64 + dd * 16 + hi * 8);
    }
    const int sr = tid >> 4, sc = (tid & 15) * 8, vst0 = v_st(sr, sc), vst1 = v_st(32 + sr, sc);
    const int rr = tid >> 3, rc = (tid & 7) * 8;
    const int vb0 = (int)(uintptr_t)V_lds + v_rd_base(lane);
    int ka[4];
#pragma unroll
    for (int dl = 0; dl < 4; ++dl) ka[dl] = (int)(uintptr_t)K_lds + r32 * 384 + ((dl * 32 + hi * 16) ^ (((r32 >> 1) & 7) << 4));
    struct { bf16x8 vs0, vs1, ks0, ks1, kr; } sr_[1];
    const unsigned ovA = (unsigned)(sr * LDV + sc) * 2u, ovB = (unsigned)((32 + sr) * LDV + sc) * 2u, orr = (unsigned)(rr * LDKR + rc) * 2u;
#define SLOAD(i, k0) do { const char* vbp = (const char*)Vh + (size_t)(k0) * (LDV * 2); const char* kbp = (const char*)Kn + (size_t)(k0) * (LDKN * 2); const char* rbp = (const char*)Kr + (size_t)(k0) * (LDKR * 2); \
    sr_[i].vs0 = *(const bf16x8*)(vbp + ovA); sr_[i].vs1 = *(const bf16x8*)(vbp + ovB); \
    sr_[i].ks0 = *(const bf16x8*)(kbp + ovA); sr_[i].ks1 = *(const bf16x8*)(kbp + ovB); \
    sr_[i].kr = *(const bf16x8*)(rbp + orr); } while (0)
#define SWRITE(b, i) do { *(bf16x8*)(V_lds + (b) * SHM_V + vst0) = sr_[i].vs0; *(bf16x8*)(V_lds + (b) * SHM_V + vst1) = sr_[i].vs1; const int kc = sc * 2; \
    *(bf16x8*)(K_lds + (b) * SHM_K + KSWZ(sr, kc)) = sr_[i].ks0; *(bf16x8*)(K_lds + (b) * SHM_K + KSWZ(32 + sr, kc)) = sr_[i].ks1; \
    *(bf16x8*)(K_lds + (b) * SHM_K + KSWZ(rr, 256 + rc * 2)) = sr_[i].kr; } while (0)
#define SWAIT() asm volatile("s_waitcnt vmcnt(0)" ::: "memory")
#define RESC(a) do { if (__any((a) < 1.f)) { if (hi == 0) al_l[r32] = (a); asm volatile("s_waitcnt lgkmcnt(0)" ::: "memory"); \
    _Pragma("unroll") for (int d = 0; d < 4; ++d) _Pragma("unroll") for (int r = 0; r < 16; ++r) o[d][r] *= al_l[crow(r, hi)]; } } while (0)
    f32x16 pA0, pA1, pB0, pB1; float mnA, mnB, alA, alB; bf16x8 pa0, pa1, pa2, pa3; const int NT = seq / KVBLK;
    constexpr int SE = 0, SO = 0;
    SLOAD(SE, 0); asm volatile("s_waitcnt vmcnt(0)" ::: "memory"); SWRITE(0, SE); __syncthreads();
    qkt(pA0, pA1, ka, 0, qr); partialSM(pA0, pA1, m_reg, mnA, alA);
    SLOAD(SO, KVBLK);
    SWAIT(); SWRITE(1, SO); __syncthreads();
    for (int j = 1; j + 1 < NT; j += 2) {
        SBAR(); qkt(pB0, pB1, ka, SHM_K, qr);
        finishSM(pA0, pA1, alA, l_reg, pa0, pa1, pa2, pa3); SBAR();
        SLOAD(SO, (j + 1) * KVBLK); SBAR();
        pv_d0(o, vb0, pa0, pa1, pa2, pa3); partialSM(pB0, pB1, m_reg, mnB, alB);
        __syncthreads(); SWAIT(); SWRITE(0, SE);
        RESC(alB); __syncthreads();
        SBAR(); qkt(pA0, pA1, ka, 0, qr);
        finishSM(pB0, pB1, alB, l_reg, pa0, pa1, pa2, pa3); SBAR();
        SLOAD(SE, (j + 2) * KVBLK); SBAR();
        pv_d0(o, vb0 + SHM_V, pa0, pa1, pa2, pa3); partialSM(pA0, pA1, m_reg, mnA, alA);
        __syncthreads(); SWAIT(); SWRITE(1, SO);
        RESC(alA); __syncthreads();
    }
    SBAR(); qkt(pB0, pB1, ka, SHM_K, qr);
    finishSM(pA0, pA1, alA, l_reg, pa0, pa1, pa2, pa3); SBAR();
    pv_d0(o, vb0, pa0, pa1, pa2, pa3); partialSM(pB0, pB1, m_reg, mnB, alB);
    __syncthreads(); RESC(alB);
    finishSM(pB0, pB1, alB, l_reg, pa0, pa1, pa2, pa3); SBAR();
    pv_d0(o, vb0 + SHM_V, pa0, pa1, pa2, pa3);
    if (hi == 0) li_l[r32] = l_reg; asm volatile("s_waitcnt lgkmcnt(0)" ::: "memory");
    float rli[16];
#pragma unroll
    for (int r = 0; r < 16; ++r) rli[r] = __builtin_amdgcn_rcpf(li_l[crow(r, hi)]);
    bf16_t* Ow = Ob + (long)(wid * QBLK) * LDO;
#pragma unroll
    for (int r = 0; r < 16; ++r) { const int orow = crow(r, hi);
#pragma unroll
        for (int d0 = 0; d0 < 4; ++d0) Ow[(long)orow * LDO + d0 * 32 + r32] = f2bf(o[d0][r] * rli[r]); }
    __syncthreads();
#undef SLOAD
#undef SWRITE
#undef SWAIT
#undef RESC
}
}

__device__ __forceinline__ void phase_attn(const Params& p, int layer, char* lds) {
    const int nunits = 256 + (layer == 0 ? 4 : 0);
#pragma unroll 1
    for (int u = blockIdx.x; u < nunits; u += gridDim.x) {
        const bool lat = u < 256;
        const int xcd = u & 7, h = lat ? (xcd >> 1) : (u - 256), qb = (u >> 3) * 2 + (xcd & 1);
        const int row0 = lat ? LC + qb * 256 : 0;
        att::attn_body(p.qkvup + (size_t)row0 * MLAN + h * 192, p.qkvup + 768 + h * 256, p.krr, p.qkvup + 768 + h * 256 + 128,
                       p.ocat + (size_t)row0 * D_ + 512 + h * 128, lat ? MT : LC, lat ? qb * 256 : -1, lds);
    }
}

__device__ __forceinline__ void phase_rec_naive(const Params& p, int layer, float* lds) {
    const int tid = threadIdx.x;
    float* kq = lds;
    float* vv = lds + 32 * 256;
    float* ab = vv + 32 * 128;
    for (int u = blockIdx.x; u < 16; u += gridDim.x) {
        const int kind = u >> 3, dir = (u >> 2) & 1, h = u & 3;
        float S[128];
#pragma unroll
        for (int i = 0; i < 128; ++i) S[i] = 0.f;
        const float gam = 1.0f - exp2f(-(float)((dir ? 6 : 5) + 2 * h));
        float* outp = (kind == 0 ? p.go : p.ro) + (size_t)dir * MT * 512 + h * 128;
        for (int s0 = 0; s0 < MT; s0 += 32) {
            __syncthreads();
            {   const int tk = tid >> 4, seg = (tid & 15) * 16; const int s = s0 + tk;
                const int row = dir == 0 ? s : (s < LC ? LC - 1 - s : MT + LC - 1 - s);
                const bf16_t* src;
                if (kind == 0) src = p.gqkv + (size_t)row * 1536 + (seg < 128 ? 512 + h * 128 + seg : h * 128 + (seg - 128));
                else           src = p.rqk + (size_t)row * 1024 + (seg < 128 ? 512 + h * 128 + seg : h * 128 + (seg - 128));
                float f[8]; unpack8(*(const u32x4*)src, f);
#pragma unroll
                for (int e = 0; e < 8; ++e) kq[tk * 256 + seg + e] = f[e];
                unpack8(*(const u32x4*)(src + 8), f);
#pragma unroll
                for (int e = 0; e < 8; ++e) kq[tk * 256 + seg + 8 + e] = f[e];
                const int vseg = (tid & 15) * 8;
                const bf16_t* vsrc = kind == 0 ? p.gqkv + (size_t)row * 1536 + 1024 + h * 128 + vseg : p.Pp + (size_t)row * NP + PC_RQKV + 1024 + h * 128 + vseg;
                unpack8(*(const u32x4*)vsrc, f);
#pragma unroll
                for (int e = 0; e < 8; ++e) vv[tk * 128 + vseg + e] = f[e];
                if (tid < 32) { const int s2 = s0 + tid; const int row2 = dir == 0 ? s2 : (s2 < LC ? LC - 1 - s2 : MT + LC - 1 - s2);
                    if (kind == 0) { ab[tid * 2] = expf(p.ggb[(size_t)row2 * 16 + dir * 4 + h]); ab[tid * 2 + 1] = p.ggb[(size_t)row2 * 16 + 8 + dir * 4 + h]; }
                    else { ab[tid * 2] = gam; ab[tid * 2 + 1] = 1.f; } }
            }
            __syncthreads();
            if (tid < 128) {
                for (int tk = 0; tk < 32; ++tk) {
                    const f32x4* kp = (const f32x4*)(kq + tk * 256); const f32x4* qp = kp + 32;
                    const float a = ab[tk * 2], b = ab[tk * 2 + 1], v = vv[tk * 128 + tid];
                    float dv;
                    if (kind == 0) { float ks = 0.f;
#pragma unroll
                        for (int i = 0; i < 32; ++i) { const f32x4 k4 = kp[i]; ks += k4[0] * S[4 * i] + k4[1] * S[4 * i + 1] + k4[2] * S[4 * i + 2] + k4[3] * S[4 * i + 3]; }
                        dv = b * (v - a * ks); }
                    else dv = v;
                    float o = 0.f;
#pragma unroll
                    for (int i = 0; i < 32; ++i) { const f32x4 k4 = kp[i], q4 = qp[i];
                        S[4 * i] = a * S[4 * i] + k4[0] * dv; S[4 * i + 1] = a * S[4 * i + 1] + k4[1] * dv; S[4 * i + 2] = a * S[4 * i + 2] + k4[2] * dv; S[4 * i + 3] = a * S[4 * i + 3] + k4[3] * dv;
                        o += q4[0] * S[4 * i] + q4[1] * S[4 * i + 1] + q4[2] * S[4 * i + 2] + q4[3] * S[4 * i + 3]; }
                    const int s = s0 + tk; const int row = dir == 0 ? s : (s < LC ? LC - 1 - s : MT + LC - 1 - s);
                    outp[(size_t)row * 512 + tid] = o;
                }
            }
        }
        __syncthreads();
    }
}

__device__ __forceinline__ void phase_mixout(const Params& p, int layer) {
    const int tid = threadIdx.x, wid = tid >> 6, lane = tid & 63;
    const float* gnw = p.in[I_GNW] + layer * 128;
    for (int r = blockIdx.x * 8 + wid; r < MT; r += gridDim.x * 8) {
        const int idx = lane * 8;
#pragma unroll
        for (int kind = 0; kind < 2; ++kind) {
            const float* o0 = (kind == 0 ? p.go : p.ro) + (size_t)r * 512 + idx; const float* o1 = o0 + (size_t)MT * 512;
            float o[8]; float ss = 0.f;
            { const f32x4 a0 = *(const f32x4*)o0, a1 = *(const f32x4*)(o0 + 4), b0 = *(const f32x4*)o1, b1 = *(const f32x4*)(o1 + 4);
#pragma unroll
              for (int e = 0; e < 4; ++e) { o[e] = a0[e] + b0[e]; o[4 + e] = a1[e] + b1[e]; } }
#pragma unroll
            for (int e = 0; e < 8; ++e) ss += o[e] * o[e];
            ss = sum16(ss);
            const float rn = rsqrtf(ss * (1.0f / 128.f) + EPS);
            float z[8]; unpack8(*(const u32x4*)(p.Pp + (size_t)r * NP + (kind == 0 ? PC_GZ : PC_RG) + idx), z);
            float y[8];
#pragma unroll
            for (int e = 0; e < 8; ++e) { const float w = kind == 0 ? gnw[(idx + e) & 127] : 1.f; y[e] = o[e] * rn * w * silu_f(z[e]); }
            *(u32x4*)(p.ocat + (size_t)r * D_ + (kind == 0 ? 0 : 1536) + idx) = pack8(y);
        }
    }
}
__device__ __forceinline__ void fft_fwd(cpx* Z, int tid) {
#pragma unroll 1
    for (int pass = 0; pass < 3; ++pass) { const int lm = pass == 0 ? 10 : (pass == 1 ? 6 : 2);

#pragma unroll 1
        for (int gi = 0; gi < 2; ++gi) fft_pass16<false>(Z, tid + gi * 512, lm);
        __syncthreads(); }
#pragma unroll 1
    for (int it = 0; it < 8; ++it) fft_pass4<false>(Z, tid + it * 512);
    __syncthreads();
}
__device__ __forceinline__ void fft_inv(cpx* Z, int tid) {
#pragma unroll 1
    for (int it = 0; it < 8; ++it) fft_pass4<true>(Z, tid + it * 512);
    __syncthreads();
#pragma unroll 1
    for (int pass = 0; pass < 3; ++pass) { const int lm = pass == 0 ? 2 : (pass == 1 ? 6 : 10);

#pragma unroll 1
        for (int gi = 0; gi < 2; ++gi) fft_pass16<true>(Z, tid + gi * 512, lm);
        __syncthreads(); }
}
constexpr size_t HY_SCR_FLOATS = 2 * 2 * (size_t)FFT_N + 4 * (size_t)SEQ;
__device__ __forceinline__ void hyena_latent_unit(const Params& p, int layer, int c, char* lds) {
    cpx* Z = (cpx*)lds; const int tid = threadIdx.x, lane = tid & 63;
    float* scr = p.hys + (size_t)blockIdx.x * HY_SCR_FLOATS;
    cpx* Zh1 = (cpx*)scr; cpx* Zh2 = Zh1 + FFT_N; float* vs = (float*)(Zh2 + FFT_N); float* x1s = vs + SEQ; float* x2s = x1s + SEQ; float* z1s = x2s + SEQ;
    const float* cw = p.in[I_HCONV] + (size_t)layer * 3 * 1536;
#pragma unroll
    for (int part = 0; part < 3; ++part) {
        const float w0 = cw[part * 512 + c], w1 = cw[1536 + part * 512 + c], w2 = cw[3072 + part * 512 + c];
        const bf16_t* col = p.Pp + (size_t)LC * NP + PC_HY + part * 512 + c;
        float* dst = part == 0 ? vs : (part == 1 ? x1s : x2s);
#pragma unroll 2
        for (int t = tid; t < SEQ; t += 512) {
            const float x0 = bf2f(col[(size_t)t * NP]);
            const float xm = t > 0 ? bf2f(col[(size_t)(t - 1) * NP]) : 0.f, xn = t < SEQ - 1 ? bf2f(col[(size_t)(t + 1) * NP]) : 0.f;
            dst[t] = w0 * xm + w1 * x0 + w2 * xn;
        }
    }
#pragma unroll 1
    for (int f = 0; f < 2; ++f) {
        const size_t ch = (size_t)layer * 1024 + f * 512 + c;
        const float* hsrc = p.hfilt + ch * SEQ;
        const f32x4 ps = *(const f32x4*)(p.hsum + ch * 256 + lane * 4);
        const float tot = wave_sum((ps[0] + ps[1]) + (ps[2] + ps[3]));
        const float scale = (1.0f / (tot + EPS)) * (1.0f / (float)FFT_N);
#pragma unroll 2
        for (int it = 0; it < 16; ++it) { const int j = tid + it * 512; const f32x2 hv = *(const f32x2*)(hsrc + 2 * j);
            Z[ZP(j)] = cpx{hv[0] * scale, hv[1] * scale}; Z[ZP(j + 8192)] = cpx{0.f, 0.f}; }
        __syncthreads();
        fft_fwd(Z, tid);
        cpx* Zh = f ? Zh2 : Zh1;
#pragma unroll 4
        for (int it = 0; it < 32; ++it) { const int q = tid + it * 512; Zh[q] = Z[ZP(q)]; }
        __syncthreads();
    }
    const float b0 = p.in[I_HBIAS][(size_t)layer * 1024 + c], b1 = p.in[I_HBIAS][(size_t)layer * 1024 + 512 + c];
#pragma unroll 2
    for (int it = 0; it < 16; ++it) { const int j = tid + it * 512; const f32x2 v2 = *(const f32x2*)(vs + 2 * j);
        Z[ZP(j)] = cpx{v2[0], v2[1]}; Z[ZP(j + 8192)] = cpx{0.f, 0.f}; }
    __syncthreads();
    fft_fwd(Z, tid);
#pragma unroll 1
    for (int it = 0; it < 16; ++it) fft_pointwise(Z, Zh1, tid + it * 512);
    __syncthreads();
    fft_inv(Z, tid);
#pragma unroll 1
    for (int half = 0; half < 2; ++half) {
#pragma unroll 2
        for (int it = 0; it < 8; ++it) { const int j = half * 4096 + tid + it * 512;
            const cpx y = Z[ZP(4096 + j)];
            const f32x2 v2 = *(const f32x2*)(vs + 2 * j), xx = *(const f32x2*)(x1s + 2 * j);
            const f32x2 z = {xx[0] * (y.x + b0 * v2[0]), xx[1] * (y.y + b0 * v2[1])};
            *(f32x2*)(z1s + 2 * j) = z; Z[ZP(j)] = cpx{z[0], z[1]};
            if (half) Z[ZP(4096 + j)] = cpx{0.f, 0.f};
            else Z[ZP(12288 + j)] = cpx{0.f, 0.f}; }
        __syncthreads();
    }
    __syncthreads();
    fft_fwd(Z, tid);
#pragma unroll 1
    for (int it = 0; it < 16; ++it) fft_pointwise(Z, Zh2, tid + it * 512);
    __syncthreads();
    fft_inv(Z, tid);
#pragma unroll 2
    for (int it = 0; it < 16; ++it) { const int j = tid + it * 512; const cpx y = Z[ZP(4096 + j)];
        const f32x2 z = *(const f32x2*)(z1s + 2 * j), x2 = *(const f32x2*)(x2s + 2 * j);
        bf16_t* op = p.ocat + (size_t)(LC + 2 * j) * D_ + 1024 + c;
        op[0] = f2bf(x2[0] * (y.x + b1 * z[0])); op[D_] = f2bf(x2[1] * (y.y + b1 * z[1])); }
    __syncthreads();
}
__device__ __forceinline__ void hyena_ctx_unit(const Params& p, int c, float* lds) {
    const int tid = threadIdx.x;
    float* vv = lds; float* x1 = vv + 256; float* x2 = x1 + 256; float* h1 = x2 + 256; float* h2 = h1 + 256; float* z1 = h2 + 256;
    const float* cw = p.in[I_HCONV];
    if (tid < 256) { const int t = tid;
#pragma unroll
        for (int part = 0; part < 3; ++part) {
            const float w0 = cw[part * 512 + c], w1 = cw[1536 + part * 512 + c], w2 = cw[3072 + part * 512 + c];
            const bf16_t* col = p.Pp + PC_HY + part * 512 + c;
            const float x0 = bf2f(col[(size_t)t * NP]), xm = t > 0 ? bf2f(col[(size_t)(t - 1) * NP]) : 0.f, xn = t < LC - 1 ? bf2f(col[(size_t)(t + 1) * NP]) : 0.f;
            (part == 0 ? vv : (part == 1 ? x1 : x2))[t] = w0 * xm + w1 * x0 + w2 * xn;
        }
        const float s1 = (p.hsc[c * 4] + p.hsc[c * 4 + 1]) + (p.hsc[c * 4 + 2] + p.hsc[c * 4 + 3]);
        const float s2 = (p.hsc[(512 + c) * 4] + p.hsc[(512 + c) * 4 + 1]) + (p.hsc[(512 + c) * 4 + 2] + p.hsc[(512 + c) * 4 + 3]);
        h1[t] = p.hfc[(size_t)c * 256 + t] / (s1 + EPS); h2[t] = p.hfc[(size_t)(512 + c) * 256 + t] / (s2 + EPS);
    }
    __syncthreads();
    const float b0 = p.in[I_HBIAS][c], b1 = p.in[I_HBIAS][512 + c];
    if (tid < 256) { const int t = tid; float y = 0.f;
        for (int s = 0; s < 256; ++s) { const int m = t - s + 128; if (m >= 0 && m < 256) y += vv[s] * h1[m]; }
        z1[t] = x1[t] * (y + b0 * vv[t]); }
    __syncthreads();
    if (tid < 256) { const int t = tid; float y = 0.f;
        for (int s = 0; s < 256; ++s) { const int m = t - s + 128; if (m >= 0 && m < 256) y += z1[s] * h2[m]; }
        p.ocat[(size_t)t * D_ + 1024 + c] = f2bf(x2[t] * (y + b1 * z1[t])); }
    __syncthreads();
}
__device__ __forceinline__ void phase_hyena(const Params& p, int layer, char* lds) {
    const int nunits = 512 + (layer == 0 ? 512 : 0);
    for (int u = blockIdx.x; u < nunits; u += gridDim.x) {
        if (u < 512) hyena_latent_unit(p, layer, u, lds); else hyena_ctx_unit(p, u - 512, (float*)lds);
    }
}

__device__ __forceinline__ void phase_gather(const Params& p) {
    const int tid = threadIdx.x, wid = tid >> 6, lane = tid & 63;
    int base[NEXP]; { int acc = 0;
#pragma unroll
        for (int e = 0; e < NEXP; ++e) { base[e] = acc * 256; acc += ((int)p.cnt[e] + 255) >> 8; } }
    for (int i = blockIdx.x * 8 + wid; i < 2 * SEQ; i += gridDim.x * 8) {
        const int t = i >> 1, e = p.tok_e[i], pos = p.tok_p[i];
        int b = 0;
#pragma unroll
        for (int k = 0; k < NEXP; ++k) b = (e == k) ? base[k] : b;
        const int row = b + pos;
        const u32x4* src = (const u32x4*)(p.hbuf + (size_t)(LC + t) * D_); u32x4* dst = (u32x4*)(p.hg + (size_t)row * D_);
#pragma unroll
        for (int k = 0; k < 4; ++k) dst[k * 64 + lane] = src[k * 64 + lane];
        if (lane == 0) p.tok_r[i] = row;
    }
}
__device__ __forceinline__ void phase_final(const Params& p) {
    const int tid = threadIdx.x, wid = tid >> 6, lane = tid & 63;
    const float* g2 = p.modv + ((size_t)1 * 2 + 0) * 6 * D_ + 5 * D_;
    const float* fw = p.in[I_FNW];
    for (int t = blockIdx.x * 8 + wid; t < SEQ; t += gridDim.x * 8) {
        const int r0 = p.tok_r[t * 2], r1 = p.tok_r[t * 2 + 1]; const float w0 = p.tok_w[t * 2], w1 = p.tok_w[t * 2 + 1];
        const float* xr = p.xcur + (size_t)(LC + t) * D_;
        f32x4 xv[8]; float ss = 0.f;
#pragma unroll
        for (int i = 0; i < 8; ++i) { const int col = (i * 64 + lane) * 4;
            const u32x2 ya = *(const u32x2*)(p.yb + (size_t)r0 * D_ + col), yb2 = *(const u32x2*)(p.yb + (size_t)r1 * D_ + col);
            const f32x4 y = {w0 * bflo(ya.x) + w1 * bflo(yb2.x), w0 * bfhi(ya.x) + w1 * bfhi(yb2.x), w0 * bflo(ya.y) + w1 * bflo(yb2.y), w0 * bfhi(ya.y) + w1 * bfhi(yb2.y)};
            xv[i] = *(const f32x4*)(xr + col) + *(const f32x4*)(g2 + col) * y;
            ss += xv[i][0] * xv[i][0] + xv[i][1] * xv[i][1] + xv[i][2] * xv[i][2] + xv[i][3] * xv[i][3]; }
        ss = wave_sum(ss);
        const float rstd = rsqrtf(ss * (1.0f / D_) + EPS);
#pragma unroll
        for (int i = 0; i < 8; ++i) { const int col = (i * 64 + lane) * 4; *(f32x4*)(p.out + (size_t)t * D_ + col) = (xv[i] * rstd) * *(const f32x4*)(fw + col); }
    }
}
enum { PH_PRO, PH_NORM1, PH_GIN, PH_PREP, PH_GMLA, PH_ATT, PH_REC, PH_HY, PH_MIXOUT, PH_GOUT, PH_NORM2, PH_F1, PH_F2, PH_GATHER, PH_MG1, PH_MG2, PH_FINAL };
constexpr int LDS_BYTES = 147456;

template <int PH> __device__ __forceinline__ void run_phase(const Params& p, int layer, unsigned char* shm) {
    LAS unsigned char* lds3 = (LAS unsigned char*)shm;
    const int G = gridDim.x, c = blockIdx.x;
    if constexpr (PH == PH_PRO) phase_prologue(p, (float*)shm);
    else if constexpr (PH == PH_NORM1) phase_norm(p, layer, 1, 0);
    else if constexpr (PH == PH_GIN) {
        pg8::Gemm g{p.hbuf, p.wb_in + (size_t)layer * NP * D_, D_, D_, D_, 0};
        pg8::StaticOrder S; S.init(MT, NP, G, c);
        pg8::EpiStoreBf16 E{p.Pp, NP, nullptr, 1 << 30};
        pg8::gemm_phase(lds3, g, S, E);
    }
    else if constexpr (PH == PH_PREP) phase_prep(p, layer);
    else if constexpr (PH == PH_GMLA) {
        pg8::Gemm g{p.Pp + PC_CQ, p.wb_mla + (size_t)layer * MLAN * MLAK, MLAK, NP, MLAK, 0};
        pg8::StaticOrder S; S.init(MT, MLAN, G, c);
        pg8::EpiStoreBf16 E{p.qkvup, MLAN, p.mrs, 3};
        pg8::gemm_phase(lds3, g, S, E);
    }
    else if constexpr (PH == PH_ATT) phase_attn(p, layer, (char*)shm);
    else if constexpr (PH == PH_REC) phase_rec_naive(p, layer, (float*)shm);
    else if constexpr (PH == PH_HY) phase_hyena(p, layer, (char*)shm);
    else if constexpr (PH == PH_MIXOUT) phase_mixout(p, layer);
    else if constexpr (PH == PH_GOUT) {
        const float* mv = p.modv + (size_t)layer * 2 * 6 * D_;
        if (layer == 0) {
            pg8::Gemm g{p.ocat, p.wb_out, D_, D_, D_, 0};
            pg8::StaticOrder S; S.init(MT, D_, G, c);
            pg8::EpiResGate E{p.xcur, p.in[I_CTX], p.in[I_X], mv + 6 * D_ + 2 * D_, mv + 2 * D_, 0};
            pg8::gemm_phase(lds3, g, S, E);
        } else {
            pg8::Gemm g{p.ocat + (size_t)LC * D_, p.wb_out + (size_t)D_ * D_, D_, D_, D_, 0};
            pg8::StaticOrder S; S.init(SEQ, D_, G, c);
            pg8::EpiResGate E{p.xcur, p.xcur, p.xcur + (size_t)LC * D_, mv + 6 * D_ + 2 * D_, mv + 2 * D_, LC};
            pg8::gemm_phase(lds3, g, S, E);
        }
    }
    else if constexpr (PH == PH_NORM2) {
        phase_norm(p, layer, 2, layer == 0 ? 0 : LC);
        if (layer == 1) { __syncthreads(); for (int u = c; u < U_MOEW; u += G) moe_w_unit(p, u, (float*)shm); }
    }
    else if constexpr (PH == PH_F1) {
        pg8::Gemm g{p.hbuf, p.wb_f13, D_, D_, D_, 0};
        pg8::StaticOrder S; S.init(MT, 2 * DFF, G, c);
        pg8::EpiSwiGLU E{p.act, DFF};
        pg8::gemm_phase(lds3, g, S, E);
    }
    else if constexpr (PH == PH_F2) {
        const float* mv = p.modv;
        pg8::Gemm g{p.act, p.wb_f2, DFF, DFF, DFF, 0};
        pg8::StaticOrder S; S.init(MT, D_, G, c);
        pg8::EpiResGate E{p.xcur, p.xcur, p.xcur + (size_t)LC * D_, mv + 6 * D_ + 5 * D_, mv + 5 * D_, 0};
        pg8::gemm_phase(lds3, g, S, E);
    }
    else if constexpr (PH == PH_GATHER) phase_gather(p);
    else if constexpr (PH == PH_MG1) {
        pg8::Gemm g{p.hg, p.wb_m13, D_, D_, D_, (size_t)2 * DFF * D_};
        pg8::GroupedOrder S; S.init(p.cnt, 2 * DFF, G, c);
        pg8::EpiSwiGLU E{p.act, DFF};
        pg8::gemm_phase(lds3, g, S, E);
    }
    else if constexpr (PH == PH_MG2) {
        pg8::Gemm g{p.act, p.wb_m2, DFF, DFF, DFF, (size_t)D_ * DFF};
        pg8::GroupedOrder S; S.init(p.cnt, D_, G, c);
        pg8::EpiStoreBf16 E{p.yb, D_, nullptr, 1 << 30};
        pg8::gemm_phase(lds3, g, S, E);
    }
    else if constexpr (PH == PH_FINAL) phase_final(p);
}
template <int PH> __global__ __launch_bounds__(512, 2) void k_ph(Params p, int layer) {
    extern __shared__ __attribute__((aligned(16))) unsigned char shm[];
    run_phase<PH>(p, layer, shm);
}
template <int PH> static void launch_ph(const Params& p, int layer, int grid, hipStream_t st) {
    static bool attr = false;
    if (!attr) { hipFuncSetAttribute((const void*)k_ph<PH>, hipFuncAttributeMaxDynamicSharedMemorySize, LDS_BYTES); attr = true; }
    hipLaunchKernelGGL((k_ph<PH>), dim3(grid), dim3(512), LDS_BYTES, st, p, layer);
}

static size_t align_up(size_t x) { return (x + 255) & ~(size_t)255; }
extern "C" void kernel_launch(void* const* d_in, const int* in_sizes, int n_in, void* d_out, int out_size, void* d_ws, size_t ws_size, hipStream_t stream) {
    Params p{};
    for (int i = 0; i < N_IN; ++i) p.in[i] = (const float*)d_in[i];
    p.out = (float*)d_out;
    const int GRID = 256;
    char* ws = (char*)d_ws; size_t off = 0;
    auto take = [&](size_t bytes) { char* r = ws + off; off = align_up(off + bytes); return r; };
    p.bar = (unsigned*)take(16384); p.cnt = (unsigned*)take(256);
    p.modv = (float*)take((size_t)2 * 2 * 6 * D_ * 4);
    p.xcur = (float*)take((size_t)MT * D_ * 4);
    p.hbuf = (bf16_t*)take((size_t)MT * D_ * 2);
    p.tok_r = (int*)take((size_t)2 * SEQ * 4); p.tok_w = (float*)take((size_t)2 * SEQ * 4); p.tok_e = (int*)take((size_t)2 * SEQ * 4); p.tok_p = (int*)take((size_t)2 * SEQ * 4);
    const size_t region = off;
    p.wb_in = (bf16_t*)take((size_t)2 * NP * D_ * 2); p.wb_out = (bf16_t*)take((size_t)2 * D_ * D_ * 2); p.wb_mla = (bf16_t*)take((size_t)2 * MLAN * MLAK * 2);
    p.wb_f13 = (bf16_t*)take((size_t)2 * DFF * D_ * 2); p.wb_f2 = (bf16_t*)take((size_t)D_ * DFF * 2);
    p.hfilt = (float*)take((size_t)2 * 1024 * SEQ * 4); p.hsum = (float*)take((size_t)2 * 1024 * 256 * 4); p.hfc = (float*)take((size_t)1024 * 256 * 4); p.hsc = (float*)take((size_t)1024 * 4 * 4);
    const size_t arena = off;
    p.Pp = (bf16_t*)take((size_t)MT * NP * 2);
    p.gqkv = (bf16_t*)take((size_t)MT * 1536 * 2); p.ggb = (float*)take((size_t)MT * 16 * 4); p.rqk = (bf16_t*)take((size_t)MT * 1024 * 2);
    p.mrs = (float*)take((size_t)MT * 2 * 4); p.krr = (bf16_t*)take((size_t)MT * 64 * 2); p.qkvup = (bf16_t*)take((size_t)MT * MLAN * 2);
    p.go = (float*)take((size_t)2 * MT * 512 * 4); p.ro = (float*)take((size_t)2 * MT * 512 * 4);
    p.hys = (float*)take((size_t)GRID * HY_SCR_FLOATS * 4); p.ocat = (bf16_t*)take((size_t)MT * D_ * 2);
    const size_t end1 = off;
    p.act = (bf16_t*)(ws + arena);
    off = region;
    p.wb_m13 = (bf16_t*)take((size_t)NEXP * 2 * DFF * D_ * 2); p.wb_m2 = (bf16_t*)take((size_t)NEXP * D_ * DFF * 2);
    p.hg = (bf16_t*)take((size_t)MAXROWS_MOE * D_ * 2); p.yb = p.hg;
    bf16_t* act_moe = (bf16_t*)take((size_t)MAXROWS_MOE * DFF * 2);
    const size_t end2 = off;
    const size_t need = end1 > end2 ? end1 : end2;
    if (ws_size < need) { fprintf(stderr, "kernel_launch: workspace too small: %zu < %zu\n", ws_size, need); return; }
    Params p1 = p; p1.act = act_moe;

    launch_ph<PH_PRO>(p, 0, GRID, stream);
    for (int l = 0; l < 2; ++l) {
        const Params& q = l == 0 ? p : p1;
        launch_ph<PH_NORM1>(q, l, GRID, stream);
        launch_ph<PH_GIN>(q, l, GRID, stream);
        launch_ph<PH_PREP>(q, l, GRID, stream);
        launch_ph<PH_GMLA>(q, l, GRID, stream);
        launch_ph<PH_ATT>(q, l, GRID, stream);
        launch_ph<PH_REC>(q, l, 16, stream);
        launch_ph<PH_HY>(q, l, GRID, stream);
        launch_ph<PH_MIXOUT>(q, l, GRID, stream);
        launch_ph<PH_GOUT>(q, l, GRID, stream);
        launch_ph<PH_NORM2>(q, l, GRID, stream);
        if (l == 0) { launch_ph<PH_F1>(q, l, GRID, stream); launch_ph<PH_F2>(q, l, GRID, stream); }
        else { launch_ph<PH_GATHER>(q, l, GRID, stream); launch_ph<PH_MG1>(q, l, GRID, stream); launch_ph<PH_MG2>(q, l, GRID, stream); launch_ph<PH_FINAL>(q, l, GRID, stream); }
    }
}
```

```cpp
#include <hip/hip_runtime.h>
#include <stdint.h>
#include <math.h>
#include <stdio.h>

#define LAS __attribute__((address_space(3)))
typedef unsigned short bf16_t;
typedef short bf16x8 __attribute__((ext_vector_type(8)));
typedef short s16x4 __attribute__((ext_vector_type(4)));
typedef float f32x4 __attribute__((ext_vector_type(4)));
typedef float f32x2 __attribute__((ext_vector_type(2)));
typedef float f32x16 __attribute__((ext_vector_type(16)));
typedef unsigned u32x4 __attribute__((ext_vector_type(4)));
typedef unsigned u32x2 __attribute__((ext_vector_type(2)));

constexpr int D_ = 2048, SEQ = 16384, LC = 256, MT = 16640, NP = 6400, DFF = 5632, NEXP = 8, DIN = 6288;
constexpr int PC_GQKV = 0, PC_GZ = 1536, PC_HY = 2048, PC_RQKV = 3584, PC_RG = 5120, PC_CQ = 5632, PC_CKV = 6144, PC_KR = 6272, PC_A = 6336, PC_B = 6344;
constexpr int MLAK = 640, MLAN = 1792;
constexpr float EPS = 1e-6f;
constexpr int MAXROWS_MOE = 2 * SEQ + NEXP * 256;
enum { I_X, I_C, I_CTX, I_CCTX, I_N1W, I_N2W, I_MODW, I_MODB, I_WIN, I_WOUT, I_GCONV, I_GALOG, I_GDT, I_GNW, I_MQN, I_MUQ, I_MKVN, I_MUKV,
       I_HCONV, I_HW1, I_HB1, I_HW2, I_HB2, I_HW3, I_HB3, I_HW4, I_HFREQ, I_HBIAS, I_FW1, I_FW3, I_FW2, I_ROUTER, I_MW1, I_MW3, I_MW2, I_FNW, N_IN };

struct Params {
    const float* in[N_IN];
    float* out;
    unsigned* bar; unsigned* cnt;
    float* modv;
    bf16_t *wb_in, *wb_out, *wb_mla, *wb_f13, *wb_f2, *wb_m13, *wb_m2;
    float *hfilt, *hsum, *hfc, *hsc;
    float* xcur; bf16_t* hbuf;
    bf16_t* Pp; bf16_t* gqkv; float* ggb; bf16_t* rqk; float* mrs; bf16_t* krr; bf16_t* qkvup;
    float *go, *ro; float* hys; bf16_t* ocat; bf16_t* act; bf16_t* act_moe;
    bf16_t* hg; bf16_t* yb; int* tok_r; float* tok_w; int* tok_e; int* tok_p;
};

__device__ __forceinline__ int otid() { int t = threadIdx.x; asm volatile("" : "+v"(t)); return t; }
__device__ __forceinline__ unsigned cvt_pk_bf16(float lo, float hi) { unsigned r; asm volatile("v_cvt_pk_bf16_f32 %0, %1, %2" : "=v"(r) : "v"(lo), "v"(hi)); return r; }
__device__ __forceinline__ bf16_t f2bf(float x) { return (bf16_t)(cvt_pk_bf16(x, 0.f) & 0xffffu); }
__device__ __forceinline__ float bf2f(bf16_t b) { return __uint_as_float(((unsigned)b) << 16); }
__device__ __forceinline__ float bflo(unsigned w) { return __uint_as_float(w << 16); }
__device__ __forceinline__ float bfhi(unsigned w) { return __uint_as_float(w & 0xffff0000u); }
__device__ __forceinline__ float silu_f(float x) { return x / (1.f + __expf(-x)); }
__device__ __forceinline__ float sigmoid_f(float x) { return 1.f / (1.f + __expf(-x)); }
__device__ __forceinline__ float softplus_f(float x) { return fmaxf(x, 0.f) + log1pf(__expf(-fabsf(x))); }
__device__ __forceinline__ float wave_sum(float v) {
#pragma unroll
    for (int o = 32; o >= 1; o >>= 1) v += __shfl_xor(v, o);
    return v;
}
__device__ __forceinline__ float sum16(float v) {
#pragma unroll
    for (int o = 8; o >= 1; o >>= 1) v += __shfl_xor(v, o);
    return v;
}
__device__ __forceinline__ void unpack8(u32x4 w, float (&f)[8]) {
    f[0] = bflo(w.x); f[1] = bfhi(w.x); f[2] = bflo(w.y); f[3] = bfhi(w.y); f[4] = bflo(w.z); f[5] = bfhi(w.z); f[6] = bflo(w.w); f[7] = bfhi(w.w);
}
__device__ __forceinline__ u32x4 pack8(const float (&f)[8]) {
    u32x4 w; w.x = cvt_pk_bf16(f[0], f[1]); w.y = cvt_pk_bf16(f[2], f[3]); w.z = cvt_pk_bf16(f[4], f[5]); w.w = cvt_pk_bf16(f[6], f[7]); return w;
}

namespace pg8 {
constexpr int BM = 256, BK = 64, HALF = 128, HTB = HALF * BK * 2, STAGE_BYTES = 8 * HTB, NXCD = 8, WGM = 8;
__host__ __device__ __forceinline__ int lds_byte(int r, int c) { const int st = (r >> 4) * 2 + (c >> 5), rr = r & 15, cc = c & 31, ob = rr * 64 + cc * 2; return st * 1024 + (ob ^ (((ob >> 9) & 1) << 5)); }
__host__ __device__ __forceinline__ void stage_rc(int b, int& R, int& C) { const int st = b / 1024, sb = b % 1024, swz = sb ^ (((sb >> 9) & 1) << 5); R = (st >> 1) * 16 + swz / 64; C = (st & 1) * 32 + (swz % 64) / 2; }
__host__ __device__ __forceinline__ int perm32(int rho) { const int n = rho >> 4, i = rho & 15; return 8 * (i >> 2) + 4 * n + (i & 3); }
struct Unit { int pm, pn, e; };
struct Gemm { const bf16_t* A; const bf16_t* Bt; int K, lda, ldb; size_t estride; };

struct StaticOrder {
    int nM, nN, nwg, G, c;
    __device__ void init(int M, int N, int G_, int c_) { nM = M / BM; nN = N / BM; nwg = nM * nN; G = G_; c = c_; }
    __device__ bool next(int i, Unit& u) const {
        const long L = (long)i * G + c; if (L >= nwg) return false;
        int wgid = (int)L; { const int q = nwg / NXCD, r = nwg % NXCD, xcd = wgid % NXCD, off = wgid / NXCD; wgid = (xcd < r ? xcd * (q + 1) : r * (q + 1) + (xcd - r) * q) + off; }
        const int nig = WGM * nN, gid = wgid / nig, fm = gid * WGM, gsz = (nM - fm) < WGM ? (nM - fm) : WGM;
        u.pm = fm + ((wgid % nig) % gsz); u.pn = (wgid % nig) / gsz; u.e = 0; return true;
    }
    __device__ __forceinline__ void a_ready(const Unit&) const {}
    __device__ __forceinline__ void done(const Unit&) const {}
};
struct GroupedOrder {
    int pb[NEXP + 1]; int nN, nwg, G, c;
    __device__ void init(const unsigned* cnt, int N, int G_, int c_) {
        int acc = 0;
#pragma unroll
        for (int e = 0; e < NEXP; ++e) { pb[e] = acc; acc += ((int)cnt[e] + 255) >> 8; }
        pb[NEXP] = acc; nN = N / BM; nwg = acc * nN; G = G_; c = c_;
    }
    __device__ bool next(int i, Unit& u) const {
        const long L = (long)i * G + c; if (L >= nwg) return false;
        const int np = pb[NEXP]; u.pn = (int)(L / np); u.pm = (int)(L % np);
        int e = 0;
#pragma unroll
        for (int k = 1; k < NEXP; ++k) e += (u.pm >= pb[k]) ? 1 : 0;
        u.e = e; return true;
    }
    __device__ __forceinline__ void a_ready(const Unit&) const {}
    __device__ __forceinline__ void done(const Unit&) const {}
};

template <class Epi, class Sched>
__device__ __forceinline__ void gemm_phase(LAS unsigned char* lds, const Gemm g, const Sched& S, const Epi& E) {
    const int tid = otid(), wid = __builtin_amdgcn_readfirstlane(tid >> 6), lane = tid & 63, wr = wid >> 2, wc = wid & 3, fr = lane & 15, fq = lane >> 4;
    const int K = g.K, nt = K / BK;
    unsigned voffA[2], voffB[2];
#pragma unroll
    for (int i = 0; i < 2; ++i) { int R, C; stage_rc(tid * 16 + i * 8192, R, C); const int Rb = Epi::PERM ? ((R & ~31) + perm32(R & 31)) : R;
        voffA[i] = (unsigned)(R * g.lda + C) * 2u; voffB[i] = (unsigned)(Rb * g.ldb + C) * 2u; }
    const size_t kstep = (size_t)(BK * 2);
    const size_t hstepA = (size_t)HALF * g.lda * 2, hstepB = (size_t)HALF * g.ldb * 2;
    const size_t tstepA = 2 * hstepA, tstepB = 2 * hstepB;
    const unsigned ldsw = (unsigned)wid * 1024u;
    const int aoff = lds_byte(wr * 64 + fr, fq * 8), boff = lds_byte(wc * 32 + fr, fq * 8);
#define PG8_SA(b, h) (((b) * 2 + (h)) * HTB)
#define PG8_SB(b, h) ((4 + (b) * 2 + (h)) * HTB)
#define PG8_STAGE(bufoff, gbase, voff) do { _Pragma("unroll") for (int _i = 0; _i < 2; ++_i) \
        __builtin_amdgcn_global_load_lds((const unsigned*)((const char*)(gbase) + (voff)[_i]), (LAS unsigned*)(lds + (bufoff) + ldsw + _i * 8192), 16, 0, 0); } while (0)
#define PG8_LDA(dst, b, h) do { _Pragma("unroll") for (int m = 0; m < 4; ++m) _Pragma("unroll") for (int k = 0; k < 2; ++k) dst[m][k] = *(const LAS bf16x8*)(lds + PG8_SA(b, h) + aoff + m * 2048 + k * 1024); } while (0)
#define PG8_LDB(dst, b, h) do { _Pragma("unroll") for (int n = 0; n < 2; ++n) _Pragma("unroll") for (int k = 0; k < 2; ++k) dst[n][k] = *(const LAS bf16x8*)(lds + PG8_SB(b, h) + boff + n * 2048 + k * 1024); } while (0)
#define PG8_MMA(ai, bj, At, Bt) do { __builtin_amdgcn_s_setprio(1); _Pragma("unroll") for (int m = 0; m < 4; ++m) _Pragma("unroll") for (int n = 0; n < 2; ++n) _Pragma("unroll") for (int k = 0; k < 2; ++k) \
        acc[ai][bj][m][n] = __builtin_amdgcn_mfma_f32_16x16x32_bf16(Bt[n][k], At[m][k], acc[ai][bj][m][n], 0, 0, 0); __builtin_amdgcn_s_setprio(0); } while (0)
#define PG8_WAIT_V(n) asm volatile("s_waitcnt vmcnt(" #n ")" ::: "memory")
#define PG8_WAIT_L(n) asm volatile("s_waitcnt lgkmcnt(" #n ")" ::: "memory")
#define PG8_BAR __builtin_amdgcn_s_barrier()
#define PG8_SCHED __builtin_amdgcn_sched_barrier(0)
    Unit cur, nxt; int ui = 0;
    if (!S.next(0, cur)) return;
    f32x4 acc[2][2][4][2];
#pragma unroll
    for (int a = 0; a < 2; ++a)
#pragma unroll
        for (int b = 0; b < 2; ++b)
#pragma unroll
            for (int m = 0; m < 4; ++m)
#pragma unroll
                for (int n = 0; n < 2; ++n) acc[a][b][m][n] = (f32x4){0.f, 0.f, 0.f, 0.f};
    bf16x8 At[4][2], B0[2][2], B1[2][2];
    const char* cA = (const char*)g.A + (size_t)cur.pm * tstepA; const char* cB = (const char*)g.Bt + (size_t)cur.pn * tstepB + (size_t)cur.e * g.estride * 2;
    S.a_ready(cur);
    PG8_STAGE(PG8_SB(0, 0), cB, voffB); PG8_STAGE(PG8_SA(0, 0), cA, voffA); PG8_STAGE(PG8_SB(0, 1), cB + hstepB, voffB); PG8_STAGE(PG8_SA(0, 1), cA + hstepA, voffA);
    if (wr == 1) PG8_BAR;
    PG8_WAIT_V(4); PG8_BAR;
    PG8_STAGE(PG8_SB(1, 0), cB + kstep, voffB); PG8_STAGE(PG8_SA(1, 0), cA + kstep, voffA); PG8_STAGE(PG8_SB(1, 1), cB + hstepB + kstep, voffB);
    PG8_WAIT_V(6); PG8_BAR;
    for (;;) {
        const bool has_next = S.next(ui + 1, nxt);
        const char* nA = has_next ? (const char*)g.A + (size_t)nxt.pm * tstepA : cA;
        const char* nB = has_next ? (const char*)g.Bt + (size_t)nxt.pn * tstepB + (size_t)nxt.e * g.estride * 2 : cB;
        for (int t = 0; t < nt; t += 2) {
            const bool last = (t == nt - 2);
            const char* a1 = cA + (size_t)(t + 1) * kstep;
            const char* a2 = last ? nA : cA + (size_t)(t + 2) * kstep; const char* b2 = last ? nB : cB + (size_t)(t + 2) * kstep;
            const char* a3 = a2 + kstep; const char* b3 = b2 + kstep;
            if (last && has_next) S.a_ready(nxt);
            PG8_LDB(B0, 0, 0); PG8_SCHED; PG8_LDA(At, 0, 0); PG8_STAGE(PG8_SA(1, 1), a1 + hstepA, voffA);
            PG8_WAIT_L(8); PG8_BAR; PG8_WAIT_L(0); PG8_MMA(0, 0, At, B0); PG8_BAR; PG8_SCHED;
            PG8_LDB(B1, 0, 1); PG8_STAGE(PG8_SB(0, 0), b2, voffB);
            PG8_BAR; PG8_WAIT_L(0); PG8_MMA(0, 1, At, B1); PG8_BAR;
            PG8_LDA(At, 0, 1); PG8_STAGE(PG8_SA(0, 0), a2, voffA);
            PG8_BAR; PG8_WAIT_L(0); PG8_MMA(1, 0, At, B0); PG8_BAR; PG8_SCHED;
            PG8_STAGE(PG8_SB(0, 1), b2 + hstepB, voffB);
            PG8_WAIT_V(6); PG8_BAR; PG8_MMA(1, 1, At, B1); PG8_BAR;
            PG8_LDB(B0, 1, 0); PG8_SCHED; PG8_LDA(At, 1, 0); PG8_STAGE(PG8_SA(0, 1), a2 + hstepA, voffA);
            PG8_WAIT_L(8); PG8_BAR; PG8_WAIT_L(0); PG8_MMA(0, 0, At, B0); PG8_BAR; PG8_SCHED;
            PG8_LDB(B1, 1, 1); PG8_STAGE(PG8_SB(1, 0), b3, voffB);
            PG8_BAR; PG8_WAIT_L(0); PG8_MMA(0, 1, At, B1); PG8_BAR;
            PG8_LDA(At, 1, 1); PG8_STAGE(PG8_SA(1, 0), a3, voffA);
            PG8_BAR; PG8_WAIT_L(0); PG8_MMA(1, 0, At, B0); PG8_BAR; PG8_SCHED;
            PG8_STAGE(PG8_SB(1, 1), b3 + hstepB, voffB);
            PG8_WAIT_V(6); PG8_BAR; PG8_MMA(1, 1, At, B1); PG8_BAR;
        }
        E(acc, cur, wr, wc, fr, fq); S.done(cur);
        if (!has_next) break;
#pragma unroll
        for (int a = 0; a < 2; ++a)
#pragma unroll
            for (int b = 0; b < 2; ++b)
#pragma unroll
                for (int m = 0; m < 4; ++m)
#pragma unroll
                    for (int n = 0; n < 2; ++n) acc[a][b][m][n] = (f32x4){0.f, 0.f, 0.f, 0.f};
        cur = nxt; cA = nA; cB = nB; ++ui;
    }
    PG8_WAIT_V(0);
    if (wr == 0) PG8_BAR;
    PG8_BAR;
#undef PG8_SA
#undef PG8_SB
#undef PG8_STAGE
#undef PG8_LDA
#undef PG8_LDB
#undef PG8_MMA
#undef PG8_WAIT_V
#undef PG8_WAIT_L
#undef PG8_BAR
#undef PG8_SCHED
}

struct EpiStoreBf16 {
    static constexpr bool PERM = true;
    bf16_t* O; int ldc; const float* rs; int rs_split;
    __device__ __forceinline__ void operator()(const f32x4 (&acc)[2][2][4][2], const Unit& u, int wr, int wc, int fr, int fq) const {
        const int row0 = u.pm * BM + wr * 64 + fr, col0 = u.pn * BM + wc * 32 + 8 * fq;
        const int sel = (u.pn >= rs_split) ? 1 : 0;
#pragma unroll
        for (int ai = 0; ai < 2; ++ai)
#pragma unroll
            for (int m = 0; m < 4; ++m) { const int row = row0 + ai * HALF + m * 16; bf16_t* rowp = O + (size_t)row * ldc + col0;
                const float sc = rs ? rs[row * 2 + sel] : 1.f;
#pragma unroll
                for (int bj = 0; bj < 2; ++bj) { const f32x4 v0 = acc[ai][bj][m][0] * sc, v1 = acc[ai][bj][m][1] * sc;
                    u32x4 w; w.x = cvt_pk_bf16(v0[0], v0[1]); w.y = cvt_pk_bf16(v0[2], v0[3]); w.z = cvt_pk_bf16(v1[0], v1[1]); w.w = cvt_pk_bf16(v1[2], v1[3]);
                    *(u32x4*)(rowp + bj * HALF) = w; } }
    }
};
struct EpiResGate {
    static constexpr bool PERM = false;
    float* out; const float* res_ctx; const float* res_lat; const float* gate_ctx; const float* gate_lat; int rowbase;
    __device__ __forceinline__ void operator()(const f32x4 (&acc)[2][2][4][2], const Unit& u, int wr, int wc, int fr, int fq) const {
        const int row0 = rowbase + u.pm * BM + wr * 64 + fr, col0 = u.pn * BM + wc * 32 + 4 * fq;
#pragma unroll
        for (int ai = 0; ai < 2; ++ai)
#pragma unroll
            for (int m = 0; m < 4; ++m) { const int row = row0 + ai * HALF + m * 16; const bool isc = row < LC;
                const float* rp = isc ? res_ctx + (size_t)row * D_ : res_lat + (size_t)(row - LC) * D_; const float* gp = isc ? gate_ctx : gate_lat;
                float* op = out + (size_t)row * D_;
#pragma unroll
                for (int bj = 0; bj < 2; ++bj)
#pragma unroll
                    for (int n = 0; n < 2; ++n) { const int c = col0 + bj * HALF + n * 16; const f32x4 r4 = *(const f32x4*)(rp + c), g4 = *(const f32x4*)(gp + c);
                        *(f32x4*)(op + c) = r4 + g4 * acc[ai][bj][m][n]; } }
    }
};
struct EpiSwiGLU {
    static constexpr bool PERM = true;
    bf16_t* O; int ldc;
    __device__ __forceinline__ void operator()(const f32x4 (&acc)[2][2][4][2], const Unit& u, int wr, int wc, int fr, int fq) const {
        const int row0 = u.pm * BM + wr * 64 + fr, col0 = u.pn * HALF + wc * 32 + 8 * fq;
#pragma unroll
        for (int ai = 0; ai < 2; ++ai)
#pragma unroll
            for (int m = 0; m < 4; ++m) { bf16_t* rowp = O + (size_t)(row0 + ai * HALF + m * 16) * ldc + col0;
                float o[8];
#pragma unroll
                for (int n = 0; n < 2; ++n)
#pragma unroll
                    for (int j = 0; j < 4; ++j) { const float gte = acc[ai][0][m][n][j], up = acc[ai][1][m][n][j]; o[n * 4 + j] = silu_f(gte) * up; }
                *(u32x4*)rowp = pack8(o); }
    }
};
}
#ifndef FFT_DEV_H
#define FFT_DEV_H
#ifndef FFT_HOST
#define FFT_FN __device__ __forceinline__
struct cpx { float x, y; };
FFT_FN void tw(float frac, float& c, float& s) { c = __builtin_amdgcn_cosf(frac); s = __builtin_amdgcn_sinf(frac); }
#else
#include <cmath>
#define FFT_FN static inline
struct cpx { float x, y; };
FFT_FN void tw(float frac, float& c, float& s) { c = (float)cos(6.283185307179586 * (double)frac); s = (float)sin(6.283185307179586 * (double)frac); }
#endif
#define ZP(i) ((i) + (((i) >> 6) << 2))
constexpr int FFT_N = 16384;
constexpr int FFT_ZN = FFT_N + 4 * (FFT_N / 64);

FFT_FN void bf_dif(cpx& a, cpx& b, float c, float s) {
    const float dx = a.x - b.x, dy = a.y - b.y;
    a.x += b.x; a.y += b.y;
    b.x = dx * c + dy * s; b.y = dy * c - dx * s;
}
FFT_FN void bf_dit(cpx& a, cpx& b, float c, float s) {
    const float tx = b.x * c - b.y * s, ty = b.x * s + b.y * c;
    b.x = a.x - tx; b.y = a.y - ty; a.x += tx; a.y += ty;
}
template <int K16> FFT_FN void rot16(float c0, float s0, float& c, float& s) {
    constexpr float CR[16] = {1.f, 0.9238795325112867f, 0.7071067811865476f, 0.3826834323650898f, 0.f, -0.3826834323650898f, -0.7071067811865476f, -0.9238795325112867f,
                              -1.f, -0.9238795325112867f, -0.7071067811865476f, -0.3826834323650898f, 0.f, 0.3826834323650898f, 0.7071067811865476f, 0.9238795325112867f};
    constexpr float SR[16] = {0.f, 0.3826834323650898f, 0.7071067811865476f, 0.9238795325112867f, 1.f, 0.9238795325112867f, 0.7071067811865476f, 0.3826834323650898f,
                              0.f, -0.3826834323650898f, -0.7071067811865476f, -0.9238795325112867f, -1.f, -0.9238795325112867f, -0.7071067811865476f, -0.3826834323650898f};
    constexpr float cr = CR[K16 & 15], sr = SR[K16 & 15];
    c = c0 * cr - s0 * sr; s = s0 * cr + c0 * sr;
}
#define FFT_BF(DIFDIT, ra, rb, K16, cb, sb) do { float _c, _s; rot16<K16>(cb, sb, _c, _s); DIFDIT(v[ra], v[rb], _c, _s); } while (0)
template <bool INV> FFT_FN void fft_pass16(cpx* Z, int g, int lm) {
    const int mp = 1 << lm, ilo = g & (mp - 1), ihi = g >> lm, base = (ihi << (lm + 4)) + ilo;
    cpx v[16];
#pragma unroll
    for (int r = 0; r < 16; ++r) v[r] = Z[ZP(base + r * mp)];
    const float th = (float)ilo / (float)(16 * mp);
    float cA, sA, cB, sB, cC, sC, cD, sD;
    tw(th, cA, sA); tw(2.f * th, cB, sB); tw(4.f * th, cC, sC); tw(8.f * th, cD, sD);
    if (!INV) {
        FFT_BF(bf_dif, 0, 8, 0, cA, sA); FFT_BF(bf_dif, 1, 9, 1, cA, sA); FFT_BF(bf_dif, 2, 10, 2, cA, sA); FFT_BF(bf_dif, 3, 11, 3, cA, sA);
        FFT_BF(bf_dif, 4, 12, 4, cA, sA); FFT_BF(bf_dif, 5, 13, 5, cA, sA); FFT_BF(bf_dif, 6, 14, 6, cA, sA); FFT_BF(bf_dif, 7, 15, 7, cA, sA);
        FFT_BF(bf_dif, 0, 4, 0, cB, sB); FFT_BF(bf_dif, 1, 5, 2, cB, sB); FFT_BF(bf_dif, 2, 6, 4, cB, sB); FFT_BF(bf_dif, 3, 7, 6, cB, sB);
        FFT_BF(bf_dif, 8, 12, 0, cB, sB); FFT_BF(bf_dif, 9, 13, 2, cB, sB); FFT_BF(bf_dif, 10, 14, 4, cB, sB); FFT_BF(bf_dif, 11, 15, 6, cB, sB);
        FFT_BF(bf_dif, 0, 2, 0, cC, sC); FFT_BF(bf_dif, 1, 3, 4, cC, sC); FFT_BF(bf_dif, 4, 6, 0, cC, sC); FFT_BF(bf_dif, 5, 7, 4, cC, sC);
        FFT_BF(bf_dif, 8, 10, 0, cC, sC); FFT_BF(bf_dif, 9, 11, 4, cC, sC); FFT_BF(bf_dif, 12, 14, 0, cC, sC); FFT_BF(bf_dif, 13, 15, 4, cC, sC);
#pragma unroll
        for (int r = 0; r < 16; r += 2) bf_dif(v[r], v[r + 1], cD, sD);
    } else {
#pragma unroll
        for (int r = 0; r < 16; r += 2) bf_dit(v[r], v[r + 1], cD, sD);
        FFT_BF(bf_dit, 0, 2, 0, cC, sC); FFT_BF(bf_dit, 1, 3, 4, cC, sC); FFT_BF(bf_dit, 4, 6, 0, cC, sC); FFT_BF(bf_dit, 5, 7, 4, cC, sC);
        FFT_BF(bf_dit, 8, 10, 0, cC, sC); FFT_BF(bf_dit, 9, 11, 4, cC, sC); FFT_BF(bf_dit, 12, 14, 0, cC, sC); FFT_BF(bf_dit, 13, 15, 4, cC, sC);
        FFT_BF(bf_dit, 0, 4, 0, cB, sB); FFT_BF(bf_dit, 1, 5, 2, cB, sB); FFT_BF(bf_dit, 2, 6, 4, cB, sB); FFT_BF(bf_dit, 3, 7, 6, cB, sB);
        FFT_BF(bf_dit, 8, 12, 0, cB, sB); FFT_BF(bf_dit, 9, 13, 2, cB, sB); FFT_BF(bf_dit, 10, 14, 4, cB, sB); FFT_BF(bf_dit, 11, 15, 6, cB, sB);
        FFT_BF(bf_dit, 0, 8, 0, cA, sA); FFT_BF(bf_dit, 1, 9, 1, cA, sA); FFT_BF(bf_dit, 2, 10, 2, cA, sA); FFT_BF(bf_dit, 3, 11, 3, cA, sA);
        FFT_BF(bf_dit, 4, 12, 4, cA, sA); FFT_BF(bf_dit, 5, 13, 5, cA, sA); FFT_BF(bf_dit, 6, 14, 6, cA, sA); FFT_BF(bf_dit, 7, 15, 7, cA, sA);
    }
#pragma unroll
    for (int r = 0; r < 16; ++r) Z[ZP(base + r * mp)] = v[r];
}
template <bool INV> FFT_FN void fft_pass4(cpx* Z, int g) {
    const int base = 4 * g;
    cpx a = Z[ZP(base)], b = Z[ZP(base + 1)], c = Z[ZP(base + 2)], d = Z[ZP(base + 3)];
    if (!INV) {
        cpx a2 = {a.x + c.x, a.y + c.y}, c2 = {a.x - c.x, a.y - c.y};
        cpx b2 = {b.x + d.x, b.y + d.y}, t = {b.x - d.x, b.y - d.y}; cpx d2 = {t.y, -t.x};
        a = {a2.x + b2.x, a2.y + b2.y}; b = {a2.x - b2.x, a2.y - b2.y};
        c = {c2.x + d2.x, c2.y + d2.y}; d = {c2.x - d2.x, c2.y - d2.y};
    } else {
        cpx a2 = {a.x + b.x, a.y + b.y}, b2 = {a.x - b.x, a.y - b.y};
        cpx c2 = {c.x + d.x, c.y + d.y}, d2 = {c.x - d.x, c.y - d.y};
        a = {a2.x + c2.x, a2.y + c2.y}; c = {a2.x - c2.x, a2.y - c2.y};
        cpx t = {-d2.y, d2.x};
        b = {b2.x + t.x, b2.y + t.y}; d = {b2.x - t.x, b2.y - t.y};
    }
    Z[ZP(base)] = a; Z[ZP(base + 1)] = b; Z[ZP(base + 2)] = c; Z[ZP(base + 3)] = d;
}
FFT_FN int rev14(int p) {
#ifndef FFT_HOST
    return (int)(__builtin_bitreverse32((unsigned)p) >> 18);
#else
    int r = 0; for (int b = 0; b < 14; ++b) r |= ((p >> b) & 1) << (13 - b); return r;
#endif
}
FFT_FN int ilog2(int q) {
#ifndef FFT_HOST
    return 31 - __builtin_clz((unsigned)q);
#else
    int b = 0; while ((1 << (b + 1)) <= q) ++b; return b;
#endif
}
FFT_FN void fft_pointwise(cpx* Z, const cpx* Zh, int q) {
    if (q == 0) {
#pragma unroll
        for (int p0 = 0; p0 < 2; ++p0) {
            const cpx a = Z[ZP(p0)], h = Zh[p0];
            const float ue = a.x, uo = a.y, he = h.x, ho = h.y, sg = p0 ? -1.f : 1.f;
            cpx o = {ue * he + sg * uo * ho, ue * ho + uo * he};
            Z[ZP(p0)] = o;
        }
        return;
    }
    const int b = ilog2(q), pp = (2 << b) + (q - (1 << b)), pq = 3 * (2 << b) - 1 - pp;
    const int kk = rev14(pp);
    float wc, ws; tw((float)kk * (1.0f / (float)FFT_N), wc, ws);
    const cpx A = Z[ZP(pp)], B = Z[ZP(pq)], HA = Zh[pp], HB = Zh[pq];
    const cpx Ue = {0.5f * (A.x + B.x), 0.5f * (A.y - B.y)};
    const cpx dU = {A.x - B.x, A.y + B.y};
    const cpx Uo = {0.5f * dU.y, -0.5f * dU.x};
    const cpx He = {0.5f * (HA.x + HB.x), 0.5f * (HA.y - HB.y)};
    const cpx dH = {HA.x - HB.x, HA.y + HB.y};
    const cpx Ho = {0.5f * dH.y, -0.5f * dH.x};
    const cpx UoHo = {Uo.x * Ho.x - Uo.y * Ho.y, Uo.x * Ho.y + Uo.y * Ho.x};
    const cpx wUH = {wc * UoHo.x + ws * UoHo.y, wc * UoHo.y - ws * UoHo.x};
    const cpx Ye = {Ue.x * He.x - Ue.y * He.y + wUH.x, Ue.x * He.y + Ue.y * He.x + wUH.y};
    const cpx Yo = {Ue.x * Ho.x - Ue.y * Ho.y + Uo.x * He.x - Uo.y * He.y, Ue.x * Ho.y + Ue.y * Ho.x + Uo.x * He.y + Uo.y * He.x};
    cpx o1 = {Ye.x - Yo.y, Ye.y + Yo.x};
    cpx o2 = {Ye.x + Yo.y, -Ye.y + Yo.x};
    Z[ZP(pp)] = o1; Z[ZP(pq)] = o2;
}
#endif
template <class F> __device__ __forceinline__ void tconv_tile(const F& f, bf16_t* dst, int K, int k0, int n0, float* tile  ) {
    const int tid = otid();
    { const int n = tid & 63, kb = tid >> 6;
#pragma unroll
      for (int i = 0; i < 8; ++i) { const int k = kb + 8 * i; tile[k * 65 + n] = f(k0 + k, n0 + n); } }
    __syncthreads();
    { const int nn = tid >> 3, kq = (tid & 7) * 8; float v[8];
#pragma unroll
      for (int e = 0; e < 8; ++e) v[e] = tile[(kq + e) * 65 + nn];
      *(u32x4*)(dst + (size_t)(n0 + nn) * K + k0 + kq) = pack8(v); }
    __syncthreads();
}
__device__ __forceinline__ int in_src_col(int n) {
    if (n < 2048) return n;
    if (n < 3584) return 2704 + (n - 2048);
    if (n < 5120) return 4240 + (n - 3584);
    if (n < 5632) return 5776 + (n - 5120);
    if (n < 6080) return 2064 + (n - 5632);
    if (n < 6144) return -1;
    if (n < 6272) return 2512 + (n - 6144);
    if (n < 6336) return 2640 + (n - 6272);
    if (n < 6344) return 2048 + (n - 6336);
    if (n < 6352) return 2056 + (n - 6344);
    return -1;
}
struct FWin { const float* src; __device__ __forceinline__ float operator()(int k, int n) const { const int c = in_src_col(n); return c < 0 ? 0.f : src[(size_t)k * DIN + c]; } };
struct FPlain { const float* src; int ld; __device__ __forceinline__ float operator()(int k, int n) const { return src[(size_t)k * ld + n]; } };
struct FMla { const float *uq, *ukv, *qn, *kvn;
    __device__ __forceinline__ float operator()(int k, int n) const {
        if (n < 768) return k < 448 ? uq[(size_t)k * 768 + n] * qn[k] : 0.f;
        return k >= 512 ? ukv[(size_t)(k - 512) * 1024 + (n - 768)] * kvn[k - 512] : 0.f; } };
struct FW13 { const float *w1, *w3;
    __device__ __forceinline__ float operator()(int k, int n) const { const int col = (n >> 8) * 128 + (n & 127);
        const uintptr_t d = (uintptr_t)w3 - (uintptr_t)w1; const float* b = (const float*)((uintptr_t)w1 + (((n >> 7) & 1) ? d : (uintptr_t)0));
        return b[(size_t)k * DFF + col]; } };

constexpr int T_WIN = (NP / 64) * (D_ / 64), T_WOUT = 32 * 32, T_MLA = (MLAN / 64) * (MLAK / 64), T_F13 = (2 * DFF / 64) * 32, T_F2 = 32 * (DFF / 64);
constexpr int U_MOD = 96, U_HF = 516, U_TR = 2 * T_WIN + 2 * T_WOUT + 2 * T_MLA + T_F13 + T_F2;
constexpr int U_PRO = U_MOD + U_HF + U_TR;

__device__ __forceinline__ void pro_mod_unit(const Params& p, int u, float* lds) {
    const int tid = otid(), wid = tid >> 6, lane = tid & 63;
    const int l = u / 48, cb = u % 48, col = cb * 256 + lane * 4;
    const float* W = p.in[I_MODW] + (size_t)l * D_ * (6 * D_) + col;
    const float* c = p.in[I_C]; const float* cc = p.in[I_CCTX];
    f32x4 al = {0, 0, 0, 0}, ac = {0, 0, 0, 0};
    const int k0 = wid * 256;
#pragma unroll 4
    for (int k = k0; k < k0 + 256; ++k) {
        const f32x4 w4 = *(const f32x4*)(W + (size_t)k * (6 * D_));
        const float sl = silu_f(c[k]), sc = silu_f(cc[k]);
        al += w4 * sl; ac += w4 * sc;
    }
    f32x4* red = (f32x4*)lds;
    red[(wid * 64 + lane) * 2] = al; red[(wid * 64 + lane) * 2 + 1] = ac;
    __syncthreads();
    if (wid == 0) {
        f32x4 sl = {0, 0, 0, 0}, sc = {0, 0, 0, 0};
#pragma unroll
        for (int w = 0; w < 8; ++w) { sl += red[(w * 64 + lane) * 2]; sc += red[(w * 64 + lane) * 2 + 1]; }
        const f32x4 b4 = *(const f32x4*)(p.in[I_MODB] + (size_t)l * 6 * D_ + col);
        *(f32x4*)(p.modv + ((size_t)l * 2 + 0) * 6 * D_ + col) = sl + b4;
        *(f32x4*)(p.modv + ((size_t)l * 2 + 1) * 6 * D_ + col) = sc + b4;
    }
    __syncthreads();
}

__device__ __forceinline__ void pro_hfilt_unit(const Params& p, int l, int Lf, int tb, float* hout, float* hsumo, float* lds) {
    const int tid = otid(), wid = tid >> 6, lane = tid & 63;
    float* zb = lds;
    float* H1 = lds + 64 * 36;
    float* H2 = H1 + 64 * 65;
    const int t0 = tb * 64;
    const float* w1 = p.in[I_HW1] + (size_t)l * 33 * 64; const float* b1 = p.in[I_HB1] + l * 64;
    const float* w2 = p.in[I_HW2] + (size_t)l * 64 * 64; const float* b2 = p.in[I_HB2] + l * 64;
    const float* w3 = p.in[I_HW3] + (size_t)l * 64 * 64; const float* b3 = p.in[I_HB3] + l * 64;
    const float* w4 = p.in[I_HW4] + (size_t)l * 64 * 1024; const float* fq = p.in[I_HFREQ] + l * 64;
    {
        const int tp = lane, part = wid; const float pf = (float)(t0 + tp);
        const float c0 = (float)(6.283185307179586 / (double)Lf);
#pragma unroll 1
        for (int e = part; e < 33; e += 8) {
            float v;
            if (e == 0) v = pf / (float)(Lf - 1);
            else { const int b = (e - 1) & 15; const float fr = 1e-4f + (float)b * ((15.0f - 1e-4f) / 15.0f); const float ang = (c0 * pf) * fr; v = (e <= 16) ? cosf(ang) : -sinf(ang); }
            zb[tp * 36 + e] = v;
        }
    }
    __syncthreads();
    {   const int tp = lane, j0 = wid * 8;
#pragma unroll 1
        for (int jj = 0; jj < 8; ++jj) { const int j = j0 + jj; float s = b1[j];
            for (int e = 0; e < 33; ++e) s += zb[tp * 36 + e] * w1[e * 64 + j];
            H1[tp * 65 + j] = sinf(fq[j] * s); }
    }
    __syncthreads();
    {   const int tp = lane, j0 = wid * 8;
#pragma unroll 1
        for (int jj = 0; jj < 8; ++jj) { const int j = j0 + jj; float s = b2[j];
            for (int i = 0; i < 64; ++i) s += H1[tp * 65 + i] * w2[i * 64 + j];
            H2[tp * 65 + j] = sinf(fq[j] * s); }
    }
    __syncthreads();
    {   const int tp = lane, j0 = wid * 8;
#pragma unroll 1
        for (int jj = 0; jj < 8; ++jj) { const int j = j0 + jj; float s = b3[j];
            for (int i = 0; i < 64; ++i) s += H2[tp * 65 + i] * w3[i * 64 + j];
            H1[tp * 65 + j] = sinf(fq[j] * s); }
    }
    __syncthreads();
    const int nblk = Lf / 64;
#pragma unroll 1
    for (int i = 0; i < 2; ++i) {
        const int c = (wid + 8 * i) * 64 + lane;
        float wreg[64];
#pragma unroll
        for (int j = 0; j < 64; ++j) wreg[j] = w4[j * 1024 + c];
        const float a0 = -120.39728043259361f, a1 = 40.546510810816436f;
        const float delta = fabsf(a0 + (float)c * ((a1 - a0) / 1023.0f));
        float asum = 0.f;
#pragma unroll 1
        for (int tp = 0; tp < 64; ++tp) {
            float s = 0.f;
#pragma unroll
            for (int j = 0; j < 64; ++j) s += H1[tp * 65 + j] * wreg[j];
            const float pf = (float)(t0 + tp), dist = fabsf(pf - (float)(Lf / 2)) / (float)Lf;
            const float val = s * expf(-dist * delta);
            hout[(size_t)c * Lf + t0 + tp] = val; asum += fabsf(val);
        }
        hsumo[(size_t)c * nblk + tb] = asum;
    }
    __syncthreads();
}

__device__ __forceinline__ void phase_prologue(const Params& p, float* lds) {
    if (blockIdx.x == 0 && otid() < 16) p.cnt[otid()] = 0u;
#pragma unroll 1
    for (int u = blockIdx.x; u < U_PRO; u += gridDim.x) {
        if (u < U_MOD) { pro_mod_unit(p, u, lds); continue; }
        int v = u - U_MOD;
        if (v < U_HF) {
            if (v < 512) { const int l = v >> 8, tb = v & 255; pro_hfilt_unit(p, l, SEQ, tb, p.hfilt + (size_t)l * 1024 * SEQ, p.hsum + (size_t)l * 1024 * 256, lds); }
            else pro_hfilt_unit(p, 0, LC, v - 512, p.hfc, p.hsc, lds);
            continue;
        }
        v -= U_HF;
        if (v < 2 * T_WIN) { const int l = v / T_WIN, t = v % T_WIN, nt = t / 32, kt = t % 32;
            FWin f{p.in[I_WIN] + (size_t)l * D_ * DIN}; tconv_tile(f, p.wb_in + (size_t)l * NP * D_, D_, kt * 64, nt * 64, lds); continue; }
        v -= 2 * T_WIN;
        if (v < 2 * T_WOUT) { const int l = v / T_WOUT, t = v % T_WOUT, nt = t / 32, kt = t % 32;
            FPlain f{p.in[I_WOUT] + (size_t)l * D_ * D_, D_}; tconv_tile(f, p.wb_out + (size_t)l * D_ * D_, D_, kt * 64, nt * 64, lds); continue; }
        v -= 2 * T_WOUT;
        if (v < 2 * T_MLA) { const int l = v / T_MLA, t = v % T_MLA, nt = t / 10, kt = t % 10;
            FMla f{p.in[I_MUQ] + (size_t)l * 448 * 768, p.in[I_MUKV] + (size_t)l * 128 * 1024, p.in[I_MQN] + l * 448, p.in[I_MKVN] + l * 128};
            tconv_tile(f, p.wb_mla + (size_t)l * MLAN * MLAK, MLAK, kt * 64, nt * 64, lds); continue; }
        v -= 2 * T_MLA;
        if (v < T_F13) { const int nt = v / 32, kt = v % 32; FW13 f{p.in[I_FW1], p.in[I_FW3]}; tconv_tile(f, p.wb_f13, D_, kt * 64, nt * 64, lds); continue; }
        v -= T_F13;
        { const int nt = v / 88, kt = v % 88; FPlain f{p.in[I_FW2], D_}; tconv_tile(f, p.wb_f2, DFF, kt * 64, nt * 64, lds); }
    }
}
constexpr int T_M13 = NEXP * T_F13, T_M2 = NEXP * T_F2, U_MOEW = T_M13 + T_M2;
__device__ __forceinline__ void moe_w_unit(const Params& p, int v, float* lds) {
    if (v < T_M13) { const int e = v / T_F13, t = v % T_F13, nt = t / 32, kt = t % 32;
        FW13 f{p.in[I_MW1] + (size_t)e * D_ * DFF, p.in[I_MW3] + (size_t)e * D_ * DFF}; tconv_tile(f, p.wb_m13 + (size_t)e * 2 * DFF * D_, D_, kt * 64, nt * 64, lds); return; }
    v -= T_M13;
    { const int e = v / T_F2, t = v % T_F2, nt = t / 88, kt = t % 88;
      FPlain f{p.in[I_MW2] + (size_t)e * DFF * D_, D_}; tconv_tile(f, p.wb_m2 + (size_t)e * D_ * DFF, DFF, kt * 64, nt * 64, lds); }
}

__device__ __forceinline__ void phase_norm(const Params& p, int layer, int which, int row_lo) {
    const int tid = otid(), wid = tid >> 6, lane = tid & 63;
    const float* nw = p.in[which == 1 ? I_N1W : I_N2W] + (size_t)layer * D_;
    const int csh = (which == 1 ? 0 : 3) * D_, csc = (which == 1 ? 1 : 4) * D_;
    const bool route = (layer == 1 && which == 2);
    for (int r = row_lo + blockIdx.x * 8 + wid; r < MT; r += gridDim.x * 8) {
        const bool isc = r < LC;
        const float* src = (layer == 0 && which == 1) ? (isc ? p.in[I_CTX] + (size_t)r * D_ : p.in[I_X] + (size_t)(r - LC) * D_) : p.xcur + (size_t)r * D_;
        const float* mv = p.modv + ((size_t)layer * 2 + (isc ? 1 : 0)) * 6 * D_;
        f32x4 xv[8]; float ss = 0.f;
#pragma unroll
        for (int i = 0; i < 8; ++i) { xv[i] = *(const f32x4*)(src + (i * 64 + lane) * 4); ss += xv[i][0] * xv[i][0] + xv[i][1] * xv[i][1] + xv[i][2] * xv[i][2] + xv[i][3] * xv[i][3]; }
        ss = wave_sum(ss);
        const float rstd = rsqrtf(ss * (1.0f / D_) + EPS);
        float lg[NEXP];
#pragma unroll
        for (int e = 0; e < NEXP; ++e) lg[e] = 0.f;
#pragma unroll
        for (int i = 0; i < 8; ++i) { const int col = (i * 64 + lane) * 4;
            const f32x4 w4 = *(const f32x4*)(nw + col), sh = *(const f32x4*)(mv + csh + col), sc = *(const f32x4*)(mv + csc + col);
            const f32x4 hv = (xv[i] * rstd) * w4 * (sc + 1.0f) + sh;
            u32x2 o; o.x = cvt_pk_bf16(hv[0], hv[1]); o.y = cvt_pk_bf16(hv[2], hv[3]);
            *(u32x2*)(p.hbuf + (size_t)r * D_ + col) = o;
            if (route) { const float* rt = p.in[I_ROUTER] + (size_t)col * NEXP;
#pragma unroll
                for (int j = 0; j < 4; ++j) { const f32x4 r0 = *(const f32x4*)(rt + j * NEXP), r1 = *(const f32x4*)(rt + j * NEXP + 4);
                    lg[0] += hv[j] * r0[0]; lg[1] += hv[j] * r0[1]; lg[2] += hv[j] * r0[2]; lg[3] += hv[j] * r0[3];
                    lg[4] += hv[j] * r1[0]; lg[5] += hv[j] * r1[1]; lg[6] += hv[j] * r1[2]; lg[7] += hv[j] * r1[3]; } }
        }
        if (route && !isc) {
#pragma unroll
            for (int e = 0; e < NEXP; ++e) lg[e] = wave_sum(lg[e]);
            if (lane == 0) {
                int e0 = 0; float v0 = lg[0];
#pragma unroll
                for (int e = 1; e < NEXP; ++e) if (lg[e] > v0) { v0 = lg[e]; e0 = e; }
                int e1 = -1; float v1 = -3.0e38f;
#pragma unroll
                for (int e = 0; e < NEXP; ++e) if (e != e0 && lg[e] > v1) { v1 = lg[e]; e1 = e; }
                const float w0 = 1.f / (1.f + expf(v1 - v0)), w1 = 1.f - w0;
                const int t = r - LC;
                const int p0 = (int)atomicAdd(&p.cnt[e0], 1u), p1 = (int)atomicAdd(&p.cnt[e1], 1u);
                p.tok_e[t * 2] = e0; p.tok_e[t * 2 + 1] = e1; p.tok_p[t * 2] = p0; p.tok_p[t * 2 + 1] = p1; p.tok_w[t * 2] = w0; p.tok_w[t * 2 + 1] = w1;
            }
        }
    }
}

__device__ __forceinline__ void phase_prep(const Params& p, int layer) {
    const int tid = otid(), wid = tid >> 6, lane = tid & 63;
    const float* gcw = p.in[I_GCONV] + (size_t)layer * 3 * 1536;
    const float LN1E4 = 9.210340371976184f;
    for (int r = blockIdx.x * 8 + wid; r < MT; r += gridDim.x * 8) {
        const bool isc = r < LC; const int t = r - LC;
        const bool hasp = isc ? (r > 0) : (r > LC), hasn = isc ? (r < LC - 1) : (r < MT - 1);
        const bf16_t* P0 = p.Pp + (size_t)r * NP;
#pragma unroll
        for (int i = 0; i < 3; ++i) {
            const int ch = i * 512 + lane * 8;
            float x0[8], xm[8], xn[8], y[8];
            unpack8(*(const u32x4*)(P0 + PC_GQKV + ch), x0);
            if (hasp) unpack8(*(const u32x4*)(P0 - NP + PC_GQKV + ch), xm); else { for (int e = 0; e < 8; ++e) xm[e] = 0.f; }
            if (hasn) unpack8(*(const u32x4*)(P0 + NP + PC_GQKV + ch), xn); else { for (int e = 0; e < 8; ++e) xn[e] = 0.f; }
            float ss = 0.f;
#pragma unroll
            for (int e = 0; e < 8; ++e) { const float v = gcw[ch + e] * xm[e] + gcw[1536 + ch + e] * x0[e] + gcw[3072 + ch + e] * xn[e]; y[e] = silu_f(v); ss += y[e] * y[e]; }
            if (i < 2) { ss = sum16(ss); const float rn = rsqrtf(ss + EPS) * (i == 0 ? 0.08838834764831845f : 1.f);
#pragma unroll
                for (int e = 0; e < 8; ++e) y[e] *= rn; }
            *(u32x4*)(p.gqkv + (size_t)r * 1536 + ch) = pack8(y);
        }
        if (lane < 8) {
            const float a = bf2f(P0[PC_A + lane]), b = bf2f(P0[PC_B + lane]);
            const float g = -expf(p.in[I_GALOG][layer * 8 + lane]) * softplus_f(a + p.in[I_GDT][layer * 8 + lane]);
            p.ggb[(size_t)r * 16 + lane] = g; p.ggb[(size_t)r * 16 + 8 + lane] = sigmoid_f(b);
        }
        {   float sq = 0.f, sk = 0.f;
            if (lane < 56) { float f[8]; unpack8(*(const u32x4*)(P0 + PC_CQ + lane * 8), f);
#pragma unroll
                for (int e = 0; e < 8; ++e) sq += f[e] * f[e]; }
            if (lane < 16) { float f[8]; unpack8(*(const u32x4*)(P0 + PC_CKV + lane * 8), f);
#pragma unroll
                for (int e = 0; e < 8; ++e) sk += f[e] * f[e]; }
            sq = wave_sum(sq); sk = wave_sum(sk);
            if (lane == 0) { p.mrs[(size_t)r * 2] = rsqrtf(sq * (1.0f / 448.f) + EPS); p.mrs[(size_t)r * 2 + 1] = rsqrtf(sk * (1.0f / 128.f) + EPS); }
        }
        if (lane < 32) {
            const int i = lane & 15, half = lane >> 4;
            const float x1 = bf2f(P0[PC_KR + half * 32 + i]), x2 = bf2f(P0[PC_KR + half * 32 + i + 16]);
            float o1 = x1, o2 = x2;
            if (!isc) { const float pos = (float)(half ? (t & 63) : (t >> 6)); const float inv = expf(-(float)i * (LN1E4 / 16.f)); float s, c; sincosf(pos * inv, &s, &c);
                o1 = x1 * c - x2 * s; o2 = x2 * c + x1 * s; }
            p.krr[(size_t)r * 64 + half * 32 + i] = f2bf(o1); p.krr[(size_t)r * 64 + half * 32 + i + 16] = f2bf(o2);
        }
        {   float s = 0.f, c = 1.f;
            if (!isc) { const float inv = expf(-(float)lane * (LN1E4 / 64.f)); sincosf((float)t * inv, &s, &c); }
#pragma unroll
            for (int it = 0; it < 8; ++it) { const int which = it >> 2, hd = it & 3; const int o = which * 512 + hd * 128 + lane;
                const float x1 = bf2f(P0[PC_RQKV + o]), x2 = bf2f(P0[PC_RQKV + o + 64]); const float sc = which ? 0.08838834764831845f : 1.f;
                p.rqk[(size_t)r * 1024 + o] = f2bf((x1 * c - x2 * s) * sc); p.rqk[(size_t)r * 1024 + o + 64] = f2bf((x2 * c + x1 * s) * sc); }
        }
    }
}
namespace att {
constexpr int NW = 8, QBLK = 32, KVBLK = 64, DK = 192, DV = 128;
constexpr float SCALE = 0.07216878364870322f;
constexpr float THR = 8.f;
constexpr int LDQ = MLAN, LDKN = MLAN, LDKR = 64, LDV = MLAN, LDO = D_;
constexpr int SHM_V = KVBLK * DV * 2, SHM_K = KVBLK * DK * 2, SHM_ATTN = 2 * SHM_V + 2 * SHM_K + NW * 64 * 4;
#define KSWZ(row, colB) ((row) * 384 + ((colB) ^ ((((row) >> 1) & 7) << 4)))
#define SBAR() __builtin_amdgcn_sched_barrier(0)
__device__ __forceinline__ int crow(int r, int hi) { return (r & 3) + 8 * (r >> 2) + 4 * hi; }
__device__ __forceinline__ void partialSM(f32x16& p0, f32x16& p1, float& m_reg, float& mn, float& alpha) {
    constexpr float C = SCALE * 1.4426950408889634f;
    float pmax = p0[0];
#pragma unroll
    for (int r = 1; r < 16; ++r) pmax = fmaxf(pmax, p0[r]);
#pragma unroll
    for (int r = 0; r < 16; ++r) pmax = fmaxf(pmax, p1[r]);
    { auto rr = __builtin_amdgcn_permlane32_swap(__float_as_uint(pmax), __float_as_uint(pmax), false, false);
      pmax = fmaxf(__uint_as_float(rr[0]), __uint_as_float(rr[1])); }
    if (__builtin_expect(__all(pmax - m_reg <= THR / SCALE), 1)) { mn = m_reg; alpha = 1.f; }
    else { mn = fmaxf(m_reg, pmax); alpha = __builtin_amdgcn_exp2f((m_reg - mn) * C); m_reg = mn; }
    const float mnC = -mn * C;
#pragma unroll
    for (int r = 0; r < 16; ++r) p0[r] = fmaf(p0[r], C, mnC);
#pragma unroll
    for (int r = 0; r < 16; ++r) p1[r] = fmaf(p1[r], C, mnC);
#pragma unroll
    for (int r = 0; r < 16; ++r) p0[r] = __builtin_amdgcn_exp2f(p0[r]);
}
__device__ __forceinline__ void finishSM(f32x16& p0, f32x16& p1, float alpha, float& l_reg, bf16x8& pa0, bf16x8& pa1, bf16x8& pa2, bf16x8& pa3) {
#pragma unroll
    for (int r = 0; r < 16; ++r) p1[r] = __builtin_amdgcn_exp2f(p1[r]);
    float ps = 0;
#pragma unroll
    for (int r = 0; r < 16; ++r) ps += p0[r];
#pragma unroll
    for (int r = 0; r < 16; ++r) ps += p1[r];
    { auto rr = __builtin_amdgcn_permlane32_swap(__float_as_uint(ps), __float_as_uint(ps), false, false);
      ps = __uint_as_float(rr[0]) + __uint_as_float(rr[1]); }
    l_reg = l_reg * alpha + ps;
#define PK4(P, BASE, OUT) do { unsigned a0 = cvt_pk_bf16(P[BASE + 0], P[BASE + 1]), a1 = cvt_pk_bf16(P[BASE + 2], P[BASE + 3]);   \
    unsigned b0 = cvt_pk_bf16(P[BASE + 4], P[BASE + 5]), b1 = cvt_pk_bf16(P[BASE + 6], P[BASE + 7]);                              \
    auto r0 = __builtin_amdgcn_permlane32_swap(a0, b0, false, false); auto r1 = __builtin_amdgcn_permlane32_swap(a1, b1, false, false); \
    u32x4 w = {r0[0], r1[0], r0[1], r1[1]}; OUT = *reinterpret_cast<bf16x8*>(&w); } while (0)
    PK4(p0, 0, pa0); PK4(p0, 8, pa1); PK4(p1, 0, pa2); PK4(p1, 8, pa3);
#undef PK4
}
__device__ __forceinline__ void qkt(f32x16& p0, f32x16& p1, const int (&ka)[4], int boff, const bf16x8* qr) {
    p0 = f32x16{}; p1 = f32x16{};
#pragma unroll
    for (int d0 = 0; d0 < 12; ++d0) { const int dl = d0 & 3, dh = d0 >> 2;
        const bf16x8 b0 = *(const LAS bf16x8*)(unsigned)(ka[dl] + (boff + dh * 128));
        const bf16x8 b1 = *(const LAS bf16x8*)(unsigned)(ka[dl] + (boff + dh * 128 + 32 * 384));
        p0 = __builtin_amdgcn_mfma_f32_32x32x16_bf16(b0, qr[d0], p0, 0, 0, 0);
        p1 = __builtin_amdgcn_mfma_f32_32x32x16_bf16(b1, qr[d0], p1, 0, 0, 0); }
}
__device__ __forceinline__ int v_st(int k, int c) { const int kk = (k & ~0xC) | ((k & 4) << 1) | ((k & 8) >> 1); return ((kk >> 3) * 4 + (c >> 5)) * 512 + ((kk & 7) * 32 + (c & 31)) * 2; }
__device__ __forceinline__ int v_rd_base(int lane) { return ((lane & 3) << 3) | (((lane >> 2) & 3) << 6) | (((lane >> 4) & 1) << 5) | (((lane >> 5) & 1) << 8); }
constexpr int v_rd_off(int d0, int ks, int half) { return d0 * 512 + ks * 4096 + half * 2048; }
template <int OFF> __device__ __forceinline__ s16x4 tr_read(int vb) {
    s16x4 r; asm volatile("ds_read_b64_tr_b16 %0, %1 offset:%2" : "=&v"(r) : "v"(vb), "i"(OFF) : "memory"); return r;
}
template <int D0> __device__ __forceinline__ void pv_one(f32x16& od, int vb, bf16x8 pa0, bf16x8 pa1, bf16x8 pa2, bf16x8 pa3) {
    const s16x4 l0 = tr_read<v_rd_off(D0, 0, 0)>(vb), h0 = tr_read<v_rd_off(D0, 0, 1)>(vb), l1 = tr_read<v_rd_off(D0, 1, 0)>(vb), h1 = tr_read<v_rd_off(D0, 1, 1)>(vb);
    const s16x4 l2 = tr_read<v_rd_off(D0, 2, 0)>(vb), h2 = tr_read<v_rd_off(D0, 2, 1)>(vb), l3 = tr_read<v_rd_off(D0, 3, 0)>(vb), h3 = tr_read<v_rd_off(D0, 3, 1)>(vb);
    asm volatile("s_waitcnt lgkmcnt(0)" ::: "memory"); SBAR();
#define PK(L, H) (bf16x8){L[0], L[1], L[2], L[3], H[0], H[1], H[2], H[3]}
    od = __builtin_amdgcn_mfma_f32_32x32x16_bf16(pa0, PK(l0, h0), od, 0, 0, 0);
    od = __builtin_amdgcn_mfma_f32_32x32x16_bf16(pa1, PK(l1, h1), od, 0, 0, 0);
    od = __builtin_amdgcn_mfma_f32_32x32x16_bf16(pa2, PK(l2, h2), od, 0, 0, 0);
    od = __builtin_amdgcn_mfma_f32_32x32x16_bf16(pa3, PK(l3, h3), od, 0, 0, 0);
#undef PK
}
__device__ __forceinline__ void pv_d0(f32x16* o, int vb, bf16x8 pa0, bf16x8 pa1, bf16x8 pa2, bf16x8 pa3) {
    pv_one<0>(o[0], vb, pa0, pa1, pa2, pa3); pv_one<1>(o[1], vb, pa0, pa1, pa2, pa3); pv_one<2>(o[2], vb, pa0, pa1, pa2, pa3); pv_one<3>(o[3], vb, pa0, pa1, pa2, pa3);
}
__device__ __forceinline__ void attn_body(const bf16_t* __restrict__ Qb, const bf16_t* __restrict__ Kn, const bf16_t* __restrict__ Kr, const bf16_t* __restrict__ Vh,
                                          bf16_t* __restrict__ Ob, int seq, int rope_t0, char* lds) {
    const int tid = otid(), wid = tid >> 6, lane = tid & 63, r32 = lane & 31, hi = lane >> 5;
    char* V_lds = lds; char* K_lds = lds + 2 * SHM_V;
    float* ws = (float*)(lds + 2 * SHM_V + 2 * SHM_K) + wid * 64; float* li_l = ws; float* al_l = ws + 32;
    float m_reg = -1e30f, l_reg = 0; f32x16 o[4] = {}; bf16x8 qr[12];
    const bf16_t* Qw = Qb + (long)(wid * QBLK + r32) * LDQ + hi * 8;
#pragma unroll
    for (int d0 = 0; d0 < 8; ++d0) qr[d0] = *reinterpret_cast<const bf16x8*>(Qw + d0 * 16);
    {
        bf16_t* Qr = (bf16_t*)(lds + SHM_ATTN);
#pragma unroll 1
        for (int it = 0; it < 16; ++it) { const int item = tid + it * 512, row = item >> 5, pr = item & 31, half = pr >> 4, i = pr & 15;
            const bf16_t* qp = Qb + (long)row * LDQ + 128 + half * 32 + i;
            const float x1 = bf2f(qp[0]), x2 = bf2f(qp[16]); float o1 = x1, o2 = x2;
            if (rope_t0 >= 0) { const int t = rope_t0 + row; const float pos = (float)(half ? (t & 63) : (t >> 6));
                const float inv = expf(-(float)i * (9.210340371976184f / 16.f)); float s, c; sincosf(pos * inv, &s, &c);
                o1 = x1 * c - x2 * s; o2 = x2 * c + x1 * s; }
            Qr[row * 64 + half * 32 + i] = f2bf(o1); Qr[row * 64 + half * 32 + i + 16] = f2bf(o2); }
        __syncthreads();
#pragma unroll
        for (int dd = 0; dd < 4; ++dd) qr[8 + dd] = *reinterpret_cast<const bf16x8*>(Qr + (wid * QBLK + r32) * 64 + dd * 16 + hi * 8);
    }
    const int sr = tid >> 4, sc = (tid & 15) * 8, vst0 = v_st(sr, sc), vst1 = v_st(32 + sr, sc);
    const int rr = tid >> 3, rc = (tid & 7) * 8;
    const int vb0 = (int)(uintptr_t)V_lds + v_rd_base(lane);
    int ka[4];
#pragma unroll
    for (int dl = 0; dl < 4; ++dl) ka[dl] = (int)(uintptr_t)K_lds + r32 * 384 + ((dl * 32 + hi * 16) ^ (((r32 >> 1) & 7) << 4));
    struct { bf16x8 vs0, vs1, ks0, ks1, kr; } sr_[1];
    const unsigned ovA = (unsigned)(sr * LDV + sc) * 2u, ovB = (unsigned)((32 + sr) * LDV + sc) * 2u, orr = (unsigned)(rr * LDKR + rc) * 2u;
#define SLOAD(i, k0) do { const char* vbp = (const char*)Vh + (size_t)(k0) * (LDV * 2); const char* kbp = (const char*)Kn + (size_t)(k0) * (LDKN * 2); const char* rbp = (const char*)Kr + (size_t)(k0) * (LDKR * 2); \
    sr_[i].vs0 = *(const bf16x8*)(vbp + ovA); sr_[i].vs1 = *(const bf16x8*)(vbp + ovB); \
    sr_[i].ks0 = *(const bf16x8*)(kbp + ovA); sr_[i].ks1 = *(const bf16x8*)(kbp + ovB); \
    sr_[i].kr = *(const bf16x8*)(rbp + orr); } while (0)
#define SWRITE(b, i) do { *(bf16x8*)(V_lds + (b) * SHM_V + vst0) = sr_[i].vs0; *(bf16x8*)(V_lds + (b) * SHM_V + vst1) = sr_[i].vs1; const int kc = sc * 2; \
    *(bf16x8*)(K_lds + (b) * SHM_K + KSWZ(sr, kc)) = sr_[i].ks0; *(bf16x8*)(K_lds + (b) * SHM_K + KSWZ(32 + sr, kc)) = sr_[i].ks1; \
    *(bf16x8*)(K_lds + (b) * SHM_K + KSWZ(rr, 256 + rc * 2)) = sr_[i].kr; } while (0)
#define SWAIT() asm volatile("s_waitcnt vmcnt(0)" ::: "memory")
#define RESC(a) do { if (__any((a) < 1.f)) { if (hi == 0) al_l[r32] = (a); asm volatile("s_waitcnt lgkmcnt(0)" ::: "memory"); \
    _Pragma("unroll") for (int d = 0; d < 4; ++d) _Pragma("unroll") for (int r = 0; r < 16; ++r) o[d][r] *= al_l[crow(r, hi)]; } } while (0)
    f32x16 pA0, pA1, pB0, pB1; float mnA, mnB, alA, alB; bf16x8 pa0, pa1, pa2, pa3; const int NT = seq / KVBLK;
    constexpr int SE = 0, SO = 0;
    SLOAD(SE, 0); asm volatile("s_waitcnt vmcnt(0)" ::: "memory"); SWRITE(0, SE); __syncthreads();
    qkt(pA0, pA1, ka, 0, qr); partialSM(pA0, pA1, m_reg, mnA, alA);
    SLOAD(SO, KVBLK);
    SWAIT(); SWRITE(1, SO); __syncthreads();
    for (int j = 1; j + 1 < NT; j += 2) {
        SBAR(); qkt(pB0, pB1, ka, SHM_K, qr);
        finishSM(pA0, pA1, alA, l_reg, pa0, pa1, pa2, pa3); SBAR();
        SLOAD(SO, (j + 1) * KVBLK); SBAR();
        pv_d0(o, vb0, pa0, pa1, pa2, pa3); partialSM(pB0, pB1, m_reg, mnB, alB);
        __syncthreads(); SWAIT(); SWRITE(0, SE);
        RESC(alB); __syncthreads();
        SBAR(); qkt(pA0, pA1, ka, 0, qr);
        finishSM(pB0, pB1, alB, l_reg, pa0, pa1, pa2, pa3); SBAR();
        SLOAD(SE, (j + 2) * KVBLK); SBAR();
        pv_d0(o, vb0 + SHM_V, pa0, pa1, pa2, pa3); partialSM(pA0, pA1, m_reg, mnA, alA);
        __syncthreads(); SWAIT(); SWRITE(1, SO);
        RESC(alA); __syncthreads();
    }
    SBAR(); qkt(pB0, pB1, ka, SHM_K, qr);
    finishSM(pA0, pA1, alA, l_reg, pa0, pa1, pa2, pa3); SBAR();
    pv_d0(o, vb0, pa0, pa1, pa2, pa3); partialSM(pB0, pB1, m_reg, mnB, alB);
    __syncthreads(); RESC(alB);
    finishSM(pB0, pB1, alB, l_reg, pa0, pa1, pa2, pa3); SBAR();
    pv_d0(o, vb0 + SHM_V, pa0, pa1, pa2, pa3);
    if (hi == 0) li_l[r32] = l_reg; asm volatile("s_waitcnt lgkmcnt(0)" ::: "memory");
    float rli[16];
#pragma unroll
    for (int r = 0; r < 16; ++r) rli[r] = __builtin_amdgcn_rcpf(li_l[crow(r, hi)]);
    bf16_t* Ow = Ob + (long)(wid * QBLK) * LDO;
#pragma unroll
    for (int r = 0; r < 16; ++r) { const int orow = crow(r, hi);
#pragma unroll
        for (int d0 = 0; d0 < 4; ++d0) Ow[(long)orow * LDO + d0 * 32 + r32] = f2bf(o[d0][r] * rli[r]); }
    __syncthreads();
#undef SLOAD
#undef SWRITE
#undef SWAIT
#undef RESC
}
}

__device__ __forceinline__ void phase_attn(const Params& p, int layer, char* lds) {
    const int nunits = 256 + (layer == 0 ? 4 : 0);
#pragma unroll 1
    for (int u = blockIdx.x; u < nunits; u += gridDim.x) {
        const bool lat = u < 256;
        const int xcd = u & 7, h = lat ? (xcd >> 1) : (u - 256), qb = (u >> 3) * 2 + (xcd & 1);
        const int row0 = lat ? LC + qb * 256 : 0;
        att::attn_body(p.qkvup + (size_t)row0 * MLAN + h * 192, p.qkvup + 768 + h * 256, p.krr, p.qkvup + 768 + h * 256 + 128,
                       p.ocat + (size_t)row0 * D_ + 512 + h * 128, lat ? MT : LC, lat ? qb * 256 : -1, lds);
    }
}

__device__ __forceinline__ void phase_rec_naive(const Params& p, int layer, float* lds) {
    const int tid = otid();
    float* kq = lds;
    float* vv = lds + 32 * 256;
    float* ab = vv + 32 * 128;
    for (int u = blockIdx.x; u < 16; u += gridDim.x) {
        const int kind = u >> 3, dir = (u >> 2) & 1, h = u & 3;
        float S[128];
#pragma unroll
        for (int i = 0; i < 128; ++i) S[i] = 0.f;
        const float gam = 1.0f - exp2f(-(float)((dir ? 6 : 5) + 2 * h));
        float* outp = (kind == 0 ? p.go : p.ro) + (size_t)dir * MT * 512 + h * 128;
        for (int s0 = 0; s0 < MT; s0 += 32) {
            __syncthreads();
            {   const int tk = tid >> 4, seg = (tid & 15) * 16; const int s = s0 + tk;
                const int row = dir == 0 ? s : (s < LC ? LC - 1 - s : MT + LC - 1 - s);
                const bf16_t* src;
                if (kind == 0) src = p.gqkv + (size_t)row * 1536 + (seg < 128 ? 512 + h * 128 + seg : h * 128 + (seg - 128));
                else           src = p.rqk + (size_t)row * 1024 + (seg < 128 ? 512 + h * 128 + seg : h * 128 + (seg - 128));
                float f[8]; unpack8(*(const u32x4*)src, f);
#pragma unroll
                for (int e = 0; e < 8; ++e) kq[tk * 256 + seg + e] = f[e];
                unpack8(*(const u32x4*)(src + 8), f);
#pragma unroll
                for (int e = 0; e < 8; ++e) kq[tk * 256 + seg + 8 + e] = f[e];
                const int vseg = (tid & 15) * 8;
                const bf16_t* vsrc = kind == 0 ? p.gqkv + (size_t)row * 1536 + 1024 + h * 128 + vseg : p.Pp + (size_t)row * NP + PC_RQKV + 1024 + h * 128 + vseg;
                unpack8(*(const u32x4*)vsrc, f);
#pragma unroll
                for (int e = 0; e < 8; ++e) vv[tk * 128 + vseg + e] = f[e];
                if (tid < 32) { const int s2 = s0 + tid; const int row2 = dir == 0 ? s2 : (s2 < LC ? LC - 1 - s2 : MT + LC - 1 - s2);
                    if (kind == 0) { ab[tid * 2] = expf(p.ggb[(size_t)row2 * 16 + dir * 4 + h]); ab[tid * 2 + 1] = p.ggb[(size_t)row2 * 16 + 8 + dir * 4 + h]; }
                    else { ab[tid * 2] = gam; ab[tid * 2 + 1] = 1.f; } }
            }
            __syncthreads();
            if (tid < 128) {
                for (int tk = 0; tk < 32; ++tk) {
                    const f32x4* kp = (const f32x4*)(kq + tk * 256); const f32x4* qp = kp + 32;
                    const float a = ab[tk * 2], b = ab[tk * 2 + 1], v = vv[tk * 128 + tid];
                    float dv;
                    if (kind == 0) { float ks = 0.f;
#pragma unroll
                        for (int i = 0; i < 32; ++i) { const f32x4 k4 = kp[i]; ks += k4[0] * S[4 * i] + k4[1] * S[4 * i + 1] + k4[2] * S[4 * i + 2] + k4[3] * S[4 * i + 3]; }
                        dv = b * (v - a * ks); }
                    else dv = v;
                    float o = 0.f;
#pragma unroll
                    for (int i = 0; i < 32; ++i) { const f32x4 k4 = kp[i], q4 = qp[i];
                        S[4 * i] = a * S[4 * i] + k4[0] * dv; S[4 * i + 1] = a * S[4 * i + 1] + k4[1] * dv; S[4 * i + 2] = a * S[4 * i + 2] + k4[2] * dv; S[4 * i + 3] = a * S[4 * i + 3] + k4[3] * dv;
                        o += q4[0] * S[4 * i] + q4[1] * S[4 * i + 1] + q4[2] * S[4 * i + 2] + q4[3] * S[4 * i + 3]; }
                    const int s = s0 + tk; const int row = dir == 0 ? s : (s < LC ? LC - 1 - s : MT + LC - 1 - s);
                    outp[(size_t)row * 512 + tid] = o;
                }
            }
        }
        __syncthreads();
    }
}

__device__ __forceinline__ void phase_mixout(const Params& p, int layer) {
    const int tid = otid(), wid = tid >> 6, lane = tid & 63;
    const float* gnw = p.in[I_GNW] + layer * 128;
    for (int r = blockIdx.x * 8 + wid; r < MT; r += gridDim.x * 8) {
        const int idx = lane * 8;
#pragma unroll
        for (int kind = 0; kind < 2; ++kind) {
            const float* o0 = (kind == 0 ? p.go : p.ro) + (size_t)r * 512 + idx; const float* o1 = o0 + (size_t)MT * 512;
            float o[8]; float ss = 0.f;
            { const f32x4 a0 = *(const f32x4*)o0, a1 = *(const f32x4*)(o0 + 4), b0 = *(const f32x4*)o1, b1 = *(const f32x4*)(o1 + 4);
#pragma unroll
              for (int e = 0; e < 4; ++e) { o[e] = a0[e] + b0[e]; o[4 + e] = a1[e] + b1[e]; } }
#pragma unroll
            for (int e = 0; e < 8; ++e) ss += o[e] * o[e];
            ss = sum16(ss);
            const float rn = rsqrtf(ss * (1.0f / 128.f) + EPS);
            float z[8]; unpack8(*(const u32x4*)(p.Pp + (size_t)r * NP + (kind == 0 ? PC_GZ : PC_RG) + idx), z);
            float y[8];
#pragma unroll
            for (int e = 0; e < 8; ++e) { const float w = kind == 0 ? gnw[(idx + e) & 127] : 1.f; y[e] = o[e] * rn * w * silu_f(z[e]); }
            *(u32x4*)(p.ocat + (size_t)r * D_ + (kind == 0 ? 0 : 1536) + idx) = pack8(y);
        }
    }
}
__device__ __forceinline__ void fft_fwd(cpx* Z, int tid) {
#pragma unroll 1
    for (int pass = 0; pass < 3; ++pass) { const int lm = pass == 0 ? 10 : (pass == 1 ? 6 : 2);

#pragma unroll 1
        for (int gi = 0; gi < 2; ++gi) fft_pass16<false>(Z, tid + gi * 512, lm);
        __syncthreads(); }
#pragma unroll 1
    for (int it = 0; it < 8; ++it) fft_pass4<false>(Z, tid + it * 512);
    __syncthreads();
}
__device__ __forceinline__ void fft_inv(cpx* Z, int tid) {
#pragma unroll 1
    for (int it = 0; it < 8; ++it) fft_pass4<true>(Z, tid + it * 512);
    __syncthreads();
#pragma unroll 1
    for (int pass = 0; pass < 3; ++pass) { const int lm = pass == 0 ? 2 : (pass == 1 ? 6 : 10);

#pragma unroll 1
        for (int gi = 0; gi < 2; ++gi) fft_pass16<true>(Z, tid + gi * 512, lm);
        __syncthreads(); }
}
constexpr size_t HY_SCR_FLOATS = 2 * 2 * (size_t)FFT_N + 4 * (size_t)SEQ;
__device__ __forceinline__ void hyena_latent_unit(const Params& p, int layer, int c, char* lds) {
    cpx* Z = (cpx*)lds; const int tid = otid(), lane = tid & 63;
    float* scr = p.hys + (size_t)blockIdx.x * HY_SCR_FLOATS;
    cpx* Zh1 = (cpx*)scr; cpx* Zh2 = Zh1 + FFT_N; float* vs = (float*)(Zh2 + FFT_N); float* x1s = vs + SEQ; float* x2s = x1s + SEQ; float* z1s = x2s + SEQ;
    const float* cw = p.in[I_HCONV] + (size_t)layer * 3 * 1536;
#pragma unroll
    for (int part = 0; part < 3; ++part) {
        const float w0 = cw[part * 512 + c], w1 = cw[1536 + part * 512 + c], w2 = cw[3072 + part * 512 + c];
        const bf16_t* col = p.Pp + (size_t)LC * NP + PC_HY + part * 512 + c;
        float* dst = part == 0 ? vs : (part == 1 ? x1s : x2s);
#pragma unroll 2
        for (int t = tid; t < SEQ; t += 512) {
            const float x0 = bf2f(col[(size_t)t * NP]);
            const float xm = t > 0 ? bf2f(col[(size_t)(t - 1) * NP]) : 0.f, xn = t < SEQ - 1 ? bf2f(col[(size_t)(t + 1) * NP]) : 0.f;
            dst[t] = w0 * xm + w1 * x0 + w2 * xn;
        }
    }
#pragma unroll 1
    for (int f = 0; f < 2; ++f) {
        const size_t ch = (size_t)layer * 1024 + f * 512 + c;
        const float* hsrc = p.hfilt + ch * SEQ;
        const f32x4 ps = *(const f32x4*)(p.hsum + ch * 256 + lane * 4);
        const float tot = wave_sum((ps[0] + ps[1]) + (ps[2] + ps[3]));
        const float scale = (1.0f / (tot + EPS)) * (1.0f / (float)FFT_N);
#pragma unroll 2
        for (int it = 0; it < 16; ++it) { const int j = tid + it * 512; const f32x2 hv = *(const f32x2*)(hsrc + 2 * j);
            Z[ZP(j)] = cpx{hv[0] * scale, hv[1] * scale}; Z[ZP(j + 8192)] = cpx{0.f, 0.f}; }
        __syncthreads();
        fft_fwd(Z, tid);
        cpx* Zh = f ? Zh2 : Zh1;
#pragma unroll 4
        for (int it = 0; it < 32; ++it) { const int q = tid + it * 512; Zh[q] = Z[ZP(q)]; }
        __syncthreads();
    }
    const float b0 = p.in[I_HBIAS][(size_t)layer * 1024 + c], b1 = p.in[I_HBIAS][(size_t)layer * 1024 + 512 + c];
#pragma unroll 2
    for (int it = 0; it < 16; ++it) { const int j = tid + it * 512; const f32x2 v2 = *(const f32x2*)(vs + 2 * j);
        Z[ZP(j)] = cpx{v2[0], v2[1]}; Z[ZP(j + 8192)] = cpx{0.f, 0.f}; }
    __syncthreads();
    fft_fwd(Z, tid);
#pragma unroll 1
    for (int it = 0; it < 16; ++it) fft_pointwise(Z, Zh1, tid + it * 512);
    __syncthreads();
    fft_inv(Z, tid);
#pragma unroll 1
    for (int half = 0; half < 2; ++half) {
#pragma unroll 2
        for (int it = 0; it < 8; ++it) { const int j = half * 4096 + tid + it * 512;
            const cpx y = Z[ZP(4096 + j)];
            const f32x2 v2 = *(const f32x2*)(vs + 2 * j), xx = *(const f32x2*)(x1s + 2 * j);
            const f32x2 z = {xx[0] * (y.x + b0 * v2[0]), xx[1] * (y.y + b0 * v2[1])};
            *(f32x2*)(z1s + 2 * j) = z; Z[ZP(j)] = cpx{z[0], z[1]};
            if (half) Z[ZP(4096 + j)] = cpx{0.f, 0.f};
            else Z[ZP(12288 + j)] = cpx{0.f, 0.f}; }
        __syncthreads();
    }
    __syncthreads();
    fft_fwd(Z, tid);
#pragma unroll 1
    for (int it = 0; it < 16; ++it) fft_pointwise(Z, Zh2, tid + it * 512);
    __syncthreads();
    fft_inv(Z, tid);
#pragma unroll 2
    for (int it = 0; it < 16; ++it) { const int j = tid + it * 512; const cpx y = Z[ZP(4096 + j)];
        const f32x2 z = *(const f32x2*)(z1s + 2 * j), x2 = *(const f32x2*)(x2s + 2 * j);
        bf16_t* op = p.ocat + (size_t)(LC + 2 * j) * D_ + 1024 + c;
        op[0] = f2bf(x2[0] * (y.x + b1 * z[0])); op[D_] = f2bf(x2[1] * (y.y + b1 * z[1])); }
    __syncthreads();
}
__device__ __forceinline__ void hyena_ctx_unit(const Params& p, int c, float* lds) {
    const int tid = otid();
    float* vv = lds; float* x1 = vv + 256; float* x2 = x1 + 256; float* h1 = x2 + 256; float* h2 = h1 + 256; float* z1 = h2 + 256;
    const float* cw = p.in[I_HCONV];
    if (tid < 256) { const int t = tid;
#pragma unroll
        for (int part = 0; part < 3; ++part) {
            const float w0 = cw[part * 512 + c], w1 = cw[1536 + part * 512 + c], w2 = cw[3072 + part * 512 + c];
            const bf16_t* col = p.Pp + PC_HY + part * 512 + c;
            const float x0 = bf2f(col[(size_t)t * NP]), xm = t > 0 ? bf2f(col[(size_t)(t - 1) * NP]) : 0.f, xn = t < LC - 1 ? bf2f(col[(size_t)(t + 1) * NP]) : 0.f;
            (part == 0 ? vv : (part == 1 ? x1 : x2))[t] = w0 * xm + w1 * x0 + w2 * xn;
        }
        const float s1 = (p.hsc[c * 4] + p.hsc[c * 4 + 1]) + (p.hsc[c * 4 + 2] + p.hsc[c * 4 + 3]);
        const float s2 = (p.hsc[(512 + c) * 4] + p.hsc[(512 + c) * 4 + 1]) + (p.hsc[(512 + c) * 4 + 2] + p.hsc[(512 + c) * 4 + 3]);
        h1[t] = p.hfc[(size_t)c * 256 + t] / (s1 + EPS); h2[t] = p.hfc[(size_t)(512 + c) * 256 + t] / (s2 + EPS);
    }
    __syncthreads();
    const float b0 = p.in[I_HBIAS][c], b1 = p.in[I_HBIAS][512 + c];
    if (tid < 256) { const int t = tid; float y = 0.f;
        for (int s = 0; s < 256; ++s) { const int m = t - s + 128; if (m >= 0 && m < 256) y += vv[s] * h1[m]; }
        z1[t] = x1[t] * (y + b0 * vv[t]); }
    __syncthreads();
    if (tid < 256) { const int t = tid; float y = 0.f;
        for (int s = 0; s < 256; ++s) { const int m = t - s + 128; if (m >= 0 && m < 256) y += z1[s] * h2[m]; }
        p.ocat[(size_t)t * D_ + 1024 + c] = f2bf(x2[t] * (y + b1 * z1[t])); }
    __syncthreads();
}
__device__ __forceinline__ void phase_hyena(const Params& p, int layer, char* lds) {
    const int nunits = 512 + (layer == 0 ? 512 : 0);
    for (int u = blockIdx.x; u < nunits; u += gridDim.x) {
        if (u < 512) hyena_latent_unit(p, layer, u, lds); else hyena_ctx_unit(p, u - 512, (float*)lds);
    }
}

__device__ __forceinline__ void phase_gather(const Params& p) {
    const int tid = otid(), wid = tid >> 6, lane = tid & 63;
    int base[NEXP]; { int acc = 0;
#pragma unroll
        for (int e = 0; e < NEXP; ++e) { base[e] = acc * 256; acc += ((int)p.cnt[e] + 255) >> 8; } }
    for (int i = blockIdx.x * 8 + wid; i < 2 * SEQ; i += gridDim.x * 8) {
        const int t = i >> 1, e = p.tok_e[i], pos = p.tok_p[i];
        int b = 0;
#pragma unroll
        for (int k = 0; k < NEXP; ++k) b = (e == k) ? base[k] : b;
        const int row = b + pos;
        const u32x4* src = (const u32x4*)(p.hbuf + (size_t)(LC + t) * D_); u32x4* dst = (u32x4*)(p.hg + (size_t)row * D_);
#pragma unroll
        for (int k = 0; k < 4; ++k) dst[k * 64 + lane] = src[k * 64 + lane];
        if (lane == 0) p.tok_r[i] = row;
    }
}
__device__ __forceinline__ void phase_final(const Params& p) {
    const int tid = otid(), wid = tid >> 6, lane = tid & 63;
    const float* g2 = p.modv + ((size_t)1 * 2 + 0) * 6 * D_ + 5 * D_;
    const float* fw = p.in[I_FNW];
    for (int t = blockIdx.x * 8 + wid; t < SEQ; t += gridDim.x * 8) {
        const int r0 = p.tok_r[t * 2], r1 = p.tok_r[t * 2 + 1]; const float w0 = p.tok_w[t * 2], w1 = p.tok_w[t * 2 + 1];
        const float* xr = p.xcur + (size_t)(LC + t) * D_;
        f32x4 xv[8]; float ss = 0.f;
#pragma unroll
        for (int i = 0; i < 8; ++i) { const int col = (i * 64 + lane) * 4;
            const u32x2 ya = *(const u32x2*)(p.yb + (size_t)r0 * D_ + col), yb2 = *(const u32x2*)(p.yb + (size_t)r1 * D_ + col);
            const f32x4 y = {w0 * bflo(ya.x) + w1 * bflo(yb2.x), w0 * bfhi(ya.x) + w1 * bfhi(yb2.x), w0 * bflo(ya.y) + w1 * bflo(yb2.y), w0 * bfhi(ya.y) + w1 * bfhi(yb2.y)};
            xv[i] = *(const f32x4*)(xr + col) + *(const f32x4*)(g2 + col) * y;
            ss += xv[i][0] * xv[i][0] + xv[i][1] * xv[i][1] + xv[i][2] * xv[i][2] + xv[i][3] * xv[i][3]; }
        ss = wave_sum(ss);
        const float rstd = rsqrtf(ss * (1.0f / D_) + EPS);
#pragma unroll
        for (int i = 0; i < 8; ++i) { const int col = (i * 64 + lane) * 4; *(f32x4*)(p.out + (size_t)t * D_ + col) = (xv[i] * rstd) * *(const f32x4*)(fw + col); }
    }
}
#define XB_TMO      128
#define XB_XCNT(j)  (256  + 64 * (j))
#define XB_XSUB(j)  (1280 + 64 * (j))
#define XB_XGEN(j)  (2304 + 64 * (j))
#define XB_TOP      3328
#define XB_TOPGEN   3392
#define XCD_BAR_WORDS 3456
#define XB_SPIN_CAP (1u << 26)

__device__ __forceinline__ unsigned xb_ld(unsigned* p)              { return __hip_atomic_load(p, __ATOMIC_RELAXED, __HIP_MEMORY_SCOPE_AGENT); }
__device__ __forceinline__ unsigned xb_add(unsigned* p, unsigned v) { return __hip_atomic_fetch_add(p, v, __ATOMIC_RELAXED, __HIP_MEMORY_SCOPE_AGENT); }
__device__ __forceinline__ unsigned xb_xcc_id() { return (unsigned)__builtin_amdgcn_s_getreg((3 << 11) | 20) & 0xFu; }
#define XB_SPIN(cond, bar) do { unsigned _sp = 0; while (cond) { __builtin_amdgcn_s_sleep(1); \
    if ((++_sp & 255u) == 0u) { if (xb_ld(&(bar)[XB_TMO])) break; if (_sp > XB_SPIN_CAP) { atomicAdd(&(bar)[XB_TMO], 1u); break; } } } } while (0)

struct XcdBarrier {
    unsigned* bar; unsigned x;
    volatile LAS unsigned* st;
};

__device__ __forceinline__ XcdBarrier xcd_barrier_post(unsigned* bar, volatile LAS unsigned* st) {
    XcdBarrier b; b.bar = bar; b.x = xb_xcc_id(); b.st = st;
    if (threadIdx.x == 0) (void)xb_add(&bar[XB_XCNT(b.x)], 1u);
    return b;
}
__device__ __forceinline__ void xcd_barrier_complete(unsigned* bar, unsigned x, unsigned& nloc, unsigned& nx) {
    const unsigned G = gridDim.x * gridDim.y * gridDim.z;
    unsigned sum, cnt, mine, sp = 0u;
    for (;;) {
        sum = 0u; cnt = 0u; mine = 0u;
#pragma unroll
        for (unsigned j = 0; j < 16; ++j) { const unsigned c = xb_ld(&bar[XB_XCNT(j)]); sum += c; cnt += (c > 0u) ? 1u : 0u; mine = (j == x) ? c : mine; }
        if (sum == G) break;
        __builtin_amdgcn_s_sleep(1);
        if ((++sp & 255u) == 0u) { if (xb_ld(&bar[XB_TMO])) break; if (sp > XB_SPIN_CAP) { atomicAdd(&bar[XB_TMO], 1u); break; } }
    }
    nloc = mine > 0u ? mine : 1u; nx = cnt > 0u ? cnt : 1u;
}

__device__ __forceinline__ void xcd_barrier(const XcdBarrier& b) {
    asm volatile("s_waitcnt vmcnt(0)" ::: "memory");
    __syncthreads();
    if (threadIdx.x == 0) {
        unsigned* bar = b.bar;
        __builtin_amdgcn_s_waitcnt(0);
        unsigned nloc = b.st[0], nx = b.st[1];
        if (nloc == 0u) { xcd_barrier_complete(bar, b.x, nloc, nx); b.st[0] = nloc; b.st[1] = nx; }
        const unsigned old = xb_add(&bar[XB_XSUB(b.x)], 1u);
        const unsigned gen = old / nloc;
        if (old + 1u == (gen + 1u) * nloc) {
            __builtin_amdgcn_fence(__ATOMIC_RELEASE, "agent");
            asm volatile("s_waitcnt vmcnt(0)" ::: "memory");
            const unsigned og = xb_add(&bar[XB_TOP], 1u);
            const unsigned tg = og / nx;
            if (og + 1u == (tg + 1u) * nx) xb_add(&bar[XB_TOPGEN], 1u);
            else XB_SPIN(xb_ld(&bar[XB_TOPGEN]) == tg, bar);
            __builtin_amdgcn_fence(__ATOMIC_ACQUIRE, "agent");
            xb_add(&bar[XB_XGEN(b.x)], 1u);
            asm volatile("s_waitcnt vmcnt(0)" ::: "memory");
        } else {
            XB_SPIN(xb_ld(&bar[XB_XGEN(b.x)]) == gen, bar);
            __builtin_amdgcn_fence(__ATOMIC_ACQUIRE, "agent");
            asm volatile("s_waitcnt vmcnt(0)" ::: "memory");
        }
    }
    __syncthreads();
}

enum { PH_PRO, PH_NORM1, PH_GIN, PH_PREP, PH_GMLA, PH_ATT, PH_REC, PH_HY, PH_MIXOUT, PH_GOUT, PH_NORM2, PH_F1, PH_F2, PH_GATHER, PH_MG1, PH_MG2, PH_FINAL };
constexpr int LDS_BYTES = 147456;

template <int PH> __device__ __forceinline__ void run_phase(const Params& p, int layer, unsigned char* shm) {
    LAS unsigned char* lds3 = (LAS unsigned char*)shm;
    const int G = gridDim.x, c = blockIdx.x;
    if constexpr (PH == PH_PRO) phase_prologue(p, (float*)shm);
    else if constexpr (PH == PH_NORM1) phase_norm(p, layer, 1, 0);
    else if constexpr (PH == PH_GIN) {
        pg8::Gemm g{p.hbuf, p.wb_in + (size_t)layer * NP * D_, D_, D_, D_, 0};
        pg8::StaticOrder S; S.init(MT, NP, G, c);
        pg8::EpiStoreBf16 E{p.Pp, NP, nullptr, 1 << 30};
        pg8::gemm_phase(lds3, g, S, E);
    }
    else if constexpr (PH == PH_PREP) phase_prep(p, layer);
    else if constexpr (PH == PH_GMLA) {
        pg8::Gemm g{p.Pp + PC_CQ, p.wb_mla + (size_t)layer * MLAN * MLAK, MLAK, NP, MLAK, 0};
        pg8::StaticOrder S; S.init(MT, MLAN, G, c);
        pg8::EpiStoreBf16 E{p.qkvup, MLAN, p.mrs, 3};
        pg8::gemm_phase(lds3, g, S, E);
    }
    else if constexpr (PH == PH_ATT) phase_attn(p, layer, (char*)shm);
    else if constexpr (PH == PH_REC) phase_rec_naive(p, layer, (float*)shm);
    else if constexpr (PH == PH_HY) phase_hyena(p, layer, (char*)shm);
    else if constexpr (PH == PH_MIXOUT) phase_mixout(p, layer);
    else if constexpr (PH == PH_GOUT) {
        const float* mv = p.modv + (size_t)layer * 2 * 6 * D_;
        if (layer == 0) {
            pg8::Gemm g{p.ocat, p.wb_out, D_, D_, D_, 0};
            pg8::StaticOrder S; S.init(MT, D_, G, c);
            pg8::EpiResGate E{p.xcur, p.in[I_CTX], p.in[I_X], mv + 6 * D_ + 2 * D_, mv + 2 * D_, 0};
            pg8::gemm_phase(lds3, g, S, E);
        } else {
            pg8::Gemm g{p.ocat + (size_t)LC * D_, p.wb_out + (size_t)D_ * D_, D_, D_, D_, 0};
            pg8::StaticOrder S; S.init(SEQ, D_, G, c);
            pg8::EpiResGate E{p.xcur, p.xcur, p.xcur + (size_t)LC * D_, mv + 6 * D_ + 2 * D_, mv + 2 * D_, LC};
            pg8::gemm_phase(lds3, g, S, E);
        }
    }
    else if constexpr (PH == PH_NORM2) {
        phase_norm(p, layer, 2, layer == 0 ? 0 : LC);
        if (layer == 1) { __syncthreads(); for (int u = c; u < U_MOEW; u += G) moe_w_unit(p, u, (float*)shm); }
    }
    else if constexpr (PH == PH_F1) {
        pg8::Gemm g{p.hbuf, p.wb_f13, D_, D_, D_, 0};
        pg8::StaticOrder S; S.init(MT, 2 * DFF, G, c);
        pg8::EpiSwiGLU E{p.act, DFF};
        pg8::gemm_phase(lds3, g, S, E);
    }
    else if constexpr (PH == PH_F2) {
        const float* mv = p.modv;
        pg8::Gemm g{p.act, p.wb_f2, DFF, DFF, DFF, 0};
        pg8::StaticOrder S; S.init(MT, D_, G, c);
        pg8::EpiResGate E{p.xcur, p.xcur, p.xcur + (size_t)LC * D_, mv + 6 * D_ + 5 * D_, mv + 5 * D_, 0};
        pg8::gemm_phase(lds3, g, S, E);
    }
    else if constexpr (PH == PH_GATHER) phase_gather(p);
    else if constexpr (PH == PH_MG1) {
        pg8::Gemm g{p.hg, p.wb_m13, D_, D_, D_, (size_t)2 * DFF * D_};
        pg8::GroupedOrder S; S.init(p.cnt, 2 * DFF, G, c);
        pg8::EpiSwiGLU E{p.act_moe, DFF};
        pg8::gemm_phase(lds3, g, S, E);
    }
    else if constexpr (PH == PH_MG2) {
        pg8::Gemm g{p.act_moe, p.wb_m2, DFF, DFF, DFF, (size_t)D_ * DFF};
        pg8::GroupedOrder S; S.init(p.cnt, D_, G, c);
        pg8::EpiStoreBf16 E{p.yb, D_, nullptr, 1 << 30};
        pg8::gemm_phase(lds3, g, S, E);
    }
    else if constexpr (PH == PH_FINAL) phase_final(p);
}

#ifndef MEGA
#define MEGA 1
#endif
constexpr int XBW_OFF = LDS_BYTES - 16;
template <int PH> __global__ __launch_bounds__(512, 2) void k_ph(Params p, int layer) {
    extern __shared__ __attribute__((aligned(16))) unsigned char shm[];
    run_phase<PH>(p, layer, shm);
}
__global__ __launch_bounds__(512, 2) void k_mega(Params p) {
    extern __shared__ __attribute__((aligned(16))) unsigned char shm[];
    volatile LAS unsigned* xbw = (volatile LAS unsigned*)(LAS unsigned char*)(shm + XBW_OFF);
    if (otid() == 0) { xbw[0] = 0u; xbw[1] = 0u; xbw[2] = 0u; xbw[3] = 0u; }
    __syncthreads();
    (void)xcd_barrier_post(p.bar, xbw);
#define GBAR() do { XcdBarrier _b; _b.bar = p.bar; _b.x = xb_xcc_id(); _b.st = xbw; xcd_barrier(_b); } while (0)
    run_phase<PH_PRO>(p, 0, shm); GBAR();
#pragma unroll 1
    for (int l = 0; l < 2; ++l) {
        run_phase<PH_NORM1>(p, l, shm); GBAR();
        run_phase<PH_GIN>(p, l, shm); GBAR();
        run_phase<PH_PREP>(p, l, shm); GBAR();
        run_phase<PH_GMLA>(p, l, shm); GBAR();
        run_phase<PH_ATT>(p, l, shm); __syncthreads();
        run_phase<PH_REC>(p, l, shm); __syncthreads();
        run_phase<PH_HY>(p, l, shm); GBAR();
        run_phase<PH_MIXOUT>(p, l, shm); GBAR();
        run_phase<PH_GOUT>(p, l, shm); GBAR();
        run_phase<PH_NORM2>(p, l, shm); GBAR();
        if (l == 0) {
            run_phase<PH_F1>(p, l, shm); GBAR();
            run_phase<PH_F2>(p, l, shm); GBAR();
        } else {
            run_phase<PH_GATHER>(p, l, shm); GBAR();
            run_phase<PH_MG1>(p, l, shm); GBAR();
            run_phase<PH_MG2>(p, l, shm); GBAR();
            run_phase<PH_FINAL>(p, l, shm);
        }
    }
}
template <int PH> static void launch_ph(const Params& p, int layer, int grid, hipStream_t st) {
    static bool attr = false;
    if (!attr) { (void)hipFuncSetAttribute((const void*)k_ph<PH>, hipFuncAttributeMaxDynamicSharedMemorySize, LDS_BYTES); attr = true; }
    hipLaunchKernelGGL((k_ph<PH>), dim3(grid), dim3(512), LDS_BYTES, st, p, layer);
}

static size_t align_up(size_t x) { return (x + 255) & ~(size_t)255; }
extern "C" void kernel_launch(void* const* d_in, const int* in_sizes, int n_in, void* d_out, int out_size, void* d_ws, size_t ws_size, hipStream_t stream) {
    Params p{};
    for (int i = 0; i < N_IN; ++i) p.in[i] = (const float*)d_in[i];
    p.out = (float*)d_out;
    static int GRID = 0;
    if (!GRID) {
#if MEGA
        int dev = 0, cus = 0, per_cu = 0;
        (void)hipGetDevice(&dev);
        (void)hipDeviceGetAttribute(&cus, hipDeviceAttributeMultiprocessorCount, dev);
        (void)hipFuncSetAttribute((const void*)k_mega, hipFuncAttributeMaxDynamicSharedMemorySize, LDS_BYTES);
        (void)hipOccupancyMaxActiveBlocksPerMultiprocessor(&per_cu, k_mega, 512, LDS_BYTES);
        if (per_cu < 1 || cus < 1) { fprintf(stderr, "kernel_launch: occupancy query failed (%d blocks/CU, %d CUs)\n", per_cu, cus); return; }
        GRID = cus;
#else
        GRID = 256;
#endif
    }
    char* ws = (char*)d_ws; size_t off = 0;
    auto take = [&](size_t bytes) { char* r = ws + off; off = align_up(off + bytes); return r; };
    p.bar = (unsigned*)take(16384); p.cnt = (unsigned*)take(256);
    p.modv = (float*)take((size_t)2 * 2 * 6 * D_ * 4);
    p.xcur = (float*)take((size_t)MT * D_ * 4);
    p.hbuf = (bf16_t*)take((size_t)MT * D_ * 2);
    p.tok_r = (int*)take((size_t)2 * SEQ * 4); p.tok_w = (float*)take((size_t)2 * SEQ * 4); p.tok_e = (int*)take((size_t)2 * SEQ * 4); p.tok_p = (int*)take((size_t)2 * SEQ * 4);
    const size_t region = off;
    p.wb_in = (bf16_t*)take((size_t)2 * NP * D_ * 2); p.wb_out = (bf16_t*)take((size_t)2 * D_ * D_ * 2); p.wb_mla = (bf16_t*)take((size_t)2 * MLAN * MLAK * 2);
    p.wb_f13 = (bf16_t*)take((size_t)2 * DFF * D_ * 2); p.wb_f2 = (bf16_t*)take((size_t)D_ * DFF * 2);
    p.hfilt = (float*)take((size_t)2 * 1024 * SEQ * 4); p.hsum = (float*)take((size_t)2 * 1024 * 256 * 4); p.hfc = (float*)take((size_t)1024 * 256 * 4); p.hsc = (float*)take((size_t)1024 * 4 * 4);
    const size_t arena = off;
    p.Pp = (bf16_t*)take((size_t)MT * NP * 2);
    p.gqkv = (bf16_t*)take((size_t)MT * 1536 * 2); p.ggb = (float*)take((size_t)MT * 16 * 4); p.rqk = (bf16_t*)take((size_t)MT * 1024 * 2);
    p.mrs = (float*)take((size_t)MT * 2 * 4); p.krr = (bf16_t*)take((size_t)MT * 64 * 2); p.qkvup = (bf16_t*)take((size_t)MT * MLAN * 2);
    p.go = (float*)take((size_t)2 * MT * 512 * 4); p.ro = (float*)take((size_t)2 * MT * 512 * 4);
    p.hys = (float*)take((size_t)GRID * HY_SCR_FLOATS * 4); p.ocat = (bf16_t*)take((size_t)MT * D_ * 2);
    const size_t end1 = off;
    p.act = (bf16_t*)(ws + arena);
    off = region;
    p.wb_m13 = (bf16_t*)take((size_t)NEXP * 2 * DFF * D_ * 2); p.wb_m2 = (bf16_t*)take((size_t)NEXP * D_ * DFF * 2);
    p.hg = (bf16_t*)take((size_t)MAXROWS_MOE * D_ * 2); p.yb = p.hg;
    p.act_moe = (bf16_t*)take((size_t)MAXROWS_MOE * DFF * 2);
    const size_t end2 = off;
    const size_t need = end1 > end2 ? end1 : end2;
    if (ws_size < need) { fprintf(stderr, "kernel_launch: workspace too small: %zu < %zu\n", ws_size, need); return; }
#if MEGA
    (void)hipMemsetAsync(p.bar, 0, XCD_BAR_WORDS * sizeof(unsigned), stream);
    hipLaunchKernelGGL(k_mega, dim3(GRID), dim3(512), LDS_BYTES, stream, p);
#else
    launch_ph<PH_PRO>(p, 0, GRID, stream);
    for (int l = 0; l < 2; ++l) {
        launch_ph<PH_NORM1>(p, l, GRID, stream);
        launch_ph<PH_GIN>(p, l, GRID, stream);
        launch_ph<PH_PREP>(p, l, GRID, stream);
        launch_ph<PH_GMLA>(p, l, GRID, stream);
        launch_ph<PH_ATT>(p, l, GRID, stream);
        launch_ph<PH_REC>(p, l, GRID, stream);
        launch_ph<PH_HY>(p, l, GRID, stream);
        launch_ph<PH_MIXOUT>(p, l, GRID, stream);
        launch_ph<PH_GOUT>(p, l, GRID, stream);
        launch_ph<PH_NORM2>(p, l, GRID, stream);
        if (l == 0) { launch_ph<PH_F1>(p, l, GRID, stream); launch_ph<PH_F2>(p, l, GRID, stream); }
        else { launch_ph<PH_GATHER>(p, l, GRID, stream); launch_ph<PH_MG1>(p, l, GRID, stream); launch_ph<PH_MG2>(p, l, GRID, stream); launch_ph<PH_FINAL>(p, l, GRID, stream); }
    }
#endif
}
```

```cpp
#include <hip/hip_runtime.h>
#include <stdint.h>
#include <math.h>
#include <stdio.h>

#define LAS __attribute__((address_space(3)))
typedef unsigned short bf16_t;
typedef short bf16x8 __attribute__((ext_vector_type(8)));
typedef short s16x4 __attribute__((ext_vector_type(4)));
typedef float f32x4 __attribute__((ext_vector_type(4)));
typedef float f32x2 __attribute__((ext_vector_type(2)));
typedef float f32x16 __attribute__((ext_vector_type(16)));
typedef unsigned u32x4 __attribute__((ext_vector_type(4)));
typedef unsigned u32x2 __attribute__((ext_vector_type(2)));

constexpr int D_ = 2048, SEQ = 16384, LC = 256, MT = 16640, NP = 6400, DFF = 5632, NEXP = 8, DIN = 6288;
constexpr int PC_GQKV = 0, PC_GZ = 1536, PC_HY = 2048, PC_RQKV = 3584, PC_RG = 5120, PC_CQ = 5632, PC_CKV = 6144, PC_KR = 6272, PC_A = 6336, PC_B = 6344;
constexpr int MLAK = 640, MLAN = 1792;
constexpr float EPS = 1e-6f;
constexpr int MAXROWS_MOE = 2 * SEQ + NEXP * 256;
enum { I_X, I_C, I_CTX, I_CCTX, I_N1W, I_N2W, I_MODW, I_MODB, I_WIN, I_WOUT, I_GCONV, I_GALOG, I_GDT, I_GNW, I_MQN, I_MUQ, I_MKVN, I_MUKV,
       I_HCONV, I_HW1, I_HB1, I_HW2, I_HB2, I_HW3, I_HB3, I_HW4, I_HFREQ, I_HBIAS, I_FW1, I_FW3, I_FW2, I_ROUTER, I_MW1, I_MW3, I_MW2, I_FNW, N_IN };

constexpr int NCHUNK_ = MT / 64;
constexpr size_t REC_BYTES_ = 90368, HY_SCR_FLOATS_ = 2 * 2 * (size_t)16384 + 4 * (size_t)SEQ;
constexpr int WS_GRID = 256;
struct WsLayout { size_t bar, cnt, modv, xcur, hbuf, tok_r, tok_w, tok_e, tok_p, wb_in, wb_out, wb_mla, wb_f13, wb_f2, hfilt, hsum, hfc, hsc, Pp, gqkv, ggb, rqk, mrs, krr, qkvup, go, ro, recs, hys, ocat,
                  act, wb_m13, wb_m2, hg, yb, act_moe, need; };
constexpr size_t ws_al(size_t x) { return (x + 255) & ~(size_t)255; }
constexpr WsLayout make_ws_layout() {
    WsLayout L{}; size_t off = 0;
    L.bar = off; off = ws_al(off + 16384); L.cnt = off; off = ws_al(off + 256);
    L.modv = off; off = ws_al(off + (size_t)2 * 2 * 6 * D_ * 4);
    L.xcur = off; off = ws_al(off + (size_t)MT * D_ * 4);
    L.hbuf = off; off = ws_al(off + (size_t)MT * D_ * 2);
    L.tok_r = off; off = ws_al(off + (size_t)2 * SEQ * 4); L.tok_w = off; off = ws_al(off + (size_t)2 * SEQ * 4); L.tok_e = off; off = ws_al(off + (size_t)2 * SEQ * 4); L.tok_p = off; off = ws_al(off + (size_t)2 * SEQ * 4);
    const size_t region = off;
    L.wb_in = off; off = ws_al(off + (size_t)2 * NP * D_ * 2); L.wb_out = off; off = ws_al(off + (size_t)2 * D_ * D_ * 2); L.wb_mla = off; off = ws_al(off + (size_t)2 * MLAN * MLAK * 2);
    L.wb_f13 = off; off = ws_al(off + (size_t)2 * DFF * D_ * 2); L.wb_f2 = off; off = ws_al(off + (size_t)D_ * DFF * 2);
    L.hfilt = off; off = ws_al(off + (size_t)2 * 1024 * SEQ * 4); L.hsum = off; off = ws_al(off + (size_t)2 * 1024 * 256 * 4); L.hfc = off; off = ws_al(off + (size_t)1024 * 256 * 4); L.hsc = off; off = ws_al(off + (size_t)1024 * 4 * 4);
    const size_t arena = off;
    L.Pp = off; off = ws_al(off + (size_t)MT * NP * 2);
    L.gqkv = off; off = ws_al(off + (size_t)MT * 1536 * 2); L.ggb = off; off = ws_al(off + (size_t)MT * 16 * 4); L.rqk = off; off = ws_al(off + (size_t)MT * 1024 * 2);
    L.mrs = off; off = ws_al(off + (size_t)MT * 2 * 4); L.krr = off; off = ws_al(off + (size_t)MT * 64 * 2); L.qkvup = off; off = ws_al(off + (size_t)MT * MLAN * 2);
    L.go = off; off = ws_al(off + (size_t)2 * MT * 512 * 4); L.ro = off; off = ws_al(off + (size_t)2 * MT * 512 * 4);
    L.recs = off; off = ws_al(off + (size_t)16 * NCHUNK_ * REC_BYTES_);
    L.hys = off; off = ws_al(off + (size_t)WS_GRID * HY_SCR_FLOATS_ * 4); L.ocat = off; off = ws_al(off + (size_t)MT * D_ * 2);
    const size_t end1 = off;
    L.act = arena;
    off = region;
    L.wb_m13 = off; off = ws_al(off + (size_t)NEXP * 2 * DFF * D_ * 2); L.wb_m2 = off; off = ws_al(off + (size_t)NEXP * D_ * DFF * 2);
    L.hg = off; L.yb = off; off = ws_al(off + (size_t)MAXROWS_MOE * D_ * 2);
    L.act_moe = off; off = ws_al(off + (size_t)MAXROWS_MOE * DFF * 2);
    const size_t end2 = off;
    L.need = end1 > end2 ? end1 : end2;
    return L;
}
constexpr WsLayout WSL = make_ws_layout();
struct Params {
    const float* in[N_IN];
    float* out;
    char* ws;
    __device__ __forceinline__ unsigned* bar() const { return (unsigned*)(ws + WSL.bar); }
    __device__ __forceinline__ unsigned* cnt() const { return (unsigned*)(ws + WSL.cnt); }
    __device__ __forceinline__ float* modv() const { return (float*)(ws + WSL.modv); }
    __device__ __forceinline__ bf16_t* wb_in() const { return (bf16_t*)(ws + WSL.wb_in); }
    __device__ __forceinline__ bf16_t* wb_out() const { return (bf16_t*)(ws + WSL.wb_out); }
    __device__ __forceinline__ bf16_t* wb_mla() const { return (bf16_t*)(ws + WSL.wb_mla); }
    __device__ __forceinline__ bf16_t* wb_f13() const { return (bf16_t*)(ws + WSL.wb_f13); }
    __device__ __forceinline__ bf16_t* wb_f2() const { return (bf16_t*)(ws + WSL.wb_f2); }
    __device__ __forceinline__ bf16_t* wb_m13() const { return (bf16_t*)(ws + WSL.wb_m13); }
    __device__ __forceinline__ bf16_t* wb_m2() const { return (bf16_t*)(ws + WSL.wb_m2); }
    __device__ __forceinline__ float* hfilt() const { return (float*)(ws + WSL.hfilt); }
    __device__ __forceinline__ float* hsum() const { return (float*)(ws + WSL.hsum); }
    __device__ __forceinline__ float* hfc() const { return (float*)(ws + WSL.hfc); }
    __device__ __forceinline__ float* hsc() const { return (float*)(ws + WSL.hsc); }
    __device__ __forceinline__ float* xcur() const { return (float*)(ws + WSL.xcur); }
    __device__ __forceinline__ bf16_t* hbuf() const { return (bf16_t*)(ws + WSL.hbuf); }
    __device__ __forceinline__ bf16_t* Pp() const { return (bf16_t*)(ws + WSL.Pp); }
    __device__ __forceinline__ bf16_t* gqkv() const { return (bf16_t*)(ws + WSL.gqkv); }
    __device__ __forceinline__ float* ggb() const { return (float*)(ws + WSL.ggb); }
    __device__ __forceinline__ bf16_t* rqk() const { return (bf16_t*)(ws + WSL.rqk); }
    __device__ __forceinline__ float* mrs() const { return (float*)(ws + WSL.mrs); }
    __device__ __forceinline__ bf16_t* krr() const { return (bf16_t*)(ws + WSL.krr); }
    __device__ __forceinline__ bf16_t* qkvup() const { return (bf16_t*)(ws + WSL.qkvup); }
    __device__ __forceinline__ float* go() const { return (float*)(ws + WSL.go); }
    __device__ __forceinline__ float* ro() const { return (float*)(ws + WSL.ro); }
    __device__ __forceinline__ char* recs() const { return (char*)(ws + WSL.recs); }
    __device__ __forceinline__ float* hys() const { return (float*)(ws + WSL.hys); }
    __device__ __forceinline__ bf16_t* ocat() const { return (bf16_t*)(ws + WSL.ocat); }
    __device__ __forceinline__ bf16_t* act() const { return (bf16_t*)(ws + WSL.act); }
    __device__ __forceinline__ bf16_t* act_moe() const { return (bf16_t*)(ws + WSL.act_moe); }
    __device__ __forceinline__ bf16_t* hg() const { return (bf16_t*)(ws + WSL.hg); }
    __device__ __forceinline__ bf16_t* yb() const { return (bf16_t*)(ws + WSL.yb); }
    __device__ __forceinline__ int* tok_r() const { return (int*)(ws + WSL.tok_r); }
    __device__ __forceinline__ float* tok_w() const { return (float*)(ws + WSL.tok_w); }
    __device__ __forceinline__ int* tok_e() const { return (int*)(ws + WSL.tok_e); }
    __device__ __forceinline__ int* tok_p() const { return (int*)(ws + WSL.tok_p); }
};

__device__ __forceinline__ int otid() { int t = threadIdx.x; asm volatile("" : "+v"(t)); return t; }
__device__ __forceinline__ unsigned cvt_pk_bf16(float lo, float hi) { unsigned r; asm volatile("v_cvt_pk_bf16_f32 %0, %1, %2" : "=v"(r) : "v"(lo), "v"(hi)); return r; }
__device__ __forceinline__ bf16_t f2bf(float x) { return (bf16_t)(cvt_pk_bf16(x, 0.f) & 0xffffu); }
__device__ __forceinline__ float bf2f(bf16_t b) { return __uint_as_float(((unsigned)b) << 16); }
__device__ __forceinline__ float bflo(unsigned w) { return __uint_as_float(w << 16); }
__device__ __forceinline__ float bfhi(unsigned w) { return __uint_as_float(w & 0xffff0000u); }
__device__ __forceinline__ float silu_f(float x) { return x / (1.f + __expf(-x)); }
__device__ __forceinline__ float sigmoid_f(float x) { return 1.f / (1.f + __expf(-x)); }
__device__ __forceinline__ float softplus_f(float x) { return fmaxf(x, 0.f) + __logf(1.f + __expf(-fabsf(x))); }
__device__ __forceinline__ float shflx(float v, int o, int lane) { return __int_as_float(__builtin_amdgcn_ds_bpermute((lane ^ o) << 2, __float_as_int(v))); }
__device__ __forceinline__ float wave_sum(float v) {
    const int lane = otid() & 63;
#pragma unroll
    for (int o = 32; o >= 1; o >>= 1) v += shflx(v, o, lane);
    return v;
}
__device__ __forceinline__ float sum16(float v) {
    const int lane = otid() & 63;
#pragma unroll
    for (int o = 8; o >= 1; o >>= 1) v += shflx(v, o, lane);
    return v;
}
__device__ __forceinline__ void unpack8(u32x4 w, float (&f)[8]) {
    f[0] = bflo(w.x); f[1] = bfhi(w.x); f[2] = bflo(w.y); f[3] = bfhi(w.y); f[4] = bflo(w.z); f[5] = bfhi(w.z); f[6] = bflo(w.w); f[7] = bfhi(w.w);
}
__device__ __forceinline__ u32x4 pack8(const float (&f)[8]) {
    u32x4 w; w.x = cvt_pk_bf16(f[0], f[1]); w.y = cvt_pk_bf16(f[2], f[3]); w.z = cvt_pk_bf16(f[4], f[5]); w.w = cvt_pk_bf16(f[6], f[7]); return w;
}

namespace pg8 {
constexpr int BM = 256, BK = 64, HALF = 128, HTB = HALF * BK * 2, STAGE_BYTES = 8 * HTB, NXCD = 8, WGM = 8;
__host__ __device__ __forceinline__ int lds_byte(int r, int c) { const int st = (r >> 4) * 2 + (c >> 5), rr = r & 15, cc = c & 31, ob = rr * 64 + cc * 2; return st * 1024 + (ob ^ (((ob >> 9) & 1) << 5)); }
__host__ __device__ __forceinline__ void stage_rc(int b, int& R, int& C) { const int st = b / 1024, sb = b % 1024, swz = sb ^ (((sb >> 9) & 1) << 5); R = (st >> 1) * 16 + swz / 64; C = (st & 1) * 32 + (swz % 64) / 2; }
__host__ __device__ __forceinline__ int perm32(int rho) { const int n = rho >> 4, i = rho & 15; return 8 * (i >> 2) + 4 * n + (i & 3); }
struct Unit { int pm, pn, e; };
struct Gemm { const bf16_t* A; const bf16_t* Bt; int K, lda, ldb; size_t estride; };

struct StaticOrder {
    int nM, nN, nwg, G, c;
    __device__ void init(int M, int N, int G_, int c_) { nM = M / BM; nN = N / BM; nwg = nM * nN; G = G_; c = c_; }
    __device__ bool next(int i, Unit& u) const {
        const long L = (long)i * G + c; if (L >= nwg) return false;
        int wgid = (int)L; { const int q = nwg / NXCD, r = nwg % NXCD, xcd = wgid % NXCD, off = wgid / NXCD; wgid = (xcd < r ? xcd * (q + 1) : r * (q + 1) + (xcd - r) * q) + off; }
        const int nig = WGM * nN, gid = wgid / nig, fm = gid * WGM, gsz = (nM - fm) < WGM ? (nM - fm) : WGM;
        u.pm = fm + ((wgid % nig) % gsz); u.pn = (wgid % nig) / gsz; u.e = 0; return true;
    }
    __device__ __forceinline__ void a_ready(const Unit&) const {}
    __device__ __forceinline__ void done(const Unit&) const {}
};
struct GroupedOrder {
    int pb[NEXP + 1]; int nN, nwg, G, c;
    __device__ void init(const unsigned* cnt, int N, int G_, int c_) {
        int acc = 0;
#pragma unroll
        for (int e = 0; e < NEXP; ++e) { pb[e] = acc; acc += ((int)cnt[e] + 255) >> 8; }
        pb[NEXP] = acc; nN = N / BM; nwg = acc * nN; G = G_; c = c_;
    }
    __device__ bool next(int i, Unit& u) const {
        const long L = (long)i * G + c; if (L >= nwg) return false;
        const int np = pb[NEXP]; u.pn = (int)(L / np); u.pm = (int)(L % np);
        int e = 0;
#pragma unroll
        for (int k = 1; k < NEXP; ++k) e += (u.pm >= pb[k]) ? 1 : 0;
        u.e = e; return true;
    }
    __device__ __forceinline__ void a_ready(const Unit&) const {}
    __device__ __forceinline__ void done(const Unit&) const {}
};

template <class Epi, class Sched>
__device__ __forceinline__ void gemm_phase(LAS unsigned char* lds, const Gemm g, const Sched& S, const Epi& E) {
    const int tid = otid(), wid = __builtin_amdgcn_readfirstlane(tid >> 6), lane = tid & 63, wr = wid >> 2, wc = wid & 3, fr = lane & 15, fq = lane >> 4;
    const int K = g.K, nt = K / BK;
    unsigned voffA[2], voffB[2];
#pragma unroll
    for (int i = 0; i < 2; ++i) { int R, C; stage_rc(tid * 16 + i * 8192, R, C); const int Rb = Epi::PERM ? ((R & ~31) + perm32(R & 31)) : R;
        voffA[i] = (unsigned)(R * g.lda + C) * 2u; voffB[i] = (unsigned)(Rb * g.ldb + C) * 2u; }
    const size_t kstep = (size_t)(BK * 2);
    const size_t hstepA = (size_t)HALF * g.lda * 2, hstepB = (size_t)HALF * g.ldb * 2;
    const size_t tstepA = 2 * hstepA, tstepB = 2 * hstepB;
    const unsigned ldsw = (unsigned)wid * 1024u;
    const int aoff = lds_byte(wr * 64 + fr, fq * 8), boff = lds_byte(wc * 32 + fr, fq * 8);
#define PG8_SA(b, h) (((b) * 2 + (h)) * HTB)
#define PG8_SB(b, h) ((4 + (b) * 2 + (h)) * HTB)
#define PG8_STAGE(bufoff, gbase, voff) do { _Pragma("unroll") for (int _i = 0; _i < 2; ++_i) \
        __builtin_amdgcn_global_load_lds((const unsigned*)((const char*)(gbase) + (voff)[_i]), (LAS unsigned*)(lds + (bufoff) + ldsw + _i * 8192), 16, 0, 0); } while (0)
#define PG8_LDA(dst, b, h) do { _Pragma("unroll") for (int m = 0; m < 4; ++m) _Pragma("unroll") for (int k = 0; k < 2; ++k) dst[m][k] = *(const LAS bf16x8*)(lds + PG8_SA(b, h) + aoff + m * 2048 + k * 1024); } while (0)
#define PG8_LDB(dst, b, h) do { _Pragma("unroll") for (int n = 0; n < 2; ++n) _Pragma("unroll") for (int k = 0; k < 2; ++k) dst[n][k] = *(const LAS bf16x8*)(lds + PG8_SB(b, h) + boff + n * 2048 + k * 1024); } while (0)
#define PG8_MMA(ai, bj, At, Bt) do { __builtin_amdgcn_s_setprio(1); _Pragma("unroll") for (int m = 0; m < 4; ++m) _Pragma("unroll") for (int n = 0; n < 2; ++n) _Pragma("unroll") for (int k = 0; k < 2; ++k) \
        acc[ai][bj][m][n] = __builtin_amdgcn_mfma_f32_16x16x32_bf16(Bt[n][k], At[m][k], acc[ai][bj][m][n], 0, 0, 0); __builtin_amdgcn_s_setprio(0); } while (0)
#define PG8_WAIT_V(n) asm volatile("s_waitcnt vmcnt(" #n ")" ::: "memory")
#define PG8_WAIT_L(n) asm volatile("s_waitcnt lgkmcnt(" #n ")" ::: "memory")
#define PG8_BAR __builtin_amdgcn_s_barrier()
#define PG8_SCHED __builtin_amdgcn_sched_barrier(0)
    Unit cur, nxt; int ui = 0;
    if (!S.next(0, cur)) return;
    f32x4 acc[2][2][4][2];
#pragma unroll
    for (int a = 0; a < 2; ++a)
#pragma unroll
        for (int b = 0; b < 2; ++b)
#pragma unroll
            for (int m = 0; m < 4; ++m)
#pragma unroll
                for (int n = 0; n < 2; ++n) acc[a][b][m][n] = (f32x4){0.f, 0.f, 0.f, 0.f};
    bf16x8 At[4][2], B0[2][2], B1[2][2];
    const char* cA = (const char*)g.A + (size_t)cur.pm * tstepA; const char* cB = (const char*)g.Bt + (size_t)cur.pn * tstepB + (size_t)cur.e * g.estride * 2;
    S.a_ready(cur);
    PG8_STAGE(PG8_SB(0, 0), cB, voffB); PG8_STAGE(PG8_SA(0, 0), cA, voffA); PG8_STAGE(PG8_SB(0, 1), cB + hstepB, voffB); PG8_STAGE(PG8_SA(0, 1), cA + hstepA, voffA);
    if (wr == 1) PG8_BAR;
    PG8_WAIT_V(4); PG8_BAR;
    PG8_STAGE(PG8_SB(1, 0), cB + kstep, voffB); PG8_STAGE(PG8_SA(1, 0), cA + kstep, voffA); PG8_STAGE(PG8_SB(1, 1), cB + hstepB + kstep, voffB);
    PG8_WAIT_V(6); PG8_BAR;
    for (;;) {
        const bool has_next = S.next(ui + 1, nxt);
        const char* nA = has_next ? (const char*)g.A + (size_t)nxt.pm * tstepA : cA;
        const char* nB = has_next ? (const char*)g.Bt + (size_t)nxt.pn * tstepB + (size_t)nxt.e * g.estride * 2 : cB;
        for (int t = 0; t < nt; t += 2) {
            const bool last = (t == nt - 2);
            const char* a1 = cA + (size_t)(t + 1) * kstep;
            const char* a2 = last ? nA : cA + (size_t)(t + 2) * kstep; const char* b2 = last ? nB : cB + (size_t)(t + 2) * kstep;
            const char* a3 = a2 + kstep; const char* b3 = b2 + kstep;
            if (last && has_next) S.a_ready(nxt);
            PG8_LDB(B0, 0, 0); PG8_SCHED; PG8_LDA(At, 0, 0); PG8_STAGE(PG8_SA(1, 1), a1 + hstepA, voffA);
            PG8_WAIT_L(8); PG8_BAR; PG8_WAIT_L(0); PG8_MMA(0, 0, At, B0); PG8_BAR; PG8_SCHED;
            PG8_LDB(B1, 0, 1); PG8_STAGE(PG8_SB(0, 0), b2, voffB);
            PG8_BAR; PG8_WAIT_L(0); PG8_MMA(0, 1, At, B1); PG8_BAR;
            PG8_LDA(At, 0, 1); PG8_STAGE(PG8_SA(0, 0), a2, voffA);
            PG8_BAR; PG8_WAIT_L(0); PG8_MMA(1, 0, At, B0); PG8_BAR; PG8_SCHED;
            PG8_STAGE(PG8_SB(0, 1), b2 + hstepB, voffB);
            PG8_WAIT_V(6); PG8_BAR; PG8_MMA(1, 1, At, B1); PG8_BAR;
            PG8_LDB(B0, 1, 0); PG8_SCHED; PG8_LDA(At, 1, 0); PG8_STAGE(PG8_SA(0, 1), a2 + hstepA, voffA);
            PG8_WAIT_L(8); PG8_BAR; PG8_WAIT_L(0); PG8_MMA(0, 0, At, B0); PG8_BAR; PG8_SCHED;
            PG8_LDB(B1, 1, 1); PG8_STAGE(PG8_SB(1, 0), b3, voffB);
            PG8_BAR; PG8_WAIT_L(0); PG8_MMA(0, 1, At, B1); PG8_BAR;
            PG8_LDA(At, 1, 1); PG8_STAGE(PG8_SA(1, 0), a3, voffA);
            PG8_BAR; PG8_WAIT_L(0); PG8_MMA(1, 0, At, B0); PG8_BAR; PG8_SCHED;
            PG8_STAGE(PG8_SB(1, 1), b3 + hstepB, voffB);
            PG8_WAIT_V(6); PG8_BAR; PG8_MMA(1, 1, At, B1); PG8_BAR;
        }
        E(acc, cur, wr, wc, fr, fq); S.done(cur);
        if (!has_next) break;
#pragma unroll
        for (int a = 0; a < 2; ++a)
#pragma unroll
            for (int b = 0; b < 2; ++b)
#pragma unroll
                for (int m = 0; m < 4; ++m)
#pragma unroll
                    for (int n = 0; n < 2; ++n) acc[a][b][m][n] = (f32x4){0.f, 0.f, 0.f, 0.f};
        cur = nxt; cA = nA; cB = nB; ++ui;
    }
    PG8_WAIT_V(0);
    if (wr == 0) PG8_BAR;
    PG8_BAR;
#undef PG8_SA
#undef PG8_SB
#undef PG8_STAGE
#undef PG8_LDA
#undef PG8_LDB
#undef PG8_MMA
#undef PG8_WAIT_V
#undef PG8_WAIT_L
#undef PG8_BAR
#undef PG8_SCHED
}

struct EpiStoreBf16 {
    static constexpr bool PERM = true;
    bf16_t* O; int ldc; const float* rs; int rs_split;
    __device__ __forceinline__ void operator()(const f32x4 (&acc)[2][2][4][2], const Unit& u, int wr, int wc, int fr, int fq) const {
        const int row0 = u.pm * BM + wr * 64 + fr, col0 = u.pn * BM + wc * 32 + 8 * fq;
        const int sel = (u.pn >= rs_split) ? 1 : 0;
#pragma unroll
        for (int ai = 0; ai < 2; ++ai)
#pragma unroll
            for (int m = 0; m < 4; ++m) { const int row = row0 + ai * HALF + m * 16; bf16_t* rowp = O + (size_t)row * ldc + col0;
                const float sc = rs ? rs[row * 2 + sel] : 1.f;
#pragma unroll
                for (int bj = 0; bj < 2; ++bj) { const f32x4 v0 = acc[ai][bj][m][0] * sc, v1 = acc[ai][bj][m][1] * sc;
                    u32x4 w; w.x = cvt_pk_bf16(v0[0], v0[1]); w.y = cvt_pk_bf16(v0[2], v0[3]); w.z = cvt_pk_bf16(v1[0], v1[1]); w.w = cvt_pk_bf16(v1[2], v1[3]);
                    *(u32x4*)(rowp + bj * HALF) = w; } }
    }
};
struct EpiResGate {
    static constexpr bool PERM = false;
    float* out; const float* res_ctx; const float* res_lat; const float* gate_ctx; const float* gate_lat; int rowbase;
    __device__ __forceinline__ void operator()(const f32x4 (&acc)[2][2][4][2], const Unit& u, int wr, int wc, int fr, int fq) const {
        const int row0 = rowbase + u.pm * BM + wr * 64 + fr, col0 = u.pn * BM + wc * 32 + 4 * fq;
#pragma unroll
        for (int ai = 0; ai < 2; ++ai)
#pragma unroll
            for (int m = 0; m < 4; ++m) { const int row = row0 + ai * HALF + m * 16; const bool isc = row < LC;
                const float* rp = isc ? res_ctx + (size_t)row * D_ : res_lat + (size_t)(row - LC) * D_; const float* gp = isc ? gate_ctx : gate_lat;
                float* op = out + (size_t)row * D_;
#pragma unroll
                for (int bj = 0; bj < 2; ++bj)
#pragma unroll
                    for (int n = 0; n < 2; ++n) { const int c = col0 + bj * HALF + n * 16; const f32x4 r4 = *(const f32x4*)(rp + c), g4 = *(const f32x4*)(gp + c);
                        *(f32x4*)(op + c) = r4 + g4 * acc[ai][bj][m][n]; } }
    }
};
struct EpiSwiGLU {
    static constexpr bool PERM = true;
    bf16_t* O; int ldc;
    __device__ __forceinline__ void operator()(const f32x4 (&acc)[2][2][4][2], const Unit& u, int wr, int wc, int fr, int fq) const {
        const int row0 = u.pm * BM + wr * 64 + fr, col0 = u.pn * HALF + wc * 32 + 8 * fq;
#pragma unroll
        for (int ai = 0; ai < 2; ++ai)
#pragma unroll
            for (int m = 0; m < 4; ++m) { bf16_t* rowp = O + (size_t)(row0 + ai * HALF + m * 16) * ldc + col0;
                float o[8];
#pragma unroll
                for (int n = 0; n < 2; ++n)
#pragma unroll
                    for (int j = 0; j < 4; ++j) { const float gte = acc[ai][0][m][n][j], up = acc[ai][1][m][n][j]; o[n * 4 + j] = silu_f(gte) * up; }
                *(u32x4*)rowp = pack8(o); }
    }
};
}
#ifndef FFT_DEV_H
#define FFT_DEV_H
#ifndef FFT_HOST
#define FFT_FN __device__ __forceinline__
struct cpx { float x, y; };
FFT_FN void tw(float frac, float& c, float& s) { c = __builtin_amdgcn_cosf(frac); s = __builtin_amdgcn_sinf(frac); }
#else
#include <cmath>
#define FFT_FN static inline
struct cpx { float x, y; };
FFT_FN void tw(float frac, float& c, float& s) { c = (float)cos(6.283185307179586 * (double)frac); s = (float)sin(6.283185307179586 * (double)frac); }
#endif
#define ZP(i) ((i) + (((i) >> 6) << 2))
constexpr int FFT_N = 16384;
constexpr int FFT_ZN = FFT_N + 4 * (FFT_N / 64);

FFT_FN void bf_dif(cpx& a, cpx& b, float c, float s) {
    const float dx = a.x - b.x, dy = a.y - b.y;
    a.x += b.x; a.y += b.y;
    b.x = dx * c + dy * s; b.y = dy * c - dx * s;
}
FFT_FN void bf_dit(cpx& a, cpx& b, float c, float s) {
    const float tx = b.x * c - b.y * s, ty = b.x * s + b.y * c;
    b.x = a.x - tx; b.y = a.y - ty; a.x += tx; a.y += ty;
}
template <int K16> FFT_FN void rot16(float c0, float s0, float& c, float& s) {
    constexpr float CR[16] = {1.f, 0.9238795325112867f, 0.7071067811865476f, 0.3826834323650898f, 0.f, -0.3826834323650898f, -0.7071067811865476f, -0.9238795325112867f,
                              -1.f, -0.9238795325112867f, -0.7071067811865476f, -0.3826834323650898f, 0.f, 0.3826834323650898f, 0.7071067811865476f, 0.9238795325112867f};
    constexpr float SR[16] = {0.f, 0.3826834323650898f, 0.7071067811865476f, 0.9238795325112867f, 1.f, 0.9238795325112867f, 0.7071067811865476f, 0.3826834323650898f,
                              0.f, -0.3826834323650898f, -0.7071067811865476f, -0.9238795325112867f, -1.f, -0.9238795325112867f, -0.7071067811865476f, -0.3826834323650898f};
    constexpr float cr = CR[K16 & 15], sr = SR[K16 & 15];
    c = c0 * cr - s0 * sr; s = s0 * cr + c0 * sr;
}
#define FFT_BF(DIFDIT, ra, rb, K16, cb, sb) do { float _c, _s; rot16<K16>(cb, sb, _c, _s); DIFDIT(v[ra], v[rb], _c, _s); } while (0)
template <bool INV> FFT_FN void fft_pass16(cpx* Z, int g, int lm) {
    const int mp = 1 << lm, ilo = g & (mp - 1), ihi = g >> lm, base = (ihi << (lm + 4)) + ilo;
    cpx v[16];
#pragma unroll
    for (int r = 0; r < 16; ++r) v[r] = Z[ZP(base + r * mp)];
    const float th = (float)ilo / (float)(16 * mp);
    float cA, sA, cB, sB, cC, sC, cD, sD;
    tw(th, cA, sA); tw(2.f * th, cB, sB); tw(4.f * th, cC, sC); tw(8.f * th, cD, sD);
    if (!INV) {
        FFT_BF(bf_dif, 0, 8, 0, cA, sA); FFT_BF(bf_dif, 1, 9, 1, cA, sA); FFT_BF(bf_dif, 2, 10, 2, cA, sA); FFT_BF(bf_dif, 3, 11, 3, cA, sA);
        FFT_BF(bf_dif, 4, 12, 4, cA, sA); FFT_BF(bf_dif, 5, 13, 5, cA, sA); FFT_BF(bf_dif, 6, 14, 6, cA, sA); FFT_BF(bf_dif, 7, 15, 7, cA, sA);
        FFT_BF(bf_dif, 0, 4, 0, cB, sB); FFT_BF(bf_dif, 1, 5, 2, cB, sB); FFT_BF(bf_dif, 2, 6, 4, cB, sB); FFT_BF(bf_dif, 3, 7, 6, cB, sB);
        FFT_BF(bf_dif, 8, 12, 0, cB, sB); FFT_BF(bf_dif, 9, 13, 2, cB, sB); FFT_BF(bf_dif, 10, 14, 4, cB, sB); FFT_BF(bf_dif, 11, 15, 6, cB, sB);
        FFT_BF(bf_dif, 0, 2, 0, cC, sC); FFT_BF(bf_dif, 1, 3, 4, cC, sC); FFT_BF(bf_dif, 4, 6, 0, cC, sC); FFT_BF(bf_dif, 5, 7, 4, cC, sC);
        FFT_BF(bf_dif, 8, 10, 0, cC, sC); FFT_BF(bf_dif, 9, 11, 4, cC, sC); FFT_BF(bf_dif, 12, 14, 0, cC, sC); FFT_BF(bf_dif, 13, 15, 4, cC, sC);
#pragma unroll
        for (int r = 0; r < 16; r += 2) bf_dif(v[r], v[r + 1], cD, sD);
    } else {
#pragma unroll
        for (int r = 0; r < 16; r += 2) bf_dit(v[r], v[r + 1], cD, sD);
        FFT_BF(bf_dit, 0, 2, 0, cC, sC); FFT_BF(bf_dit, 1, 3, 4, cC, sC); FFT_BF(bf_dit, 4, 6, 0, cC, sC); FFT_BF(bf_dit, 5, 7, 4, cC, sC);
        FFT_BF(bf_dit, 8, 10, 0, cC, sC); FFT_BF(bf_dit, 9, 11, 4, cC, sC); FFT_BF(bf_dit, 12, 14, 0, cC, sC); FFT_BF(bf_dit, 13, 15, 4, cC, sC);
        FFT_BF(bf_dit, 0, 4, 0, cB, sB); FFT_BF(bf_dit, 1, 5, 2, cB, sB); FFT_BF(bf_dit, 2, 6, 4, cB, sB); FFT_BF(bf_dit, 3, 7, 6, cB, sB);
        FFT_BF(bf_dit, 8, 12, 0, cB, sB); FFT_BF(bf_dit, 9, 13, 2, cB, sB); FFT_BF(bf_dit, 10, 14, 4, cB, sB); FFT_BF(bf_dit, 11, 15, 6, cB, sB);
        FFT_BF(bf_dit, 0, 8, 0, cA, sA); FFT_BF(bf_dit, 1, 9, 1, cA, sA); FFT_BF(bf_dit, 2, 10, 2, cA, sA); FFT_BF(bf_dit, 3, 11, 3, cA, sA);
        FFT_BF(bf_dit, 4, 12, 4, cA, sA); FFT_BF(bf_dit, 5, 13, 5, cA, sA); FFT_BF(bf_dit, 6, 14, 6, cA, sA); FFT_BF(bf_dit, 7, 15, 7, cA, sA);
    }
#pragma unroll
    for (int r = 0; r < 16; ++r) Z[ZP(base + r * mp)] = v[r];
}
template <bool INV> FFT_FN void fft_pass4(cpx* Z, int g) {
    const int base = 4 * g;
    cpx a = Z[ZP(base)], b = Z[ZP(base + 1)], c = Z[ZP(base + 2)], d = Z[ZP(base + 3)];
    if (!INV) {
        cpx a2 = {a.x + c.x, a.y + c.y}, c2 = {a.x - c.x, a.y - c.y};
        cpx b2 = {b.x + d.x, b.y + d.y}, t = {b.x - d.x, b.y - d.y}; cpx d2 = {t.y, -t.x};
        a = {a2.x + b2.x, a2.y + b2.y}; b = {a2.x - b2.x, a2.y - b2.y};
        c = {c2.x + d2.x, c2.y + d2.y}; d = {c2.x - d2.x, c2.y - d2.y};
    } else {
        cpx a2 = {a.x + b.x, a.y + b.y}, b2 = {a.x - b.x, a.y - b.y};
        cpx c2 = {c.x + d.x, c.y + d.y}, d2 = {c.x - d.x, c.y - d.y};
        a = {a2.x + c2.x, a2.y + c2.y}; c = {a2.x - c2.x, a2.y - c2.y};
        cpx t = {-d2.y, d2.x};
        b = {b2.x + t.x, b2.y + t.y}; d = {b2.x - t.x, b2.y - t.y};
    }
    Z[ZP(base)] = a; Z[ZP(base + 1)] = b; Z[ZP(base + 2)] = c; Z[ZP(base + 3)] = d;
}
FFT_FN int rev14(int p) {
#ifndef FFT_HOST
    return (int)(__builtin_bitreverse32((unsigned)p) >> 18);
#else
    int r = 0; for (int b = 0; b < 14; ++b) r |= ((p >> b) & 1) << (13 - b); return r;
#endif
}
FFT_FN int ilog2(int q) {
#ifndef FFT_HOST
    return 31 - __builtin_clz((unsigned)q);
#else
    int b = 0; while ((1 << (b + 1)) <= q) ++b; return b;
#endif
}
FFT_FN void fft_pointwise(cpx* Z, const cpx* Zh, int q) {
    if (q == 0) {
#pragma unroll
        for (int p0 = 0; p0 < 2; ++p0) {
            const cpx a = Z[ZP(p0)], h = Zh[p0];
            const float ue = a.x, uo = a.y, he = h.x, ho = h.y, sg = p0 ? -1.f : 1.f;
            cpx o = {ue * he + sg * uo * ho, ue * ho + uo * he};
            Z[ZP(p0)] = o;
        }
        return;
    }
    const int b = ilog2(q), pp = (2 << b) + (q - (1 << b)), pq = 3 * (2 << b) - 1 - pp;
    const int kk = rev14(pp);
    float wc, ws; tw((float)kk * (1.0f / (float)FFT_N), wc, ws);
    const cpx A = Z[ZP(pp)], B = Z[ZP(pq)], HA = Zh[pp], HB = Zh[pq];
    const cpx Ue = {0.5f * (A.x + B.x), 0.5f * (A.y - B.y)};
    const cpx dU = {A.x - B.x, A.y + B.y};
    const cpx Uo = {0.5f * dU.y, -0.5f * dU.x};
    const cpx He = {0.5f * (HA.x + HB.x), 0.5f * (HA.y - HB.y)};
    const cpx dH = {HA.x - HB.x, HA.y + HB.y};
    const cpx Ho = {0.5f * dH.y, -0.5f * dH.x};
    const cpx UoHo = {Uo.x * Ho.x - Uo.y * Ho.y, Uo.x * Ho.y + Uo.y * Ho.x};
    const cpx wUH = {wc * UoHo.x + ws * UoHo.y, wc * UoHo.y - ws * UoHo.x};
    const cpx Ye = {Ue.x * He.x - Ue.y * He.y + wUH.x, Ue.x * He.y + Ue.y * He.x + wUH.y};
    const cpx Yo = {Ue.x * Ho.x - Ue.y * Ho.y + Uo.x * He.x - Uo.y * He.y, Ue.x * Ho.y + Ue.y * Ho.x + Uo.x * He.y + Uo.y * He.x};
    cpx o1 = {Ye.x - Yo.y, Ye.y + Yo.x};
    cpx o2 = {Ye.x + Yo.y, -Ye.y + Yo.x};
    Z[ZP(pp)] = o1; Z[ZP(pq)] = o2;
}
#endif
template <class F> __device__ __forceinline__ void tconv_tile(const F& f, bf16_t* dst, int K, int k0, int n0, float* tile  ) {
    const int tid = otid();
    { const int n = tid & 63, kb = tid >> 6;
#pragma unroll
      for (int i = 0; i < 8; ++i) { const int k = kb + 8 * i; tile[k * 65 + n] = f(k0 + k, n0 + n); } }
    __syncthreads();
    { const int nn = tid >> 3, kq = (tid & 7) * 8; float v[8];
#pragma unroll
      for (int e = 0; e < 8; ++e) v[e] = tile[(kq + e) * 65 + nn];
      *(u32x4*)(dst + (size_t)(n0 + nn) * K + k0 + kq) = pack8(v); }
    __syncthreads();
}
__device__ __forceinline__ int in_src_col(int n) {
    if (n < 2048) return n;
    if (n < 3584) return 2704 + (n - 2048);
    if (n < 5120) return 4240 + (n - 3584);
    if (n < 5632) return 5776 + (n - 5120);
    if (n < 6080) return 2064 + (n - 5632);
    if (n < 6144) return -1;
    if (n < 6272) return 2512 + (n - 6144);
    if (n < 6336) return 2640 + (n - 6272);
    if (n < 6344) return 2048 + (n - 6336);
    if (n < 6352) return 2056 + (n - 6344);
    return -1;
}
struct FWin { const float* src; __device__ __forceinline__ float operator()(int k, int n) const { const int c = in_src_col(n); return c < 0 ? 0.f : src[(size_t)k * DIN + c]; } };
struct FPlain { const float* src; int ld; __device__ __forceinline__ float operator()(int k, int n) const { return src[(size_t)k * ld + n]; } };
struct FMla { const float *uq, *ukv, *qn, *kvn;
    __device__ __forceinline__ float operator()(int k, int n) const {
        if (n < 768) return k < 448 ? uq[(size_t)k * 768 + n] * qn[k] : 0.f;
        return k >= 512 ? ukv[(size_t)(k - 512) * 1024 + (n - 768)] * kvn[k - 512] : 0.f; } };
struct FW13 { const float *w1, *w3;
    __device__ __forceinline__ float operator()(int k, int n) const { const int col = (n >> 8) * 128 + (n & 127);
        const uintptr_t d = (uintptr_t)w3 - (uintptr_t)w1; const float* b = (const float*)((uintptr_t)w1 + (((n >> 7) & 1) ? d : (uintptr_t)0));
        return b[(size_t)k * DFF + col]; } };

constexpr int T_WIN = (NP / 64) * (D_ / 64), T_WOUT = 32 * 32, T_MLA = (MLAN / 64) * (MLAK / 64), T_F13 = (2 * DFF / 64) * 32, T_F2 = 32 * (DFF / 64);
constexpr int U_MOD = 96, U_HF = 516, U_TR = 2 * T_WIN + 2 * T_WOUT + 2 * T_MLA + T_F13 + T_F2;
constexpr int U_PRO = U_MOD + U_HF + U_TR;

__device__ __forceinline__ void pro_mod_unit(const Params& p, int u, float* lds) {
    const int tid = otid(), wid = tid >> 6, lane = tid & 63;
    const int l = u / 48, cb = u % 48, col = cb * 256 + lane * 4;
    const float* W = p.in[I_MODW] + (size_t)l * D_ * (6 * D_) + col;
    const float* c = p.in[I_C]; const float* cc = p.in[I_CCTX];
    f32x4 al = {0, 0, 0, 0}, ac = {0, 0, 0, 0};
    const int k0 = wid * 256;
#pragma unroll 4
    for (int k = k0; k < k0 + 256; ++k) {
        const f32x4 w4 = *(const f32x4*)(W + (size_t)k * (6 * D_));
        const float sl = silu_f(c[k]), sc = silu_f(cc[k]);
        al += w4 * sl; ac += w4 * sc;
    }
    f32x4* red = (f32x4*)lds;
    red[(wid * 64 + lane) * 2] = al; red[(wid * 64 + lane) * 2 + 1] = ac;
    __syncthreads();
    if (wid == 0) {
        f32x4 sl = {0, 0, 0, 0}, sc = {0, 0, 0, 0};
#pragma unroll
        for (int w = 0; w < 8; ++w) { sl += red[(w * 64 + lane) * 2]; sc += red[(w * 64 + lane) * 2 + 1]; }
        const f32x4 b4 = *(const f32x4*)(p.in[I_MODB] + (size_t)l * 6 * D_ + col);
        *(f32x4*)(p.modv() + ((size_t)l * 2 + 0) * 6 * D_ + col) = sl + b4;
        *(f32x4*)(p.modv() + ((size_t)l * 2 + 1) * 6 * D_ + col) = sc + b4;
    }
    __syncthreads();
}

__device__ __forceinline__ void pro_hfilt_unit(const Params& p, int l, int Lf, int tb, float* hout, float* hsumo, float* lds) {
    const int tid = otid(), wid = tid >> 6, lane = tid & 63;
    float* zb = lds;
    float* H1 = lds + 64 * 36;
    float* H2 = H1 + 64 * 65;
    const int t0 = tb * 64;
    const float* w1 = p.in[I_HW1] + (size_t)l * 33 * 64; const float* b1 = p.in[I_HB1] + l * 64;
    const float* w2 = p.in[I_HW2] + (size_t)l * 64 * 64; const float* b2 = p.in[I_HB2] + l * 64;
    const float* w3 = p.in[I_HW3] + (size_t)l * 64 * 64; const float* b3 = p.in[I_HB3] + l * 64;
    const float* w4 = p.in[I_HW4] + (size_t)l * 64 * 1024; const float* fq = p.in[I_HFREQ] + l * 64;
    {
        const int tp = lane, part = wid; const float pf = (float)(t0 + tp);
        const float c0 = (float)(6.283185307179586 / (double)Lf);
#pragma unroll 1
        for (int e = part; e < 33; e += 8) {
            float v;
            if (e == 0) v = pf / (float)(Lf - 1);
            else { const int b = (e - 1) & 15; const float fr = 1e-4f + (float)b * ((15.0f - 1e-4f) / 15.0f); const float ang = (c0 * pf) * fr; v = (e <= 16) ? cosf(ang) : -sinf(ang); }
            zb[tp * 36 + e] = v;
        }
    }
    __syncthreads();
    {   const int tp = lane, j0 = wid * 8;
#pragma unroll 1
        for (int jj = 0; jj < 8; ++jj) { const int j = j0 + jj; float s = b1[j];
            for (int e = 0; e < 33; ++e) s += zb[tp * 36 + e] * w1[e * 64 + j];
            H1[tp * 65 + j] = sinf(fq[j] * s); }
    }
    __syncthreads();
    {   const int tp = lane, j0 = wid * 8;
#pragma unroll 1
        for (int jj = 0; jj < 8; ++jj) { const int j = j0 + jj; float s = b2[j];
            for (int i = 0; i < 64; ++i) s += H1[tp * 65 + i] * w2[i * 64 + j];
            H2[tp * 65 + j] = sinf(fq[j] * s); }
    }
    __syncthreads();
    {   const int tp = lane, j0 = wid * 8;
#pragma unroll 1
        for (int jj = 0; jj < 8; ++jj) { const int j = j0 + jj; float s = b3[j];
            for (int i = 0; i < 64; ++i) s += H2[tp * 65 + i] * w3[i * 64 + j];
            H1[tp * 65 + j] = sinf(fq[j] * s); }
    }
    __syncthreads();
    const int nblk = Lf / 64;
#pragma unroll 1
    for (int i = 0; i < 2; ++i) {
        const int c = (wid + 8 * i) * 64 + lane;
        float wreg[64];
#pragma unroll
        for (int j = 0; j < 64; ++j) wreg[j] = w4[j * 1024 + c];
        const float a0 = -120.39728043259361f, a1 = 40.546510810816436f;
        const float delta = fabsf(a0 + (float)c * ((a1 - a0) / 1023.0f));
        float asum = 0.f;
#pragma unroll 1
        for (int tp = 0; tp < 64; ++tp) {
            float s = 0.f;
#pragma unroll
            for (int j = 0; j < 64; ++j) s += H1[tp * 65 + j] * wreg[j];
            const float pf = (float)(t0 + tp), dist = fabsf(pf - (float)(Lf / 2)) / (float)Lf;
            const float val = s * expf(-dist * delta);
            hout[(size_t)c * Lf + t0 + tp] = val; asum += fabsf(val);
        }
        hsumo[(size_t)c * nblk + tb] = asum;
    }
    __syncthreads();
}

__device__ __forceinline__ void phase_prologue(const Params& p, float* lds) {
    if (blockIdx.x == 0 && otid() < 16) p.cnt()[otid()] = 0u;
#pragma unroll 1
    for (int u = blockIdx.x; u < U_PRO; u += gridDim.x) {
        if (u < U_MOD) { pro_mod_unit(p, u, lds); continue; }
        int v = u - U_MOD;
        if (v < U_HF) {
            if (v < 512) { const int l = v >> 8, tb = v & 255; pro_hfilt_unit(p, l, SEQ, tb, p.hfilt() + (size_t)l * 1024 * SEQ, p.hsum() + (size_t)l * 1024 * 256, lds); }
            else pro_hfilt_unit(p, 0, LC, v - 512, p.hfc(), p.hsc(), lds);
            continue;
        }
        v -= U_HF;
        if (v < 2 * T_WIN) { const int l = v / T_WIN, t = v % T_WIN, nt = t / 32, kt = t % 32;
            FWin f{p.in[I_WIN] + (size_t)l * D_ * DIN}; tconv_tile(f, p.wb_in() + (size_t)l * NP * D_, D_, kt * 64, nt * 64, lds); continue; }
        v -= 2 * T_WIN;
        if (v < 2 * T_WOUT) { const int l = v / T_WOUT, t = v % T_WOUT, nt = t / 32, kt = t % 32;
            FPlain f{p.in[I_WOUT] + (size_t)l * D_ * D_, D_}; tconv_tile(f, p.wb_out() + (size_t)l * D_ * D_, D_, kt * 64, nt * 64, lds); continue; }
        v -= 2 * T_WOUT;
        if (v < 2 * T_MLA) { const int l = v / T_MLA, t = v % T_MLA, nt = t / 10, kt = t % 10;
            FMla f{p.in[I_MUQ] + (size_t)l * 448 * 768, p.in[I_MUKV] + (size_t)l * 128 * 1024, p.in[I_MQN] + l * 448, p.in[I_MKVN] + l * 128};
            tconv_tile(f, p.wb_mla() + (size_t)l * MLAN * MLAK, MLAK, kt * 64, nt * 64, lds); continue; }
        v -= 2 * T_MLA;
        if (v < T_F13) { const int nt = v / 32, kt = v % 32; FW13 f{p.in[I_FW1], p.in[I_FW3]}; tconv_tile(f, p.wb_f13(), D_, kt * 64, nt * 64, lds); continue; }
        v -= T_F13;
        { const int nt = v / 88, kt = v % 88; FPlain f{p.in[I_FW2], D_}; tconv_tile(f, p.wb_f2(), DFF, kt * 64, nt * 64, lds); }
    }
}
constexpr int T_M13 = NEXP * T_F13, T_M2 = NEXP * T_F2, U_MOEW = T_M13 + T_M2;
__device__ __forceinline__ void moe_w_unit(const Params& p, int v, float* lds) {
    if (v < T_M13) { const int e = v / T_F13, t = v % T_F13, nt = t / 32, kt = t % 32;
        FW13 f{p.in[I_MW1] + (size_t)e * D_ * DFF, p.in[I_MW3] + (size_t)e * D_ * DFF}; tconv_tile(f, p.wb_m13() + (size_t)e * 2 * DFF * D_, D_, kt * 64, nt * 64, lds); return; }
    v -= T_M13;
    { const int e = v / T_F2, t = v % T_F2, nt = t / 88, kt = t % 88;
      FPlain f{p.in[I_MW2] + (size_t)e * DFF * D_, D_}; tconv_tile(f, p.wb_m2() + (size_t)e * D_ * DFF, DFF, kt * 64, nt * 64, lds); }
}

__device__ __forceinline__ void phase_norm(const Params& p, int layer, int which, int row_lo) {
    const int tid = otid(), wid = tid >> 6, lane = tid & 63;
    const float* nw = p.in[which == 1 ? I_N1W : I_N2W] + (size_t)layer * D_;
    const int csh = (which == 1 ? 0 : 3) * D_, csc = (which == 1 ? 1 : 4) * D_;
    const bool route = (layer == 1 && which == 2);
    for (int r = row_lo + blockIdx.x * 8 + wid; r < MT; r += gridDim.x * 8) {
        const bool isc = r < LC;
        const float* src = (layer == 0 && which == 1) ? (isc ? p.in[I_CTX] + (size_t)r * D_ : p.in[I_X] + (size_t)(r - LC) * D_) : p.xcur() + (size_t)r * D_;
        const float* mv = p.modv() + ((size_t)layer * 2 + (isc ? 1 : 0)) * 6 * D_;
        f32x4 xv[8]; float ss = 0.f;
#pragma unroll
        for (int i = 0; i < 8; ++i) { xv[i] = *(const f32x4*)(src + (i * 64 + lane) * 4); ss += xv[i][0] * xv[i][0] + xv[i][1] * xv[i][1] + xv[i][2] * xv[i][2] + xv[i][3] * xv[i][3]; }
        ss = wave_sum(ss);
        const float rstd = rsqrtf(ss * (1.0f / D_) + EPS);
        float lg[NEXP];
#pragma unroll
        for (int e = 0; e < NEXP; ++e) lg[e] = 0.f;
#pragma unroll
        for (int i = 0; i < 8; ++i) { const int col = (i * 64 + lane) * 4;
            const f32x4 w4 = *(const f32x4*)(nw + col), sh = *(const f32x4*)(mv + csh + col), sc = *(const f32x4*)(mv + csc + col);
            const f32x4 hv = (xv[i] * rstd) * w4 * (sc + 1.0f) + sh;
            u32x2 o; o.x = cvt_pk_bf16(hv[0], hv[1]); o.y = cvt_pk_bf16(hv[2], hv[3]);
            *(u32x2*)(p.hbuf() + (size_t)r * D_ + col) = o;
            if (route) { const float* rt = p.in[I_ROUTER] + (size_t)col * NEXP;
#pragma unroll
                for (int j = 0; j < 4; ++j) { const f32x4 r0 = *(const f32x4*)(rt + j * NEXP), r1 = *(const f32x4*)(rt + j * NEXP + 4);
                    lg[0] += hv[j] * r0[0]; lg[1] += hv[j] * r0[1]; lg[2] += hv[j] * r0[2]; lg[3] += hv[j] * r0[3];
                    lg[4] += hv[j] * r1[0]; lg[5] += hv[j] * r1[1]; lg[6] += hv[j] * r1[2]; lg[7] += hv[j] * r1[3]; } }
        }
        if (route && !isc) {
#pragma unroll
            for (int e = 0; e < NEXP; ++e) lg[e] = wave_sum(lg[e]);
            if (lane == 0) {
                int e0 = 0; float v0 = lg[0];
#pragma unroll
                for (int e = 1; e < NEXP; ++e) if (lg[e] > v0) { v0 = lg[e]; e0 = e; }
                int e1 = -1; float v1 = -3.0e38f;
#pragma unroll
                for (int e = 0; e < NEXP; ++e) if (e != e0 && lg[e] > v1) { v1 = lg[e]; e1 = e; }
                const float w0 = 1.f / (1.f + expf(v1 - v0)), w1 = 1.f - w0;
                const int t = r - LC;
                const int p0 = (int)atomicAdd(&p.cnt()[e0], 1u), p1 = (int)atomicAdd(&p.cnt()[e1], 1u);
                p.tok_e()[t * 2] = e0; p.tok_e()[t * 2 + 1] = e1; p.tok_p()[t * 2] = p0; p.tok_p()[t * 2 + 1] = p1; p.tok_w()[t * 2] = w0; p.tok_w()[t * 2 + 1] = w1;
            }
        }
    }
}

__device__ __forceinline__ void phase_prep(const Params& p, int layer) {
    const int tid = otid(), wid = tid >> 6, lane = tid & 63;
    const float* gcw = p.in[I_GCONV] + (size_t)layer * 3 * 1536;
    const float LN1E4 = 9.210340371976184f;
    for (int r = blockIdx.x * 8 + wid; r < MT; r += gridDim.x * 8) {
        const bool isc = r < LC; const int t = r - LC;
        const bool hasp = isc ? (r > 0) : (r > LC), hasn = isc ? (r < LC - 1) : (r < MT - 1);
        const bf16_t* P0 = p.Pp() + (size_t)r * NP;
#pragma unroll
        for (int i = 0; i < 3; ++i) {
            const int ch = i * 512 + lane * 8;
            float x0[8], xm[8], xn[8], y[8];
            unpack8(*(const u32x4*)(P0 + PC_GQKV + ch), x0);
            if (hasp) unpack8(*(const u32x4*)(P0 - NP + PC_GQKV + ch), xm); else { for (int e = 0; e < 8; ++e) xm[e] = 0.f; }
            if (hasn) unpack8(*(const u32x4*)(P0 + NP + PC_GQKV + ch), xn); else { for (int e = 0; e < 8; ++e) xn[e] = 0.f; }
            float ss = 0.f;
#pragma unroll
            for (int e = 0; e < 8; ++e) { const float v = gcw[ch + e] * xm[e] + gcw[1536 + ch + e] * x0[e] + gcw[3072 + ch + e] * xn[e]; y[e] = silu_f(v); ss += y[e] * y[e]; }
            if (i < 2) { ss = sum16(ss); const float rn = rsqrtf(ss + EPS) * (i == 0 ? 0.08838834764831845f : 1.f);
#pragma unroll
                for (int e = 0; e < 8; ++e) y[e] *= rn; }
            *(u32x4*)(p.gqkv() + (size_t)r * 1536 + ch) = pack8(y);
        }
        if (lane < 8) {
            const float a = bf2f(P0[PC_A + lane]), b = bf2f(P0[PC_B + lane]);
            const float g = -expf(p.in[I_GALOG][layer * 8 + lane]) * softplus_f(a + p.in[I_GDT][layer * 8 + lane]);
            p.ggb()[(size_t)r * 16 + lane] = g; p.ggb()[(size_t)r * 16 + 8 + lane] = sigmoid_f(b);
        }
        {   float sq = 0.f, sk = 0.f;
            if (lane < 56) { float f[8]; unpack8(*(const u32x4*)(P0 + PC_CQ + lane * 8), f);
#pragma unroll
                for (int e = 0; e < 8; ++e) sq += f[e] * f[e]; }
            if (lane < 16) { float f[8]; unpack8(*(const u32x4*)(P0 + PC_CKV + lane * 8), f);
#pragma unroll
                for (int e = 0; e < 8; ++e) sk += f[e] * f[e]; }
            sq = wave_sum(sq); sk = wave_sum(sk);
            if (lane == 0) { p.mrs()[(size_t)r * 2] = rsqrtf(sq * (1.0f / 448.f) + EPS); p.mrs()[(size_t)r * 2 + 1] = rsqrtf(sk * (1.0f / 128.f) + EPS); }
        }
        if (lane < 32) {
            const int i = lane & 15, half = lane >> 4;
            const float x1 = bf2f(P0[PC_KR + half * 32 + i]), x2 = bf2f(P0[PC_KR + half * 32 + i + 16]);
            float o1 = x1, o2 = x2;
            if (!isc) { const float pos = (float)(half ? (t & 63) : (t >> 6)); const float inv = expf(-(float)i * (LN1E4 / 16.f)); float s, c; sincosf(pos * inv, &s, &c);
                o1 = x1 * c - x2 * s; o2 = x2 * c + x1 * s; }
            p.krr()[(size_t)r * 64 + half * 32 + i] = f2bf(o1); p.krr()[(size_t)r * 64 + half * 32 + i + 16] = f2bf(o2);
        }
        {   float s = 0.f, c = 1.f;
            if (!isc) { const float inv = expf(-(float)lane * (LN1E4 / 64.f)); sincosf((float)t * inv, &s, &c); }
#pragma unroll
            for (int it = 0; it < 8; ++it) { const int which = it >> 2, hd = it & 3; const int o = which * 512 + hd * 128 + lane;
                const float x1 = bf2f(P0[PC_RQKV + o]), x2 = bf2f(P0[PC_RQKV + o + 64]); const float sc = which ? 0.08838834764831845f : 1.f;
                p.rqk()[(size_t)r * 1024 + o] = f2bf((x1 * c - x2 * s) * sc); p.rqk()[(size_t)r * 1024 + o + 64] = f2bf((x2 * c + x1 * s) * sc); }
        }
    }
}
namespace att {
constexpr int NW = 8, QBLK = 32, KVBLK = 64, DK = 192, DV = 128;
constexpr float SCALE = 0.07216878364870322f;
constexpr float THR = 8.f;
constexpr int LDQ = MLAN, LDKN = MLAN, LDKR = 64, LDV = MLAN, LDO = D_;
constexpr int SHM_V = KVBLK * DV * 2, SHM_K = KVBLK * DK * 2, SHM_ATTN = 2 * SHM_V + 2 * SHM_K + NW * 64 * 4;
#define KSWZ(row, colB) ((row) * 384 + ((colB) ^ ((((row) >> 1) & 7) << 4)))
#define SBAR() __builtin_amdgcn_sched_barrier(0)
__device__ __forceinline__ int crow(int r, int hi) { return (r & 3) + 8 * (r >> 2) + 4 * hi; }
__device__ __forceinline__ void partialSM(f32x16& p0, f32x16& p1, float& m_reg, float& mn, float& alpha) {
    constexpr float C = SCALE * 1.4426950408889634f;
    float pmax = p0[0];
#pragma unroll
    for (int r = 1; r < 16; ++r) pmax = fmaxf(pmax, p0[r]);
#pragma unroll
    for (int r = 0; r < 16; ++r) pmax = fmaxf(pmax, p1[r]);
    { auto rr = __builtin_amdgcn_permlane32_swap(__float_as_uint(pmax), __float_as_uint(pmax), false, false);
      pmax = fmaxf(__uint_as_float(rr[0]), __uint_as_float(rr[1])); }
    if (__builtin_expect(__all(pmax - m_reg <= THR / SCALE), 1)) { mn = m_reg; alpha = 1.f; }
    else { mn = fmaxf(m_reg, pmax); alpha = __builtin_amdgcn_exp2f((m_reg - mn) * C); m_reg = mn; }
    const float mnC = -mn * C;
#pragma unroll
    for (int r = 0; r < 16; ++r) p0[r] = fmaf(p0[r], C, mnC);
#pragma unroll
    for (int r = 0; r < 16; ++r) p1[r] = fmaf(p1[r], C, mnC);
#pragma unroll
    for (int r = 0; r < 16; ++r) p0[r] = __builtin_amdgcn_exp2f(p0[r]);
}
__device__ __forceinline__ void finishSM(f32x16& p0, f32x16& p1, float alpha, float& l_reg, bf16x8& pa0, bf16x8& pa1, bf16x8& pa2, bf16x8& pa3) {
#pragma unroll
    for (int r = 0; r < 16; ++r) p1[r] = __builtin_amdgcn_exp2f(p1[r]);
    float ps = 0;
#pragma unroll
    for (int r = 0; r < 16; ++r) ps += p0[r];
#pragma unroll
    for (int r = 0; r < 16; ++r) ps += p1[r];
    { auto rr = __builtin_amdgcn_permlane32_swap(__float_as_uint(ps), __float_as_uint(ps), false, false);
      ps = __uint_as_float(rr[0]) + __uint_as_float(rr[1]); }
    l_reg = l_reg * alpha + ps;
#define PK4(P, BASE, OUT) do { unsigned a0 = cvt_pk_bf16(P[BASE + 0], P[BASE + 1]), a1 = cvt_pk_bf16(P[BASE + 2], P[BASE + 3]);   \
    unsigned b0 = cvt_pk_bf16(P[BASE + 4], P[BASE + 5]), b1 = cvt_pk_bf16(P[BASE + 6], P[BASE + 7]);                              \
    auto r0 = __builtin_amdgcn_permlane32_swap(a0, b0, false, false); auto r1 = __builtin_amdgcn_permlane32_swap(a1, b1, false, false); \
    u32x4 w = {r0[0], r1[0], r0[1], r1[1]}; OUT = *reinterpret_cast<bf16x8*>(&w); } while (0)
    PK4(p0, 0, pa0); PK4(p0, 8, pa1); PK4(p1, 0, pa2); PK4(p1, 8, pa3);
#undef PK4
}
__device__ __forceinline__ void qkt(f32x16& p0, f32x16& p1, const int (&ka)[4], int boff, const bf16x8* qr) {
    p0 = f32x16{}; p1 = f32x16{};
#pragma unroll
    for (int d0 = 0; d0 < 12; ++d0) { const int dl = d0 & 3, dh = d0 >> 2;
        const bf16x8 b0 = *(const LAS bf16x8*)(unsigned)(ka[dl] + (boff + dh * 128));
        const bf16x8 b1 = *(const LAS bf16x8*)(unsigned)(ka[dl] + (boff + dh * 128 + 32 * 384));
        p0 = __builtin_amdgcn_mfma_f32_32x32x16_bf16(b0, qr[d0], p0, 0, 0, 0);
        p1 = __builtin_amdgcn_mfma_f32_32x32x16_bf16(b1, qr[d0], p1, 0, 0, 0); }
}
__device__ __forceinline__ int v_st(int k, int c) { const int kk = (k & ~0xC) | ((k & 4) << 1) | ((k & 8) >> 1); return ((kk >> 3) * 4 + (c >> 5)) * 512 + ((kk & 7) * 32 + (c & 31)) * 2; }
__device__ __forceinline__ int v_rd_base(int lane) { return ((lane & 3) << 3) | (((lane >> 2) & 3) << 6) | (((lane >> 4) & 1) << 5) | (((lane >> 5) & 1) << 8); }
constexpr int v_rd_off(int d0, int ks, int half) { return d0 * 512 + ks * 4096 + half * 2048; }
template <int OFF> __device__ __forceinline__ s16x4 tr_read(int vb) {
    s16x4 r; asm volatile("ds_read_b64_tr_b16 %0, %1 offset:%2" : "=&v"(r) : "v"(vb), "i"(OFF) : "memory"); return r;
}
template <int D0> __device__ __forceinline__ void pv_one(f32x16& od, int vb, bf16x8 pa0, bf16x8 pa1, bf16x8 pa2, bf16x8 pa3) {
    const s16x4 l0 = tr_read<v_rd_off(D0, 0, 0)>(vb), h0 = tr_read<v_rd_off(D0, 0, 1)>(vb), l1 = tr_read<v_rd_off(D0, 1, 0)>(vb), h1 = tr_read<v_rd_off(D0, 1, 1)>(vb);
    const s16x4 l2 = tr_read<v_rd_off(D0, 2, 0)>(vb), h2 = tr_read<v_rd_off(D0, 2, 1)>(vb), l3 = tr_read<v_rd_off(D0, 3, 0)>(vb), h3 = tr_read<v_rd_off(D0, 3, 1)>(vb);
    asm volatile("s_waitcnt lgkmcnt(0)" ::: "memory"); SBAR();
#define PK(L, H) (bf16x8){L[0], L[1], L[2], L[3], H[0], H[1], H[2], H[3]}
    od = __builtin_amdgcn_mfma_f32_32x32x16_bf16(pa0, PK(l0, h0), od, 0, 0, 0);
    od = __builtin_amdgcn_mfma_f32_32x32x16_bf16(pa1, PK(l1, h1), od, 0, 0, 0);
    od = __builtin_amdgcn_mfma_f32_32x32x16_bf16(pa2, PK(l2, h2), od, 0, 0, 0);
    od = __builtin_amdgcn_mfma_f32_32x32x16_bf16(pa3, PK(l3, h3), od, 0, 0, 0);
#undef PK
}
__device__ __forceinline__ void pv_d0(f32x16* o, int vb, bf16x8 pa0, bf16x8 pa1, bf16x8 pa2, bf16x8 pa3) {
    pv_one<0>(o[0], vb, pa0, pa1, pa2, pa3); pv_one<1>(o[1], vb, pa0, pa1, pa2, pa3); pv_one<2>(o[2], vb, pa0, pa1, pa2, pa3); pv_one<3>(o[3], vb, pa0, pa1, pa2, pa3);
}
__device__ __forceinline__ void attn_body(const bf16_t* __restrict__ Qb, const bf16_t* __restrict__ Kn, const bf16_t* __restrict__ Kr, const bf16_t* __restrict__ Vh,
                                          bf16_t* __restrict__ Ob, int seq, int rope_t0, char* lds) {
    const int tid = otid(), wid = tid >> 6, lane = tid & 63, r32 = lane & 31, hi = lane >> 5;
    char* V_lds = lds; char* K_lds = lds + 2 * SHM_V;
    float* ws = (float*)(lds + 2 * SHM_V + 2 * SHM_K) + wid * 64; float* li_l = ws; float* al_l = ws + 32;
    float m_reg = -1e30f, l_reg = 0; f32x16 o[4] = {}; bf16x8 qr[12];
    const bf16_t* Qw = Qb + (long)(wid * QBLK + r32) * LDQ + hi * 8;
#pragma unroll
    for (int d0 = 0; d0 < 8; ++d0) qr[d0] = *reinterpret_cast<const bf16x8*>(Qw + d0 * 16);
    {
        bf16_t* Qr = (bf16_t*)(lds + SHM_ATTN);
#pragma unroll 1
        for (int it = 0; it < 16; ++it) { const int item = tid + it * 512, row = item >> 5, pr = item & 31, half = pr >> 4, i = pr & 15;
            const bf16_t* qp = Qb + (long)row * LDQ + 128 + half * 32 + i;
            const float x1 = bf2f(qp[0]), x2 = bf2f(qp[16]); float o1 = x1, o2 = x2;
            if (rope_t0 >= 0) { const int t = rope_t0 + row; const float pos = (float)(half ? (t & 63) : (t >> 6));
                const float inv = expf(-(float)i * (9.210340371976184f / 16.f)); float s, c; sincosf(pos * inv, &s, &c);
                o1 = x1 * c - x2 * s; o2 = x2 * c + x1 * s; }
            Qr[row * 64 + half * 32 + i] = f2bf(o1); Qr[row * 64 + half * 32 + i + 16] = f2bf(o2); }
        __syncthreads();
#pragma unroll
        for (int dd = 0; dd < 4; ++dd) qr[8 + dd] = *reinterpret_cast<const bf16x8*>(Qr + (wid * QBLK + r32) * 64 + dd * 16 + hi * 8);
    }
    const int sr = tid >> 4, sc = (tid & 15) * 8, vst0 = v_st(sr, sc), vst1 = v_st(32 + sr, sc);
    const int rr = tid >> 3, rc = (tid & 7) * 8;
    const int vb0 = (int)(uintptr_t)V_lds + v_rd_base(lane);
    int ka[4];
#pragma unroll
    for (int dl = 0; dl < 4; ++dl) ka[dl] = (int)(uintptr_t)K_lds + r32 * 384 + ((dl * 32 + hi * 16) ^ (((r32 >> 1) & 7) << 4));
    struct { bf16x8 vs0, vs1, ks0, ks1, kr; } sr_[1];
    const unsigned ovA = (unsigned)(sr * LDV + sc) * 2u, ovB = (unsigned)((32 + sr) * LDV + sc) * 2u, orr = (unsigned)(rr * LDKR + rc) * 2u;
#define SLOAD(i, k0) do { const char* vbp = (const char*)Vh + (size_t)(k0) * (LDV * 2); const char* kbp = (const char*)Kn + (size_t)(k0) * (LDKN * 2); const char* rbp = (const char*)Kr + (size_t)(k0) * (LDKR * 2); \
    sr_[i].vs0 = *(const bf16x8*)(vbp + ovA); sr_[i].vs1 = *(const bf16x8*)(vbp + ovB); \
    sr_[i].ks0 = *(const bf16x8*)(kbp + ovA); sr_[i].ks1 = *(const bf16x8*)(kbp + ovB); \
    sr_[i].kr = *(const bf16x8*)(rbp + orr); } while (0)
#define SWRITE(b, i) do { *(bf16x8*)(V_lds + (b) * SHM_V + vst0) = sr_[i].vs0; *(bf16x8*)(V_lds + (b) * SHM_V + vst1) = sr_[i].vs1; const int kc = sc * 2; \
    *(bf16x8*)(K_lds + (b) * SHM_K + KSWZ(sr, kc)) = sr_[i].ks0; *(bf16x8*)(K_lds + (b) * SHM_K + KSWZ(32 + sr, kc)) = sr_[i].ks1; \
    *(bf16x8*)(K_lds + (b) * SHM_K + KSWZ(rr, 256 + rc * 2)) = sr_[i].kr; } while (0)
#define SWAIT() asm volatile("s_waitcnt vmcnt(0)" ::: "memory")
#define RESC(a) do { if (__any((a) < 1.f)) { if (hi == 0) al_l[r32] = (a); asm volatile("s_waitcnt lgkmcnt(0)" ::: "memory"); \
    _Pragma("unroll") for (int d = 0; d < 4; ++d) _Pragma("unroll") for (int r = 0; r < 16; ++r) o[d][r] *= al_l[crow(r, hi)]; } } while (0)
    f32x16 pA0, pA1, pB0, pB1; float mnA, mnB, alA, alB; bf16x8 pa0, pa1, pa2, pa3; const int NT = seq / KVBLK;
    constexpr int SE = 0, SO = 0;
    SLOAD(SE, 0); asm volatile("s_waitcnt vmcnt(0)" ::: "memory"); SWRITE(0, SE); __syncthreads();
    qkt(pA0, pA1, ka, 0, qr); partialSM(pA0, pA1, m_reg, mnA, alA);
    SLOAD(SO, KVBLK);
    SWAIT(); SWRITE(1, SO); __syncthreads();
    for (int j = 1; j + 1 < NT; j += 2) {
        SBAR(); qkt(pB0, pB1, ka, SHM_K, qr);
        finishSM(pA0, pA1, alA, l_reg, pa0, pa1, pa2, pa3); SBAR();
        SLOAD(SO, (j + 1) * KVBLK); SBAR();
        pv_d0(o, vb0, pa0, pa1, pa2, pa3); partialSM(pB0, pB1, m_reg, mnB, alB);
        __syncthreads(); SWAIT(); SWRITE(0, SE);
        RESC(alB); __syncthreads();
        SBAR(); qkt(pA0, pA1, ka, 0, qr);
        finishSM(pB0, pB1, alB, l_reg, pa0, pa1, pa2, pa3); SBAR();
        SLOAD(SE, (j + 2) * KVBLK); SBAR();
        pv_d0(o, vb0 + SHM_V, pa0, pa1, pa2, pa3); partialSM(pA0, pA1, m_reg, mnA, alA);
        __syncthreads(); SWAIT(); SWRITE(1, SO);
        RESC(alA); __syncthreads();
    }
    SBAR(); qkt(pB0, pB1, ka, SHM_K, qr);
    finishSM(pA0, pA1, alA, l_reg, pa0, pa1, pa2, pa3); SBAR();
    pv_d0(o, vb0, pa0, pa1, pa2, pa3); partialSM(pB0, pB1, m_reg, mnB, alB);
    __syncthreads(); RESC(alB);
    finishSM(pB0, pB1, alB, l_reg, pa0, pa1, pa2, pa3); SBAR();
    pv_d0(o, vb0 + SHM_V, pa0, pa1, pa2, pa3);
    if (hi == 0) li_l[r32] = l_reg; asm volatile("s_waitcnt lgkmcnt(0)" ::: "memory");
    float rli[16];
#pragma unroll
    for (int r = 0; r < 16; ++r) rli[r] = __builtin_amdgcn_rcpf(li_l[crow(r, hi)]);
    bf16_t* Ow = Ob + (long)(wid * QBLK) * LDO;
#pragma unroll
    for (int r = 0; r < 16; ++r) { const int orow = crow(r, hi);
#pragma unroll
        for (int d0 = 0; d0 < 4; ++d0) Ow[(long)orow * LDO + d0 * 32 + r32] = f2bf(o[d0][r] * rli[r]); }
    __syncthreads();
#undef SLOAD
#undef SWRITE
#undef SWAIT
#undef RESC
}
}

__device__ __forceinline__ void phase_attn(const Params& p, int layer, char* lds) {
    const int nunits = 256 + (layer == 0 ? 4 : 0);
#pragma unroll 1
    for (int u = blockIdx.x; u < nunits; u += gridDim.x) {
        const bool lat = u < 256;
        const int xcd = u & 7, h = lat ? (xcd >> 1) : (u - 256), qb = (u >> 3) * 2 + (xcd & 1);
        const int row0 = lat ? LC + qb * 256 : 0;
        att::attn_body(p.qkvup() + (size_t)row0 * MLAN + h * 192, p.qkvup() + 768 + h * 256, p.krr(), p.qkvup() + 768 + h * 256 + 128,
                       p.ocat() + (size_t)row0 * D_ + 512 + h * 128, lat ? MT : LC, lat ? qb * 256 : -1, lds);
    }
}

__device__ __forceinline__ void phase_rec_naive(const Params& p, int layer, float* lds) {
    const int tid = otid();
    float* kq = lds;
    float* vv = lds + 32 * 256;
    float* ab = vv + 32 * 128;
    for (int u = blockIdx.x; u < 16; u += gridDim.x) {
        const int kind = u >> 3, dir = (u >> 2) & 1, h = u & 3;
        float S[128];
#pragma unroll
        for (int i = 0; i < 128; ++i) S[i] = 0.f;
        const float gam = 1.0f - exp2f(-(float)((dir ? 6 : 5) + 2 * h));
        float* outp = (kind == 0 ? p.go() : p.ro()) + (size_t)dir * MT * 512 + h * 128;
        for (int s0 = 0; s0 < MT; s0 += 32) {
            __syncthreads();
            {   const int tk = tid >> 4, seg = (tid & 15) * 16; const int s = s0 + tk;
                const int row = dir == 0 ? s : (s < LC ? LC - 1 - s : MT + LC - 1 - s);
                const bf16_t* src;
                if (kind == 0) src = p.gqkv() + (size_t)row * 1536 + (seg < 128 ? 512 + h * 128 + seg : h * 128 + (seg - 128));
                else           src = p.rqk() + (size_t)row * 1024 + (seg < 128 ? 512 + h * 128 + seg : h * 128 + (seg - 128));
                float f[8]; unpack8(*(const u32x4*)src, f);
#pragma unroll
                for (int e = 0; e < 8; ++e) kq[tk * 256 + seg + e] = f[e];
                unpack8(*(const u32x4*)(src + 8), f);
#pragma unroll
                for (int e = 0; e < 8; ++e) kq[tk * 256 + seg + 8 + e] = f[e];
                const int vseg = (tid & 15) * 8;
                const bf16_t* vsrc = kind == 0 ? p.gqkv() + (size_t)row * 1536 + 1024 + h * 128 + vseg : p.Pp() + (size_t)row * NP + PC_RQKV + 1024 + h * 128 + vseg;
                unpack8(*(const u32x4*)vsrc, f);
#pragma unroll
                for (int e = 0; e < 8; ++e) vv[tk * 128 + vseg + e] = f[e];
                if (tid < 32) { const int s2 = s0 + tid; const int row2 = dir == 0 ? s2 : (s2 < LC ? LC - 1 - s2 : MT + LC - 1 - s2);
                    if (kind == 0) { ab[tid * 2] = expf(p.ggb()[(size_t)row2 * 16 + dir * 4 + h]); ab[tid * 2 + 1] = p.ggb()[(size_t)row2 * 16 + 8 + dir * 4 + h]; }
                    else { ab[tid * 2] = gam; ab[tid * 2 + 1] = 1.f; } }
            }
            __syncthreads();
            if (tid < 128) {
                for (int tk = 0; tk < 32; ++tk) {
                    const f32x4* kp = (const f32x4*)(kq + tk * 256); const f32x4* qp = kp + 32;
                    const float a = ab[tk * 2], b = ab[tk * 2 + 1], v = vv[tk * 128 + tid];
                    float dv;
                    if (kind == 0) { float ks = 0.f;
#pragma unroll
                        for (int i = 0; i < 32; ++i) { const f32x4 k4 = kp[i]; ks += k4[0] * S[4 * i] + k4[1] * S[4 * i + 1] + k4[2] * S[4 * i + 2] + k4[3] * S[4 * i + 3]; }
                        dv = b * (v - a * ks); }
                    else dv = v;
                    float o = 0.f;
#pragma unroll
                    for (int i = 0; i < 32; ++i) { const f32x4 k4 = kp[i], q4 = qp[i];
                        S[4 * i] = a * S[4 * i] + k4[0] * dv; S[4 * i + 1] = a * S[4 * i + 1] + k4[1] * dv; S[4 * i + 2] = a * S[4 * i + 2] + k4[2] * dv; S[4 * i + 3] = a * S[4 * i + 3] + k4[3] * dv;
                        o += q4[0] * S[4 * i] + q4[1] * S[4 * i + 1] + q4[2] * S[4 * i + 2] + q4[3] * S[4 * i + 3]; }
                    const int s = s0 + tk; const int row = dir == 0 ? s : (s < LC ? LC - 1 - s : MT + LC - 1 - s);
                    outp[(size_t)row * 512 + tid] = o;
                }
            }
        }
        __syncthreads();
    }
}

__device__ __forceinline__ void phase_mixout(const Params& p, int layer) {
    const int tid = otid(), wid = tid >> 6, lane = tid & 63;
    const float* gnw = p.in[I_GNW] + layer * 128;
    for (int r = blockIdx.x * 8 + wid; r < MT; r += gridDim.x * 8) {
        const int idx = lane * 8;
#pragma unroll
        for (int kind = 0; kind < 2; ++kind) {
            const float* o0 = (kind == 0 ? p.go() : p.ro()) + (size_t)r * 512 + idx; const float* o1 = o0 + (size_t)MT * 512;
            float o[8]; float ss = 0.f;
            { const f32x4 a0 = *(const f32x4*)o0, a1 = *(const f32x4*)(o0 + 4), b0 = *(const f32x4*)o1, b1 = *(const f32x4*)(o1 + 4);
#pragma unroll
              for (int e = 0; e < 4; ++e) { o[e] = a0[e] + b0[e]; o[4 + e] = a1[e] + b1[e]; } }
#pragma unroll
            for (int e = 0; e < 8; ++e) ss += o[e] * o[e];
            ss = sum16(ss);
            const float rn = rsqrtf(ss * (1.0f / 128.f) + EPS);
            float z[8]; unpack8(*(const u32x4*)(p.Pp() + (size_t)r * NP + (kind == 0 ? PC_GZ : PC_RG) + idx), z);
            float y[8];
#pragma unroll
            for (int e = 0; e < 8; ++e) { const float w = kind == 0 ? gnw[(idx + e) & 127] : 1.f; y[e] = o[e] * rn * w * silu_f(z[e]); }
            *(u32x4*)(p.ocat() + (size_t)r * D_ + (kind == 0 ? 0 : 1536) + idx) = pack8(y);
        }
    }
}
constexpr int NCHUNK = MT / 64;
constexpr size_t REC_Q = 0, REC_KT = 16384, REC_A = 32768, REC_W = 40960, REC_U = 57344, REC_DL = 90112, REC_BYTES = 90368;
__device__ __forceinline__ int scan_row(int dir, int s) { return dir == 0 ? s : (s < LC ? LC - 1 - s : MT + LC - 1 - s); }
__device__ __forceinline__ int crow32(int r, int hi) { return (r & 3) + 8 * (r >> 2) + 4 * hi; }

__device__ __forceinline__ void chunkprep_unit(const Params& p, int layer, int c, int n, char* lds) {
    const int tid = otid(), wid = tid >> 6, lane = tid & 63, r32 = lane & 31, hi = lane >> 5;
    const int kind = c >> 3, dir = (c >> 2) & 1, h = c & 3;
    char* qL = lds; char* kL = lds + 17408; char* vL = lds + 34816; float* AM = (float*)(lds + 52224); float* scv = (float*)(lds + 69632);
    float* gcL = scv; float* btL = scv + 64; float* egL = scv + 128; float* ekL = scv + 192;
    char* rec = p.recs() + ((size_t)c * NCHUNK + n) * REC_BYTES;
    {   const int tk = tid >> 3, seg = (tid & 7) * 16; const int row = scan_row(dir, n * 64 + tk);
        const bf16_t *qs, *ks, *vs;
        if (kind == 0) { const bf16_t* b = p.gqkv() + (size_t)row * 1536 + h * 128 + seg; qs = b; ks = b + 512; vs = b + 1024; }
        else { const bf16_t* b = p.rqk() + (size_t)row * 1024 + h * 128 + seg; qs = b; ks = b + 512; vs = p.Pp() + (size_t)row * NP + PC_RQKV + 1024 + h * 128 + seg; }
        const u32x4 q0 = *(const u32x4*)qs, q1 = *(const u32x4*)(qs + 8), k0 = *(const u32x4*)ks, k1 = *(const u32x4*)(ks + 8), v0 = *(const u32x4*)vs, v1 = *(const u32x4*)(vs + 8);
        const int lo = tk * 272 + seg * 2;
        *(u32x4*)(qL + lo) = q0; *(u32x4*)(qL + lo + 16) = q1; *(u32x4*)(kL + lo) = k0; *(u32x4*)(kL + lo + 16) = k1; *(u32x4*)(vL + lo) = v0; *(u32x4*)(vL + lo + 16) = v1;
    }
    if (wid == 0) {
        float g, b;
        if (kind == 0) { const int row = scan_row(dir, n * 64 + lane); g = p.ggb()[(size_t)row * 16 + dir * 4 + h]; b = p.ggb()[(size_t)row * 16 + 8 + dir * 4 + h]; }
        else { const int ei = dir + 2 * h; g = (ei == 0 ? -3.1748698315e-02f : (ei == 1 ? -1.5748356968e-02f : (ei == 2 ? -7.8431774610e-03f : (ei == 3 ? -3.9138993211e-03f : (ei == 4 ? -1.9550348358e-03f : (ei == 5 ? -9.7703964783e-04f : (ei == 6 ? -4.8840049811e-04f : -2.4417043217e-04f))))))); b = 1.f; }
        float gc = g;
#pragma unroll
        for (int o = 1; o < 64; o <<= 1) { const float t = __int_as_float(__builtin_amdgcn_ds_bpermute(((lane - o) & 63) << 2, __float_as_int(gc))); if (lane >= o) gc += t; }
        const float gl = __int_as_float(__builtin_amdgcn_readlane(__float_as_int(gc), 63));
        gcL[lane] = gc; btL[lane] = b; egL[lane] = expf(gc); ekL[lane] = expf(gl - gc);
        if (lane == 63) *(float*)(rec + REC_DL) = expf(gc);
    }
    __syncthreads();
    {   const int mat = wid >> 2, mi = (wid >> 1) & 1, ni = wid & 1;
        if (mat == 1 || kind == 0) {
            f32x16 acc = {};
            if (!(mi == 0 && ni == 1)) {
                const char* XL = mat ? qL : kL;
#pragma unroll
                for (int ks = 0; ks < 8; ++ks) {
                    const bf16x8 a = *(const bf16x8*)(XL + (32 * mi + r32) * 272 + (16 * ks + 8 * hi) * 2);
                    const bf16x8 b = *(const bf16x8*)(kL + (32 * ni + r32) * 272 + (16 * ks + 8 * hi) * 2);
                    acc = __builtin_amdgcn_mfma_f32_32x32x16_bf16(a, b, acc, 0, 0, 0);
                }
            }
            const int j = 32 * ni + r32; const float gj = gcL[j];
#pragma unroll
            for (int r = 0; r < 16; ++r) { const int i = 32 * mi + crow32(r, hi);
                const float dec = expf(fminf(gcL[i] - gj, 0.f));
                if (mat == 0) AM[i * 68 + j] = (j < i) ? btL[i] * acc[r] * dec : 0.f;
                else *(bf16_t*)(rec + REC_A + (size_t)(i * 64 + j) * 2) = f2bf((j <= i) ? acc[r] * dec : 0.f); }
        }
    }
    __syncthreads();
    if (tid < 256) {
        if (kind == 0) {
            const int cc = tid & 127; const bool isw = tid >= 128; const char* src = isw ? kL : vL;
            float x[64];
#pragma unroll
            for (int i = 0; i < 64; ++i) {
                float a = bf2f(*(const bf16_t*)(src + i * 272 + cc * 2)) * btL[i]; if (isw) a *= egL[i];
#pragma unroll
                for (int j4 = 0; j4 < (i + 3) / 4; ++j4) { const f32x4 a4 = *(const f32x4*)(AM + i * 68 + j4 * 4);
                    if (4 * j4 + 0 < i) a -= a4[0] * x[4 * j4 + 0]; if (4 * j4 + 1 < i) a -= a4[1] * x[4 * j4 + 1];
                    if (4 * j4 + 2 < i) a -= a4[2] * x[4 * j4 + 2]; if (4 * j4 + 3 < i) a -= a4[3] * x[4 * j4 + 3]; }
                x[i] = a;
                if (isw) *(bf16_t*)(rec + REC_W + (size_t)(i * 128 + cc) * 2) = f2bf(a); else *(float*)(rec + REC_U + (size_t)(i * 128 + cc) * 4) = a;
            }
        } else if (tid < 128) {
#pragma unroll 8
            for (int i = 0; i < 64; ++i) *(float*)(rec + REC_U + (size_t)(i * 128 + tid) * 4) = bf2f(*(const bf16_t*)(vL + i * 272 + tid * 2));
        }
    } else {
        const int t2 = tid - 256;
        {   const int i = t2 >> 2, seg = (t2 & 3) * 32; const float e = egL[i];
#pragma unroll
            for (int k8 = 0; k8 < 4; ++k8) { float f[8]; unpack8(*(const u32x4*)(qL + i * 272 + (seg + k8 * 8) * 2), f);
#pragma unroll
                for (int e8 = 0; e8 < 8; ++e8) f[e8] *= e;
                *(u32x4*)(rec + REC_Q + (size_t)(i * 128 + seg + k8 * 8) * 2) = pack8(f); } }
        {   const int d = t2 >> 1, half = t2 & 1;
#pragma unroll
            for (int k8 = 0; k8 < 4; ++k8) { float f[8];
#pragma unroll
                for (int e8 = 0; e8 < 8; ++e8) { const int i = half * 32 + k8 * 8 + e8; f[e8] = bf2f(*(const bf16_t*)(kL + i * 272 + d * 2)) * ekL[i]; }
                *(u32x4*)(rec + REC_KT + (size_t)(d * 64 + half * 32 + k8 * 8) * 2) = pack8(f); } }
    }
    __syncthreads();
}
__device__ __forceinline__ void phase_chunkprep(const Params& p, int layer, char* lds) {
#pragma unroll 1
    for (int u = blockIdx.x; u < 16 * NCHUNK; u += gridDim.x) chunkprep_unit(p, layer, u & 15, u >> 4, lds);
}

constexpr int CH_W = 0, CH_Q = 16896, CH_A = 33792, CH_K = 42496, CH_BUF = 59904;
__device__ __forceinline__ bf16x8 frag_rd(const char* base, int row, int stride, int ks, int hi) {
    const char* a = base + row * stride + (16 * ks + 4 * hi) * 2;
    const u32x2 lo = *(const u32x2*)a, hi2 = *(const u32x2*)(a + 16);
    u32x4 w = {lo.x, lo.y, hi2.x, hi2.y}; return *reinterpret_cast<bf16x8*>(&w);
}
__device__ __forceinline__ bf16x8 acc_frag(const f32x16& x, int s) {
    u32x4 w = {cvt_pk_bf16(x[8 * s + 0], x[8 * s + 1]), cvt_pk_bf16(x[8 * s + 2], x[8 * s + 3]), cvt_pk_bf16(x[8 * s + 4], x[8 * s + 5]), cvt_pk_bf16(x[8 * s + 6], x[8 * s + 7])};
    return *reinterpret_cast<bf16x8*>(&w);
}
__device__ __forceinline__ void chain_stage(const char* rec, char* buf, int t  , bool gdn) {
#pragma unroll
    for (int it = 0; it < 4; ++it) { const int pc = t + it * 256; const u32x4 v = *(const u32x4*)(rec + REC_Q + (size_t)pc * 16);
        char* d = buf + CH_Q + (pc >> 4) * 264 + (pc & 15) * 16; *(u32x2*)d = (u32x2){v.x, v.y}; *(u32x2*)(d + 8) = (u32x2){v.z, v.w}; }
#pragma unroll
    for (int it = 0; it < 4; ++it) { const int pc = t + it * 256; const u32x4 v = *(const u32x4*)(rec + REC_KT + (size_t)pc * 16);
        char* d = buf + CH_K + (pc >> 3) * 136 + (pc & 7) * 16; *(u32x2*)d = (u32x2){v.x, v.y}; *(u32x2*)(d + 8) = (u32x2){v.z, v.w}; }
#pragma unroll
    for (int it = 0; it < 2; ++it) { const int pc = t + it * 256; const u32x4 v = *(const u32x4*)(rec + REC_A + (size_t)pc * 16);
        char* d = buf + CH_A + (pc >> 3) * 136 + (pc & 7) * 16; *(u32x2*)d = (u32x2){v.x, v.y}; *(u32x2*)(d + 8) = (u32x2){v.z, v.w}; }
    if (gdn) {
#pragma unroll
        for (int it = 0; it < 4; ++it) { const int pc = t + it * 256; const u32x4 v = *(const u32x4*)(rec + REC_W + (size_t)pc * 16);
            char* d = buf + CH_W + (pc >> 4) * 264 + (pc & 15) * 16; *(u32x2*)d = (u32x2){v.x, v.y}; *(u32x2*)(d + 8) = (u32x2){v.z, v.w}; }
    }
}
__device__ __forceinline__ void chain_unit(const Params& p, int c, char* lds) {
    const int tid = otid(), wid = tid >> 6, lane = tid & 63, r32 = lane & 31, hi = lane >> 5;
    const int kind = c >> 3, dir = (c >> 2) & 1, h = c & 3; const bool gdn = kind == 0;
    const char* rec0 = p.recs() + (size_t)c * NCHUNK * REC_BYTES;
    float* outp = (gdn ? p.go() : p.ro()) + (size_t)dir * MT * 512 + h * 128;
    const bool comp = wid < 4; const int sl = wid & 3;
    f32x16 S[4] = {}; f32x16 un[2];
    if (!comp) chain_stage(rec0, lds, tid - 256, gdn);
    else {
#pragma unroll
        for (int mt = 0; mt < 2; ++mt)
#pragma unroll
            for (int r = 0; r < 16; ++r) un[mt][r] = *(const float*)(rec0 + REC_U + (size_t)((32 * mt + crow32(r, hi)) * 128 + 32 * sl + r32) * 4);
    }
    __syncthreads();
#pragma unroll 1
    for (int n = 0; n < NCHUNK; ++n) {
        const char* rec = rec0 + (size_t)n * REC_BYTES; char* buf = lds + (n & 1) * CH_BUF;
        if (!comp) { if (n + 1 < NCHUNK) chain_stage(rec + REC_BYTES, lds + ((n + 1) & 1) * CH_BUF, tid - 256, gdn); }
        else {
            const float dl = *(const float*)(rec + REC_DL);
            bf16x8 Sb[4][2];
#pragma unroll
            for (int kt = 0; kt < 4; ++kt) { Sb[kt][0] = acc_frag(S[kt], 0); Sb[kt][1] = acc_frag(S[kt], 1); }
            f32x16 vn[2];
#pragma unroll
            for (int mt = 0; mt < 2; ++mt) {
                f32x16 X = {};
                if (gdn) {
#pragma unroll
                    for (int ks = 0; ks < 8; ++ks) X = __builtin_amdgcn_mfma_f32_32x32x16_bf16(frag_rd(buf + CH_W, 32 * mt + r32, 264, ks, hi), Sb[ks >> 1][ks & 1], X, 0, 0, 0);
                }
                vn[mt] = un[mt] - X;
            }
            if (n + 1 < NCHUNK) {
#pragma unroll
                for (int mt = 0; mt < 2; ++mt)
#pragma unroll
                    for (int r = 0; r < 16; ++r) un[mt][r] = *(const float*)(rec + REC_BYTES + REC_U + (size_t)((32 * mt + crow32(r, hi)) * 128 + 32 * sl + r32) * 4);
            }
            bf16x8 Vb[2][2];
#pragma unroll
            for (int tt = 0; tt < 2; ++tt) { Vb[tt][0] = acc_frag(vn[tt], 0); Vb[tt][1] = acc_frag(vn[tt], 1); }
#pragma unroll
            for (int mt = 0; mt < 2; ++mt) {
                f32x16 O = {};
#pragma unroll
                for (int ks = 0; ks < 8; ++ks) O = __builtin_amdgcn_mfma_f32_32x32x16_bf16(frag_rd(buf + CH_Q, 32 * mt + r32, 264, ks, hi), Sb[ks >> 1][ks & 1], O, 0, 0, 0);
#pragma unroll
                for (int ks = 0; ks < 4; ++ks) O = __builtin_amdgcn_mfma_f32_32x32x16_bf16(frag_rd(buf + CH_A, 32 * mt + r32, 136, ks, hi), Vb[ks >> 1][ks & 1], O, 0, 0, 0);
#pragma unroll
                for (int r = 0; r < 16; ++r) { const int row = scan_row(dir, n * 64 + 32 * mt + crow32(r, hi)); outp[(size_t)row * 512 + 32 * sl + r32] = O[r]; }
            }
#pragma unroll
            for (int kt = 0; kt < 4; ++kt) {
                f32x16 a = S[kt] * dl;
#pragma unroll
                for (int ks = 0; ks < 4; ++ks) a = __builtin_amdgcn_mfma_f32_32x32x16_bf16(frag_rd(buf + CH_K, 32 * kt + r32, 136, ks, hi), Vb[ks >> 1][ks & 1], a, 0, 0, 0);
                S[kt] = a;
            }
        }
        __syncthreads();
    }
}
__device__ __forceinline__ void phase_chain(const Params& p, char* lds) {
#pragma unroll 1
    for (int c = blockIdx.x; c < 16; c += gridDim.x) chain_unit(p, c, lds);
}
__device__ __forceinline__ void fft_fwd(cpx* Z, int tid) {
#pragma unroll 1
    for (int pass = 0; pass < 3; ++pass) { const int lm = pass == 0 ? 10 : (pass == 1 ? 6 : 2);

#pragma unroll 1
        for (int gi = 0; gi < 2; ++gi) fft_pass16<false>(Z, tid + gi * 512, lm);
        __syncthreads(); }
#pragma unroll 1
    for (int it = 0; it < 8; ++it) fft_pass4<false>(Z, tid + it * 512);
    __syncthreads();
}
__device__ __forceinline__ void fft_inv(cpx* Z, int tid) {
#pragma unroll 1
    for (int it = 0; it < 8; ++it) fft_pass4<true>(Z, tid + it * 512);
    __syncthreads();
#pragma unroll 1
    for (int pass = 0; pass < 3; ++pass) { const int lm = pass == 0 ? 2 : (pass == 1 ? 6 : 10);

#pragma unroll 1
        for (int gi = 0; gi < 2; ++gi) fft_pass16<true>(Z, tid + gi * 512, lm);
        __syncthreads(); }
}
constexpr size_t HY_SCR_FLOATS = 2 * 2 * (size_t)FFT_N + 4 * (size_t)SEQ;
__device__ __forceinline__ void hyena_latent_unit(const Params& p, int layer, int c, char* lds) {
    cpx* Z = (cpx*)lds; const int tid = otid(), lane = tid & 63;
    float* scr = p.hys() + (size_t)blockIdx.x * HY_SCR_FLOATS;
    cpx* Zh1 = (cpx*)scr; cpx* Zh2 = Zh1 + FFT_N; float* vs = (float*)(Zh2 + FFT_N); float* x1s = vs + SEQ; float* x2s = x1s + SEQ; float* z1s = x2s + SEQ;
    const float* cw = p.in[I_HCONV] + (size_t)layer * 3 * 1536;
#pragma unroll
    for (int part = 0; part < 3; ++part) {
        const float w0 = cw[part * 512 + c], w1 = cw[1536 + part * 512 + c], w2 = cw[3072 + part * 512 + c];
        const bf16_t* col = p.Pp() + (size_t)LC * NP + PC_HY + part * 512 + c;
        float* dst = part == 0 ? vs : (part == 1 ? x1s : x2s);
#pragma unroll 2
        for (int t = tid; t < SEQ; t += 512) {
            const float x0 = bf2f(col[(size_t)t * NP]);
            const float xm = t > 0 ? bf2f(col[(size_t)(t - 1) * NP]) : 0.f, xn = t < SEQ - 1 ? bf2f(col[(size_t)(t + 1) * NP]) : 0.f;
            dst[t] = w0 * xm + w1 * x0 + w2 * xn;
        }
    }
#pragma unroll 1
    for (int f = 0; f < 2; ++f) {
        const size_t ch = (size_t)layer * 1024 + f * 512 + c;
        const float* hsrc = p.hfilt() + ch * SEQ;
        const f32x4 ps = *(const f32x4*)(p.hsum() + ch * 256 + lane * 4);
        const float tot = wave_sum((ps[0] + ps[1]) + (ps[2] + ps[3]));
        const float scale = (1.0f / (tot + EPS)) * (1.0f / (float)FFT_N);
#pragma unroll 2
        for (int it = 0; it < 16; ++it) { const int j = tid + it * 512; const f32x2 hv = *(const f32x2*)(hsrc + 2 * j);
            Z[ZP(j)] = cpx{hv[0] * scale, hv[1] * scale}; Z[ZP(j + 8192)] = cpx{0.f, 0.f}; }
        __syncthreads();
        fft_fwd(Z, tid);
        cpx* Zh = f ? Zh2 : Zh1;
#pragma unroll 4
        for (int it = 0; it < 32; ++it) { const int q = tid + it * 512; Zh[q] = Z[ZP(q)]; }
        __syncthreads();
    }
    const float b0 = p.in[I_HBIAS][(size_t)layer * 1024 + c], b1 = p.in[I_HBIAS][(size_t)layer * 1024 + 512 + c];
#pragma unroll 2
    for (int it = 0; it < 16; ++it) { const int j = tid + it * 512; const f32x2 v2 = *(const f32x2*)(vs + 2 * j);
        Z[ZP(j)] = cpx{v2[0], v2[1]}; Z[ZP(j + 8192)] = cpx{0.f, 0.f}; }
    __syncthreads();
    fft_fwd(Z, tid);
#pragma unroll 1
    for (int it = 0; it < 16; ++it) fft_pointwise(Z, Zh1, tid + it * 512);
    __syncthreads();
    fft_inv(Z, tid);
#pragma unroll 1
    for (int half = 0; half < 2; ++half) {
#pragma unroll 2
        for (int it = 0; it < 8; ++it) { const int j = half * 4096 + tid + it * 512;
            const cpx y = Z[ZP(4096 + j)];
            const f32x2 v2 = *(const f32x2*)(vs + 2 * j), xx = *(const f32x2*)(x1s + 2 * j);
            const f32x2 z = {xx[0] * (y.x + b0 * v2[0]), xx[1] * (y.y + b0 * v2[1])};
            *(f32x2*)(z1s + 2 * j) = z; Z[ZP(j)] = cpx{z[0], z[1]};
            if (half) Z[ZP(4096 + j)] = cpx{0.f, 0.f};
            else Z[ZP(12288 + j)] = cpx{0.f, 0.f}; }
        __syncthreads();
    }
    __syncthreads();
    fft_fwd(Z, tid);
#pragma unroll 1
    for (int it = 0; it < 16; ++it) fft_pointwise(Z, Zh2, tid + it * 512);
    __syncthreads();
    fft_inv(Z, tid);
#pragma unroll 2
    for (int it = 0; it < 16; ++it) { const int j = tid + it * 512; const cpx y = Z[ZP(4096 + j)];
        const f32x2 z = *(const f32x2*)(z1s + 2 * j), x2 = *(const f32x2*)(x2s + 2 * j);
        bf16_t* op = p.ocat() + (size_t)(LC + 2 * j) * D_ + 1024 + c;
        op[0] = f2bf(x2[0] * (y.x + b1 * z[0])); op[D_] = f2bf(x2[1] * (y.y + b1 * z[1])); }
    __syncthreads();
}
__device__ __forceinline__ void hyena_ctx_unit(const Params& p, int c, float* lds) {
    const int tid = otid();
    float* vv = lds; float* x1 = vv + 256; float* x2 = x1 + 256; float* h1 = x2 + 256; float* h2 = h1 + 256; float* z1 = h2 + 256;
    const float* cw = p.in[I_HCONV];
    if (tid < 256) { const int t = tid;
#pragma unroll
        for (int part = 0; part < 3; ++part) {
            const float w0 = cw[part * 512 + c], w1 = cw[1536 + part * 512 + c], w2 = cw[3072 + part * 512 + c];
            const bf16_t* col = p.Pp() + PC_HY + part * 512 + c;
            const float x0 = bf2f(col[(size_t)t * NP]), xm = t > 0 ? bf2f(col[(size_t)(t - 1) * NP]) : 0.f, xn = t < LC - 1 ? bf2f(col[(size_t)(t + 1) * NP]) : 0.f;
            (part == 0 ? vv : (part == 1 ? x1 : x2))[t] = w0 * xm + w1 * x0 + w2 * xn;
        }
        const float s1 = (p.hsc()[c * 4] + p.hsc()[c * 4 + 1]) + (p.hsc()[c * 4 + 2] + p.hsc()[c * 4 + 3]);
        const float s2 = (p.hsc()[(512 + c) * 4] + p.hsc()[(512 + c) * 4 + 1]) + (p.hsc()[(512 + c) * 4 + 2] + p.hsc()[(512 + c) * 4 + 3]);
        h1[t] = p.hfc()[(size_t)c * 256 + t] / (s1 + EPS); h2[t] = p.hfc()[(size_t)(512 + c) * 256 + t] / (s2 + EPS);
    }
    __syncthreads();
    const float b0 = p.in[I_HBIAS][c], b1 = p.in[I_HBIAS][512 + c];
    if (tid < 256) { const int t = tid; float y = 0.f;
        for (int s = 0; s < 256; ++s) { const int m = t - s + 128; if (m >= 0 && m < 256) y += vv[s] * h1[m]; }
        z1[t] = x1[t] * (y + b0 * vv[t]); }
    __syncthreads();
    if (tid < 256) { const int t = tid; float y = 0.f;
        for (int s = 0; s < 256; ++s) { const int m = t - s + 128; if (m >= 0 && m < 256) y += z1[s] * h2[m]; }
        p.ocat()[(size_t)t * D_ + 1024 + c] = f2bf(x2[t] * (y + b1 * z1[t])); }
    __syncthreads();
}
__device__ __forceinline__ void phase_hyena(const Params& p, int layer, char* lds) {
    const int nunits = 512 + (layer == 0 ? 512 : 0);
    for (int u = blockIdx.x; u < nunits; u += gridDim.x) {
        if (u < 512) hyena_latent_unit(p, layer, u, lds); else hyena_ctx_unit(p, u - 512, (float*)lds);
    }
}

__device__ __forceinline__ void phase_gather(const Params& p) {
    const int tid = otid(), wid = tid >> 6, lane = tid & 63;
    int base[NEXP]; { int acc = 0;
#pragma unroll
        for (int e = 0; e < NEXP; ++e) { base[e] = acc * 256; acc += ((int)p.cnt()[e] + 255) >> 8; } }
    for (int i = blockIdx.x * 8 + wid; i < 2 * SEQ; i += gridDim.x * 8) {
        const int t = i >> 1, e = p.tok_e()[i], pos = p.tok_p()[i];
        int b = 0;
#pragma unroll
        for (int k = 0; k < NEXP; ++k) b = (e == k) ? base[k] : b;
        const int row = b + pos;
        const u32x4* src = (const u32x4*)(p.hbuf() + (size_t)(LC + t) * D_); u32x4* dst = (u32x4*)(p.hg() + (size_t)row * D_);
#pragma unroll
        for (int k = 0; k < 4; ++k) dst[k * 64 + lane] = src[k * 64 + lane];
        if (lane == 0) p.tok_r()[i] = row;
    }
}
__device__ __forceinline__ void phase_final(const Params& p) {
    const int tid = otid(), wid = tid >> 6, lane = tid & 63;
    const float* g2 = p.modv() + ((size_t)1 * 2 + 0) * 6 * D_ + 5 * D_;
    const float* fw = p.in[I_FNW];
    for (int t = blockIdx.x * 8 + wid; t < SEQ; t += gridDim.x * 8) {
        const int r0 = p.tok_r()[t * 2], r1 = p.tok_r()[t * 2 + 1]; const float w0 = p.tok_w()[t * 2], w1 = p.tok_w()[t * 2 + 1];
        const float* xr = p.xcur() + (size_t)(LC + t) * D_;
        f32x4 xv[8]; float ss = 0.f;
#pragma unroll
        for (int i = 0; i < 8; ++i) { const int col = (i * 64 + lane) * 4;
            const u32x2 ya = *(const u32x2*)(p.yb() + (size_t)r0 * D_ + col), yb2 = *(const u32x2*)(p.yb() + (size_t)r1 * D_ + col);
            const f32x4 y = {w0 * bflo(ya.x) + w1 * bflo(yb2.x), w0 * bfhi(ya.x) + w1 * bfhi(yb2.x), w0 * bflo(ya.y) + w1 * bflo(yb2.y), w0 * bfhi(ya.y) + w1 * bfhi(yb2.y)};
            xv[i] = *(const f32x4*)(xr + col) + *(const f32x4*)(g2 + col) * y;
            ss += xv[i][0] * xv[i][0] + xv[i][1] * xv[i][1] + xv[i][2] * xv[i][2] + xv[i][3] * xv[i][3]; }
        ss = wave_sum(ss);
        const float rstd = rsqrtf(ss * (1.0f / D_) + EPS);
#pragma unroll
        for (int i = 0; i < 8; ++i) { const int col = (i * 64 + lane) * 4; *(f32x4*)(p.out + (size_t)t * D_ + col) = (xv[i] * rstd) * *(const f32x4*)(fw + col); }
    }
}
#define XB_TMO      128
#define XB_XCNT(j)  (256  + 64 * (j))
#define XB_XSUB(j)  (1280 + 64 * (j))
#define XB_XGEN(j)  (2304 + 64 * (j))
#define XB_TOP      3328
#define XB_TOPGEN   3392
#define XCD_BAR_WORDS 3456
#define XB_SPIN_CAP (1u << 26)

__device__ __forceinline__ unsigned xb_ld(unsigned* p)              { return __hip_atomic_load(p, __ATOMIC_RELAXED, __HIP_MEMORY_SCOPE_AGENT); }
__device__ __forceinline__ unsigned xb_add(unsigned* p, unsigned v) { return __hip_atomic_fetch_add(p, v, __ATOMIC_RELAXED, __HIP_MEMORY_SCOPE_AGENT); }
__device__ __forceinline__ unsigned xb_xcc_id() { return (unsigned)__builtin_amdgcn_s_getreg((3 << 11) | 20) & 0xFu; }
#define XB_SPIN(cond, bar) do { unsigned _sp = 0; while (cond) { __builtin_amdgcn_s_sleep(1); \
    if ((++_sp & 255u) == 0u) { if (xb_ld(&(bar)[XB_TMO])) break; if (_sp > XB_SPIN_CAP) { atomicAdd(&(bar)[XB_TMO], 1u); break; } } } } while (0)

struct XcdBarrier {
    unsigned* bar; unsigned x;
    volatile LAS unsigned* st;
};

__device__ __forceinline__ XcdBarrier xcd_barrier_post(unsigned* bar, volatile LAS unsigned* st) {
    XcdBarrier b; b.bar = bar; b.x = xb_xcc_id(); b.st = st;
    if (threadIdx.x == 0) (void)xb_add(&bar[XB_XCNT(b.x)], 1u);
    return b;
}
__device__ __forceinline__ void xcd_barrier_complete(unsigned* bar, unsigned x, unsigned& nloc, unsigned& nx) {
    const unsigned G = gridDim.x * gridDim.y * gridDim.z;
    unsigned sum, cnt, mine, sp = 0u;
    for (;;) {
        sum = 0u; cnt = 0u; mine = 0u;
#pragma unroll
        for (unsigned j = 0; j < 16; ++j) { const unsigned c = xb_ld(&bar[XB_XCNT(j)]); sum += c; cnt += (c > 0u) ? 1u : 0u; mine = (j == x) ? c : mine; }
        if (sum == G) break;
        __builtin_amdgcn_s_sleep(1);
        if ((++sp & 255u) == 0u) { if (xb_ld(&bar[XB_TMO])) break; if (sp > XB_SPIN_CAP) { atomicAdd(&bar[XB_TMO], 1u); break; } }
    }
    nloc = mine > 0u ? mine : 1u; nx = cnt > 0u ? cnt : 1u;
}

__device__ __forceinline__ void xcd_barrier(const XcdBarrier& b) {
    asm volatile("s_waitcnt vmcnt(0)" ::: "memory");
    __syncthreads();
    if (threadIdx.x == 0) {
        unsigned* bar = b.bar;
        __builtin_amdgcn_s_waitcnt(0);
        unsigned nloc = b.st[0], nx = b.st[1];
        if (nloc == 0u) { xcd_barrier_complete(bar, b.x, nloc, nx); b.st[0] = nloc; b.st[1] = nx; }
        const unsigned old = xb_add(&bar[XB_XSUB(b.x)], 1u);
        const unsigned gen = old / nloc;
        if (old + 1u == (gen + 1u) * nloc) {
            __builtin_amdgcn_fence(__ATOMIC_RELEASE, "agent");
            asm volatile("s_waitcnt vmcnt(0)" ::: "memory");
            const unsigned og = xb_add(&bar[XB_TOP], 1u);
            const unsigned tg = og / nx;
            if (og + 1u == (tg + 1u) * nx) xb_add(&bar[XB_TOPGEN], 1u);
            else XB_SPIN(xb_ld(&bar[XB_TOPGEN]) == tg, bar);
            __builtin_amdgcn_fence(__ATOMIC_ACQUIRE, "agent");
            xb_add(&bar[XB_XGEN(b.x)], 1u);
            asm volatile("s_waitcnt vmcnt(0)" ::: "memory");
        } else {
            XB_SPIN(xb_ld(&bar[XB_XGEN(b.x)]) == gen, bar);
            __builtin_amdgcn_fence(__ATOMIC_ACQUIRE, "agent");
            asm volatile("s_waitcnt vmcnt(0)" ::: "memory");
        }
    }
    __syncthreads();
}

enum { PH_PRO, PH_NORM1, PH_GIN, PH_PREP, PH_GMLA, PH_ATT, PH_REC, PH_CPREP, PH_CHAIN, PH_HY, PH_MIXOUT, PH_GOUT, PH_NORM2, PH_F1, PH_F2, PH_GATHER, PH_MG1, PH_MG2, PH_FINAL };
constexpr int LDS_BYTES = 147456;

template <int PH> __device__ __forceinline__ void run_phase(const Params& p, int layer, unsigned char* shm) {
    LAS unsigned char* lds3 = (LAS unsigned char*)shm;
    const int G = gridDim.x, c = blockIdx.x;
    if constexpr (PH == PH_PRO) phase_prologue(p, (float*)shm);
    else if constexpr (PH == PH_NORM1) phase_norm(p, layer, 1, 0);
    else if constexpr (PH == PH_GIN) {
        pg8::Gemm g{p.hbuf(), p.wb_in() + (size_t)layer * NP * D_, D_, D_, D_, 0};
        pg8::StaticOrder S; S.init(MT, NP, G, c);
        pg8::EpiStoreBf16 E{p.Pp(), NP, nullptr, 1 << 30};
        pg8::gemm_phase(lds3, g, S, E);
    }
    else if constexpr (PH == PH_PREP) phase_prep(p, layer);
    else if constexpr (PH == PH_GMLA) {
        pg8::Gemm g{p.Pp() + PC_CQ, p.wb_mla() + (size_t)layer * MLAN * MLAK, MLAK, NP, MLAK, 0};
        pg8::StaticOrder S; S.init(MT, MLAN, G, c);
        pg8::EpiStoreBf16 E{p.qkvup(), MLAN, p.mrs(), 3};
        pg8::gemm_phase(lds3, g, S, E);
    }
    else if constexpr (PH == PH_ATT) phase_attn(p, layer, (char*)shm);
    else if constexpr (PH == PH_REC) phase_rec_naive(p, layer, (float*)shm);
    else if constexpr (PH == PH_CPREP) phase_chunkprep(p, layer, (char*)shm);
    else if constexpr (PH == PH_CHAIN) phase_chain(p, (char*)shm);
    else if constexpr (PH == PH_HY) phase_hyena(p, layer, (char*)shm);
    else if constexpr (PH == PH_MIXOUT) phase_mixout(p, layer);
    else if constexpr (PH == PH_GOUT) {
        const float* mv = p.modv() + (size_t)layer * 2 * 6 * D_;
        if (layer == 0) {
            pg8::Gemm g{p.ocat(), p.wb_out(), D_, D_, D_, 0};
            pg8::StaticOrder S; S.init(MT, D_, G, c);
            pg8::EpiResGate E{p.xcur(), p.in[I_CTX], p.in[I_X], mv + 6 * D_ + 2 * D_, mv + 2 * D_, 0};
            pg8::gemm_phase(lds3, g, S, E);
        } else {
            pg8::Gemm g{p.ocat() + (size_t)LC * D_, p.wb_out() + (size_t)D_ * D_, D_, D_, D_, 0};
            pg8::StaticOrder S; S.init(SEQ, D_, G, c);
            pg8::EpiResGate E{p.xcur(), p.xcur(), p.xcur() + (size_t)LC * D_, mv + 6 * D_ + 2 * D_, mv + 2 * D_, LC};
            pg8::gemm_phase(lds3, g, S, E);
        }
    }
    else if constexpr (PH == PH_NORM2) {
        phase_norm(p, layer, 2, layer == 0 ? 0 : LC);
        if (layer == 1) { __syncthreads(); for (int u = c; u < U_MOEW; u += G) moe_w_unit(p, u, (float*)shm); }
    }
    else if constexpr (PH == PH_F1) {
        pg8::Gemm g{p.hbuf(), p.wb_f13(), D_, D_, D_, 0};
        pg8::StaticOrder S; S.init(MT, 2 * DFF, G, c);
        pg8::EpiSwiGLU E{p.act(), DFF};
        pg8::gemm_phase(lds3, g, S, E);
    }
    else if constexpr (PH == PH_F2) {
        const float* mv = p.modv();
        pg8::Gemm g{p.act(), p.wb_f2(), DFF, DFF, DFF, 0};
        pg8::StaticOrder S; S.init(MT, D_, G, c);
        pg8::EpiResGate E{p.xcur(), p.xcur(), p.xcur() + (size_t)LC * D_, mv + 6 * D_ + 5 * D_, mv + 5 * D_, 0};
        pg8::gemm_phase(lds3, g, S, E);
    }
    else if constexpr (PH == PH_GATHER) phase_gather(p);
    else if constexpr (PH == PH_MG1) {
        pg8::Gemm g{p.hg(), p.wb_m13(), D_, D_, D_, (size_t)2 * DFF * D_};
        pg8::GroupedOrder S; S.init(p.cnt(), 2 * DFF, G, c);
        pg8::EpiSwiGLU E{p.act_moe(), DFF};
        pg8::gemm_phase(lds3, g, S, E);
    }
    else if constexpr (PH == PH_MG2) {
        pg8::Gemm g{p.act_moe(), p.wb_m2(), DFF, DFF, DFF, (size_t)D_ * DFF};
        pg8::GroupedOrder S; S.init(p.cnt(), D_, G, c);
        pg8::EpiStoreBf16 E{p.yb(), D_, nullptr, 1 << 30};
        pg8::gemm_phase(lds3, g, S, E);
    }
    else if constexpr (PH == PH_FINAL) phase_final(p);
}

#ifndef MEGA
#define MEGA 1
#endif
constexpr int XBW_OFF = LDS_BYTES - 16;
template <int PH> __global__ __launch_bounds__(512, 2) void k_ph(Params p, int layer) {
    extern __shared__ __attribute__((aligned(16))) unsigned char shm[];
    run_phase<PH>(p, layer, shm);
}
__global__ __launch_bounds__(512, 2) void k_mega(Params p) {
    extern __shared__ __attribute__((aligned(16))) unsigned char shm[];
    volatile LAS unsigned* xbw = (volatile LAS unsigned*)(LAS unsigned char*)(shm + XBW_OFF);
    if (otid() == 0) { xbw[0] = 0u; xbw[1] = 0u; xbw[2] = 0u; xbw[3] = 0u; }
    __syncthreads();
    (void)xcd_barrier_post(p.bar(), xbw);
#define GBAR() do { XcdBarrier _b; _b.bar = p.bar(); _b.x = xb_xcc_id(); _b.st = xbw; xcd_barrier(_b); } while (0)
    run_phase<PH_PRO>(p, 0, shm); GBAR();
#pragma unroll 1
    for (int l = 0; l < 2; ++l) {
        run_phase<PH_NORM1>(p, l, shm); GBAR();
        run_phase<PH_GIN>(p, l, shm); GBAR();
        run_phase<PH_PREP>(p, l, shm); GBAR();
        run_phase<PH_GMLA>(p, l, shm); __syncthreads();
        run_phase<PH_CPREP>(p, l, shm); GBAR();
        run_phase<PH_CHAIN>(p, l, shm); __syncthreads();
        run_phase<PH_ATT>(p, l, shm); __syncthreads();
        run_phase<PH_HY>(p, l, shm); GBAR();
        run_phase<PH_MIXOUT>(p, l, shm); GBAR();
        run_phase<PH_GOUT>(p, l, shm); GBAR();
        run_phase<PH_NORM2>(p, l, shm); GBAR();
        if (l == 0) {
            run_phase<PH_F1>(p, l, shm); GBAR();
            run_phase<PH_F2>(p, l, shm); GBAR();
        } else {
            run_phase<PH_GATHER>(p, l, shm); GBAR();
            run_phase<PH_MG1>(p, l, shm); GBAR();
            run_phase<PH_MG2>(p, l, shm); GBAR();
            run_phase<PH_FINAL>(p, l, shm);
        }
    }
}
template <int PH> static void launch_ph(const Params& p, int layer, int grid, hipStream_t st) {
    static bool attr = false;
    if (!attr) { (void)hipFuncSetAttribute((const void*)k_ph<PH>, hipFuncAttributeMaxDynamicSharedMemorySize, LDS_BYTES); attr = true; }
    hipLaunchKernelGGL((k_ph<PH>), dim3(grid), dim3(512), LDS_BYTES, st, p, layer);
}

static size_t align_up(size_t x) { return (x + 255) & ~(size_t)255; }
extern "C" void kernel_launch(void* const* d_in, const int* in_sizes, int n_in, void* d_out, int out_size, void* d_ws, size_t ws_size, hipStream_t stream) {
    Params p{};
    for (int i = 0; i < N_IN; ++i) p.in[i] = (const float*)d_in[i];
    p.out = (float*)d_out;
    static int GRID = 0;
    if (!GRID) {
#if MEGA
        int dev = 0, cus = 0, per_cu = 0;
        (void)hipGetDevice(&dev);
        (void)hipDeviceGetAttribute(&cus, hipDeviceAttributeMultiprocessorCount, dev);
        (void)hipFuncSetAttribute((const void*)k_mega, hipFuncAttributeMaxDynamicSharedMemorySize, LDS_BYTES);
        (void)hipOccupancyMaxActiveBlocksPerMultiprocessor(&per_cu, k_mega, 512, LDS_BYTES);
        if (per_cu < 1 || cus < 1) { fprintf(stderr, "kernel_launch: occupancy query failed (%d blocks/CU, %d CUs)\n", per_cu, cus); return; }
        GRID = cus < WS_GRID ? cus : WS_GRID;
#else
        GRID = 256;
#endif
    }
    p.ws = (char*)d_ws;
    if (ws_size < WSL.need) { fprintf(stderr, "kernel_launch: workspace too small: %zu < %zu\n", ws_size, (size_t)WSL.need); return; }
#if MEGA
    (void)hipMemsetAsync((char*)d_ws + WSL.bar, 0, XCD_BAR_WORDS * sizeof(unsigned), stream);
    hipLaunchKernelGGL(k_mega, dim3(GRID), dim3(512), LDS_BYTES, stream, p);
#else
    launch_ph<PH_PRO>(p, 0, GRID, stream);
    for (int l = 0; l < 2; ++l) {
        launch_ph<PH_NORM1>(p, l, GRID, stream);
        launch_ph<PH_GIN>(p, l, GRID, stream);
        launch_ph<PH_PREP>(p, l, GRID, stream);
        launch_ph<PH_GMLA>(p, l, GRID, stream);
        launch_ph<PH_ATT>(p, l, GRID, stream);
        launch_ph<PH_CPREP>(p, l, GRID, stream);
        launch_ph<PH_CHAIN>(p, l, GRID, stream);
        launch_ph<PH_HY>(p, l, GRID, stream);
        launch_ph<PH_MIXOUT>(p, l, GRID, stream);
        launch_ph<PH_GOUT>(p, l, GRID, stream);
        launch_ph<PH_NORM2>(p, l, GRID, stream);
        if (l == 0) { launch_ph<PH_F1>(p, l, GRID, stream); launch_ph<PH_F2>(p, l, GRID, stream); }
        else { launch_ph<PH_GATHER>(p, l, GRID, stream); launch_ph<PH_MG1>(p, l, GRID, stream); launch_ph<PH_MG2>(p, l, GRID, stream); launch_ph<PH_FINAL>(p, l, GRID, stream); }
    }
#endif
}
```

```cpp
#include <hip/hip_runtime.h>
#include <stdint.h>
#include <math.h>
#include <stdio.h>

#define LAS __attribute__((address_space(3)))
typedef unsigned short bf16_t;
typedef short bf16x8 __attribute__((ext_vector_type(8)));
typedef short s16x4 __attribute__((ext_vector_type(4)));
typedef float f32x4 __attribute__((ext_vector_type(4)));
typedef float f32x2 __attribute__((ext_vector_type(2)));
typedef float f32x16 __attribute__((ext_vector_type(16)));
typedef unsigned u32x4 __attribute__((ext_vector_type(4)));
typedef unsigned u32x2 __attribute__((ext_vector_type(2)));

constexpr int D_ = 2048, SEQ = 16384, LC = 256, MT = 16640, NP = 6400, DFF = 5632, NEXP = 8, DIN = 6288;
constexpr int PC_GQKV = 0, PC_GZ = 1536, PC_HY = 2048, PC_RQKV = 3584, PC_RG = 5120, PC_CQ = 5632, PC_CKV = 6144, PC_KR = 6272, PC_A = 6336, PC_B = 6344;
constexpr int MLAK = 640, MLAN = 1792;
constexpr float EPS = 1e-6f;
constexpr int MAXROWS_MOE = 2 * SEQ + NEXP * 256;
enum { I_X, I_C, I_CTX, I_CCTX, I_N1W, I_N2W, I_MODW, I_MODB, I_WIN, I_WOUT, I_GCONV, I_GALOG, I_GDT, I_GNW, I_MQN, I_MUQ, I_MKVN, I_MUKV,
       I_HCONV, I_HW1, I_HB1, I_HW2, I_HB2, I_HW3, I_HB3, I_HW4, I_HFREQ, I_HBIAS, I_FW1, I_FW3, I_FW2, I_ROUTER, I_MW1, I_MW3, I_MW2, I_FNW, N_IN };

constexpr int NCHUNK_ = MT / 64;
constexpr size_t REC_BYTES_ = 73984, HY_SCR_FLOATS_ = 2 * 2 * (size_t)16384 + (size_t)SEQ;
constexpr int WS_GRID = 256;
constexpr int WAM_F13 = 0, WAM_F2 = 2 * DFF, WAM_M13 = WAM_F2 + D_, WAM_M2 = WAM_M13 + NEXP * 2 * DFF, WAM_IN = WAM_M2 + NEXP * D_, WAM_WORDS = WAM_IN + 2 * NP;
struct WsLayout { size_t bar, cnt, wam, hs, acts, hsg, modv, xcur, hbuf, tok_r, tok_w, tok_e, tok_p, gidx, tailidx, wq_m13, wq_m2, wb_in, wb_out, wb_mla, wb_f13, wb_f2, hfilt, hsum, hfc, hsc, Pp, gqkv, ggb, rqk, mrs, krr, qkvup, go, ro, recs, hys, ocat,
                  act, wb_m13, wb_m2, hg, yb, act_moe, hyT, hyO, partG, partF, attp, actq, actq_moe, need; };
constexpr size_t ws_al(size_t x) { return (x + 255) & ~(size_t)255; }
constexpr WsLayout make_ws_layout() {
    WsLayout L{}; size_t off = 0;
    L.bar = off; off = ws_al(off + 16384); L.cnt = off; off = ws_al(off + 256);
    L.wam = off; off = ws_al(off + (size_t)WAM_WORDS * 4);
    L.hs = off; off = ws_al(off + (size_t)MT * 4); L.acts = off; off = ws_al(off + (size_t)MAXROWS_MOE * 4); L.hsg = off; off = ws_al(off + (size_t)MAXROWS_MOE * 4);
    L.modv = off; off = ws_al(off + (size_t)2 * 2 * 6 * D_ * 4);
    L.xcur = off; off = ws_al(off + (size_t)MT * D_ * 4);
    L.hbuf = off; off = ws_al(off + (size_t)MT * D_);
    L.tok_r = off; off = ws_al(off + (size_t)2 * SEQ * 4); L.tok_w = off; off = ws_al(off + (size_t)2 * SEQ * 4); L.tok_e = off; off = ws_al(off + (size_t)2 * SEQ * 4); L.tok_p = off; off = ws_al(off + (size_t)2 * SEQ * 4); L.gidx = off; off = ws_al(off + (size_t)MAXROWS_MOE * 4); L.tailidx = off; off = ws_al(off + (size_t)(MAXROWS_MOE / 256) * 8 * 4);
    L.wq_m13 = off; off = ws_al(off + (size_t)NEXP * 2 * DFF * D_); L.wq_m2 = off; off = ws_al(off + (size_t)NEXP * D_ * DFF);
    const size_t region = off;
    L.wb_in = off; off = ws_al(off + (size_t)2 * NP * D_); L.wb_out = off; off = ws_al(off + (size_t)2 * D_ * D_ * 2); L.wb_mla = off; off = ws_al(off + (size_t)2 * MLAN * MLAK * 2);
    L.wb_f13 = off; off = ws_al(off + (size_t)2 * DFF * D_); L.wb_f2 = off; off = ws_al(off + (size_t)D_ * DFF);
    L.hfilt = off; off = ws_al(off + (size_t)2 * 1024 * SEQ * 4); L.hsum = off; off = ws_al(off + (size_t)2 * 1024 * 256 * 4); L.hfc = off; off = ws_al(off + (size_t)1024 * 256 * 4); L.hsc = off; off = ws_al(off + (size_t)1024 * 4 * 4);
    const size_t arena = off;
    L.Pp = off; off = ws_al(off + (size_t)MT * NP * 2);
    L.gqkv = off; off = ws_al(off + (size_t)MT * 1536 * 2); L.ggb = off; off = ws_al(off + (size_t)MT * 16 * 4); L.rqk = off; off = ws_al(off + (size_t)MT * 1024 * 2);
    L.mrs = off; off = ws_al(off + (size_t)MT * 2 * 4); L.krr = off; off = ws_al(off + (size_t)MT * 64 * 2); L.qkvup = off; off = ws_al(off + (size_t)MT * MLAN * 2);
    L.go = off; off = ws_al(off + (size_t)2 * MT * 512 * 4); L.ro = off; off = ws_al(off + (size_t)2 * MT * 512 * 4);
    L.recs = off; off = ws_al(off + (size_t)16 * NCHUNK_ * REC_BYTES_);
    L.hys = off; off = ws_al(off + (size_t)WS_GRID * HY_SCR_FLOATS_ * 4);
    L.hyT = off; off = ws_al(off + (size_t)1536 * SEQ * 4); L.hyO = off; off = ws_al(off + (size_t)512 * SEQ * 2);
    L.attp = off; off = ws_al(off + (size_t)64 * (256 * 128 + 512) * 4);
    L.ocat = L.gqkv;
    L.partG = L.recs; L.partF = L.recs + ws_al((size_t)4 * LC * D_ * 4);
    const size_t end1 = off;
    L.act = arena;
    L.actq = L.gqkv;
    off = region;
    L.wb_m13 = L.wq_m13; L.wb_m2 = L.wq_m2;
    L.hg = off; L.yb = off; off = ws_al(off + (size_t)MAXROWS_MOE * D_ * 2);
    L.act_moe = off; off = ws_al(off + (size_t)MAXROWS_MOE * DFF * 2);
    L.actq_moe = off; off = ws_al(off + (size_t)MAXROWS_MOE * DFF);
    const size_t end2 = off;
    L.need = end1 > end2 ? end1 : end2;
    return L;
}
constexpr WsLayout WSL = make_ws_layout();
struct Params {
    const float* in[N_IN];
    float* out;
    char* ws;
    __device__ __forceinline__ unsigned* bar() const { return (unsigned*)(ws + WSL.bar); }
    __device__ __forceinline__ unsigned* cnt() const { return (unsigned*)(ws + WSL.cnt); }
    __device__ __forceinline__ unsigned* wam() const { return (unsigned*)(ws + WSL.wam); }
    __device__ __forceinline__ float* hs() const { return (float*)(ws + WSL.hs); }
    __device__ __forceinline__ float* acts() const { return (float*)(ws + WSL.acts); }
    __device__ __forceinline__ float* hsg() const { return (float*)(ws + WSL.hsg); }
    __device__ __forceinline__ float* modv() const { return (float*)(ws + WSL.modv); }
    __device__ __forceinline__ bf16_t* wb_in() const { return (bf16_t*)(ws + WSL.wb_in); }
    __device__ __forceinline__ bf16_t* wb_out() const { return (bf16_t*)(ws + WSL.wb_out); }
    __device__ __forceinline__ bf16_t* wb_mla() const { return (bf16_t*)(ws + WSL.wb_mla); }
    __device__ __forceinline__ bf16_t* wb_f13() const { return (bf16_t*)(ws + WSL.wb_f13); }
    __device__ __forceinline__ bf16_t* wb_f2() const { return (bf16_t*)(ws + WSL.wb_f2); }
    __device__ __forceinline__ bf16_t* wb_m13() const { return (bf16_t*)(ws + WSL.wb_m13); }
    __device__ __forceinline__ bf16_t* wb_m2() const { return (bf16_t*)(ws + WSL.wb_m2); }
    __device__ __forceinline__ float* hfilt() const { return (float*)(ws + WSL.hfilt); }
    __device__ __forceinline__ float* hsum() const { return (float*)(ws + WSL.hsum); }
    __device__ __forceinline__ float* hfc() const { return (float*)(ws + WSL.hfc); }
    __device__ __forceinline__ float* hsc() const { return (float*)(ws + WSL.hsc); }
    __device__ __forceinline__ float* xcur() const { return (float*)(ws + WSL.xcur); }
    __device__ __forceinline__ bf16_t* hbuf() const { return (bf16_t*)(ws + WSL.hbuf); }
    __device__ __forceinline__ bf16_t* Pp() const { return (bf16_t*)(ws + WSL.Pp); }
    __device__ __forceinline__ bf16_t* gqkv() const { return (bf16_t*)(ws + WSL.gqkv); }
    __device__ __forceinline__ float* ggb() const { return (float*)(ws + WSL.ggb); }
    __device__ __forceinline__ bf16_t* rqk() const { return (bf16_t*)(ws + WSL.rqk); }
    __device__ __forceinline__ float* mrs() const { return (float*)(ws + WSL.mrs); }
    __device__ __forceinline__ bf16_t* krr() const { return (bf16_t*)(ws + WSL.krr); }
    __device__ __forceinline__ bf16_t* qkvup() const { return (bf16_t*)(ws + WSL.qkvup); }
    __device__ __forceinline__ float* go() const { return (float*)(ws + WSL.go); }
    __device__ __forceinline__ float* ro() const { return (float*)(ws + WSL.ro); }
    __device__ __forceinline__ char* recs() const { return (char*)(ws + WSL.recs); }
    __device__ __forceinline__ float* hys() const { return (float*)(ws + WSL.hys); }
    __device__ __forceinline__ float* hyT() const { return (float*)(ws + WSL.hyT); }
    __device__ __forceinline__ bf16_t* hyO() const { return (bf16_t*)(ws + WSL.hyO); }
    __device__ __forceinline__ float* partG() const { return (float*)(ws + WSL.partG); }
    __device__ __forceinline__ float* partF() const { return (float*)(ws + WSL.partF); }
    __device__ __forceinline__ float* attp() const { return (float*)(ws + WSL.attp); }
    __device__ __forceinline__ signed char* actq() const { return (signed char*)(ws + WSL.actq); }
    __device__ __forceinline__ signed char* actq_moe() const { return (signed char*)(ws + WSL.actq_moe); }
    __device__ __forceinline__ bf16_t* ocat() const { return (bf16_t*)(ws + WSL.ocat); }
    __device__ __forceinline__ bf16_t* act() const { return (bf16_t*)(ws + WSL.act); }
    __device__ __forceinline__ bf16_t* act_moe() const { return (bf16_t*)(ws + WSL.act_moe); }
    __device__ __forceinline__ bf16_t* hg() const { return (bf16_t*)(ws + WSL.hg); }
    __device__ __forceinline__ bf16_t* yb() const { return (bf16_t*)(ws + WSL.yb); }
    __device__ __forceinline__ int* tok_r() const { return (int*)(ws + WSL.tok_r); }
    __device__ __forceinline__ float* tok_w() const { return (float*)(ws + WSL.tok_w); }
    __device__ __forceinline__ int* tok_e() const { return (int*)(ws + WSL.tok_e); }
    __device__ __forceinline__ int* tok_p() const { return (int*)(ws + WSL.tok_p); }
    __device__ __forceinline__ int* gidx() const { return (int*)(ws + WSL.gidx); }
    __device__ __forceinline__ int* tailidx() const { return (int*)(ws + WSL.tailidx); }
    __device__ __forceinline__ float* ypart() const { return (float*)(ws + WSL.wb_m13); }
};

__device__ __forceinline__ int otid() { int t = threadIdx.x; asm volatile("" : "+v"(t)); return t; }
__device__ __forceinline__ unsigned cvt_pk_bf16(float lo, float hi) { unsigned r; asm volatile("v_cvt_pk_bf16_f32 %0, %1, %2" : "=v"(r) : "v"(lo), "v"(hi)); return r; }
__device__ __forceinline__ bf16_t f2bf(float x) { return (bf16_t)(cvt_pk_bf16(x, 0.f) & 0xffffu); }
__device__ __forceinline__ float bf2f(bf16_t b) { return __uint_as_float(((unsigned)b) << 16); }
__device__ __forceinline__ float bflo(unsigned w) { return __uint_as_float(w << 16); }
__device__ __forceinline__ float bfhi(unsigned w) { return __uint_as_float(w & 0xffff0000u); }
__device__ __forceinline__ float silu_f(float x) { return x / (1.f + __expf(-x)); }
__device__ __forceinline__ float sigmoid_f(float x) { return 1.f / (1.f + __expf(-x)); }
__device__ __forceinline__ float softplus_f(float x) { return fmaxf(x, 0.f) + __logf(1.f + __expf(-fabsf(x))); }
__device__ __forceinline__ float shflx(float v, int o, int lane) { return __int_as_float(__builtin_amdgcn_ds_bpermute((lane ^ o) << 2, __float_as_int(v))); }
__device__ __forceinline__ float wave_sum(float v) {
    const int lane = otid() & 63;
#pragma unroll
    for (int o = 32; o >= 1; o >>= 1) v += shflx(v, o, lane);
    return v;
}
__device__ __forceinline__ float sum16(float v) {
    const int lane = otid() & 63;
#pragma unroll
    for (int o = 8; o >= 1; o >>= 1) v += shflx(v, o, lane);
    return v;
}
__device__ __forceinline__ void unpack8(u32x4 w, float (&f)[8]) {
    f[0] = bflo(w.x); f[1] = bfhi(w.x); f[2] = bflo(w.y); f[3] = bfhi(w.y); f[4] = bflo(w.z); f[5] = bfhi(w.z); f[6] = bflo(w.w); f[7] = bfhi(w.w);
}
__device__ __forceinline__ u32x4 pack8(const float (&f)[8]) {
    u32x4 w; w.x = cvt_pk_bf16(f[0], f[1]); w.y = cvt_pk_bf16(f[2], f[3]); w.z = cvt_pk_bf16(f[4], f[5]); w.w = cvt_pk_bf16(f[6], f[7]); return w;
}

namespace pg8 {
constexpr int BM = 256, BK = 64, HALF = 128, HTB = HALF * BK * 2, STAGE_BYTES = 8 * HTB, NXCD = 8, WGM = 4;
__host__ __device__ __forceinline__ int lds_byte(int r, int c) { const int st = (r >> 4) * 2 + (c >> 5), rr = r & 15, cc = c & 31, ob = rr * 64 + cc * 2; return st * 1024 + (ob ^ (((ob >> 9) & 1) << 5)); }
__host__ __device__ __forceinline__ void stage_rc(int b, int& R, int& C) { const int st = b / 1024, sb = b % 1024, swz = sb ^ (((sb >> 9) & 1) << 5); R = (st >> 1) * 16 + swz / 64; C = (st & 1) * 32 + (swz % 64) / 2; }
__host__ __device__ __forceinline__ int perm32(int rho) { const int n = rho >> 4, i = rho & 15; return 8 * (i >> 2) + 4 * n + (i & 3); }
struct Unit { int pm, pn, e, kt0, nt, ks, tu; };
struct Gemm { const bf16_t* A; const bf16_t* Bt; int K, lda, ldb; size_t estride; const int* gidx; };

struct StaticOrder {
    int nM, nN, nwg, G, c, ntk;
    __device__ void init(int M, int N, int G_, int c_, int K) { nM = M / BM; nN = N / BM; nwg = nM * nN; G = G_; c = c_; ntk = K / BK; }
    __device__ bool next(int i, Unit& u) const {
        const long L = (long)i * G + c; if (L >= nwg) return false;
        int wgid = (int)L; { const int q = nwg / NXCD, r = nwg % NXCD, xcd = wgid % NXCD, off = wgid / NXCD; wgid = (xcd < r ? xcd * (q + 1) : r * (q + 1) + (xcd - r) * q) + off; }
        const int nig = WGM * nN, gid = wgid / nig, fm = gid * WGM, gsz = (nM - fm) < WGM ? (nM - fm) : WGM;
        u.pm = fm + ((wgid % nig) % gsz); u.pn = (wgid % nig) / gsz; u.e = 0; u.kt0 = 0; u.nt = ntk; u.ks = -1; u.tu = 0; return true;
    }
    __device__ __forceinline__ void a_ready(const Unit&) const {}
    __device__ __forceinline__ void done(const Unit&) const {}
};
struct CtxSplitOrder {
    StaticOrder S; int ns, G, c;
    __device__ void init(int G_, int c_, int K, int NS) { S.init(SEQ, D_, G_, c_, K); ns = NS; G = G_; c = c_; }
    __device__ bool next(int i, Unit& u) const {
        const long L = (long)i * G + c;
        if (L < S.nwg) { S.next(i, u); u.pm += 1; return true; }
        const int s = (int)(L - S.nwg); if (s >= 8 * ns) return false;
        u.pm = 0; u.pn = s & 7; u.e = 0; u.ks = s >> 3; u.tu = 0; u.nt = S.ntk / ns; u.kt0 = u.ks * u.nt; return true;
    }
    __device__ __forceinline__ void a_ready(const Unit&) const {}
    __device__ __forceinline__ void done(const Unit&) const {}
};
struct GroupedOrder {
    int pb[NEXP + 1]; int ub[NEXP + 1]; int nN, nwg, G, c, ntk, nfull, ntail;
    __device__ void init(const unsigned* cnt, int N, int G_, int c_, int K, bool split_tail = false) {
        ntk = K / BK; nN = N / BM; int acc = 0, ua = 0;
#pragma unroll
        for (int e = 0; e < NEXP; ++e) { pb[e] = acc; ub[e] = ua; const int np = ((int)cnt[e] + 255) >> 8; acc += np; ua += np * nN; }
        pb[NEXP] = acc; ub[NEXP] = ua; nwg = ua; G = G_; c = c_;
        const int rem = nwg % G; ntail = (split_tail && rem > 0 && rem <= 64) ? rem : 0; nfull = nwg - ntail;
    }
    __device__ bool next(int i, Unit& u) const {
        long L = (long)i * G + c; int ks = -1, tu = 0;
        if (L >= nfull) { const long t = L - nfull; if (t >= (long)ntail * 4) return false; tu = (int)(t >> 2); ks = (int)(t & 3); L = nfull + tu; }
        int wgid = (int)L; { const int q = nwg / NXCD, r = nwg % NXCD, xcd = wgid % NXCD, off = wgid / NXCD; wgid = (xcd < r ? xcd * (q + 1) : r * (q + 1) + (xcd - r) * q) + off; }
        int e = 0;
#pragma unroll
        for (int k = 1; k < NEXP; ++k) e += (wgid >= ub[k]) ? 1 : 0;
        int ube = 0, pbe = 0, npe = 0;
#pragma unroll
        for (int k = 0; k < NEXP; ++k) if (e == k) { ube = ub[k]; pbe = pb[k]; npe = pb[k + 1] - pb[k]; }
        const int l = wgid - ube, nig = WGM * nN, gid = l / nig, fm = gid * WGM, gsz = (npe - fm) < WGM ? (npe - fm) : WGM;
        u.pm = pbe + fm + ((l % nig) % gsz); u.pn = (l % nig) / gsz; u.e = e; u.ks = ks; u.tu = tu;
        const int ntq = ntk >> 2; u.nt = ks < 0 ? ntk : ntq; u.kt0 = ks < 0 ? 0 : ks * ntq;
        return true;
    }
    __device__ __forceinline__ void a_ready(const Unit&) const {}
    __device__ __forceinline__ void done(const Unit&) const {}
};

typedef int i32x4 __attribute__((ext_vector_type(4)));
template <class Epi, class Sched, bool GATHER = false, bool I8 = false>
__device__ __forceinline__ void gemm_phase(LAS unsigned char* lds, const Gemm g, const Sched& S, const Epi& E) {
    const int tid = otid(), wid = __builtin_amdgcn_readfirstlane(tid >> 6), lane = tid & 63, wr = wid >> 2, wc = wid & 3, fr = lane & 15, fq = lane >> 4;
    unsigned voffA[2], voffB[2]; int rA[2], cA2[2];
#pragma unroll
    for (int i = 0; i < 2; ++i) { int R, C; stage_rc(tid * 16 + i * 8192, R, C); const int Rb = Epi::PERM ? ((R & ~31) + perm32(R & 31)) : R;
        voffA[i] = (unsigned)(R * g.lda + C) * 2u; voffB[i] = (unsigned)(Rb * g.ldb + C) * 2u; rA[i] = R; cA2[i] = C * 2; }
    unsigned gA[2][2], gN[2][2];
#define PG8_GIDX(dst, pm_) do { _Pragma("unroll") for (int h_ = 0; h_ < 2; ++h_) _Pragma("unroll") for (int i_ = 0; i_ < 2; ++i_) \
        dst[h_][i_] = (unsigned)g.gidx[(pm_) * BM + h_ * HALF + rA[i_]] * (unsigned)(g.lda * 2) + (unsigned)cA2[i_]; } while (0)
#define PG8_STAGE_A(bufoff, kptr, h, useN) do { if constexpr (GATHER) { _Pragma("unroll") for (int _i = 0; _i < 2; ++_i) \
        __builtin_amdgcn_global_load_lds((const unsigned*)((const char*)(kptr) + ((useN) ? gN[h][_i] : gA[h][_i])), (LAS unsigned*)(lds + (bufoff) + ldsw + _i * 8192), 16, 0, 0); } \
        else PG8_STAGE(bufoff, (kptr) + (h) * hstepA, voffA); } while (0)
    const size_t kstep = (size_t)(BK * 2);
    const size_t hstepA = (size_t)HALF * g.lda * 2, hstepB = (size_t)HALF * g.ldb * 2;
    const size_t tstepA = 2 * hstepA, tstepB = 2 * hstepB;
    const unsigned ldsw = (unsigned)wid * 1024u;
    const int aoff = lds_byte(wr * 64 + fr, fq * 8), boff = lds_byte(wc * 32 + fr, fq * 8);
#define PG8_SA(b, h) (((b) * 2 + (h)) * HTB)
#define PG8_SB(b, h) ((4 + (b) * 2 + (h)) * HTB)
#define PG8_STAGE(bufoff, gbase, voff) do { _Pragma("unroll") for (int _i = 0; _i < 2; ++_i) \
        __builtin_amdgcn_global_load_lds((const unsigned*)((const char*)(gbase) + (voff)[_i]), (LAS unsigned*)(lds + (bufoff) + ldsw + _i * 8192), 16, 0, 0); } while (0)
#define PG8_LDA(dst, b, h) do { _Pragma("unroll") for (int m = 0; m < 4; ++m) _Pragma("unroll") for (int k = 0; k < 2; ++k) dst[m][k] = *(const LAS bf16x8*)(lds + PG8_SA(b, h) + aoff + m * 2048 + k * 1024); } while (0)
#define PG8_LDB(dst, b, h) do { _Pragma("unroll") for (int n = 0; n < 2; ++n) _Pragma("unroll") for (int k = 0; k < 2; ++k) dst[n][k] = *(const LAS bf16x8*)(lds + PG8_SB(b, h) + boff + n * 2048 + k * 1024); } while (0)
#define PG8_MMA(ai, bj, At, Bt) do { __builtin_amdgcn_s_setprio(1); _Pragma("unroll") for (int m = 0; m < 4; ++m) _Pragma("unroll") for (int n = 0; n < 2; ++n) _Pragma("unroll") for (int k = 0; k < 2; ++k) \
        { if constexpr (I8) acc[ai][bj][m][n] = __builtin_bit_cast(f32x4, __builtin_amdgcn_mfma_i32_16x16x64_i8(__builtin_bit_cast(i32x4, Bt[n][k]), __builtin_bit_cast(i32x4, At[m][k]), __builtin_bit_cast(i32x4, acc[ai][bj][m][n]), 0, 0, 0)); \
          else acc[ai][bj][m][n] = __builtin_amdgcn_mfma_f32_16x16x32_bf16(Bt[n][k], At[m][k], acc[ai][bj][m][n], 0, 0, 0); } __builtin_amdgcn_s_setprio(0); } while (0)
#define PG8_WAIT_V(n) asm volatile("s_waitcnt vmcnt(" #n ")" ::: "memory")
#define PG8_WAIT_L(n) asm volatile("s_waitcnt lgkmcnt(" #n ")" ::: "memory")
#define PG8_BAR __builtin_amdgcn_s_barrier()
#define PG8_SCHED __builtin_amdgcn_sched_barrier(0)
    Unit cur, nxt; int ui = 0; typename Epi::Regs er;
    if (!S.next(0, cur)) return;
    f32x4 acc[2][2][4][2];
#pragma unroll
    for (int a = 0; a < 2; ++a)
#pragma unroll
        for (int b = 0; b < 2; ++b)
#pragma unroll
            for (int m = 0; m < 4; ++m)
#pragma unroll
                for (int n = 0; n < 2; ++n) acc[a][b][m][n] = (f32x4){0.f, 0.f, 0.f, 0.f};
    bf16x8 At[4][2], B0[2][2], B1[2][2];
    const char* cA = (const char*)g.A + (GATHER ? (size_t)0 : (size_t)cur.pm * tstepA) + (size_t)cur.kt0 * kstep; const char* cB = (const char*)g.Bt + (size_t)cur.pn * tstepB + (size_t)cur.e * g.estride * 2 + (size_t)cur.kt0 * kstep;
    S.a_ready(cur);
    if constexpr (GATHER) { PG8_GIDX(gA, cur.pm); }
    PG8_STAGE(PG8_SB(0, 0), cB, voffB); PG8_STAGE_A(PG8_SA(0, 0), cA, 0, false); PG8_STAGE(PG8_SB(0, 1), cB + hstepB, voffB); PG8_STAGE_A(PG8_SA(0, 1), cA, 1, false);
    if (wr == 1) PG8_BAR;
    PG8_WAIT_V(4); PG8_BAR;
    PG8_STAGE(PG8_SB(1, 0), cB + kstep, voffB); PG8_STAGE_A(PG8_SA(1, 0), cA + kstep, 0, false); PG8_STAGE(PG8_SB(1, 1), cB + hstepB + kstep, voffB);
    PG8_WAIT_V(6); PG8_BAR;
    for (;;) {
        const bool has_next = S.next(ui + 1, nxt);
        const char* nA = has_next ? (const char*)g.A + (GATHER ? (size_t)0 : (size_t)nxt.pm * tstepA) + (size_t)nxt.kt0 * kstep : cA;
        if constexpr (GATHER) { if (has_next) { PG8_GIDX(gN, nxt.pm); } else { _Pragma("unroll") for (int h_ = 0; h_ < 2; ++h_) _Pragma("unroll") for (int i_ = 0; i_ < 2; ++i_) gN[h_][i_] = gA[h_][i_]; } }
        const char* nB = has_next ? (const char*)g.Bt + (size_t)nxt.pn * tstepB + (size_t)nxt.e * g.estride * 2 + (size_t)nxt.kt0 * kstep : cB;
        const int nt = cur.nt;
        for (int t = 0; t < nt; t += 2) {
            const bool last = (t == nt - 2);
            const char* a1 = cA + (size_t)(t + 1) * kstep;
            const char* a2 = last ? nA : cA + (size_t)(t + 2) * kstep; const char* b2 = last ? nB : cB + (size_t)(t + 2) * kstep;
            const char* a3 = a2 + kstep; const char* b3 = b2 + kstep;
            if (last && has_next) S.a_ready(nxt);
            PG8_LDB(B0, 0, 0); PG8_SCHED; PG8_LDA(At, 0, 0); PG8_STAGE_A(PG8_SA(1, 1), a1, 1, false);
            PG8_WAIT_L(8); PG8_BAR; PG8_WAIT_L(0); PG8_MMA(0, 0, At, B0); PG8_BAR; PG8_SCHED;
            PG8_LDB(B1, 0, 1); PG8_STAGE(PG8_SB(0, 0), b2, voffB);
            PG8_BAR; PG8_WAIT_L(0); PG8_MMA(0, 1, At, B1); PG8_BAR;
            PG8_LDA(At, 0, 1); PG8_STAGE_A(PG8_SA(0, 0), a2, 0, last);
            PG8_BAR; PG8_WAIT_L(0); PG8_MMA(1, 0, At, B0); PG8_BAR; PG8_SCHED;
            PG8_STAGE(PG8_SB(0, 1), b2 + hstepB, voffB);
            PG8_WAIT_V(6); PG8_BAR; PG8_MMA(1, 1, At, B1); PG8_BAR;
            PG8_LDB(B0, 1, 0); PG8_SCHED; PG8_LDA(At, 1, 0); PG8_STAGE_A(PG8_SA(0, 1), a2, 1, last);
            PG8_WAIT_L(8); PG8_BAR; PG8_WAIT_L(0); PG8_MMA(0, 0, At, B0); PG8_BAR; PG8_SCHED;
            PG8_LDB(B1, 1, 1); PG8_STAGE(PG8_SB(1, 0), b3, voffB);
            PG8_BAR; PG8_WAIT_L(0); PG8_MMA(0, 1, At, B1); PG8_BAR;
            PG8_LDA(At, 1, 1); PG8_STAGE_A(PG8_SA(1, 0), a3, 0, last);
            PG8_BAR; PG8_WAIT_L(0); PG8_MMA(1, 0, At, B0); PG8_BAR; PG8_SCHED;
            PG8_STAGE(PG8_SB(1, 1), b3 + hstepB, voffB);
            PG8_WAIT_V(6); PG8_BAR; PG8_MMA(1, 1, At, B1); PG8_BAR;
        }
        E.pre(er, cur, wr, wc, fr, fq);
        if constexpr (I8) {
#pragma unroll
            for (int a = 0; a < 2; ++a)
#pragma unroll
                for (int b = 0; b < 2; ++b)
#pragma unroll
                    for (int m = 0; m < 4; ++m)
#pragma unroll
                        for (int n = 0; n < 2; ++n) { const i32x4 iv = __builtin_bit_cast(i32x4, acc[a][b][m][n]); acc[a][b][m][n] = (f32x4){(float)iv[0], (float)iv[1], (float)iv[2], (float)iv[3]}; }
        }
        E(acc, cur, wr, wc, fr, fq, er); S.done(cur);
        if (!has_next) break;
#pragma unroll
        for (int a = 0; a < 2; ++a)
#pragma unroll
            for (int b = 0; b < 2; ++b)
#pragma unroll
                for (int m = 0; m < 4; ++m)
#pragma unroll
                    for (int n = 0; n < 2; ++n) acc[a][b][m][n] = (f32x4){0.f, 0.f, 0.f, 0.f};
        cur = nxt; cA = nA; cB = nB; ++ui;
        if constexpr (GATHER) { _Pragma("unroll") for (int h_ = 0; h_ < 2; ++h_) _Pragma("unroll") for (int i_ = 0; i_ < 2; ++i_) gA[h_][i_] = gN[h_][i_]; }
    }
    PG8_WAIT_V(0);
    if (wr == 0) PG8_BAR;
    PG8_BAR;
#undef PG8_SA
#undef PG8_GIDX
#undef PG8_STAGE_A
#undef PG8_SB
#undef PG8_STAGE
#undef PG8_LDA
#undef PG8_LDB
#undef PG8_MMA
#undef PG8_WAIT_V
#undef PG8_WAIT_L
#undef PG8_BAR
#undef PG8_SCHED
}

struct EpiStoreBf16 {
    static constexpr bool PERM = true;
    bf16_t* O; int ldc; const float* rs; int rs_split; float* part; int* tailidx; const float* sa; const unsigned* sb;
    struct Regs { float scr[8]; f32x4 cs[2][2]; };
    __device__ __forceinline__ void pre(Regs& R, const Unit& u, int wr, int wc, int fr, int fq) const {
        const int row0 = u.pm * BM + wr * 64 + fr, col0 = u.pn * BM + wc * 32 + 8 * fq; const int sel = (u.pn >= rs_split) ? 1 : 0;
#pragma unroll
        for (int i = 0; i < 8; ++i) { const int row = row0 + (i >> 2) * HALF + (i & 3) * 16; R.scr[i] = (rs ? rs[row * 2 + sel] : 1.f) * (sa ? sa[row] : 1.f); }
#pragma unroll
        for (int bj = 0; bj < 2; ++bj) { if (sb) { const u32x4* sp = (const u32x4*)(sb + (size_t)u.e * D_ + col0 + bj * HALF); const u32x4 a = sp[0], b = sp[1];
                R.cs[bj][0] = (f32x4){__uint_as_float(a.x), __uint_as_float(a.y), __uint_as_float(a.z), __uint_as_float(a.w)} * (1.0f / 127.f);
                R.cs[bj][1] = (f32x4){__uint_as_float(b.x), __uint_as_float(b.y), __uint_as_float(b.z), __uint_as_float(b.w)} * (1.0f / 127.f); }
            else { R.cs[bj][0] = (f32x4){1.f, 1.f, 1.f, 1.f}; R.cs[bj][1] = R.cs[bj][0]; } }
    }
    __device__ __forceinline__ void operator()(const f32x4 (&acc)[2][2][4][2], const Unit& u, int wr, int wc, int fr, int fq, const Regs& R) const {
        if (u.ks >= 0) {
            float* pp = part + ((size_t)(u.tu * 4 + u.ks) * BM + wr * 64 + fr) * BM + wc * 32 + 8 * fq;
#pragma unroll
            for (int ai = 0; ai < 2; ++ai)
#pragma unroll
                for (int m = 0; m < 4; ++m)
#pragma unroll
                    for (int bj = 0; bj < 2; ++bj)
#pragma unroll
                        for (int n = 0; n < 2; ++n) *(f32x4*)(pp + (size_t)(ai * HALF + m * 16) * BM + bj * HALF + 4 * n) = acc[ai][bj][m][n];
            if (wr == 0 && wc == 0 && fr == 0 && fq == 0) tailidx[u.pm * 8 + u.pn] = u.tu;
            return;
        }
        const int row0 = u.pm * BM + wr * 64 + fr, col0 = u.pn * BM + wc * 32 + 8 * fq;
        const int sel = (u.pn >= rs_split) ? 1 : 0;
#pragma unroll
        for (int ai = 0; ai < 2; ++ai)
#pragma unroll
            for (int m = 0; m < 4; ++m) { const int row = row0 + ai * HALF + m * 16; bf16_t* rowp = O + (size_t)row * ldc + col0;
                const float sc = R.scr[ai * 4 + m];
#pragma unroll
                for (int bj = 0; bj < 2; ++bj) { f32x4 v0 = acc[ai][bj][m][0] * sc, v1 = acc[ai][bj][m][1] * sc;
                    if (sb) { v0 *= R.cs[bj][0]; v1 *= R.cs[bj][1]; }
                    u32x4 w; w.x = cvt_pk_bf16(v0[0], v0[1]); w.y = cvt_pk_bf16(v0[2], v0[3]); w.z = cvt_pk_bf16(v1[0], v1[1]); w.w = cvt_pk_bf16(v1[2], v1[3]);
                    *(u32x4*)(rowp + bj * HALF) = w; } }
    }
};
struct EpiResGate {
    static constexpr bool PERM = false;
    float* out; const float* res_ctx; const float* res_lat; const float* gate_ctx; const float* gate_lat; int rowbase; float* part;
    const float* sa; const unsigned* sb;
    struct Regs { float ra[8]; };
    __device__ __forceinline__ void pre(Regs& R, const Unit& u, int wr, int wc, int fr, int fq) const {
        const int r0 = u.pm * BM + wr * 64 + fr;
#pragma unroll
        for (int i = 0; i < 8; ++i) R.ra[i] = sa ? sa[r0 + (i >> 2) * HALF + (i & 3) * 16] : 1.f;
    }
    __device__ __forceinline__ void operator()(const f32x4 (&acc)[2][2][4][2], const Unit& u, int wr, int wc, int fr, int fq, const Regs& R) const {
        const int row0 = rowbase + u.pm * BM + wr * 64 + fr, col0 = u.pn * BM + wc * 32 + 4 * fq;
        f32x4 cs[2][2];
#pragma unroll
        for (int bj = 0; bj < 2; ++bj)
#pragma unroll
            for (int n = 0; n < 2; ++n) { if (sb) { const unsigned* sp = sb + col0 + bj * HALF + n * 16; cs[bj][n] = (f32x4){__uint_as_float(sp[0]), __uint_as_float(sp[1]), __uint_as_float(sp[2]), __uint_as_float(sp[3])} * (1.0f / 127.f); }
                else cs[bj][n] = (f32x4){1.f, 1.f, 1.f, 1.f}; }
        if (u.ks >= 0) {
            float* pp = part + ((size_t)u.ks * LC + wr * 64 + fr) * D_ + col0;
#pragma unroll
            for (int ai = 0; ai < 2; ++ai)
#pragma unroll
                for (int m = 0; m < 4; ++m)
#pragma unroll
                    for (int bj = 0; bj < 2; ++bj)
#pragma unroll
                        for (int n = 0; n < 2; ++n) *(f32x4*)(pp + (size_t)(ai * HALF + m * 16) * D_ + bj * HALF + n * 16) = acc[ai][bj][m][n] * cs[bj][n] * R.ra[ai * 4 + m];
            return;
        }
        f32x4 g4[2][2];
#pragma unroll
        for (int bj = 0; bj < 2; ++bj)
#pragma unroll
            for (int n = 0; n < 2; ++n) g4[bj][n] = *(const f32x4*)(gate_lat + col0 + bj * HALF + n * 16) * cs[bj][n];
#pragma unroll
        for (int hb = 0; hb < 4; ++hb) { f32x4 r4[2][2][2];
#pragma unroll
            for (int mm = 0; mm < 2; ++mm) { const int ai = hb >> 1, m = (hb & 1) * 2 + mm; const float* rp = res_lat + (size_t)(row0 + ai * HALF + m * 16 - LC) * D_;
#pragma unroll
                for (int bj = 0; bj < 2; ++bj)
#pragma unroll
                    for (int n = 0; n < 2; ++n) r4[mm][bj][n] = *(const f32x4*)(rp + col0 + bj * HALF + n * 16); }
#pragma unroll
            for (int mm = 0; mm < 2; ++mm) { const int ai = hb >> 1, m = (hb & 1) * 2 + mm; float* op = out + (size_t)(row0 + ai * HALF + m * 16) * D_;
#pragma unroll
                for (int bj = 0; bj < 2; ++bj)
#pragma unroll
                    for (int n = 0; n < 2; ++n) *(f32x4*)(op + col0 + bj * HALF + n * 16) = r4[mm][bj][n] + g4[bj][n] * (acc[ai][bj][m][n] * R.ra[ai * 4 + m]); } }
    }
};
struct EpiSwiGLU {
    static constexpr bool PERM = true;
    bf16_t* O; int ldc; const float* sa; const unsigned* sb; unsigned* rmax;
    struct Regs { float rav[8]; u32x4 sg[2], su[2]; };
    __device__ __forceinline__ void pre(Regs& R, const Unit& u, int wr, int wc, int fr, int fq) const {
        const int row0 = u.pm * BM + wr * 64 + fr;
#pragma unroll
        for (int i = 0; i < 8; ++i) R.rav[i] = sa ? sa[row0 + (i >> 2) * HALF + (i & 3) * 16] : 1.f;
        if (sb) { const unsigned* sp = sb + (size_t)u.e * (2 * DFF) + u.pn * BM + wc * 32 + 8 * fq;
            R.sg[0] = *(const u32x4*)sp; R.sg[1] = *(const u32x4*)(sp + 4); R.su[0] = *(const u32x4*)(sp + HALF); R.su[1] = *(const u32x4*)(sp + HALF + 4); }
    }
    __device__ __forceinline__ void operator()(const f32x4 (&acc)[2][2][4][2], const Unit& u, int wr, int wc, int fr, int fq, const Regs& R) const {
        const int row0 = u.pm * BM + wr * 64 + fr, col0 = u.pn * HALF + wc * 32 + 8 * fq;
        float sg[8], su[8];
#pragma unroll
        for (int j = 0; j < 8; ++j) { sg[j] = 1.f; su[j] = 1.f; }
        if (sb) {
#pragma unroll
            for (int j = 0; j < 8; ++j) { sg[j] = __uint_as_float(R.sg[j >> 2][j & 3]) * (1.0f / 127.f); su[j] = __uint_as_float(R.su[j >> 2][j & 3]) * (1.0f / 127.f); } }
#pragma unroll
        for (int ai = 0; ai < 2; ++ai)
#pragma unroll
            for (int m = 0; m < 4; ++m) { const int row = row0 + ai * HALF + m * 16; bf16_t* rowp = O + (size_t)row * ldc + col0;
                const float ra = R.rav[ai * 4 + m];
                float o[8];
#pragma unroll
                for (int n = 0; n < 2; ++n)
#pragma unroll
                    for (int j = 0; j < 4; ++j) { const float gte = acc[ai][0][m][n][j] * (ra * sg[n * 4 + j]), up = acc[ai][1][m][n][j] * (ra * su[n * 4 + j]); o[n * 4 + j] = gte * __builtin_amdgcn_rcpf(1.f + __expf(-gte)) * up; }
                *(u32x4*)rowp = pack8(o);
                if (rmax) { float mx = fmaxf(fmaxf(fmaxf(fabsf(o[0]), fabsf(o[1])), fmaxf(fabsf(o[2]), fabsf(o[3]))), fmaxf(fmaxf(fabsf(o[4]), fabsf(o[5])), fmaxf(fabsf(o[6]), fabsf(o[7]))));
                    const int ln = otid() & 63; mx = fmaxf(mx, shflx(mx, 16, ln)); mx = fmaxf(mx, shflx(mx, 32, ln));
                    if (fq == 0) atomicMax(rmax + row, __float_as_uint(mx)); } }
    }
};
}
#ifndef FFT_DEV_H
#define FFT_DEV_H
#ifndef FFT_HOST
#define FFT_FN __device__ __forceinline__
struct cpx { float x, y; };
FFT_FN void tw(float frac, float& c, float& s) { c = __builtin_amdgcn_cosf(frac); s = __builtin_amdgcn_sinf(frac); }
#else
#include <cmath>
#define FFT_FN static inline
struct cpx { float x, y; };
FFT_FN void tw(float frac, float& c, float& s) { c = (float)cos(6.283185307179586 * (double)frac); s = (float)sin(6.283185307179586 * (double)frac); }
#endif
#define ZP(i) ((i) + (((i) >> 6) << 2))
constexpr int FFT_N = 16384;
constexpr int FFT_ZN = FFT_N + 4 * (FFT_N / 64);

FFT_FN void bf_dif(cpx& a, cpx& b, float c, float s) {
    const float dx = a.x - b.x, dy = a.y - b.y;
    a.x += b.x; a.y += b.y;
    b.x = dx * c + dy * s; b.y = dy * c - dx * s;
}
FFT_FN void bf_dit(cpx& a, cpx& b, float c, float s) {
    const float tx = b.x * c - b.y * s, ty = b.x * s + b.y * c;
    b.x = a.x - tx; b.y = a.y - ty; a.x += tx; a.y += ty;
}
template <int K16> FFT_FN void rot16(float c0, float s0, float& c, float& s) {
    constexpr float CR[16] = {1.f, 0.9238795325112867f, 0.7071067811865476f, 0.3826834323650898f, 0.f, -0.3826834323650898f, -0.7071067811865476f, -0.9238795325112867f,
                              -1.f, -0.9238795325112867f, -0.7071067811865476f, -0.3826834323650898f, 0.f, 0.3826834323650898f, 0.7071067811865476f, 0.9238795325112867f};
    constexpr float SR[16] = {0.f, 0.3826834323650898f, 0.7071067811865476f, 0.9238795325112867f, 1.f, 0.9238795325112867f, 0.7071067811865476f, 0.3826834323650898f,
                              0.f, -0.3826834323650898f, -0.7071067811865476f, -0.9238795325112867f, -1.f, -0.9238795325112867f, -0.7071067811865476f, -0.3826834323650898f};
    constexpr float cr = CR[K16 & 15], sr = SR[K16 & 15];
    if constexpr ((K16 & 15) == 0) { c = c0; s = s0; }
    else if constexpr ((K16 & 15) == 4) { c = -s0; s = c0; }
    else if constexpr ((K16 & 15) == 8) { c = -c0; s = -s0; }
    else if constexpr ((K16 & 15) == 12) { c = s0; s = -c0; }
    else { c = c0 * cr - s0 * sr; s = s0 * cr + c0 * sr; }
}
#define FFT_BF(DIFDIT, ra, rb, K16, cb, sb) do { float _c, _s; rot16<K16>(cb, sb, _c, _s); DIFDIT(v[ra], v[rb], _c, _s); } while (0)
template <bool INV> FFT_FN void fft_pass16(cpx* Z, int g, int lm) {
    const int mp = 1 << lm, ilo = g & (mp - 1), ihi = g >> lm, base = (ihi << (lm + 4)) + ilo;
    const int zb = ZP(base), st = (lm >= 6) ? mp + (mp >> 4) : mp;
    cpx v[16];
#pragma unroll
    for (int r = 0; r < 16; ++r) v[r] = Z[zb + r * st];
#ifndef FFT_HOST
    const float th = __builtin_amdgcn_ldexpf((float)ilo, -(lm + 4));
#else
    const float th = (float)ilo / (float)(16 * mp);
#endif
    float cA, sA, cB, sB, cC, sC, cD, sD;
    tw(th, cA, sA); tw(2.f * th, cB, sB); tw(4.f * th, cC, sC); tw(8.f * th, cD, sD);
    if (!INV) {
        FFT_BF(bf_dif, 0, 8, 0, cA, sA); FFT_BF(bf_dif, 1, 9, 1, cA, sA); FFT_BF(bf_dif, 2, 10, 2, cA, sA); FFT_BF(bf_dif, 3, 11, 3, cA, sA);
        FFT_BF(bf_dif, 4, 12, 4, cA, sA); FFT_BF(bf_dif, 5, 13, 5, cA, sA); FFT_BF(bf_dif, 6, 14, 6, cA, sA); FFT_BF(bf_dif, 7, 15, 7, cA, sA);
        FFT_BF(bf_dif, 0, 4, 0, cB, sB); FFT_BF(bf_dif, 1, 5, 2, cB, sB); FFT_BF(bf_dif, 2, 6, 4, cB, sB); FFT_BF(bf_dif, 3, 7, 6, cB, sB);
        FFT_BF(bf_dif, 8, 12, 0, cB, sB); FFT_BF(bf_dif, 9, 13, 2, cB, sB); FFT_BF(bf_dif, 10, 14, 4, cB, sB); FFT_BF(bf_dif, 11, 15, 6, cB, sB);
        FFT_BF(bf_dif, 0, 2, 0, cC, sC); FFT_BF(bf_dif, 1, 3, 4, cC, sC); FFT_BF(bf_dif, 4, 6, 0, cC, sC); FFT_BF(bf_dif, 5, 7, 4, cC, sC);
        FFT_BF(bf_dif, 8, 10, 0, cC, sC); FFT_BF(bf_dif, 9, 11, 4, cC, sC); FFT_BF(bf_dif, 12, 14, 0, cC, sC); FFT_BF(bf_dif, 13, 15, 4, cC, sC);
#pragma unroll
        for (int r = 0; r < 16; r += 2) bf_dif(v[r], v[r + 1], cD, sD);
    } else {
#pragma unroll
        for (int r = 0; r < 16; r += 2) bf_dit(v[r], v[r + 1], cD, sD);
        FFT_BF(bf_dit, 0, 2, 0, cC, sC); FFT_BF(bf_dit, 1, 3, 4, cC, sC); FFT_BF(bf_dit, 4, 6, 0, cC, sC); FFT_BF(bf_dit, 5, 7, 4, cC, sC);
        FFT_BF(bf_dit, 8, 10, 0, cC, sC); FFT_BF(bf_dit, 9, 11, 4, cC, sC); FFT_BF(bf_dit, 12, 14, 0, cC, sC); FFT_BF(bf_dit, 13, 15, 4, cC, sC);
        FFT_BF(bf_dit, 0, 4, 0, cB, sB); FFT_BF(bf_dit, 1, 5, 2, cB, sB); FFT_BF(bf_dit, 2, 6, 4, cB, sB); FFT_BF(bf_dit, 3, 7, 6, cB, sB);
        FFT_BF(bf_dit, 8, 12, 0, cB, sB); FFT_BF(bf_dit, 9, 13, 2, cB, sB); FFT_BF(bf_dit, 10, 14, 4, cB, sB); FFT_BF(bf_dit, 11, 15, 6, cB, sB);
        FFT_BF(bf_dit, 0, 8, 0, cA, sA); FFT_BF(bf_dit, 1, 9, 1, cA, sA); FFT_BF(bf_dit, 2, 10, 2, cA, sA); FFT_BF(bf_dit, 3, 11, 3, cA, sA);
        FFT_BF(bf_dit, 4, 12, 4, cA, sA); FFT_BF(bf_dit, 5, 13, 5, cA, sA); FFT_BF(bf_dit, 6, 14, 6, cA, sA); FFT_BF(bf_dit, 7, 15, 7, cA, sA);
    }
#pragma unroll
    for (int r = 0; r < 16; ++r) Z[zb + r * st] = v[r];
}
template <bool INV> FFT_FN void fft_pass4(cpx* Z, int g) {
    const int base = 4 * g;
#ifndef FFT_HOST
    typedef float f4_t __attribute__((ext_vector_type(4)));
    f4_t* zv = (f4_t*)(Z + ZP(base)); const f4_t q0 = zv[0], q1 = zv[1];
    cpx a = {q0[0], q0[1]}, b = {q0[2], q0[3]}, c = {q1[0], q1[1]}, d = {q1[2], q1[3]};
#else
    cpx a = Z[ZP(base)], b = Z[ZP(base + 1)], c = Z[ZP(base + 2)], d = Z[ZP(base + 3)];
#endif
    if (!INV) {
        cpx a2 = {a.x + c.x, a.y + c.y}, c2 = {a.x - c.x, a.y - c.y};
        cpx b2 = {b.x + d.x, b.y + d.y}, t = {b.x - d.x, b.y - d.y}; cpx d2 = {t.y, -t.x};
        a = {a2.x + b2.x, a2.y + b2.y}; b = {a2.x - b2.x, a2.y - b2.y};
        c = {c2.x + d2.x, c2.y + d2.y}; d = {c2.x - d2.x, c2.y - d2.y};
    } else {
        cpx a2 = {a.x + b.x, a.y + b.y}, b2 = {a.x - b.x, a.y - b.y};
        cpx c2 = {c.x + d.x, c.y + d.y}, d2 = {c.x - d.x, c.y - d.y};
        a = {a2.x + c2.x, a2.y + c2.y}; c = {a2.x - c2.x, a2.y - c2.y};
        cpx t = {-d2.y, d2.x};
        b = {b2.x + t.x, b2.y + t.y}; d = {b2.x - t.x, b2.y - t.y};
    }
#ifndef FFT_HOST
    zv[0] = (f4_t){a.x, a.y, b.x, b.y}; zv[1] = (f4_t){c.x, c.y, d.x, d.y};
#else
    Z[ZP(base)] = a; Z[ZP(base + 1)] = b; Z[ZP(base + 2)] = c; Z[ZP(base + 3)] = d;
#endif
}
FFT_FN int rev14(int p) {
#ifndef FFT_HOST
    return (int)(__builtin_bitreverse32((unsigned)p) >> 18);
#else
    int r = 0; for (int b = 0; b < 14; ++b) r |= ((p >> b) & 1) << (13 - b); return r;
#endif
}
FFT_FN int ilog2(int q) {
#ifndef FFT_HOST
    return 31 - __builtin_clz((unsigned)q);
#else
    int b = 0; while ((1 << (b + 1)) <= q) ++b; return b;
#endif
}
FFT_FN void fft_pw_idx(int q, int& pp, int& pq) { if (q == 0) { pp = 0; pq = 1; return; } const int b = ilog2(q); pp = (2 << b) + (q - (1 << b)); pq = 3 * (2 << b) - 1 - pp; }
FFT_FN void fft_pointwise_pre(cpx* Z, const cpx HA, const cpx HB, int q) {
    if (q == 0) {
        { const cpx a = Z[ZP(0)]; Z[ZP(0)] = cpx{a.x * HA.x + a.y * HA.y, a.x * HA.y + a.y * HA.x}; }
        { const cpx a = Z[ZP(1)]; Z[ZP(1)] = cpx{a.x * HB.x - a.y * HB.y, a.x * HB.y + a.y * HB.x}; }
        return;
    }
    const int b = ilog2(q), pp = (2 << b) + (q - (1 << b)), pq = 3 * (2 << b) - 1 - pp;
    const int kk = rev14(pp);
    float wc, ws; tw((float)kk * (1.0f / (float)FFT_N), wc, ws);
    const cpx A = Z[ZP(pp)], B = Z[ZP(pq)];
    const cpx Ue = {0.5f * (A.x + B.x), 0.5f * (A.y - B.y)};
    const cpx dU = {A.x - B.x, A.y + B.y};
    const cpx Uo = {0.5f * dU.y, -0.5f * dU.x};
    const cpx He = {0.5f * (HA.x + HB.x), 0.5f * (HA.y - HB.y)};
    const cpx dH = {HA.x - HB.x, HA.y + HB.y};
    const cpx Ho = {0.5f * dH.y, -0.5f * dH.x};
    const cpx UoHo = {Uo.x * Ho.x - Uo.y * Ho.y, Uo.x * Ho.y + Uo.y * Ho.x};
    const cpx wUH = {wc * UoHo.x + ws * UoHo.y, wc * UoHo.y - ws * UoHo.x};
    const cpx Ye = {Ue.x * He.x - Ue.y * He.y + wUH.x, Ue.x * He.y + Ue.y * He.x + wUH.y};
    const cpx Yo = {Ue.x * Ho.x - Ue.y * Ho.y + Uo.x * He.x - Uo.y * He.y, Ue.x * Ho.y + Ue.y * Ho.x + Uo.x * He.y + Uo.y * He.x};
    cpx o1 = {Ye.x - Yo.y, Ye.y + Yo.x};
    cpx o2 = {Ye.x + Yo.y, -Ye.y + Yo.x};
    Z[ZP(pp)] = o1; Z[ZP(pq)] = o2;
}
FFT_FN void fft_pointwise(cpx* Z, const cpx* Zh, int q) {
    if (q == 0) {
#pragma unroll
        for (int p0 = 0; p0 < 2; ++p0) {
            const cpx a = Z[ZP(p0)], h = Zh[p0];
            const float ue = a.x, uo = a.y, he = h.x, ho = h.y, sg = p0 ? -1.f : 1.f;
            cpx o = {ue * he + sg * uo * ho, ue * ho + uo * he};
            Z[ZP(p0)] = o;
        }
        return;
    }
    const int b = ilog2(q), pp = (2 << b) + (q - (1 << b)), pq = 3 * (2 << b) - 1 - pp;
    const int kk = rev14(pp);
    float wc, ws; tw((float)kk * (1.0f / (float)FFT_N), wc, ws);
    const cpx A = Z[ZP(pp)], B = Z[ZP(pq)], HA = Zh[pp], HB = Zh[pq];
    const cpx Ue = {0.5f * (A.x + B.x), 0.5f * (A.y - B.y)};
    const cpx dU = {A.x - B.x, A.y + B.y};
    const cpx Uo = {0.5f * dU.y, -0.5f * dU.x};
    const cpx He = {0.5f * (HA.x + HB.x), 0.5f * (HA.y - HB.y)};
    const cpx dH = {HA.x - HB.x, HA.y + HB.y};
    const cpx Ho = {0.5f * dH.y, -0.5f * dH.x};
    const cpx UoHo = {Uo.x * Ho.x - Uo.y * Ho.y, Uo.x * Ho.y + Uo.y * Ho.x};
    const cpx wUH = {wc * UoHo.x + ws * UoHo.y, wc * UoHo.y - ws * UoHo.x};
    const cpx Ye = {Ue.x * He.x - Ue.y * He.y + wUH.x, Ue.x * He.y + Ue.y * He.x + wUH.y};
    const cpx Yo = {Ue.x * Ho.x - Ue.y * Ho.y + Uo.x * He.x - Uo.y * He.y, Ue.x * Ho.y + Ue.y * Ho.x + Uo.x * He.y + Uo.y * He.x};
    cpx o1 = {Ye.x - Yo.y, Ye.y + Yo.x};
    cpx o2 = {Ye.x + Yo.y, -Ye.y + Yo.x};
    Z[ZP(pp)] = o1; Z[ZP(pq)] = o2;
}
#endif
template <class F> __device__ __forceinline__ void tconv_tile(const F& f, bf16_t* dst, int K, int k0, int n0, float* tile  , int lane) {
    f32x4 v[16];
    const int n4 = (lane & 15) * 4, kr = lane >> 4;
#pragma unroll
    for (int i = 0; i < 16; ++i) v[i] = f.ld4(k0 + kr + 4 * i, n0 + n4);
#pragma unroll
    for (int i = 0; i < 16; ++i) { float* t = tile + (kr + 4 * i) * 65 + n4; t[0] = v[i][0]; t[1] = v[i][1]; t[2] = v[i][2]; t[3] = v[i][3]; }
    __builtin_amdgcn_fence(__ATOMIC_RELEASE, "wavefront"); __builtin_amdgcn_wave_barrier(); __builtin_amdgcn_fence(__ATOMIC_ACQUIRE, "wavefront");
    const int kq = (lane & 7) * 8, nr = lane >> 3;
#pragma unroll
    for (int i = 0; i < 8; ++i) { const int nn = nr + 8 * i; float o[8];
#pragma unroll
        for (int e = 0; e < 8; ++e) o[e] = tile[(kq + e) * 65 + nn];
        *(u32x4*)(dst + (size_t)(n0 + nn) * K + k0 + kq) = pack8(o); }
    __builtin_amdgcn_fence(__ATOMIC_RELEASE, "wavefront"); __builtin_amdgcn_wave_barrier(); __builtin_amdgcn_fence(__ATOMIC_ACQUIRE, "wavefront");
}
__device__ __forceinline__ int in_src_col(int n) {
    if (n < 2048) return n;
    if (n < 3584) return 2704 + (n - 2048);
    if (n < 5120) return 4240 + (n - 3584);
    if (n < 5632) return 5776 + (n - 5120);
    if (n < 6080) return 2064 + (n - 5632);
    if (n < 6144) return -1;
    if (n < 6272) return 2512 + (n - 6144);
    if (n < 6336) return 2640 + (n - 6272);
    if (n < 6344) return 2048 + (n - 6336);
    if (n < 6352) return 2056 + (n - 6344);
    return -1;
}
struct FWin { const float* src;
    __device__ __forceinline__ f32x4 ld4(int k, int n) const {
        if (n < 6336) { const int c = in_src_col(n); return c < 0 ? (f32x4){0.f, 0.f, 0.f, 0.f} : *(const f32x4*)(src + (size_t)k * DIN + c); }
        f32x4 r;
#pragma unroll
        for (int e = 0; e < 4; ++e) { const int c = in_src_col(n + e); r[e] = c < 0 ? 0.f : src[(size_t)k * DIN + c]; }
        return r; } };
struct FPlain { const float* src; int ld; __device__ __forceinline__ f32x4 ld4(int k, int n) const { return *(const f32x4*)(src + (size_t)k * ld + n); } };
struct FMla { const float *uq, *ukv, *qn, *kvn;
    __device__ __forceinline__ f32x4 ld4(int k, int n) const {
        if (n < 768) { if (k >= 448) return (f32x4){0.f, 0.f, 0.f, 0.f}; return *(const f32x4*)(uq + (size_t)k * 768 + n) * qn[k]; }
        if (k < 512) return (f32x4){0.f, 0.f, 0.f, 0.f};
        return *(const f32x4*)(ukv + (size_t)(k - 512) * 1024 + (n - 768)) * kvn[k - 512]; } };
struct FW13 { const float *w1, *w3;
    __device__ __forceinline__ f32x4 ld4(int k, int n) const { const int col = (n >> 8) * 128 + (n & 127);
        const uintptr_t d = (uintptr_t)w3 - (uintptr_t)w1; const float* b = (const float*)((uintptr_t)w1 + (((n >> 7) & 1) ? d : (uintptr_t)0));
        return *(const f32x4*)(b + (size_t)k * DFF + col); } };

constexpr int T_WIN = (NP / 64) * (D_ / 64), T_WOUT = 32 * 32, T_MLA = (MLAN / 64) * (MLAK / 64), T_F13 = (2 * DFF / 64) * 32, T_F2 = 32 * (DFF / 64);
constexpr int U_MOD = 96, U_HF = 516, U_TR = 2 * T_WOUT + 2 * T_MLA;
constexpr int XBW_OFF_ = 147456 - 16;
constexpr int U_WABS_IN = 2 * (NP / 32);
constexpr int U_TRB = (U_TR + 7) / 8;
constexpr int U_S13 = 2 * (DFF / 32), U_S2 = D_ / 16, U_SBIG = 9 * U_S2, U_SSMALL = 9 * U_S13;
constexpr int U_STREAM = U_MOD + U_SBIG + U_SSMALL + U_WABS_IN + U_TRB, U_QTOT = U_HF + U_STREAM, Q_STRIDE = 9;

__device__ __forceinline__ void pro_mod_unit(const Params& p, int u, float* lds) {
    const int tid = otid(), wid = tid >> 6, lane = tid & 63;
    const int l = u / 48, cb = u % 48, col = cb * 256 + lane * 4;
    const float* W = p.in[I_MODW] + (size_t)l * D_ * (6 * D_) + col;
    const float* c = p.in[I_C]; const float* cc = p.in[I_CCTX];
    f32x4 al = {0, 0, 0, 0}, ac = {0, 0, 0, 0};
    const int k0 = wid * 256;
#pragma unroll 16
    for (int k = k0; k < k0 + 256; ++k) {
        const f32x4 w4 = *(const f32x4*)(W + (size_t)k * (6 * D_));
        const float sl = silu_f(c[k]), sc = silu_f(cc[k]);
        al += w4 * sl; ac += w4 * sc;
    }
    f32x4* red = (f32x4*)lds;
    red[(wid * 64 + lane) * 2] = al; red[(wid * 64 + lane) * 2 + 1] = ac;
    __syncthreads();
    if (wid == 0) {
        f32x4 sl = {0, 0, 0, 0}, sc = {0, 0, 0, 0};
#pragma unroll
        for (int w = 0; w < 8; ++w) { sl += red[(w * 64 + lane) * 2]; sc += red[(w * 64 + lane) * 2 + 1]; }
        const f32x4 b4 = *(const f32x4*)(p.in[I_MODB] + (size_t)l * 6 * D_ + col);
        *(f32x4*)(p.modv() + ((size_t)l * 2 + 0) * 6 * D_ + col) = sl + b4;
        *(f32x4*)(p.modv() + ((size_t)l * 2 + 1) * 6 * D_ + col) = sc + b4;
    }
    __syncthreads();
}

__device__ __forceinline__ void pro_hfilt_unit(const Params& p, int l, int Lf, int tb, float* hout, float* hsumo, float* lds) {
    const int tid = otid(), wid = tid >> 6, lane = tid & 63;
    float* zb = lds;
    float* H1 = lds + 64 * 36;
    float* H2 = H1 + 64 * 68;
    float* tl = H2 + 64 * 68 + wid * (64 * 33);
    const int t0 = tb * 64;
    const float* w1 = p.in[I_HW1] + (size_t)l * 33 * 64; const float* b1 = p.in[I_HB1] + l * 64;
    const float* w2 = p.in[I_HW2] + (size_t)l * 64 * 64; const float* b2 = p.in[I_HB2] + l * 64;
    const float* w3 = p.in[I_HW3] + (size_t)l * 64 * 64; const float* b3 = p.in[I_HB3] + l * 64;
    const float* w4 = p.in[I_HW4] + (size_t)l * 64 * 1024; const float* fq = p.in[I_HFREQ] + l * 64;
    {
        const int tp = lane, part = wid; const float pf = (float)(t0 + tp);
        const float c0 = (float)(6.283185307179586 / (double)Lf);
#pragma unroll 1
        for (int e = part; e < 33; e += 8) {
            float v;
            if (e == 0) v = pf / (float)(Lf - 1);
            else { const int b = (e - 1) & 15; const float fr = 1e-4f + (float)b * ((15.0f - 1e-4f) / 15.0f); const float ang = (c0 * pf) * fr; v = (e <= 16) ? cosf(ang) : -sinf(ang); }
            zb[tp * 36 + e] = v;
        }
    }
    __syncthreads();
    {   const int tp = lane, j0 = wid * 8; float s[8];
#pragma unroll
        for (int jj = 0; jj < 8; ++jj) s[jj] = b1[j0 + jj];
#pragma unroll 3
        for (int e = 0; e < 33; ++e) { const float z = zb[tp * 36 + e];
#pragma unroll
            for (int jj = 0; jj < 8; ++jj) s[jj] += z * w1[e * 64 + j0 + jj]; }
#pragma unroll 1
        for (int jj = 0; jj < 8; ++jj) H1[tp * 68 + j0 + jj] = sinf(fq[j0 + jj] * s[jj]);
    }
    __syncthreads();
    {   const int tp = lane, j0 = wid * 8; float s[8];
#pragma unroll
        for (int jj = 0; jj < 8; ++jj) s[jj] = b2[j0 + jj];
#pragma unroll 4
        for (int i = 0; i < 64; ++i) { const float z = H1[tp * 68 + i];
#pragma unroll
            for (int jj = 0; jj < 8; ++jj) s[jj] += z * w2[i * 64 + j0 + jj]; }
#pragma unroll 1
        for (int jj = 0; jj < 8; ++jj) H2[tp * 68 + j0 + jj] = sinf(fq[j0 + jj] * s[jj]);
    }
    __syncthreads();
    {   const int tp = lane, j0 = wid * 8; float s[8];
#pragma unroll
        for (int jj = 0; jj < 8; ++jj) s[jj] = b3[j0 + jj];
#pragma unroll 4
        for (int i = 0; i < 64; ++i) { const float z = H2[tp * 68 + i];
#pragma unroll
            for (int jj = 0; jj < 8; ++jj) s[jj] += z * w3[i * 64 + j0 + jj]; }
        __syncthreads();
#pragma unroll 1
        for (int jj = 0; jj < 8; ++jj) H1[tp * 68 + j0 + jj] = sinf(fq[j0 + jj] * s[jj]);
    }
    __syncthreads();
    const int nblk = Lf / 64;
#pragma unroll 1
    for (int i = 0; i < 2; ++i) {
        const int cg = wid + 8 * i, c = cg * 64 + lane;
        float wreg[64];
#pragma unroll
        for (int j = 0; j < 64; ++j) wreg[j] = w4[j * 1024 + c];
        const float a0 = -120.39728043259361f, a1 = 40.546510810816436f;
        const float delta = fabsf(a0 + (float)c * ((a1 - a0) / 1023.0f));
        float asum = 0.f; const float rLf = 1.0f / (float)Lf;
#pragma unroll 1
        for (int hh = 0; hh < 2; ++hh) {
#pragma unroll 2
            for (int tq = 0; tq < 32; ++tq) { const int tp = hh * 32 + tq;
                float s = 0.f;
#pragma unroll
                for (int j4 = 0; j4 < 16; ++j4) { const f32x4 h4 = *(const f32x4*)(H1 + tp * 68 + 4 * j4);
                    s += h4[0] * wreg[4 * j4] + h4[1] * wreg[4 * j4 + 1] + h4[2] * wreg[4 * j4 + 2] + h4[3] * wreg[4 * j4 + 3]; }
                const float pf = (float)(t0 + tp), dist = fabsf(pf - (float)(Lf / 2)) * rLf;
                const float val = s * expf(-dist * delta);
                tl[lane * 33 + tq] = val; asum += fabsf(val);
            }
            __builtin_amdgcn_fence(__ATOMIC_RELEASE, "wavefront"); __builtin_amdgcn_wave_barrier(); __builtin_amdgcn_fence(__ATOMIC_ACQUIRE, "wavefront");
#pragma unroll
            for (int ps = 0; ps < 2; ++ps) { const int rr = (lane >> 1) + 32 * ps, tq0 = (lane & 1) * 16;
                float* dst = hout + (size_t)(cg * 64 + rr) * Lf + t0 + hh * 32 + tq0;
#pragma unroll
                for (int k = 0; k < 4; ++k) { f32x4 v;
#pragma unroll
                    for (int e = 0; e < 4; ++e) v[e] = tl[rr * 33 + tq0 + 4 * k + e];
                    *(f32x4*)(dst + 4 * k) = v; } }
            __builtin_amdgcn_fence(__ATOMIC_RELEASE, "wavefront"); __builtin_amdgcn_wave_barrier(); __builtin_amdgcn_fence(__ATOMIC_ACQUIRE, "wavefront");
        }
        hsumo[(size_t)c * nblk + tb] = asum;
    }
    __syncthreads();
}

template <class M> __device__ __forceinline__ void wabs_unit(const float* src, int ld, int c0, int k0, unsigned* wam, const M& map, float* lds) {
    const int tid = otid(), wid = tid >> 6, lane = tid & 63;
    const float* sp = src + (size_t)(k0 + wid * 64) * ld + c0 + lane * 4;
    f32x4 m4 = {0.f, 0.f, 0.f, 0.f};
#pragma unroll 8
    for (int k = 0; k < 64; ++k) { const f32x4 v = *(const f32x4*)(sp + (size_t)k * ld); m4 = __builtin_elementwise_max(m4, __builtin_elementwise_abs(v)); }
    f32x4* red = (f32x4*)lds; red[wid * 64 + lane] = m4;
    __syncthreads();
    if (wid == 0) {
#pragma unroll
        for (int w = 1; w < 8; ++w) m4 = __builtin_elementwise_max(m4, red[w * 64 + lane]);
#pragma unroll
        for (int e = 0; e < 4; ++e) atomicMax(wam + map(c0 + lane * 4 + e), __float_as_uint(m4[e]));
    }
    __syncthreads();
}
struct ColId { __device__ __forceinline__ int operator()(int n) const { return n; } };
struct ColWin { __device__ __forceinline__ int operator()(int n) const { return in_src_col(n); } };
template <int K, int NCH, class M, class C = ColId> __device__ __forceinline__ void strip_unit(const float* src, int ld, int n0, signed char* dst, unsigned* wam, const M& map, char* lds, const C& colmap = C()) {
    constexpr int LPR = NCH / 4, RPP = 512 / LPR, NPASS = K / RPP, KS = K + 16, CH = 8;
    static_assert(NPASS % 4 == 0 && NPASS % CH == 0 || NPASS % 4 == 0, "strip geometry");
    const int tid = otid(), wid = tid >> 6, lane = tid & 63, tr = tid / LPR, m = tid % LPR;
    const int c4 = colmap(n0 + m * 4); const bool zcol = c4 < 0;
    const float* sp = src + (size_t)(tr * 4) * ld + (c4 < 0 ? 0 : c4);
    unsigned pk[NPASS][2]; f32x4 m4 = {0.f, 0.f, 0.f, 0.f};
    constexpr int NCK = (NPASS + CH - 1) / CH;
    f32x4 v[2][CH];
#pragma unroll
    for (int j = 0; j < CH; ++j) v[0][j] = *(const f32x4*)(sp + (size_t)((j >> 2) * (4 * RPP) + (j & 3)) * ld);
#pragma unroll
    for (int ck = 0; ck < NCK; ++ck) {
        if (ck + 1 < NCK) {
#pragma unroll
            for (int j = 0; j < CH; ++j) { const int i = (ck + 1) * CH + j; if (i < NPASS) v[(ck + 1) & 1][j] = *(const f32x4*)(sp + (size_t)((i >> 2) * (4 * RPP) + (i & 3)) * ld); }
        }
        __builtin_amdgcn_sched_barrier(0);
#pragma unroll
        for (int j = 0; j < CH; ++j) { const int i = ck * CH + j; if (i < NPASS) { const f32x4 x = zcol ? (f32x4){0.f, 0.f, 0.f, 0.f} : v[ck & 1][j]; m4 = __builtin_elementwise_max(m4, __builtin_elementwise_abs(x)); pk[i][0] = cvt_pk_bf16(x[0], x[1]); pk[i][1] = cvt_pk_bf16(x[2], x[3]); } }
        __builtin_amdgcn_sched_barrier(0);
    }
    float* red = (float*)(lds + NCH * KS);
#pragma unroll
    for (int e = 0; e < 4; ++e) { float a = m4[e];
#pragma unroll
        for (int o = LPR; o < 64; o <<= 1) a = fmaxf(a, shflx(a, o, lane));
        m4[e] = a; }
    if (lane < LPR) *(f32x4*)(red + (wid * LPR + m) * 4) = m4;
    __syncthreads();
    f32x4 mx = *(const f32x4*)(red + m * 4);
#pragma unroll
    for (int w = 1; w < 8; ++w) mx = __builtin_elementwise_max(mx, *(const f32x4*)(red + (w * LPR + m) * 4));
    if (tid < LPR) {
#pragma unroll
        for (int e = 0; e < 4; ++e) wam[map(n0 + m * 4 + e)] = __float_as_uint(mx[e]); }
    float inv[4];
#pragma unroll
    for (int e = 0; e < 4; ++e) inv[e] = 127.f / fmaxf(mx[e], 1e-30f);
    {   char* wb = lds + (size_t)(m * 4) * KS + tr * 4;
#pragma unroll
        for (int g = 0; g < NPASS / 4; ++g) {
#pragma unroll
            for (int e = 0; e < 4; ++e) { unsigned acc = 0u;
#pragma unroll
                for (int q4 = 0; q4 < 4; ++q4) { const unsigned w = pk[4 * g + q4][e >> 1]; const float f = __uint_as_float((e & 1) ? (w & 0xffff0000u) : (w << 16));
                    acc |= (unsigned)((int)rintf(f * inv[e]) & 255) << (8 * q4); }
                *(unsigned*)(wb + e * KS + g * (4 * RPP)) = acc; }
        }
    }
    __syncthreads();
#pragma unroll 1
    for (int j = tid; j < NCH * (K / 16); j += 512) { const int c = j / (K / 16), ch = j % (K / 16);
        *(u32x4*)(dst + (size_t)map(n0 + c) * K + ch * 16) = *(const u32x4*)(lds + (size_t)c * KS + ch * 16); }
    __syncthreads();
}
template <class F> __device__ __forceinline__ void wabsf_unit(const F& f, int n0, int k0, unsigned* wam, float* lds) {
    const int tid = otid(), wid = tid >> 6, lane = tid & 63;
    f32x4 m4 = {0.f, 0.f, 0.f, 0.f};
#pragma unroll 8
    for (int k = 0; k < 64; ++k) { const f32x4 v = f.ld4(k0 + wid * 64 + k, n0 + lane * 4); m4 = __builtin_elementwise_max(m4, __builtin_elementwise_abs(v)); }
    f32x4* red = (f32x4*)lds; red[wid * 64 + lane] = m4;
    __syncthreads();
    if (wid == 0) {
#pragma unroll
        for (int w = 1; w < 8; ++w) m4 = __builtin_elementwise_max(m4, red[w * 64 + lane]);
#pragma unroll
        for (int e = 0; e < 4; ++e) atomicMax(wam + n0 + lane * 4 + e, __float_as_uint(m4[e]));
    }
    __syncthreads();
}
struct MapW13 { int which; __device__ __forceinline__ int operator()(int col) const { return (col >> 7) * 256 + which * 128 + (col & 127); } };
struct MapId { __device__ __forceinline__ int operator()(int col) const { return col; } };
template <class F> __device__ __forceinline__ void tconv8_tile(const F& f, signed char* dst, int K, int k0, int n0, const unsigned* wam, float* tile, int lane) {
    f32x4 v[16];
    const int n4 = (lane & 15) * 4, kr = lane >> 4;
#pragma unroll
    for (int i = 0; i < 16; ++i) v[i] = f.ld4(k0 + kr + 4 * i, n0 + n4);
#pragma unroll
    for (int i = 0; i < 16; ++i) { float* t = tile + (kr + 4 * i) * 65 + n4; t[0] = v[i][0]; t[1] = v[i][1]; t[2] = v[i][2]; t[3] = v[i][3]; }
    __builtin_amdgcn_fence(__ATOMIC_RELEASE, "wavefront"); __builtin_amdgcn_wave_barrier(); __builtin_amdgcn_fence(__ATOMIC_ACQUIRE, "wavefront");
    const int kq = (lane & 3) * 16, nr = lane >> 2;
#pragma unroll
    for (int i = 0; i < 4; ++i) { const int nn = nr + 16 * i; const float inv = 127.f / fmaxf(__uint_as_float(wam[n0 + nn]), 1e-30f);
        unsigned w[4];
#pragma unroll
        for (int g4 = 0; g4 < 4; ++g4) { unsigned acc = 0u;
#pragma unroll
            for (int e = 0; e < 4; ++e) { const int q = (int)rintf(tile[(kq + g4 * 4 + e) * 65 + nn] * inv); acc |= (unsigned)(q & 255) << (8 * e); }
            w[g4] = acc; }
        *(u32x4*)(dst + (size_t)(n0 + nn) * K + k0 + kq) = (u32x4){w[0], w[1], w[2], w[3]}; }
    __builtin_amdgcn_fence(__ATOMIC_RELEASE, "wavefront"); __builtin_amdgcn_wave_barrier(); __builtin_amdgcn_fence(__ATOMIC_ACQUIRE, "wavefront");
}
__device__ __forceinline__ void tr_unit(const Params& p, int v, float* tile, int lane) {
    if (v < 2 * T_WOUT) { const int l = v / T_WOUT, t = v % T_WOUT, nt = t / 32, kt = t % 32;
        FPlain f{p.in[I_WOUT] + (size_t)l * D_ * D_, D_}; tconv_tile(f, p.wb_out() + (size_t)l * D_ * D_, D_, kt * 64, nt * 64, tile, lane); return; }
    v -= 2 * T_WOUT;
    if (v < 2 * T_MLA) { const int l = v / T_MLA, t = v % T_MLA, nt = t / 10, kt = t % 10;
        FMla f{p.in[I_MUQ] + (size_t)l * 448 * 768, p.in[I_MUKV] + (size_t)l * 128 * 1024, p.in[I_MQN] + l * 448, p.in[I_MKVN] + l * 128};
        tconv_tile(f, p.wb_mla() + (size_t)l * MLAN * MLAK, MLAK, kt * 64, nt * 64, tile, lane); return; }
}
__device__ __forceinline__ void pro_stream_unit(const Params& p, int v, float* lds) {
    if (v < U_MOD) { pro_mod_unit(p, v, lds); return; }
    v -= U_MOD;
    if (v < U_SBIG) { const int set = v / U_S2, s = v % U_S2; MapId mp;
        const float* src = set == 0 ? p.in[I_FW2] : p.in[I_MW2] + (size_t)(set - 1) * DFF * D_;
        signed char* dst = set == 0 ? (signed char*)p.wb_f2() : (signed char*)p.wb_m2() + (size_t)(set - 1) * D_ * DFF;
        strip_unit<DFF, 16>(src, D_, s * 16, dst, p.wam() + (set == 0 ? WAM_F2 : WAM_M2 + (set - 1) * D_), mp, (char*)lds); return; }
    v -= U_SBIG;
    if (v < U_SSMALL) { const int set = v / U_S13, w = v % U_S13, which = w / (DFF / 32), s = w % (DFF / 32); MapW13 mp{which};
        const float* src = set == 0 ? p.in[which ? I_FW3 : I_FW1] : p.in[which ? I_MW3 : I_MW1] + (size_t)(set - 1) * D_ * DFF;
        signed char* dst = set == 0 ? (signed char*)p.wb_f13() : (signed char*)p.wb_m13() + (size_t)(set - 1) * 2 * DFF * D_;
        strip_unit<D_, 32>(src, DFF, s * 32, dst, p.wam() + (set == 0 ? WAM_F13 : WAM_M13 + (set - 1) * 2 * DFF), mp, (char*)lds); return; }
    v -= U_SSMALL;
    if (v < U_WABS_IN) { const int l = v / (NP / 32), s = v % (NP / 32); MapId mp; ColWin cw;
        strip_unit<D_, 32>(p.in[I_WIN] + (size_t)l * D_ * DIN, DIN, s * 32, (signed char*)p.wb_in() + (size_t)l * NP * D_, p.wam() + WAM_IN + l * NP, mp, (char*)lds, cw); return; }
    v -= U_WABS_IN;
    { const int tid = otid(), wid = tid >> 6, lane = tid & 63; float* tile = lds + wid * (64 * 68);
      if (v * 8 + wid < U_TR) tr_unit(p, v * 8 + wid, tile, lane);
      __syncthreads(); }
}
__device__ __forceinline__ void phase_prologue(const Params& p, float* lds) {
    static_assert((U_HF - 1) * Q_STRIDE < U_QTOT, "every filter unit needs a queue slot");
    unsigned* qctr = p.cnt() + 24; volatile LAS unsigned* qw = (volatile LAS unsigned*)(LAS unsigned char*)((unsigned char*)lds + XBW_OFF_ - 32);
#pragma unroll 1
    for (;;) {
        __syncthreads();
        if (otid() == 0) qw[0] = atomicAdd(qctr, 1u);
        __syncthreads();
        const int q = (int)qw[0];
        if (q >= U_QTOT) break;
        const int nf = (q + Q_STRIDE - 1) / Q_STRIDE, nfb = nf < U_HF ? nf : U_HF;
        if (q % Q_STRIDE == 0 && q / Q_STRIDE < U_HF) { const int u = q / Q_STRIDE;
            if (u < 512) { const int l = u >> 8, tb = u & 255; pro_hfilt_unit(p, l, SEQ, tb, p.hfilt() + (size_t)l * 1024 * SEQ, p.hsum() + (size_t)l * 1024 * 256, lds); }
            else pro_hfilt_unit(p, 0, LC, u - 512, p.hfc(), p.hsc(), lds); }
        else pro_stream_unit(p, q - nfb, lds);
    }
    __syncthreads();
}
__device__ __forceinline__ void f13q_unit(const Params& p, int v, float* tile, int lane) {
    const int nt = v / 32, kt = v % 32; FW13 f{p.in[I_FW1], p.in[I_FW3]}; tconv8_tile(f, (signed char*)p.wb_f13(), D_, kt * 64, nt * 64, p.wam() + WAM_F13, tile, lane);
}
__device__ __forceinline__ void f2q_unit(const Params& p, int v, float* tile, int lane) {
    const int nt = v / 88, kt = v % 88; FPlain f{p.in[I_FW2], D_}; tconv8_tile(f, (signed char*)p.wb_f2(), DFF, kt * 64, nt * 64, p.wam() + WAM_F2, tile, lane);
}
__device__ __forceinline__ void winq_unit(const Params& p, int v, float* tile, int lane) {
    const int l = v / T_WIN, t = v % T_WIN, nt = t / 32, kt = t % 32; FWin f{p.in[I_WIN] + (size_t)l * D_ * DIN};
    tconv8_tile(f, (signed char*)p.wb_in() + (size_t)l * NP * D_, D_, kt * 64, nt * 64, p.wam() + WAM_IN + l * NP, tile, lane);
}
constexpr int T_M13 = NEXP * T_F13, T_M2 = NEXP * T_F2, U_MOEW = T_M13 + T_M2;
__device__ __forceinline__ void moe_w_unit(const Params& p, int v, float* tile, int lane) {
    if (v < T_M13) { const int e = v / T_F13, t = v % T_F13, nt = t / 32, kt = t % 32;
        FW13 f{p.in[I_MW1] + (size_t)e * D_ * DFF, p.in[I_MW3] + (size_t)e * D_ * DFF};
        tconv8_tile(f, (signed char*)p.wb_m13() + (size_t)e * 2 * DFF * D_, D_, kt * 64, nt * 64, p.wam() + WAM_M13 + e * 2 * DFF, tile, lane); return; }
    v -= T_M13;
    { const int e = v / T_F2, t = v % T_F2, nt = t / 88, kt = t % 88;
      FPlain f{p.in[I_MW2] + (size_t)e * DFF * D_, D_};
      tconv8_tile(f, (signed char*)p.wb_m2() + (size_t)e * D_ * DFF, DFF, kt * 64, nt * 64, p.wam() + WAM_M2 + e * D_, tile, lane); }
}

__device__ __forceinline__ void phase_norm(const Params& p, int layer, int which, int row_lo) {
    const int tid = otid(), wid = tid >> 6, lane = tid & 63;
    const float* nw = p.in[which == 1 ? I_N1W : I_N2W] + (size_t)layer * D_;
    const int csh = (which == 1 ? 0 : 3) * D_, csc = (which == 1 ? 1 : 4) * D_;
    const bool route = (layer == 1 && which == 2);
    for (int r = row_lo + blockIdx.x * 8 + wid; r < MT; r += gridDim.x * 8) {
        const bool isc = r < LC;
        const float* src = (layer == 0 && which == 1) ? (isc ? p.in[I_CTX] + (size_t)r * D_ : p.in[I_X] + (size_t)(r - LC) * D_)
                         : ((layer == 0 && isc) ? p.in[I_CTX] + (size_t)r * D_ : p.xcur() + (size_t)r * D_);
        const float* mv = p.modv() + ((size_t)layer * 2 + (isc ? 1 : 0)) * 6 * D_;
        const bool fixG = isc && layer == 0 && which == 2, fixF = isc && layer == 1 && which == 1;
        f32x4 xv[8]; float ss = 0.f;
#pragma unroll
        for (int i = 0; i < 8; ++i) { const int col = (i * 64 + lane) * 4; xv[i] = *(const f32x4*)(src + col);
            if (fixG || fixF) {
                const float* pp = (fixG ? p.partG() : p.partF()) + (size_t)r * D_ + col; const int ns = fixG ? 4 : 11;
                f32x4 a = {0.f, 0.f, 0.f, 0.f};
                for (int s2 = 0; s2 < ns; ++s2) a += *(const f32x4*)(pp + (size_t)s2 * LC * D_);
                const f32x4 g4 = *(const f32x4*)(p.modv() + ((size_t)(fixG ? 0 : 0) * 2 + 1) * 6 * D_ + (fixG ? 2 : 5) * D_ + col);
                xv[i] += g4 * a;
                if (fixG) *(f32x4*)(p.xcur() + (size_t)r * D_ + col) = xv[i];
            }
            ss += xv[i][0] * xv[i][0] + xv[i][1] * xv[i][1] + xv[i][2] * xv[i][2] + xv[i][3] * xv[i][3]; }
        ss = wave_sum(ss);
        const float rstd = rsqrtf(ss * (1.0f / D_) + EPS);
        float lg[NEXP];
#pragma unroll
        for (int e = 0; e < NEXP; ++e) lg[e] = 0.f;
        float qinv = 0.f;
        {   float am = 0.f;
#pragma unroll
            for (int i = 0; i < 8; ++i) { const int col = (i * 64 + lane) * 4;
                const f32x4 w4 = *(const f32x4*)(nw + col), sh = *(const f32x4*)(mv + csh + col), sc = *(const f32x4*)(mv + csc + col);
                xv[i] = (xv[i] * rstd) * w4 * (sc + 1.0f) + sh;
                am = fmaxf(am, fmaxf(fmaxf(fabsf(xv[i][0]), fabsf(xv[i][1])), fmaxf(fabsf(xv[i][2]), fabsf(xv[i][3])))); }
#pragma unroll
            for (int o = 32; o >= 1; o >>= 1) am = fmaxf(am, shflx(am, o, lane));
            am = fmaxf(am, 1e-20f); qinv = 127.f / am;
            if (lane == 0) p.hs()[r] = am * (1.0f / 127.f);
        }
#pragma unroll
        for (int i = 0; i < 8; ++i) { const int col = (i * 64 + lane) * 4;
            const f32x4 hv = xv[i];
            {
                const int q0 = (int)rintf(hv[0] * qinv), q1 = (int)rintf(hv[1] * qinv), q2 = (int)rintf(hv[2] * qinv), q3 = (int)rintf(hv[3] * qinv);
                *(unsigned*)((char*)p.hbuf() + (size_t)r * D_ + col) = (unsigned)(q0 & 255) | ((unsigned)(q1 & 255) << 8) | ((unsigned)(q2 & 255) << 16) | ((unsigned)(q3 & 255) << 24);
            }
            if (route) { const float* rt = p.in[I_ROUTER] + (size_t)col * NEXP;
#pragma unroll
                for (int j = 0; j < 4; ++j) { const f32x4 r0 = *(const f32x4*)(rt + j * NEXP), r1 = *(const f32x4*)(rt + j * NEXP + 4);
                    lg[0] += hv[j] * r0[0]; lg[1] += hv[j] * r0[1]; lg[2] += hv[j] * r0[2]; lg[3] += hv[j] * r0[3];
                    lg[4] += hv[j] * r1[0]; lg[5] += hv[j] * r1[1]; lg[6] += hv[j] * r1[2]; lg[7] += hv[j] * r1[3]; } }
        }
        if (route && !isc) {
#pragma unroll
            for (int e = 0; e < NEXP; ++e) lg[e] = wave_sum(lg[e]);
            if (lane == 0) {
                int e0 = 0; float v0 = lg[0];
#pragma unroll
                for (int e = 1; e < NEXP; ++e) if (lg[e] > v0) { v0 = lg[e]; e0 = e; }
                int e1 = -1; float v1 = -3.0e38f;
#pragma unroll
                for (int e = 0; e < NEXP; ++e) if (e != e0 && lg[e] > v1) { v1 = lg[e]; e1 = e; }
                const float w0 = 1.f / (1.f + expf(v1 - v0)), w1 = 1.f - w0;
                const int t = r - LC;
                const int p0 = (int)atomicAdd(&p.cnt()[e0], 1u), p1 = (int)atomicAdd(&p.cnt()[e1], 1u);
                p.tok_e()[t * 2] = e0; p.tok_e()[t * 2 + 1] = e1; p.tok_p()[t * 2] = p0; p.tok_p()[t * 2 + 1] = p1; p.tok_w()[t * 2] = w0; p.tok_w()[t * 2 + 1] = w1;
            }
        }
    }
}

__device__ __forceinline__ void phase_prep(const Params& p, int layer) {
    const int tid = otid(), wid = tid >> 6, lane = tid & 63;
    const float* gcw = p.in[I_GCONV] + (size_t)layer * 3 * 1536;
    const float LN1E4 = 9.210340371976184f;
    for (int r = blockIdx.x * 8 + wid; r < MT; r += gridDim.x * 8) {
        const bool isc = r < LC; const int t = r - LC;
        const bool hasp = isc ? (r > 0) : (r > LC), hasn = isc ? (r < LC - 1) : (r < MT - 1);
        const bf16_t* P0 = p.Pp() + (size_t)r * NP;
        const bf16_t* Pm = hasp ? P0 - NP : P0; const bf16_t* Pn = hasn ? P0 + NP : P0;
        u32x4 gx[3][3];
#pragma unroll
        for (int i = 0; i < 3; ++i) { const int ch = i * 512 + lane * 8; gx[i][0] = *(const u32x4*)(Pm + PC_GQKV + ch); gx[i][1] = *(const u32x4*)(P0 + PC_GQKV + ch); gx[i][2] = *(const u32x4*)(Pn + PC_GQKV + ch); }
        const bf16_t gab = P0[PC_A + (lane & 7)], gbb = P0[PC_B + (lane & 7)];
        const u32x4 cqr = *(const u32x4*)(P0 + PC_CQ + (lane < 56 ? lane : 55) * 8), ckr = *(const u32x4*)(P0 + PC_CKV + (lane & 15) * 8);
        const bf16_t kr1 = P0[PC_KR + ((lane >> 4) & 1) * 32 + (lane & 15)], kr2 = P0[PC_KR + ((lane >> 4) & 1) * 32 + (lane & 15) + 16];
        bf16_t rq[8][2];
#pragma unroll
        for (int it = 0; it < 8; ++it) { const int o = (it >> 2) * 512 + (it & 3) * 128 + lane; rq[it][0] = P0[PC_RQKV + o]; rq[it][1] = P0[PC_RQKV + o + 64]; }
#pragma unroll
        for (int i = 0; i < 3; ++i) {
            const int ch = i * 512 + lane * 8;
            float x0[8], xm[8], xn[8], y[8];
            unpack8(gx[i][1], x0); unpack8(gx[i][0], xm); unpack8(gx[i][2], xn);
            const float fm = hasp ? 1.f : 0.f, fn = hasn ? 1.f : 0.f;
            float ss = 0.f;
#pragma unroll
            for (int e = 0; e < 8; ++e) { const float v = gcw[ch + e] * (xm[e] * fm) + gcw[1536 + ch + e] * x0[e] + gcw[3072 + ch + e] * (xn[e] * fn); y[e] = silu_f(v); ss += y[e] * y[e]; }
            if (i < 2) { ss = sum16(ss); const float rn = rsqrtf(ss + EPS) * (i == 0 ? 0.08838834764831845f : 1.f);
#pragma unroll
                for (int e = 0; e < 8; ++e) y[e] *= rn; }
            *(u32x4*)(p.gqkv() + (size_t)r * 1536 + ch) = pack8(y);
        }
        if (lane < 8) {
            const float a = bf2f(gab), b = bf2f(gbb);
            const float g = -expf(p.in[I_GALOG][layer * 8 + lane]) * softplus_f(a + p.in[I_GDT][layer * 8 + lane]);
            p.ggb()[(size_t)r * 16 + lane] = g; p.ggb()[(size_t)r * 16 + 8 + lane] = sigmoid_f(b);
        }
        {   float sq = 0.f, sk = 0.f;
            if (lane < 56) { float f[8]; unpack8(cqr, f);
#pragma unroll
                for (int e = 0; e < 8; ++e) sq += f[e] * f[e]; }
            if (lane < 16) { float f[8]; unpack8(ckr, f);
#pragma unroll
                for (int e = 0; e < 8; ++e) sk += f[e] * f[e]; }
            sq = wave_sum(sq); sk = wave_sum(sk);
            if (lane == 0) { p.mrs()[(size_t)r * 2] = rsqrtf(sq * (1.0f / 448.f) + EPS); p.mrs()[(size_t)r * 2 + 1] = rsqrtf(sk * (1.0f / 128.f) + EPS); }
        }
        if (lane < 32) {
            const int i = lane & 15, half = lane >> 4;
            const float x1 = bf2f(kr1), x2 = bf2f(kr2);
            float o1 = x1, o2 = x2;
            if (!isc) { const float pos = (float)(half ? (t & 63) : (t >> 6)); const float inv = expf(-(float)i * (LN1E4 / 16.f)); float s, c; sincosf(pos * inv, &s, &c);
                o1 = x1 * c - x2 * s; o2 = x2 * c + x1 * s; }
            p.krr()[(size_t)r * 64 + half * 32 + i] = f2bf(o1); p.krr()[(size_t)r * 64 + half * 32 + i + 16] = f2bf(o2);
        }
        {   float s = 0.f, c = 1.f;
            if (!isc) { const float inv = expf(-(float)lane * (LN1E4 / 64.f)); sincosf((float)t * inv, &s, &c); }
#pragma unroll
            for (int it = 0; it < 8; ++it) { const int which = it >> 2, hd = it & 3; const int o = which * 512 + hd * 128 + lane;
                const float x1 = bf2f(rq[it][0]), x2 = bf2f(rq[it][1]); const float sc = which ? 0.08838834764831845f : 1.f;
                p.rqk()[(size_t)r * 1024 + o] = f2bf((x1 * c - x2 * s) * sc); p.rqk()[(size_t)r * 1024 + o + 64] = f2bf((x2 * c + x1 * s) * sc); }
        }
    }
}
namespace att {
constexpr int NW = 8, QBLK = 32, KVBLK = 64, DK = 192, DV = 128;
constexpr float SCALE = 0.07216878364870322f;
constexpr float THR = 8.f;
constexpr int LDQ = MLAN, LDKN = MLAN, LDKR = 64, LDV = MLAN, LDO = D_;
constexpr int SHM_V = KVBLK * DV * 2, SHM_K = KVBLK * DK * 2, SHM_ATTN = 2 * SHM_V + 2 * SHM_K + NW * 64 * 4;
#define KSWZ(row, colB) ((row) * 384 + ((colB) ^ ((((row) >> 1) & 7) << 4)))
#define SBAR() __builtin_amdgcn_sched_barrier(0)
__device__ __forceinline__ int crow(int r, int hi) { return (r & 3) + 8 * (r >> 2) + 4 * hi; }
__device__ __forceinline__ void partialSM(f32x16& p0, f32x16& p1, float& m_reg, float& mn, float& alpha) {
    constexpr float C = SCALE * 1.4426950408889634f;
    float pmax = p0[0];
#pragma unroll
    for (int r = 1; r < 16; ++r) pmax = fmaxf(pmax, p0[r]);
#pragma unroll
    for (int r = 0; r < 16; ++r) pmax = fmaxf(pmax, p1[r]);
    { auto rr = __builtin_amdgcn_permlane32_swap(__float_as_uint(pmax), __float_as_uint(pmax), false, false);
      pmax = fmaxf(__uint_as_float(rr[0]), __uint_as_float(rr[1])); }
    if (__builtin_expect(__all(pmax - m_reg <= THR / SCALE), 1)) { mn = m_reg; alpha = 1.f; }
    else { mn = fmaxf(m_reg, pmax); alpha = __builtin_amdgcn_exp2f((m_reg - mn) * C); m_reg = mn; }
    const float mnC = -mn * C;
#pragma unroll
    for (int r = 0; r < 16; ++r) p0[r] = fmaf(p0[r], C, mnC);
#pragma unroll
    for (int r = 0; r < 16; ++r) p1[r] = fmaf(p1[r], C, mnC);
#pragma unroll
    for (int r = 0; r < 16; ++r) p0[r] = __builtin_amdgcn_exp2f(p0[r]);
}
__device__ __forceinline__ void finishSM(f32x16& p0, f32x16& p1, float alpha, float& l_reg, bf16x8& pa0, bf16x8& pa1, bf16x8& pa2, bf16x8& pa3) {
#pragma unroll
    for (int r = 0; r < 16; ++r) p1[r] = __builtin_amdgcn_exp2f(p1[r]);
    float ps = 0;
#pragma unroll
    for (int r = 0; r < 16; ++r) ps += p0[r];
#pragma unroll
    for (int r = 0; r < 16; ++r) ps += p1[r];
    { auto rr = __builtin_amdgcn_permlane32_swap(__float_as_uint(ps), __float_as_uint(ps), false, false);
      ps = __uint_as_float(rr[0]) + __uint_as_float(rr[1]); }
    l_reg = l_reg * alpha + ps;
#define PK4(P, BASE, OUT) do { unsigned a0 = cvt_pk_bf16(P[BASE + 0], P[BASE + 1]), a1 = cvt_pk_bf16(P[BASE + 2], P[BASE + 3]);   \
    unsigned b0 = cvt_pk_bf16(P[BASE + 4], P[BASE + 5]), b1 = cvt_pk_bf16(P[BASE + 6], P[BASE + 7]);                              \
    auto r0 = __builtin_amdgcn_permlane32_swap(a0, b0, false, false); auto r1 = __builtin_amdgcn_permlane32_swap(a1, b1, false, false); \
    u32x4 w = {r0[0], r1[0], r0[1], r1[1]}; OUT = *reinterpret_cast<bf16x8*>(&w); } while (0)
    PK4(p0, 0, pa0); PK4(p0, 8, pa1); PK4(p1, 0, pa2); PK4(p1, 8, pa3);
#undef PK4
}
__device__ __forceinline__ void qkt(f32x16& p0, f32x16& p1, const int (&ka)[4], int boff, const bf16x8* qr) {
    p0 = f32x16{}; p1 = f32x16{};
    bf16x8 kb[3][2];
#define QK_LD(D0) do { const int dl_ = (D0) & 3, dh_ = (D0) >> 2; kb[(D0) % 3][0] = *(const LAS bf16x8*)(unsigned)(ka[dl_] + (boff + dh_ * 128)); \
        kb[(D0) % 3][1] = *(const LAS bf16x8*)(unsigned)(ka[dl_] + (boff + dh_ * 128 + 32 * 384)); } while (0)
    QK_LD(0); QK_LD(1);
#pragma unroll
    for (int d0 = 0; d0 < 12; ++d0) {
        if (d0 + 2 < 12) QK_LD(d0 + 2);
        p0 = __builtin_amdgcn_mfma_f32_32x32x16_bf16(kb[d0 % 3][0], qr[d0], p0, 0, 0, 0);
        p1 = __builtin_amdgcn_mfma_f32_32x32x16_bf16(kb[d0 % 3][1], qr[d0], p1, 0, 0, 0);
    }
#undef QK_LD
}
__device__ __forceinline__ int v_st(int k, int c) { const int kk = (k & ~0xC) | ((k & 4) << 1) | ((k & 8) >> 1); return ((kk >> 3) * 4 + (c >> 5)) * 512 + ((kk & 7) * 32 + (c & 31)) * 2; }
__device__ __forceinline__ int v_rd_base(int lane) { return ((lane & 3) << 3) | (((lane >> 2) & 3) << 6) | (((lane >> 4) & 1) << 5) | (((lane >> 5) & 1) << 8); }
constexpr int v_rd_off(int d0, int ks, int half) { return d0 * 512 + ks * 4096 + half * 2048; }
template <int OFF> __device__ __forceinline__ s16x4 tr_read(int vb) {
    s16x4 r; asm volatile("ds_read_b64_tr_b16 %0, %1 offset:%2" : "=&v"(r) : "v"(vb), "i"(OFF) : "memory"); return r;
}
template <int D0> __device__ __forceinline__ void pv_one(f32x16& od, int vb, bf16x8 pa0, bf16x8 pa1, bf16x8 pa2, bf16x8 pa3) {
    const s16x4 l0 = tr_read<v_rd_off(D0, 0, 0)>(vb), h0 = tr_read<v_rd_off(D0, 0, 1)>(vb), l1 = tr_read<v_rd_off(D0, 1, 0)>(vb), h1 = tr_read<v_rd_off(D0, 1, 1)>(vb);
    const s16x4 l2 = tr_read<v_rd_off(D0, 2, 0)>(vb), h2 = tr_read<v_rd_off(D0, 2, 1)>(vb), l3 = tr_read<v_rd_off(D0, 3, 0)>(vb), h3 = tr_read<v_rd_off(D0, 3, 1)>(vb);
    asm volatile("s_waitcnt lgkmcnt(0)" ::: "memory"); SBAR();
#define PK(L, H) (bf16x8){L[0], L[1], L[2], L[3], H[0], H[1], H[2], H[3]}
    od = __builtin_amdgcn_mfma_f32_32x32x16_bf16(pa0, PK(l0, h0), od, 0, 0, 0);
    od = __builtin_amdgcn_mfma_f32_32x32x16_bf16(pa1, PK(l1, h1), od, 0, 0, 0);
    od = __builtin_amdgcn_mfma_f32_32x32x16_bf16(pa2, PK(l2, h2), od, 0, 0, 0);
    od = __builtin_amdgcn_mfma_f32_32x32x16_bf16(pa3, PK(l3, h3), od, 0, 0, 0);
#undef PK
}
__device__ __forceinline__ void pv_d0(f32x16* o, int vb, bf16x8 pa0, bf16x8 pa1, bf16x8 pa2, bf16x8 pa3) {
    pv_one<0>(o[0], vb, pa0, pa1, pa2, pa3); pv_one<1>(o[1], vb, pa0, pa1, pa2, pa3); pv_one<2>(o[2], vb, pa0, pa1, pa2, pa3); pv_one<3>(o[3], vb, pa0, pa1, pa2, pa3);
}
__device__ __forceinline__ void attn_body(const bf16_t* __restrict__ Qb, const bf16_t* __restrict__ Kn, const bf16_t* __restrict__ Kr, const bf16_t* __restrict__ Vh,
                                          bf16_t* __restrict__ Ob, int seq, int rope_t0, char* lds, float* __restrict__ Opart, float* __restrict__ MLpart) {
    const int tid = otid(), wid = tid >> 6, lane = tid & 63, r32 = lane & 31, hi = lane >> 5;
    char* V_lds = lds; char* K_lds = lds + 2 * SHM_V;
    float* ws = (float*)(lds + 2 * SHM_V + 2 * SHM_K) + wid * 64; float* li_l = ws; float* al_l = ws + 32;
    float m_reg = -1e30f, l_reg = 0; f32x16 o[4] = {}; bf16x8 qr[12];
    const bf16_t* Qw = Qb + (long)(wid * QBLK + r32) * LDQ + hi * 8;
#pragma unroll
    for (int d0 = 0; d0 < 8; ++d0) qr[d0] = *reinterpret_cast<const bf16x8*>(Qw + d0 * 16);
    {
        bf16_t* Qr = (bf16_t*)(lds + SHM_ATTN);
        bf16_t qa[16][2];
#pragma unroll
        for (int it = 0; it < 16; ++it) { const int item = tid + it * 512, row = item >> 5, pr = item & 31; const bf16_t* qp = Qb + (long)row * LDQ + 128 + (pr >> 4) * 32 + (pr & 15); qa[it][0] = qp[0]; qa[it][1] = qp[16]; }
#pragma unroll
        for (int it = 0; it < 16; ++it) { const int item = tid + it * 512, row = item >> 5, pr = item & 31, half = pr >> 4, i = pr & 15;
            const float x1 = bf2f(qa[it][0]), x2 = bf2f(qa[it][1]); float o1 = x1, o2 = x2;
            if (rope_t0 >= 0) { const int t = rope_t0 + row; const float pos = (float)(half ? (t & 63) : (t >> 6));
                const float inv = expf(-(float)i * (9.210340371976184f / 16.f)); float s, c; sincosf(pos * inv, &s, &c);
                o1 = x1 * c - x2 * s; o2 = x2 * c + x1 * s; }
            Qr[row * 64 + half * 32 + i] = f2bf(o1); Qr[row * 64 + half * 32 + i + 16] = f2bf(o2); }
        __syncthreads();
#pragma unroll
        for (int dd = 0; dd < 4; ++dd) qr[8 + dd] = *reinterpret_cast<const bf16x8*>(Qr + (wid * QBLK + r32) * 64 + dd * 16 + hi * 8);
    }
    const int sr = tid >> 4, sc = (tid & 15) * 8, vst0 = v_st(sr, sc), vst1 = v_st(32 + sr, sc);
    const int rr = tid >> 3, rc = (tid & 7) * 8;
    const int vb0 = (int)(uintptr_t)V_lds + v_rd_base(lane);
    int ka[4];
#pragma unroll
    for (int dl = 0; dl < 4; ++dl) ka[dl] = (int)(uintptr_t)K_lds + r32 * 384 + ((dl * 32 + hi * 16) ^ (((r32 >> 1) & 7) << 4));
    struct { bf16x8 vs0, vs1, ks0, ks1, kr; } sr_[1];
    const unsigned ovA = (unsigned)(sr * LDV + sc) * 2u, ovB = (unsigned)((32 + sr) * LDV + sc) * 2u, orr = (unsigned)(rr * LDKR + rc) * 2u;
#define SLOAD(i, k0) do { const char* vbp = (const char*)Vh + (size_t)(k0) * (LDV * 2); const char* kbp = (const char*)Kn + (size_t)(k0) * (LDKN * 2); const char* rbp = (const char*)Kr + (size_t)(k0) * (LDKR * 2); \
    sr_[i].vs0 = *(const bf16x8*)(vbp + ovA); sr_[i].vs1 = *(const bf16x8*)(vbp + ovB); \
    sr_[i].ks0 = *(const bf16x8*)(kbp + ovA); sr_[i].ks1 = *(const bf16x8*)(kbp + ovB); \
    sr_[i].kr = *(const bf16x8*)(rbp + orr); } while (0)
#define SWRITE(b, i) do { *(bf16x8*)(V_lds + (b) * SHM_V + vst0) = sr_[i].vs0; *(bf16x8*)(V_lds + (b) * SHM_V + vst1) = sr_[i].vs1; const int kc = sc * 2; \
    *(bf16x8*)(K_lds + (b) * SHM_K + KSWZ(sr, kc)) = sr_[i].ks0; *(bf16x8*)(K_lds + (b) * SHM_K + KSWZ(32 + sr, kc)) = sr_[i].ks1; \
    *(bf16x8*)(K_lds + (b) * SHM_K + KSWZ(rr, 256 + rc * 2)) = sr_[i].kr; } while (0)
#define SWAIT() asm volatile("s_waitcnt vmcnt(0)" ::: "memory")
#define RESC(a) do { if (__any((a) < 1.f)) { if (hi == 0) al_l[r32] = (a); asm volatile("s_waitcnt lgkmcnt(0)" ::: "memory"); \
    _Pragma("unroll") for (int d = 0; d < 4; ++d) _Pragma("unroll") for (int r = 0; r < 16; ++r) o[d][r] *= al_l[crow(r, hi)]; } } while (0)
    f32x16 pA0, pA1, pB0, pB1; float mnA, mnB, alA, alB; bf16x8 pa0, pa1, pa2, pa3; const int NT = seq / KVBLK;
    constexpr int SE = 0, SO = 0;
    SLOAD(SE, 0); asm volatile("s_waitcnt vmcnt(0)" ::: "memory"); SWRITE(0, SE); __syncthreads();
    qkt(pA0, pA1, ka, 0, qr); partialSM(pA0, pA1, m_reg, mnA, alA);
    SLOAD(SO, KVBLK);
    SWAIT(); SWRITE(1, SO); __syncthreads();
    for (int j = 1; j + 1 < NT; j += 2) {
        SBAR(); qkt(pB0, pB1, ka, SHM_K, qr);
        finishSM(pA0, pA1, alA, l_reg, pa0, pa1, pa2, pa3); SBAR();
        SLOAD(SO, (j + 1) * KVBLK); SBAR();
        pv_d0(o, vb0, pa0, pa1, pa2, pa3); partialSM(pB0, pB1, m_reg, mnB, alB);
        __syncthreads(); SWAIT(); SWRITE(0, SE);
        RESC(alB); __syncthreads();
        SBAR(); qkt(pA0, pA1, ka, 0, qr);
        finishSM(pB0, pB1, alB, l_reg, pa0, pa1, pa2, pa3); SBAR();
        SLOAD(SE, (j + 2) * KVBLK); SBAR();
        pv_d0(o, vb0 + SHM_V, pa0, pa1, pa2, pa3); partialSM(pA0, pA1, m_reg, mnA, alA);
        __syncthreads(); SWAIT(); SWRITE(1, SO);
        RESC(alA); __syncthreads();
    }
    SBAR(); qkt(pB0, pB1, ka, SHM_K, qr);
    finishSM(pA0, pA1, alA, l_reg, pa0, pa1, pa2, pa3); SBAR();
    pv_d0(o, vb0, pa0, pa1, pa2, pa3); partialSM(pB0, pB1, m_reg, mnB, alB);
    __syncthreads(); RESC(alB);
    finishSM(pB0, pB1, alB, l_reg, pa0, pa1, pa2, pa3); SBAR();
    pv_d0(o, vb0 + SHM_V, pa0, pa1, pa2, pa3);
    if (Opart != nullptr) {
        if (hi == 0) { MLpart[(wid * QBLK + r32) * 2] = m_reg; MLpart[(wid * QBLK + r32) * 2 + 1] = l_reg; }
#pragma unroll
        for (int r = 0; r < 16; ++r) { const int orow = wid * QBLK + crow(r, hi);
#pragma unroll
            for (int d0 = 0; d0 < 4; ++d0) Opart[orow * 128 + d0 * 32 + r32] = o[d0][r]; }
        __syncthreads();
        return;
    }
    if (hi == 0) li_l[r32] = l_reg; asm volatile("s_waitcnt lgkmcnt(0)" ::: "memory");
    float rli[16];
#pragma unroll
    for (int r = 0; r < 16; ++r) rli[r] = __builtin_amdgcn_rcpf(li_l[crow(r, hi)]);
    bf16_t* Ow = Ob + (long)(wid * QBLK) * LDO;
#pragma unroll
    for (int r = 0; r < 16; ++r) { const int orow = crow(r, hi);
#pragma unroll
        for (int d0 = 0; d0 < 4; ++d0) Ow[(long)orow * LDO + d0 * 32 + r32] = f2bf(o[d0][r] * rli[r]); }
    __syncthreads();
#undef SLOAD
#undef SWRITE
#undef SWAIT
#undef RESC
}
}

constexpr int ATT_SPLIT_K0[4] = {0, 4096, 8192, 12416};
constexpr size_t ATT_PART_FLOATS = 256 * 128 + 512;
__device__ __forceinline__ void attn_unit(const Params& p, int u, int sp, char* lds) {
    const bool lat = u < 256;
    const int xcd = u & 7, h = lat ? (xcd >> 1) : (u - 256), qb = (u >> 3) * 2 + (xcd & 1);
    const int row0 = lat ? LC + qb * 256 : 0;
    const int k0 = sp < 0 ? 0 : (sp == 0 ? 0 : (sp == 1 ? 4096 : (sp == 2 ? 8192 : 12416)));
    const int nk = sp < 0 ? (lat ? MT : LC) : (sp < 2 ? 4096 : 4224);
    float* part = sp < 0 ? nullptr : p.attp() + (size_t)(u * 4 + sp) * ATT_PART_FLOATS;
    att::attn_body(p.qkvup() + (size_t)row0 * MLAN + h * 192, p.qkvup() + (size_t)k0 * MLAN + 768 + h * 256, p.krr() + (size_t)k0 * 64, p.qkvup() + (size_t)k0 * MLAN + 768 + h * 256 + 128,
                   p.ocat() + (size_t)row0 * D_ + 512 + h * 128, nk, lat ? qb * 256 : -1, lds, part, part ? part + 256 * 128 : nullptr);
}
__device__ __forceinline__ void phase_attn(const Params& p, int layer, char* lds) {
    const int nunits = 256 + (layer == 0 ? 4 : 0);
#pragma unroll 1
    for (int u = blockIdx.x; u < nunits; u += gridDim.x) attn_unit(p, u, -1, lds);
}

__device__ __forceinline__ void phase_rec_naive(const Params& p, int layer, float* lds) {
    const int tid = otid();
    float* kq = lds;
    float* vv = lds + 32 * 256;
    float* ab = vv + 32 * 128;
    for (int u = blockIdx.x; u < 16; u += gridDim.x) {
        const int kind = u >> 3, dir = (u >> 2) & 1, h = u & 3;
        float S[128];
#pragma unroll
        for (int i = 0; i < 128; ++i) S[i] = 0.f;
        const float gam = 1.0f - exp2f(-(float)((dir ? 6 : 5) + 2 * h));
        float* outp = (kind == 0 ? p.go() : p.ro()) + (size_t)dir * MT * 512 + h * 128;
        for (int s0 = 0; s0 < MT; s0 += 32) {
            __syncthreads();
            {   const int tk = tid >> 4, seg = (tid & 15) * 16; const int s = s0 + tk;
                const int row = dir == 0 ? s : (s < LC ? LC - 1 - s : MT + LC - 1 - s);
                const bf16_t* src;
                if (kind == 0) src = p.gqkv() + (size_t)row * 1536 + (seg < 128 ? 512 + h * 128 + seg : h * 128 + (seg - 128));
                else           src = p.rqk() + (size_t)row * 1024 + (seg < 128 ? 512 + h * 128 + seg : h * 128 + (seg - 128));
                float f[8]; unpack8(*(const u32x4*)src, f);
#pragma unroll
                for (int e = 0; e < 8; ++e) kq[tk * 256 + seg + e] = f[e];
                unpack8(*(const u32x4*)(src + 8), f);
#pragma unroll
                for (int e = 0; e < 8; ++e) kq[tk * 256 + seg + 8 + e] = f[e];
                const int vseg = (tid & 15) * 8;
                const bf16_t* vsrc = kind == 0 ? p.gqkv() + (size_t)row * 1536 + 1024 + h * 128 + vseg : p.Pp() + (size_t)row * NP + PC_RQKV + 1024 + h * 128 + vseg;
                unpack8(*(const u32x4*)vsrc, f);
#pragma unroll
                for (int e = 0; e < 8; ++e) vv[tk * 128 + vseg + e] = f[e];
                if (tid < 32) { const int s2 = s0 + tid; const int row2 = dir == 0 ? s2 : (s2 < LC ? LC - 1 - s2 : MT + LC - 1 - s2);
                    if (kind == 0) { ab[tid * 2] = expf(p.ggb()[(size_t)row2 * 16 + dir * 4 + h]); ab[tid * 2 + 1] = p.ggb()[(size_t)row2 * 16 + 8 + dir * 4 + h]; }
                    else { ab[tid * 2] = gam; ab[tid * 2 + 1] = 1.f; } }
            }
            __syncthreads();
            if (tid < 128) {
                for (int tk = 0; tk < 32; ++tk) {
                    const f32x4* kp = (const f32x4*)(kq + tk * 256); const f32x4* qp = kp + 32;
                    const float a = ab[tk * 2], b = ab[tk * 2 + 1], v = vv[tk * 128 + tid];
                    float dv;
                    if (kind == 0) { float ks = 0.f;
#pragma unroll
                        for (int i = 0; i < 32; ++i) { const f32x4 k4 = kp[i]; ks += k4[0] * S[4 * i] + k4[1] * S[4 * i + 1] + k4[2] * S[4 * i + 2] + k4[3] * S[4 * i + 3]; }
                        dv = b * (v - a * ks); }
                    else dv = v;
                    float o = 0.f;
#pragma unroll
                    for (int i = 0; i < 32; ++i) { const f32x4 k4 = kp[i], q4 = qp[i];
                        S[4 * i] = a * S[4 * i] + k4[0] * dv; S[4 * i + 1] = a * S[4 * i + 1] + k4[1] * dv; S[4 * i + 2] = a * S[4 * i + 2] + k4[2] * dv; S[4 * i + 3] = a * S[4 * i + 3] + k4[3] * dv;
                        o += q4[0] * S[4 * i] + q4[1] * S[4 * i + 1] + q4[2] * S[4 * i + 2] + q4[3] * S[4 * i + 3]; }
                    const int s = s0 + tk; const int row = dir == 0 ? s : (s < LC ? LC - 1 - s : MT + LC - 1 - s);
                    outp[(size_t)row * 512 + tid] = o;
                }
            }
        }
        __syncthreads();
    }
}

__device__ __forceinline__ void phase_mixout(const Params& p, int layer) {
    const int tid = otid(), wid = tid >> 6, lane = tid & 63;
    const float* gnw = p.in[I_GNW] + layer * 128;
    for (int r = blockIdx.x * 8 + wid; r < MT; r += gridDim.x * 8) {
        const int idx = lane * 8;
        f32x4 ga[2][4]; u32x4 zr[2]; float gw8[8];
        { const f32x4 g0 = *(const f32x4*)(gnw + (idx & 127)), g1 = *(const f32x4*)(gnw + (idx & 127) + 4); gw8[0] = g0[0]; gw8[1] = g0[1]; gw8[2] = g0[2]; gw8[3] = g0[3]; gw8[4] = g1[0]; gw8[5] = g1[1]; gw8[6] = g1[2]; gw8[7] = g1[3]; }
#pragma unroll
        for (int kind = 0; kind < 2; ++kind) {
            const float* o0 = (kind == 0 ? p.go() : p.ro()) + (size_t)r * 512 + idx; const float* o1 = o0 + (size_t)MT * 512;
            ga[kind][0] = *(const f32x4*)o0; ga[kind][1] = *(const f32x4*)(o0 + 4); ga[kind][2] = *(const f32x4*)o1; ga[kind][3] = *(const f32x4*)(o1 + 4);
            zr[kind] = *(const u32x4*)(p.Pp() + (size_t)r * NP + (kind == 0 ? PC_GZ : PC_RG) + idx); }
        if (r >= LC && r < LC + 1024) {
            const int qb = (r - LC) >> 8, rl = (r - LC) & 255, hh = lane >> 4, col = (lane & 15) * 8;
            const int uu = (qb >> 1) * 8 + 2 * hh + (qb & 1);
            const float* pb = p.attp() + (size_t)(uu * 4) * ATT_PART_FLOATS;
            float mm[4], ll[4], M = -3.0e38f;
#pragma unroll
            for (int s4 = 0; s4 < 4; ++s4) { mm[s4] = pb[s4 * ATT_PART_FLOATS + 256 * 128 + rl * 2]; ll[s4] = pb[s4 * ATT_PART_FLOATS + 256 * 128 + rl * 2 + 1]; M = fmaxf(M, mm[s4]); }
            float acc[8] = {0.f, 0.f, 0.f, 0.f, 0.f, 0.f, 0.f, 0.f}, L = 0.f;
#pragma unroll
            for (int s4 = 0; s4 < 4; ++s4) { const float w = __builtin_amdgcn_exp2f((mm[s4] - M) * (att::SCALE * 1.4426950408889634f)); L += w * ll[s4];
                const f32x4 o0 = *(const f32x4*)(pb + s4 * ATT_PART_FLOATS + rl * 128 + col), o1 = *(const f32x4*)(pb + s4 * ATT_PART_FLOATS + rl * 128 + col + 4);
#pragma unroll
                for (int e = 0; e < 4; ++e) { acc[e] += w * o0[e]; acc[4 + e] += w * o1[e]; } }
            const float il = 1.0f / L;
#pragma unroll
            for (int e = 0; e < 8; ++e) acc[e] *= il;
            *(u32x4*)(p.ocat() + (size_t)r * D_ + 512 + hh * 128 + col) = pack8(acc);
        }
#pragma unroll
        for (int kind = 0; kind < 2; ++kind) {
            float o[8]; float ss = 0.f;
#pragma unroll
            for (int e = 0; e < 4; ++e) { o[e] = ga[kind][0][e] + ga[kind][2][e]; o[4 + e] = ga[kind][1][e] + ga[kind][3][e]; }
#pragma unroll
            for (int e = 0; e < 8; ++e) ss += o[e] * o[e];
            ss = sum16(ss);
            const float rn = rsqrtf(ss * (1.0f / 128.f) + EPS);
            float z[8]; unpack8(zr[kind], z);
            float y[8];
#pragma unroll
            for (int e = 0; e < 8; ++e) { const float w = kind == 0 ? gw8[e] : 1.f; y[e] = o[e] * rn * w * silu_f(z[e]); }
            *(u32x4*)(p.ocat() + (size_t)r * D_ + (kind == 0 ? 0 : 1536) + idx) = pack8(y);
        }
    }
}
constexpr int NCHUNK = MT / 64;
constexpr size_t REC_Q = 0, REC_KT = 16384, REC_A = 32768, REC_W = 40960, REC_U = 57344, REC_DL = 73728, REC_BYTES = 73984;
__device__ __forceinline__ int scan_row(int dir, int s) { return dir == 0 ? s : (s < LC ? LC - 1 - s : MT + LC - 1 - s); }
__device__ __forceinline__ int crow32(int r, int hi) { return (r & 3) + 8 * (r >> 2) + 4 * hi; }

constexpr int CP_LDS = 70656;
__device__ __forceinline__ void chunkprep_pair(const Params& p, int layer, int u0, char* lds0) {
    const int tid = otid(), half = tid >> 8, t = tid & 255, hw = (tid >> 6) & 3, lane = tid & 63, r32 = lane & 31, hi = lane >> 5;
    const int u = u0 + half; const bool valid = u < 16 * NCHUNK;
    const int c = valid ? (u & 15) : 0, n = valid ? (u >> 4) : 0;
    const int kind = c >> 3, dir = (c >> 2) & 1, h = c & 3;
    char* lds = lds0 + half * CP_LDS;
    char* qL = lds; char* kL = lds + 17408; char* vL = lds + 34816; float* AM = (float*)(lds + 52224); float* scv = (float*)(lds + 69632);
    float* gcL = scv; float* btL = scv + 64; float* egL = scv + 128; float* ekL = scv + 192;
    char* rec = p.recs() + ((size_t)c * NCHUNK + n) * REC_BYTES;
    if (valid) {
        const int tk = t >> 2, seg = (t & 3) * 32; const int row = scan_row(dir, n * 64 + tk);
        const bf16_t *qs, *ks, *vs;
        if (kind == 0) { const bf16_t* b = p.gqkv() + (size_t)row * 1536 + h * 128 + seg; qs = b; ks = b + 512; vs = b + 1024; }
        else { const bf16_t* b = p.rqk() + (size_t)row * 1024 + h * 128 + seg; qs = b; ks = b + 512; vs = p.Pp() + (size_t)row * NP + PC_RQKV + 1024 + h * 128 + seg; }
        u32x4 qv[4], kv[4], vv[4];
#pragma unroll
        for (int k = 0; k < 4; ++k) { qv[k] = *(const u32x4*)(qs + 8 * k); kv[k] = *(const u32x4*)(ks + 8 * k); vv[k] = *(const u32x4*)(vs + 8 * k); }
        const int lo = tk * 272 + seg * 2;
#pragma unroll
        for (int k = 0; k < 4; ++k) { *(u32x4*)(qL + lo + 16 * k) = qv[k]; *(u32x4*)(kL + lo + 16 * k) = kv[k]; *(u32x4*)(vL + lo + 16 * k) = vv[k]; }
    }
    if (hw == 0) {
        float g, b;
        if (kind == 0) { const int row = scan_row(dir, n * 64 + lane); g = p.ggb()[(size_t)row * 16 + dir * 4 + h]; b = p.ggb()[(size_t)row * 16 + 8 + dir * 4 + h]; }
        else { const int ei = dir + 2 * h; g = (ei == 0 ? -3.1748698315e-02f : (ei == 1 ? -1.5748356968e-02f : (ei == 2 ? -7.8431774610e-03f : (ei == 3 ? -3.9138993211e-03f : (ei == 4 ? -1.9550348358e-03f : (ei == 5 ? -9.7703964783e-04f : (ei == 6 ? -4.8840049811e-04f : -2.4417043217e-04f))))))); b = 1.f; }
        float gc = g;
#pragma unroll
        for (int o = 1; o < 64; o <<= 1) { const float tt = __int_as_float(__builtin_amdgcn_ds_bpermute(((lane - o) & 63) << 2, __float_as_int(gc))); if (lane >= o) gc += tt; }
        const float gl = __int_as_float(__builtin_amdgcn_readlane(__float_as_int(gc), 63));
        gcL[lane] = gc; btL[lane] = b; egL[lane] = expf(gc); ekL[lane] = expf(gl - gc);
        if (lane == 63 && valid) *(float*)(rec + REC_DL) = expf(gc);
    }
    __syncthreads();
    {   const int mi = hw >> 1, ni = hw & 1;
#pragma unroll
        for (int mat = 0; mat < 2; ++mat) {
            if (mat == 1 || kind == 0) {
                f32x16 acc = {};
                if (!(mi == 0 && ni == 1)) {
                    const char* XL = mat ? qL : kL;
#pragma unroll
                    for (int ks = 0; ks < 8; ++ks) {
                        const bf16x8 a = *(const bf16x8*)(XL + (32 * mi + r32) * 272 + (16 * ks + 8 * hi) * 2);
                        const bf16x8 b = *(const bf16x8*)(kL + (32 * ni + r32) * 272 + (16 * ks + 8 * hi) * 2);
                        acc = __builtin_amdgcn_mfma_f32_32x32x16_bf16(a, b, acc, 0, 0, 0);
                    }
                }
                const int j = 32 * ni + r32; const float gj = gcL[j];
#pragma unroll
                for (int r = 0; r < 16; ++r) { const int i = 32 * mi + crow32(r, hi);
                    const float dec = __expf(fminf(gcL[i] - gj, 0.f));
                    if (mat == 0) AM[i * 68 + j] = (j < i) ? btL[i] * acc[r] * dec : 0.f;
                    else if (valid) *(bf16_t*)(rec + REC_A + (size_t)(i * 64 + j) * 2) = f2bf((j <= i) ? acc[r] * dec : 0.f); }
            }
        }
    }
    __syncthreads();
    if (valid) {
        if (kind == 0) {
            const int cc = t & 127; const bool isw = t >= 128; const char* src = isw ? kL : vL;
            float x[64];
#pragma unroll
            for (int i = 0; i < 64; ++i) x[i] = bf2f(*(const bf16_t*)(src + i * 272 + cc * 2)) * (isw ? btL[i] * egL[i] : btL[i]);
            f32x4 ar[2][16];
#pragma unroll
            for (int i = 1; i < 64; ++i) {
                if (i == 1) { ar[1][0] = *(const f32x4*)(AM + 68); }
                if (i + 1 < 64) {
#pragma unroll
                    for (int j4 = 0; j4 < (i + 4) / 4; ++j4) ar[(i + 1) & 1][j4] = *(const f32x4*)(AM + (i + 1) * 68 + j4 * 4);
                }
                __builtin_amdgcn_sched_barrier(0);
                float a = x[i];
#pragma unroll
                for (int j4 = 0; j4 < (i + 3) / 4; ++j4) { const f32x4 a4 = ar[i & 1][j4];
                    if (4 * j4 + 0 < i) a -= a4[0] * x[4 * j4 + 0]; if (4 * j4 + 1 < i) a -= a4[1] * x[4 * j4 + 1];
                    if (4 * j4 + 2 < i) a -= a4[2] * x[4 * j4 + 2]; if (4 * j4 + 3 < i) a -= a4[3] * x[4 * j4 + 3]; }
                x[i] = a;
                __builtin_amdgcn_sched_barrier(0);
            }
            bf16_t* dstp = (bf16_t*)(rec + (isw ? REC_W : REC_U)) + cc;
#pragma unroll
            for (int i = 0; i < 64; ++i) dstp[i * 128] = f2bf(x[i]);
        } else if (t < 128) {
#pragma unroll 8
            for (int i = 0; i < 64; ++i) *(bf16_t*)(rec + REC_U + (size_t)(i * 128 + t) * 2) = *(const bf16_t*)(vL + i * 272 + t * 2);
        }
        {   const int i = t >> 2, seg = (t & 3) * 32; const float e = egL[i];
#pragma unroll
            for (int k8 = 0; k8 < 4; ++k8) { float f[8]; unpack8(*(const u32x4*)(qL + i * 272 + (seg + k8 * 8) * 2), f);
#pragma unroll
                for (int e8 = 0; e8 < 8; ++e8) f[e8] *= e;
                *(u32x4*)(rec + REC_Q + (size_t)(i * 128 + seg + k8 * 8) * 2) = pack8(f); } }
        {   const int d = t >> 1, hf = t & 1;
#pragma unroll
            for (int k8 = 0; k8 < 4; ++k8) { float f[8];
#pragma unroll
                for (int e8 = 0; e8 < 8; ++e8) { const int i = hf * 32 + k8 * 8 + e8; f[e8] = bf2f(*(const bf16_t*)(kL + i * 272 + d * 2)) * ekL[i]; }
                *(u32x4*)(rec + REC_KT + (size_t)(d * 64 + hf * 32 + k8 * 8) * 2) = pack8(f); } }
    }
    __syncthreads();
}
__device__ __forceinline__ void phase_chunkprep(const Params& p, int layer, char* lds) {
    int k = 0;
#pragma unroll 1
    for (int id = blockIdx.x; id < 8 * NCHUNK; id += gridDim.x, ++k) { const int j = ((id & 7) + 4 * (k & 1)) & 7; chunkprep_pair(p, layer, ((id >> 3) * 8 + j) * 2, lds); }
}

constexpr int CH_W = 0, CH_Q = 16896, CH_A = 33792, CH_K = 42496, CH_BUF = 59904;
constexpr int CH_U = 2 * CH_BUF, CH_DL = CH_U + 16896;
__device__ __forceinline__ bf16x8 frag_rd(const char* base, int row, int stride, int ks, int hi) {
    const char* a = base + row * stride + (16 * ks + 4 * hi) * 2;
    const u32x2 lo = *(const u32x2*)a, hi2 = *(const u32x2*)(a + 16);
    u32x4 w = {lo.x, lo.y, hi2.x, hi2.y}; return *reinterpret_cast<bf16x8*>(&w);
}
__device__ __forceinline__ bf16x8 acc_frag(const f32x16& x, int s) {
    u32x4 w = {cvt_pk_bf16(x[8 * s + 0], x[8 * s + 1]), cvt_pk_bf16(x[8 * s + 2], x[8 * s + 3]), cvt_pk_bf16(x[8 * s + 4], x[8 * s + 5]), cvt_pk_bf16(x[8 * s + 6], x[8 * s + 7])};
    return *reinterpret_cast<bf16x8*>(&w);
}
struct ChainRegs { u32x4 q[4], k[4], a[2], w[4], u[4]; float dl; };
__device__ __forceinline__ void chain_ld(ChainRegs& R, const char* rec, int t, bool gdn) {
#pragma unroll
    for (int it = 0; it < 4; ++it) R.q[it] = *(const u32x4*)(rec + REC_Q + (size_t)(t + it * 256) * 16);
#pragma unroll
    for (int it = 0; it < 4; ++it) R.k[it] = *(const u32x4*)(rec + REC_KT + (size_t)(t + it * 256) * 16);
#pragma unroll
    for (int it = 0; it < 2; ++it) R.a[it] = *(const u32x4*)(rec + REC_A + (size_t)(t + it * 256) * 16);
#pragma unroll
    for (int it = 0; it < 4; ++it) R.u[it] = *(const u32x4*)(rec + REC_U + (size_t)(t + it * 256) * 16);
    R.dl = *(const float*)(rec + REC_DL);
    if (gdn) {
#pragma unroll
        for (int it = 0; it < 4; ++it) R.w[it] = *(const u32x4*)(rec + REC_W + (size_t)(t + it * 256) * 16);
    }
}
#define CH_ST16(DST, V) do { char* d_ = (DST); *(u32x2*)d_ = (u32x2){(V).x, (V).y}; *(u32x2*)(d_ + 8) = (u32x2){(V).z, (V).w}; } while (0)
__device__ __forceinline__ void chain_st(const ChainRegs& R, char* lds, int b, int t, bool gdn) {
    char* buf = lds + b * CH_BUF;
#pragma unroll
    for (int it = 0; it < 4; ++it) { const int pc = t + it * 256; CH_ST16(buf + CH_Q + (pc >> 4) * 264 + (pc & 15) * 16, R.q[it]); }
#pragma unroll
    for (int it = 0; it < 4; ++it) { const int pc = t + it * 256; CH_ST16(buf + CH_K + (pc >> 3) * 136 + (pc & 7) * 16, R.k[it]); }
#pragma unroll
    for (int it = 0; it < 2; ++it) { const int pc = t + it * 256; CH_ST16(buf + CH_A + (pc >> 3) * 136 + (pc & 7) * 16, R.a[it]); }
#pragma unroll
    for (int it = 0; it < 4; ++it) { const int pc = t + it * 256; CH_ST16(lds + CH_U + (pc >> 4) * 264 + (pc & 15) * 16, R.u[it]); }
    if (t == 0) *(float*)(lds + CH_DL + b * 4) = R.dl;
    if (gdn) {
#pragma unroll
        for (int it = 0; it < 4; ++it) { const int pc = t + it * 256; CH_ST16(buf + CH_W + (pc >> 4) * 264 + (pc & 15) * 16, R.w[it]); }
    }
}
#define CH_BAR() do { asm volatile("s_waitcnt lgkmcnt(0)" ::: "memory"); __builtin_amdgcn_s_barrier(); asm volatile("" ::: "memory"); } while (0)
__device__ __forceinline__ void chain_unit(const Params& p, int c, char* lds) {
    const int tid = otid(), wid = tid >> 6, lane = tid & 63, r32 = lane & 31, hi = lane >> 5;
    const int kind = c >> 3, dir = (c >> 2) & 1, h = c & 3; const bool gdn = kind == 0;
    const char* rec0 = p.recs() + (size_t)c * NCHUNK * REC_BYTES;
    float* outp = (gdn ? p.go() : p.ro()) + (size_t)dir * MT * 512 + h * 128;
    const bool comp = wid < 4; const int sl = wid & 3;
    if (!comp) {
        const int t = tid - 256; ChainRegs R0, R1;
        chain_ld(R0, rec0, t, gdn); chain_st(R0, lds, 0, t, gdn);
        chain_ld(R1, rec0 + REC_BYTES, t, gdn); chain_ld(R0, rec0 + 2 * REC_BYTES, t, gdn);
        CH_BAR();
#define CH_LSTEP(R, N) do { CH_BAR(); if ((N) + 1 < NCHUNK) { chain_st(R, lds, ((N) + 1) & 1, t, gdn); if ((N) + 3 < NCHUNK) chain_ld(R, rec0 + (size_t)((N) + 3) * REC_BYTES, t, gdn); } CH_BAR(); } while (0)
#pragma unroll 1
        for (int n = 0; n < NCHUNK; n += 2) { CH_LSTEP(R1, n); CH_LSTEP(R0, n + 1); }
#undef CH_LSTEP
    } else {
        f32x16 S[4] = {};
        unsigned warm = 0u; const char* wbase = rec0 + (size_t)((wid * 3) * 64 + lane) * 128;
        CH_BAR();
#define CH_FR8(BASE, STRIDE, ROWA, ROWB, KS0) do { _Pragma("unroll") for (int k_ = 0; k_ < 4; ++k_) { fr[k_] = frag_rd(BASE, ROWA, STRIDE, (KS0) + k_, hi); fr[4 + k_] = frag_rd(BASE, ROWB, STRIDE, (KS0) + k_, hi); } \
        __builtin_amdgcn_sched_barrier(0); } while (0)
#define CH_MM8(ACC0, ACC1, B, KS0) do { _Pragma("unroll") for (int k_ = 0; k_ < 4; ++k_) { \
        ACC0 = __builtin_amdgcn_mfma_f32_32x32x16_bf16(fr[k_], B[((KS0) + k_) >> 1][((KS0) + k_) & 1], ACC0, 0, 0, 0); \
        ACC1 = __builtin_amdgcn_mfma_f32_32x32x16_bf16(fr[4 + k_], B[((KS0) + k_) >> 1][((KS0) + k_) & 1], ACC1, 0, 0, 0); } \
        __builtin_amdgcn_sched_barrier(0); } while (0)
#pragma unroll 1
        for (int n = 0; n < NCHUNK; ++n) {
            const char* buf = lds + (n & 1) * CH_BUF;
            {   const char* wp = wbase + (size_t)(n + 6 < NCHUNK ? n + 6 : NCHUNK - 1) * REC_BYTES;
                const char* wp1 = wp + 8192; const char* wp2 = wp + 16384;
                asm volatile("global_load_dword %0, %1, off\n\tglobal_load_dword %0, %2, off\n\tglobal_load_dword %0, %3, off" : "+v"(warm) : "v"(wp), "v"(wp1), "v"(wp2) : "memory"); }
            f32x16 un[2];
#pragma unroll
            for (int mt = 0; mt < 2; ++mt)
#pragma unroll
                for (int r = 0; r < 16; ++r) un[mt][r] = bf2f(*(const bf16_t*)(lds + CH_U + (32 * mt + crow32(r, hi)) * 264 + (32 * sl + r32) * 2));
            const float dl = *(const float*)(lds + CH_DL + (n & 1) * 4);
            CH_BAR();
            bf16x8 Sb[4][2], Vb[2][2], fr[8];
#pragma unroll
            for (int kt = 0; kt < 4; ++kt) { Sb[kt][0] = acc_frag(S[kt], 0); Sb[kt][1] = acc_frag(S[kt], 1); }
            {   f32x16 X0 = {}, X1 = {};
                if (gdn) {
                    CH_FR8(buf + CH_W, 264, r32, 32 + r32, 0); CH_MM8(X0, X1, Sb, 0);
                    CH_FR8(buf + CH_W, 264, r32, 32 + r32, 4); CH_MM8(X0, X1, Sb, 4);
                }
                const f32x16 v0 = un[0] - X0, v1 = un[1] - X1;
                Vb[0][0] = acc_frag(v0, 0); Vb[0][1] = acc_frag(v0, 1); Vb[1][0] = acc_frag(v1, 0); Vb[1][1] = acc_frag(v1, 1);
            }
            {   f32x16 O0 = {}, O1 = {};
                CH_FR8(buf + CH_Q, 264, r32, 32 + r32, 0); CH_MM8(O0, O1, Sb, 0);
                CH_FR8(buf + CH_Q, 264, r32, 32 + r32, 4); CH_MM8(O0, O1, Sb, 4);
                CH_FR8(buf + CH_A, 136, r32, 32 + r32, 0); CH_MM8(O0, O1, Vb, 0);
#pragma unroll
                for (int r = 0; r < 16; ++r) { const int row = scan_row(dir, n * 64 + crow32(r, hi)); outp[(size_t)row * 512 + 32 * sl + r32] = O0[r]; }
#pragma unroll
                for (int r = 0; r < 16; ++r) { const int row = scan_row(dir, n * 64 + 32 + crow32(r, hi)); outp[(size_t)row * 512 + 32 * sl + r32] = O1[r]; }
            }
            S[0] *= dl; S[1] *= dl; S[2] *= dl; S[3] *= dl;
            CH_FR8(buf + CH_K, 136, r32, 32 + r32, 0); CH_MM8(S[0], S[1], Vb, 0);
            CH_FR8(buf + CH_K, 136, 64 + r32, 96 + r32, 0); CH_MM8(S[2], S[3], Vb, 0);
            CH_BAR();
        }
#undef CH_FR8
#undef CH_MM8
        asm volatile("s_waitcnt vmcnt(0)" : "+v"(warm) :: "memory");
    }
    __syncthreads();
}
__device__ __forceinline__ void phase_chain(const Params& p, char* lds) {
#pragma unroll 1
    for (int c = blockIdx.x; c < 16; c += gridDim.x) chain_unit(p, c, lds);
}
__device__ __forceinline__ void fft_fwd(cpx* Z, int tid) {
#pragma unroll 1
    for (int pass = 0; pass < 3; ++pass) { const int lm = pass == 0 ? 10 : (pass == 1 ? 6 : 2);

#pragma unroll 1
        for (int gi = 0; gi < 2; ++gi) fft_pass16<false>(Z, tid + gi * 512, lm);
        __syncthreads(); }
#pragma unroll 1
    for (int it = 0; it < 8; ++it) fft_pass4<false>(Z, tid + it * 512);
    __syncthreads();
}
__device__ __forceinline__ void fft_inv(cpx* Z, int tid) {
#pragma unroll 1
    for (int it = 0; it < 8; ++it) fft_pass4<true>(Z, tid + it * 512);
    __syncthreads();
#pragma unroll 1
    for (int pass = 0; pass < 3; ++pass) { const int lm = pass == 0 ? 2 : (pass == 1 ? 6 : 10);

#pragma unroll 1
        for (int gi = 0; gi < 2; ++gi) fft_pass16<true>(Z, tid + gi * 512, lm);
        __syncthreads(); }
}
constexpr size_t HY_SCR_FLOATS = 2 * 2 * (size_t)FFT_N + (size_t)SEQ;
__device__ __forceinline__ void hyena_latent_unit(const Params& p, int layer, int c, char* lds) {
    cpx* Z = (cpx*)lds; const int tid = otid(), lane = tid & 63;
    float* scr = p.hys() + (size_t)blockIdx.x * HY_SCR_FLOATS;
    cpx* Zh1 = (cpx*)scr; cpx* Zh2 = Zh1 + FFT_N; float* z1s = (float*)(Zh2 + FFT_N);
    const float* vs = p.hyT() + (size_t)c * SEQ; const float* x1s = p.hyT() + (size_t)(512 + c) * SEQ; const float* x2s = p.hyT() + (size_t)(1024 + c) * SEQ;
#pragma unroll 1
    for (int f = 0; f < 2; ++f) {
        const size_t ch = (size_t)layer * 1024 + f * 512 + c;
        const float* hsrc = p.hfilt() + ch * SEQ;
        const f32x4 ps = *(const f32x4*)(p.hsum() + ch * 256 + lane * 4);
        const float tot = wave_sum((ps[0] + ps[1]) + (ps[2] + ps[3]));
        const float scale = (1.0f / (tot + EPS)) * (1.0f / (float)FFT_N);
        {   f32x2 hv[16];
#pragma unroll
            for (int it = 0; it < 16; ++it) hv[it] = *(const f32x2*)(hsrc + 2 * (tid + it * 512));
#pragma unroll
            for (int it = 0; it < 16; ++it) { const int j = tid + it * 512; Z[ZP(j)] = cpx{hv[it][0] * scale, hv[it][1] * scale}; Z[ZP(j + 8192)] = cpx{0.f, 0.f}; } }
        __syncthreads();
        fft_fwd(Z, tid);
        cpx* Zh = f ? Zh2 : Zh1;
#pragma unroll 4
        for (int it = 0; it < 32; ++it) { const int q = tid + it * 512; Zh[q] = Z[ZP(q)]; }
        __syncthreads();
    }
    const float b0 = p.in[I_HBIAS][(size_t)layer * 1024 + c], b1 = p.in[I_HBIAS][(size_t)layer * 1024 + 512 + c];
    {   f32x2 hv[16];
#pragma unroll
        for (int it = 0; it < 16; ++it) hv[it] = *(const f32x2*)(vs + 2 * (tid + it * 512));
#pragma unroll
        for (int it = 0; it < 16; ++it) { const int j = tid + it * 512; Z[ZP(j)] = cpx{hv[it][0], hv[it][1]}; Z[ZP(j + 8192)] = cpx{0.f, 0.f}; } }
    __syncthreads();
    fft_fwd(Z, tid);
    {   cpx ha[16], hb[16];
#pragma unroll
        for (int it = 0; it < 16; ++it) { int pp, pq; fft_pw_idx(tid + it * 512, pp, pq); ha[it] = Zh1[pp]; hb[it] = Zh1[pq]; }
#pragma unroll
        for (int it = 0; it < 16; ++it) fft_pointwise_pre(Z, ha[it], hb[it], tid + it * 512); }
    __syncthreads();
    fft_inv(Z, tid);
#pragma unroll 1
    for (int half = 0; half < 2; ++half) {
        f32x2 va[8], xa[8];
#pragma unroll
        for (int it = 0; it < 8; ++it) { const int j = half * 4096 + tid + it * 512; va[it] = *(const f32x2*)(vs + 2 * j); xa[it] = *(const f32x2*)(x1s + 2 * j); }
#pragma unroll
        for (int it = 0; it < 8; ++it) { const int j = half * 4096 + tid + it * 512;
            const cpx y = Z[ZP(4096 + j)];
            const f32x2 v2 = va[it], xx = xa[it];
            const f32x2 z = {xx[0] * (y.x + b0 * v2[0]), xx[1] * (y.y + b0 * v2[1])};
            *(f32x2*)(z1s + 2 * j) = z; Z[ZP(j)] = cpx{z[0], z[1]};
            if (half) Z[ZP(4096 + j)] = cpx{0.f, 0.f};
            else Z[ZP(12288 + j)] = cpx{0.f, 0.f}; }
        __syncthreads();
    }
    __syncthreads();
    fft_fwd(Z, tid);
    {   cpx ha[16], hb[16];
#pragma unroll
        for (int it = 0; it < 16; ++it) { int pp, pq; fft_pw_idx(tid + it * 512, pp, pq); ha[it] = Zh2[pp]; hb[it] = Zh2[pq]; }
#pragma unroll
        for (int it = 0; it < 16; ++it) fft_pointwise_pre(Z, ha[it], hb[it], tid + it * 512); }
    __syncthreads();
    fft_inv(Z, tid);
    f32x2 za[16], xb[16];
#pragma unroll
    for (int it = 0; it < 16; ++it) { const int j = tid + it * 512; za[it] = *(const f32x2*)(z1s + 2 * j); xb[it] = *(const f32x2*)(x2s + 2 * j); }
#pragma unroll
    for (int it = 0; it < 16; ++it) { const int j = tid + it * 512; const cpx y = Z[ZP(4096 + j)];
        const f32x2 z = za[it], x2 = xb[it];
        *(unsigned*)(p.hyO() + (size_t)c * SEQ + 2 * j) = cvt_pk_bf16(x2[0] * (y.x + b1 * z[0]), x2[1] * (y.y + b1 * z[1])); }
    __syncthreads();
}
__device__ __forceinline__ void hyena_ctx_unit(const Params& p, int c, float* lds) {
    const int tid = otid();
    float* vv = lds; float* x1 = vv + 256; float* x2 = x1 + 256; float* h1 = x2 + 256; float* h2 = h1 + 256; float* z1 = h2 + 256;
    const float* cw = p.in[I_HCONV];
    if (tid < 256) { const int t = tid;
#pragma unroll
        for (int part = 0; part < 3; ++part) {
            const float w0 = cw[part * 512 + c], w1 = cw[1536 + part * 512 + c], w2 = cw[3072 + part * 512 + c];
            const bf16_t* col = p.Pp() + PC_HY + part * 512 + c;
            const float x0 = bf2f(col[(size_t)t * NP]), xm = t > 0 ? bf2f(col[(size_t)(t - 1) * NP]) : 0.f, xn = t < LC - 1 ? bf2f(col[(size_t)(t + 1) * NP]) : 0.f;
            (part == 0 ? vv : (part == 1 ? x1 : x2))[t] = w0 * xm + w1 * x0 + w2 * xn;
        }
        const float s1 = (p.hsc()[c * 4] + p.hsc()[c * 4 + 1]) + (p.hsc()[c * 4 + 2] + p.hsc()[c * 4 + 3]);
        const float s2 = (p.hsc()[(512 + c) * 4] + p.hsc()[(512 + c) * 4 + 1]) + (p.hsc()[(512 + c) * 4 + 2] + p.hsc()[(512 + c) * 4 + 3]);
        h1[t] = p.hfc()[(size_t)c * 256 + t] / (s1 + EPS); h2[t] = p.hfc()[(size_t)(512 + c) * 256 + t] / (s2 + EPS);
    }
    __syncthreads();
    const float b0 = p.in[I_HBIAS][c], b1 = p.in[I_HBIAS][512 + c];
    if (tid < 256) { const int t = tid; float y = 0.f;
        for (int s = 0; s < 256; ++s) { const int m = t - s + 128; if (m >= 0 && m < 256) y += vv[s] * h1[m]; }
        z1[t] = x1[t] * (y + b0 * vv[t]); }
    __syncthreads();
    if (tid < 256) { const int t = tid; float y = 0.f;
        for (int s = 0; s < 256; ++s) { const int m = t - s + 128; if (m >= 0 && m < 256) y += z1[s] * h2[m]; }
        p.ocat()[(size_t)t * D_ + 1024 + c] = f2bf(x2[t] * (y + b1 * z1[t])); }
    __syncthreads();
}
__device__ __forceinline__ void phase_hyena(const Params& p, int layer, char* lds) {
    const int nunits = 512 + (layer == 0 ? 512 : 0);
    for (int u = blockIdx.x; u < nunits; u += gridDim.x) {
        if (u < 512) hyena_latent_unit(p, layer, u, lds); else hyena_ctx_unit(p, u - 512, (float*)lds);
    }
}

__device__ __forceinline__ void phase_gather(const Params& p) {
    const int tid = otid();
    int base[NEXP], cn[NEXP]; { int acc = 0;
#pragma unroll
        for (int e = 0; e < NEXP; ++e) { base[e] = acc * 256; cn[e] = (int)p.cnt()[e]; acc += (cn[e] + 255) >> 8; } }
    for (int i = blockIdx.x * 512 + tid; i < 2 * SEQ; i += gridDim.x * 512) {
        const int t = i >> 1, e = p.tok_e()[i], pos = p.tok_p()[i];
        int b = 0;
#pragma unroll
        for (int k = 0; k < NEXP; ++k) b = (e == k) ? base[k] : b;
        const int row = b + pos;
        p.gidx()[row] = LC + t; p.tok_r()[i] = row; p.hsg()[row] = p.hs()[LC + t];
    }
    for (int i = blockIdx.x * 512 + tid; i < (MAXROWS_MOE / 256) * 8; i += gridDim.x * 512) p.tailidx()[i] = -1;
    for (int i = blockIdx.x * 512 + tid; i < MAXROWS_MOE; i += gridDim.x * 512) ((unsigned*)p.acts())[i] = 0u;
    if (blockIdx.x < NEXP && tid < 256) {
        int b = 0, cc = 0;
#pragma unroll
        for (int k = 0; k < NEXP; ++k) if ((int)blockIdx.x == k) { b = base[k]; cc = cn[k]; }
        const int r = cc + tid; if (r < ((cc + 255) & ~255)) { p.gidx()[b + r] = LC; p.hsg()[b + r] = 0.f; }
    }
}
__device__ __forceinline__ void phase_final(const Params& p) {
    const int tid = otid(), wid = tid >> 6, lane = tid & 63;
    const float* g2 = p.modv() + ((size_t)1 * 2 + 0) * 6 * D_ + 5 * D_;
    const float* fw = p.in[I_FNW];
#ifdef PROBE
    const float prc = ((const float*)(p.cnt() + 32))[0], pre = ((const float*)(p.cnt() + 32))[1];
#endif
    int tn = blockIdx.x * 8 + wid;
    int r0n = p.tok_r()[tn * 2], r1n = p.tok_r()[tn * 2 + 1]; float w0n = p.tok_w()[tn * 2], w1n = p.tok_w()[tn * 2 + 1];
    for (int t = tn; t < SEQ; t += gridDim.x * 8) {
        const int r0 = r0n, r1 = r1n; const float w0 = w0n, w1 = w1n;
        tn = t + gridDim.x * 8; if (tn < SEQ) { r0n = p.tok_r()[tn * 2]; r1n = p.tok_r()[tn * 2 + 1]; w0n = p.tok_w()[tn * 2]; w1n = p.tok_w()[tn * 2 + 1]; }
        const float* xr = p.xcur() + (size_t)(LC + t) * D_;
        f32x4 xv[8]; float ss = 0.f; u32x2 ya[8], yc[8];
#pragma unroll
        for (int i = 0; i < 8; ++i) { const int col = (i * 64 + lane) * 4; ya[i] = *(const u32x2*)(p.yb() + (size_t)r0 * D_ + col); yc[i] = *(const u32x2*)(p.yb() + (size_t)r1 * D_ + col); xv[i] = *(const f32x4*)(xr + col); }
#pragma unroll
        for (int i = 0; i < 8; ++i) { const int col = (i * 64 + lane) * 4;
            const f32x4 y0 = (f32x4){bflo(ya[i].x), bfhi(ya[i].x), bflo(ya[i].y), bfhi(ya[i].y)}, y1 = (f32x4){bflo(yc[i].x), bfhi(yc[i].x), bflo(yc[i].y), bfhi(yc[i].y)};
            const f32x4 y = y0 * w0 + y1 * w1;
            xv[i] = xv[i] + *(const f32x4*)(g2 + col) * y;
            ss += xv[i][0] * xv[i][0] + xv[i][1] * xv[i][1] + xv[i][2] * xv[i][2] + xv[i][3] * xv[i][3]; }
        ss = wave_sum(ss);
        const float rstd = rsqrtf(ss * (1.0f / D_) + EPS);
        f32x4 fwv[8];
#pragma unroll
        for (int i = 0; i < 8; ++i) fwv[i] = *(const f32x4*)(fw + (i * 64 + lane) * 4);
#pragma unroll
        for (int i = 0; i < 8; ++i) { const int col = (i * 64 + lane) * 4; const f32x4 ov = (xv[i] * rstd) * fwv[i];
            *(f32x4*)(p.out + (size_t)t * D_ + col) = ov; }
    }
}

__device__ __forceinline__ void hyprep_unit(const Params& p, int layer, int u, float* tile  ) {
    const int tid = otid(); const int rb = u / 24, cg = u % 24, t0 = rb * 128, ch0 = cg * 64;
    const float* cw = p.in[I_HCONV] + (size_t)layer * 3 * 1536 + ch0;
    {   const int c8 = (tid & 7) * 8; float w0[8], w1[8], w2[8];
#pragma unroll
        for (int e = 0; e < 8; ++e) { w0[e] = cw[c8 + e]; w1[e] = cw[1536 + c8 + e]; w2[e] = cw[3072 + c8 + e]; }
        u32x4 raw[2][3];
#pragma unroll
        for (int i = 0; i < 2; ++i) { const int t = t0 + (tid >> 3) + 64 * i;
            const bf16_t* P0 = p.Pp() + (size_t)(LC + t) * NP + PC_HY + ch0 + c8;
            raw[i][1] = *(const u32x4*)P0; raw[i][0] = *(const u32x4*)(t > 0 ? P0 - NP : P0); raw[i][2] = *(const u32x4*)(t < SEQ - 1 ? P0 + NP : P0); }
#pragma unroll
        for (int i = 0; i < 2; ++i) { const int tl = (tid >> 3) + 64 * i, t = t0 + tl;
            float x0[8], xm[8], xn[8];
            unpack8(raw[i][1], x0); unpack8(raw[i][0], xm); unpack8(raw[i][2], xn);
            const float fm = t > 0 ? 1.f : 0.f, fn = t < SEQ - 1 ? 1.f : 0.f;
#pragma unroll
            for (int e = 0; e < 8; ++e) tile[tl * 65 + c8 + e] = w0[e] * (xm[e] * fm) + w1[e] * x0[e] + w2[e] * (xn[e] * fn); }
    }
    __syncthreads();
    {   const int cl = tid >> 3, tq = (tid & 7) * 16; float* dst = p.hyT() + (size_t)(ch0 + cl) * SEQ + t0 + tq;
#pragma unroll
        for (int k = 0; k < 4; ++k) { f32x4 v;
#pragma unroll
            for (int e = 0; e < 4; ++e) v[e] = tile[(tq + 4 * k + e) * 65 + cl];
            *(f32x4*)(dst + 4 * k) = v; }
    }
    __syncthreads();
}
__device__ __forceinline__ void hyout_unit(const Params& p, int u, float* tile  ) {
    const int tid = otid(); const int rb = u >> 3, cg = u & 7, t0 = rb * 128, c0 = cg * 64;
    {   const int cl = tid >> 3, tq = (tid & 7) * 16; const bf16_t* src = p.hyO() + (size_t)(c0 + cl) * SEQ + t0 + tq;
        float f[8];
        unpack8(*(const u32x4*)src, f);
#pragma unroll
        for (int e = 0; e < 8; ++e) tile[cl * 129 + tq + e] = f[e];
        unpack8(*(const u32x4*)(src + 8), f);
#pragma unroll
        for (int e = 0; e < 8; ++e) tile[cl * 129 + tq + 8 + e] = f[e];
    }
    __syncthreads();
    {   const int c8 = (tid & 7) * 8;
#pragma unroll
        for (int i = 0; i < 2; ++i) { const int tl = (tid >> 3) + 64 * i; float f[8];
#pragma unroll
            for (int e = 0; e < 8; ++e) f[e] = tile[(c8 + e) * 129 + tl];
            *(u32x4*)(p.ocat() + (size_t)(LC + t0 + tl) * D_ + 1024 + c0 + c8) = pack8(f); }
    }
    __syncthreads();
}

__device__ __forceinline__ void phase_quant(const Params& p, const bf16_t* act, signed char* actq, float* rs, int nrows) {
    const int tid = otid(), wid = tid >> 6, lane = tid & 63;
    for (int r = blockIdx.x * 8 + wid; r < nrows; r += gridDim.x * 8) {
        const float am = fmaxf(__uint_as_float(((const unsigned*)rs)[r]), 1e-20f), inv = 127.f / am;
        const bf16_t* src = act + (size_t)r * DFF; signed char* dst = actq + (size_t)r * DFF;
        u32x4 raw[11];
#pragma unroll
        for (int it = 0; it < 11; ++it) raw[it] = *(const u32x4*)(src + (it * 64 + lane) * 8);
#pragma unroll
        for (int it = 0; it < 11; ++it) { float f[8]; unpack8(raw[it], f);
            unsigned w0 = 0u, w1 = 0u;
#pragma unroll
            for (int e = 0; e < 4; ++e) { w0 |= (unsigned)((int)rintf(f[e] * inv) & 255) << (8 * e); w1 |= (unsigned)((int)rintf(f[4 + e] * inv) & 255) << (8 * e); }
            *(u32x2*)(dst + (it * 64 + lane) * 8) = (u32x2){w0, w1}; }
        __builtin_amdgcn_wave_barrier();
        if (lane == 0) rs[r] = am * (1.0f / 127.f);
    }
}
#define XB_TMO      128
#define XB_XCNT(j)  (256  + 64 * (j))
#define XB_XSUB(j)  (1280 + 64 * (j))
#define XB_XGEN(j)  (2304 + 64 * (j))
#define XB_TOP      3328
#define XB_TOPGEN   3392
#define XCD_BAR_WORDS 3456
#define XB_SPIN_CAP (1u << 26)

__device__ __forceinline__ unsigned xb_ld(unsigned* p)              { return __hip_atomic_load(p, __ATOMIC_RELAXED, __HIP_MEMORY_SCOPE_AGENT); }
__device__ __forceinline__ unsigned xb_add(unsigned* p, unsigned v) { return __hip_atomic_fetch_add(p, v, __ATOMIC_RELAXED, __HIP_MEMORY_SCOPE_AGENT); }
__device__ __forceinline__ unsigned xb_xcc_id() { return (unsigned)__builtin_amdgcn_s_getreg((3 << 11) | 20) & 0xFu; }
#define XB_SPIN(cond, bar) do { unsigned _sp = 0; while (cond) { __builtin_amdgcn_s_sleep(1); \
    if ((++_sp & 255u) == 0u) { if (xb_ld(&(bar)[XB_TMO])) break; if (_sp > XB_SPIN_CAP) { atomicAdd(&(bar)[XB_TMO], 1u); break; } } } } while (0)

struct XcdBarrier {
    unsigned* bar; unsigned x;
    volatile LAS unsigned* st;
};

__device__ __forceinline__ XcdBarrier xcd_barrier_post(unsigned* bar, volatile LAS unsigned* st) {
    XcdBarrier b; b.bar = bar; b.x = xb_xcc_id(); b.st = st;
    if (threadIdx.x == 0) (void)xb_add(&bar[XB_XCNT(b.x)], 1u);
    return b;
}
__device__ __forceinline__ void xcd_barrier_complete(unsigned* bar, unsigned x, unsigned& nloc, unsigned& nx) {
    const unsigned G = gridDim.x * gridDim.y * gridDim.z;
    unsigned sum, cnt, mine, sp = 0u;
    for (;;) {
        sum = 0u; cnt = 0u; mine = 0u;
#pragma unroll
        for (unsigned j = 0; j < 16; ++j) { const unsigned c = xb_ld(&bar[XB_XCNT(j)]); sum += c; cnt += (c > 0u) ? 1u : 0u; mine = (j == x) ? c : mine; }
        if (sum == G) break;
        __builtin_amdgcn_s_sleep(1);
        if ((++sp & 255u) == 0u) { if (xb_ld(&bar[XB_TMO])) break; if (sp > XB_SPIN_CAP) { atomicAdd(&bar[XB_TMO], 1u); break; } }
    }
    nloc = mine > 0u ? mine : 1u; nx = cnt > 0u ? cnt : 1u;
}

__device__ __forceinline__ void xcd_barrier(const XcdBarrier& b) {
    asm volatile("s_waitcnt vmcnt(0)" ::: "memory");
    __syncthreads();
    if (threadIdx.x == 0) {
        unsigned* bar = b.bar;
        __builtin_amdgcn_s_waitcnt(0);
        unsigned nloc = b.st[0], nx = b.st[1];
        if (nloc == 0u) { xcd_barrier_complete(bar, b.x, nloc, nx); b.st[0] = nloc; b.st[1] = nx; }
        const unsigned old = xb_add(&bar[XB_XSUB(b.x)], 1u);
        const unsigned gen = old / nloc;
        if (old + 1u == (gen + 1u) * nloc) {
            __builtin_amdgcn_fence(__ATOMIC_RELEASE, "agent");
            asm volatile("s_waitcnt vmcnt(0)" ::: "memory");
            const unsigned og = xb_add(&bar[XB_TOP], 1u);
            const unsigned tg = og / nx;
            if (og + 1u == (tg + 1u) * nx) xb_add(&bar[XB_TOPGEN], 1u);
            else XB_SPIN(xb_ld(&bar[XB_TOPGEN]) == tg, bar);
            __builtin_amdgcn_fence(__ATOMIC_ACQUIRE, "agent");
            xb_add(&bar[XB_XGEN(b.x)], 1u);
            asm volatile("s_waitcnt vmcnt(0)" ::: "memory");
        } else {
            XB_SPIN(xb_ld(&bar[XB_XGEN(b.x)]) == gen, bar);
            __builtin_amdgcn_fence(__ATOMIC_ACQUIRE, "agent");
            asm volatile("s_waitcnt vmcnt(0)" ::: "memory");
        }
    }
    __syncthreads();
}

enum { PH_PRO, PH_NORM1, PH_GIN, PH_PREP, PH_GMLA, PH_ATT, PH_REC, PH_CPREP, PH_CHAIN, PH_MIX3, PH_HY, PH_MIXOUT, PH_GOUT, PH_NORM2, PH_F1, PH_Q1, PH_F2, PH_GATHER, PH_MG1, PH_Q2, PH_MG2, PH_FINAL };
constexpr int LDS_BYTES = 147456;
constexpr int XBW_OFF = LDS_BYTES - 16;

template <int PH> __device__ __forceinline__ void run_phase(const Params& p, int layer, unsigned char* shm) {
    LAS unsigned char* lds3 = (LAS unsigned char*)shm;
    const int G = gridDim.x, c = blockIdx.x;
    if constexpr (PH == PH_PRO) phase_prologue(p, (float*)shm);
    else if constexpr (PH == PH_NORM1) {
        phase_norm(p, layer, 1, 0);
    }
    else if constexpr (PH == PH_GIN) {
        pg8::Gemm g{p.hbuf(), p.wb_in() + (size_t)layer * NP * (D_ / 2), D_ / 2, D_ / 2, D_ / 2, 0, nullptr};
        pg8::StaticOrder S; S.init(MT, NP, G, c, D_ / 2);
        pg8::EpiStoreBf16 E{p.Pp(), NP, nullptr, 1 << 30, nullptr, nullptr, p.hs(), p.wam() + WAM_IN + layer * NP};
        pg8::gemm_phase<pg8::EpiStoreBf16, pg8::StaticOrder, false, true>(lds3, g, S, E);
    }
    else if constexpr (PH == PH_PREP) phase_prep(p, layer);
    else if constexpr (PH == PH_GMLA) {
        pg8::Gemm g{p.Pp() + PC_CQ, p.wb_mla() + (size_t)layer * MLAN * MLAK, MLAK, NP, MLAK, 0, nullptr};
        pg8::StaticOrder S; S.init(MT, MLAN, G, c, MLAK);
        pg8::EpiStoreBf16 E{p.qkvup(), MLAN, p.mrs(), 3, nullptr, nullptr, nullptr, nullptr};
        pg8::gemm_phase(lds3, g, S, E);
    }
    else if constexpr (PH == PH_ATT) phase_attn(p, layer, (char*)shm);
    else if constexpr (PH == PH_REC) phase_rec_naive(p, layer, (float*)shm);
    else if constexpr (PH == PH_CPREP) {
        phase_chunkprep(p, layer, (char*)shm);
#pragma unroll 1
        for (int u = c; u < 128 * 24; u += G) hyprep_unit(p, layer, u, (float*)shm);
    }
    else if constexpr (PH == PH_CHAIN) phase_chain(p, (char*)shm);
    else if constexpr (PH == PH_MIX3) {
        const int nctx = layer == 0 ? 4 : 0, nq = 64 + nctx + 512 + (layer == 0 ? 512 : 0);
        unsigned* qctr = p.cnt() + 16 + layer; volatile LAS unsigned* qw = (volatile LAS unsigned*)(LAS unsigned char*)(shm + XBW_OFF - 32);
        int code = c < 16 ? c : (c < 256 ? 16 + c : -1);
#pragma unroll 1
        for (;;) {
            if (code < 0) {
                __syncthreads();
                if (otid() == 0) qw[0] = atomicAdd(qctr, 1u);
                __syncthreads();
                const int q = (int)qw[0];
                if (q >= nq) break;
                code = q < 64 ? 1300 + q : (q < 64 + nctx ? 16 + 256 + (q - 64) : (q < 64 + nctx + 512 ? 276 + (q - 64 - nctx) : 788 + (q - 64 - nctx - 512)));
            }
            if (code < 16) chain_unit(p, code, (char*)shm);
            else if (code < 276 || code >= 1300) { const bool spl = code >= 1300; attn_unit(p, spl ? (code - 1300) >> 2 : code - 16, spl ? (code - 1300) & 3 : -1, (char*)shm); }
            else if (code < 788) hyena_latent_unit(p, layer, code - 276, (char*)shm);
            else hyena_ctx_unit(p, code - 788, (float*)shm);
            code = -1;
        }
    }
    else if constexpr (PH == PH_HY) phase_hyena(p, layer, (char*)shm);
    else if constexpr (PH == PH_MIXOUT) {
        phase_mixout(p, layer);
        __syncthreads();
#pragma unroll 1
        for (int u = c; u < 128 * 8; u += G) hyout_unit(p, u, (float*)shm);
    }
    else if constexpr (PH == PH_GOUT) {
        const float* mv = p.modv() + (size_t)layer * 2 * 6 * D_;
        if (layer == 0) {
            pg8::Gemm g{p.ocat(), p.wb_out(), D_, D_, D_, 0, nullptr};
            pg8::CtxSplitOrder S; S.init(G, c, D_, 4);
            pg8::EpiResGate E{p.xcur(), p.in[I_CTX], p.in[I_X], mv + 6 * D_ + 2 * D_, mv + 2 * D_, 0, p.partG(), nullptr, nullptr};
            pg8::gemm_phase(lds3, g, S, E);
        } else {
            pg8::Gemm g{p.ocat() + (size_t)LC * D_, p.wb_out() + (size_t)D_ * D_, D_, D_, D_, 0, nullptr};
            pg8::StaticOrder S; S.init(SEQ, D_, G, c, D_);
            pg8::EpiResGate E{p.xcur(), p.xcur(), p.xcur() + (size_t)LC * D_, mv + 6 * D_ + 2 * D_, mv + 2 * D_, LC, nullptr, nullptr, nullptr};
            pg8::gemm_phase(lds3, g, S, E);
        }
    }
    else if constexpr (PH == PH_NORM2) {
        phase_norm(p, layer, 2, layer == 0 ? 0 : LC);
    }
    else if constexpr (PH == PH_F1) {
        pg8::Gemm g{p.hbuf(), p.wb_f13(), D_ / 2, D_ / 2, D_ / 2, 0, nullptr};
        pg8::StaticOrder S; S.init(MT, 2 * DFF, G, c, D_ / 2);
        pg8::EpiSwiGLU E{p.act(), DFF, p.hs(), p.wam() + WAM_F13, (unsigned*)p.acts()};
        pg8::gemm_phase<pg8::EpiSwiGLU, pg8::StaticOrder, false, true>(lds3, g, S, E);
    }
    else if constexpr (PH == PH_Q1) phase_quant(p, p.act(), p.actq(), p.acts(), MT);
    else if constexpr (PH == PH_F2) {
        const float* mv = p.modv();
        pg8::Gemm g{(const bf16_t*)p.actq(), p.wb_f2(), DFF / 2, DFF / 2, DFF / 2, 0, nullptr};
        pg8::CtxSplitOrder S; S.init(G, c, DFF / 2, 11);
        pg8::EpiResGate E{p.xcur(), p.xcur(), p.xcur() + (size_t)LC * D_, mv + 6 * D_ + 5 * D_, mv + 5 * D_, 0, p.partF(), p.acts(), p.wam() + WAM_F2};
        pg8::gemm_phase<pg8::EpiResGate, pg8::CtxSplitOrder, false, true>(lds3, g, S, E);
    }
    else if constexpr (PH == PH_GATHER) phase_gather(p);
    else if constexpr (PH == PH_MG1) {
        pg8::Gemm g{p.hbuf(), p.wb_m13(), D_ / 2, D_ / 2, D_ / 2, (size_t)2 * DFF * (D_ / 2), p.gidx()};
        pg8::GroupedOrder S; S.init(p.cnt(), 2 * DFF, G, c, D_ / 2);
        pg8::EpiSwiGLU E{p.act_moe(), DFF, p.hsg(), p.wam() + WAM_M13, (unsigned*)p.acts()};
        pg8::gemm_phase<pg8::EpiSwiGLU, pg8::GroupedOrder, true, true>(lds3, g, S, E);
    }
    else if constexpr (PH == PH_Q2) { int np = 0;
#pragma unroll
        for (int e = 0; e < NEXP; ++e) np += ((int)p.cnt()[e] + 255) >> 8;
        phase_quant(p, p.act_moe(), p.actq_moe(), p.acts(), np * 256); }
    else if constexpr (PH == PH_MG2) {
        pg8::Gemm g{(const bf16_t*)p.actq_moe(), p.wb_m2(), DFF / 2, DFF / 2, DFF / 2, (size_t)D_ * (DFF / 2), nullptr};
        pg8::GroupedOrder S; S.init(p.cnt(), D_, G, c, DFF / 2, false);
        pg8::EpiStoreBf16 E{p.yb(), D_, nullptr, 1 << 30, p.ypart(), p.tailidx(), p.acts(), p.wam() + WAM_M2};
        pg8::gemm_phase<pg8::EpiStoreBf16, pg8::GroupedOrder, false, true>(lds3, g, S, E);
    }
    else if constexpr (PH == PH_FINAL) phase_final(p);
}

#ifndef MEGA
#define MEGA 1
#endif
template <int PH> __global__ __launch_bounds__(512, 2) void k_ph(Params p, int layer) {
    extern __shared__ __attribute__((aligned(16))) unsigned char shm[];
    run_phase<PH>(p, layer, shm);
}
#ifdef PROBE
#ifndef PROBE_A0
#define PROBE_A0 0
#define PROBE_A1 1
#define PROBE_B0 0
#define PROBE_B1 1
#endif
#define STAMP(k) do { if (blockIdx.x == 0 && otid() == 0) tsl[k] = (unsigned long long)wall_clock64(); } while (0)
#else
#define STAMP(k) do {} while (0)
#endif
__global__ __launch_bounds__(512, 2) void k_mega(Params p) {
    extern __shared__ __attribute__((aligned(16))) unsigned char shm[];
    volatile LAS unsigned* xbw = (volatile LAS unsigned*)(LAS unsigned char*)(shm + XBW_OFF);
#ifdef PROBE
    volatile LAS unsigned long long* tsl = (volatile LAS unsigned long long*)(LAS unsigned char*)(shm + XBW_OFF - 512);
#endif
    if (otid() == 0) { xbw[0] = 0u; xbw[1] = 0u; xbw[2] = 0u; xbw[3] = 0u; }
    __syncthreads();
    STAMP(0);
    (void)xcd_barrier_post(p.bar(), xbw);
#define GBAR() do { XcdBarrier _b; _b.bar = p.bar(); _b.x = xb_xcc_id(); _b.st = xbw; xcd_barrier(_b); } while (0)
    run_phase<PH_PRO>(p, 0, shm); GBAR(); STAMP(1);
#pragma unroll 1
    for (int l = 0; l < 2; ++l) {
        const int sb = 2 + 16 * l; (void)sb;
        run_phase<PH_NORM1>(p, l, shm); GBAR(); STAMP(sb + 0);
        run_phase<PH_GIN>(p, l, shm); GBAR(); STAMP(sb + 1);
        run_phase<PH_PREP>(p, l, shm); GBAR(); STAMP(sb + 2);
        run_phase<PH_GMLA>(p, l, shm); __syncthreads();
        run_phase<PH_CPREP>(p, l, shm); GBAR(); STAMP(sb + 3);
        run_phase<PH_MIX3>(p, l, shm); GBAR(); STAMP(sb + 6);
        run_phase<PH_MIXOUT>(p, l, shm); GBAR(); STAMP(sb + 7);
        run_phase<PH_GOUT>(p, l, shm); GBAR(); STAMP(sb + 8);
        run_phase<PH_NORM2>(p, l, shm); GBAR(); STAMP(sb + 9);
        if (l == 0) {
            run_phase<PH_F1>(p, l, shm); GBAR(); STAMP(sb + 10);
            run_phase<PH_Q1>(p, l, shm); GBAR();
            run_phase<PH_F2>(p, l, shm); GBAR(); STAMP(sb + 11);
        } else {
            run_phase<PH_GATHER>(p, l, shm); GBAR(); STAMP(sb + 10);
            run_phase<PH_MG1>(p, l, shm); GBAR(); STAMP(sb + 11);
            run_phase<PH_Q2>(p, l, shm); GBAR();
            run_phase<PH_MG2>(p, l, shm); GBAR(); STAMP(sb + 12);
#ifdef PROBE
            if (blockIdx.x == 0 && otid() == 0) {
                float* pw = (float*)(p.cnt() + 32);
                pw[0] = (float)(tsl[PROBE_A1] - tsl[PROBE_A0]) * 1e-5f; pw[1] = (float)(tsl[PROBE_B1] - tsl[PROBE_B0]) * 0.0025f;
            }
            GBAR();
#endif
            run_phase<PH_FINAL>(p, l, shm);
        }
    }
}
template <int PH> static void launch_ph(const Params& p, int layer, int grid, hipStream_t st) {
    static bool attr = false;
    if (!attr) { (void)hipFuncSetAttribute((const void*)k_ph<PH>, hipFuncAttributeMaxDynamicSharedMemorySize, LDS_BYTES); attr = true; }
    hipLaunchKernelGGL((k_ph<PH>), dim3(grid), dim3(512), LDS_BYTES, st, p, layer);
}

static size_t align_up(size_t x) { return (x + 255) & ~(size_t)255; }
extern "C" void kernel_launch(void* const* d_in, const int* in_sizes, int n_in, void* d_out, int out_size, void* d_ws, size_t ws_size, hipStream_t stream) {
    Params p{};
    for (int i = 0; i < N_IN; ++i) p.in[i] = (const float*)d_in[i];
    p.out = (float*)d_out;
    static int GRID = 0;
    if (!GRID) {
#if MEGA
        int dev = 0, cus = 0, per_cu = 0;
        (void)hipGetDevice(&dev);
        (void)hipDeviceGetAttribute(&cus, hipDeviceAttributeMultiprocessorCount, dev);
        (void)hipFuncSetAttribute((const void*)k_mega, hipFuncAttributeMaxDynamicSharedMemorySize, LDS_BYTES);
        (void)hipOccupancyMaxActiveBlocksPerMultiprocessor(&per_cu, k_mega, 512, LDS_BYTES);
        if (per_cu < 1 || cus < 1) { fprintf(stderr, "kernel_launch: occupancy query failed (%d blocks/CU, %d CUs)\n", per_cu, cus); return; }
        GRID = cus < WS_GRID ? cus : WS_GRID;
#else
        GRID = 256;
#endif
    }
    p.ws = (char*)d_ws;
    if (ws_size < WSL.need) { fprintf(stderr, "kernel_launch: workspace too small: %zu < %zu\n", ws_size, (size_t)WSL.need); return; }
#if MEGA
    (void)hipMemsetAsync((char*)d_ws + WSL.bar, 0, WSL.modv - WSL.bar, stream);
    hipLaunchKernelGGL(k_mega, dim3(GRID), dim3(512), LDS_BYTES, stream, p);
#else
    launch_ph<PH_PRO>(p, 0, GRID, stream);
    for (int l = 0; l < 2; ++l) {
        launch_ph<PH_NORM1>(p, l, GRID, stream);
        launch_ph<PH_GIN>(p, l, GRID, stream);
        launch_ph<PH_PREP>(p, l, GRID, stream);
        launch_ph<PH_GMLA>(p, l, GRID, stream);
        launch_ph<PH_ATT>(p, l, GRID, stream);
        launch_ph<PH_CPREP>(p, l, GRID, stream);
        launch_ph<PH_CHAIN>(p, l, GRID, stream);
        launch_ph<PH_HY>(p, l, GRID, stream);
        launch_ph<PH_MIXOUT>(p, l, GRID, stream);
        launch_ph<PH_GOUT>(p, l, GRID, stream);
        launch_ph<PH_NORM2>(p, l, GRID, stream);
        if (l == 0) { launch_ph<PH_F1>(p, l, GRID, stream); launch_ph<PH_F2>(p, l, GRID, stream); }
        else { launch_ph<PH_GATHER>(p, l, GRID, stream); launch_ph<PH_MG1>(p, l, GRID, stream); launch_ph<PH_MG2>(p, l, GRID, stream); launch_ph<PH_FINAL>(p, l, GRID, stream); }
    }
#endif
}
```

```cpp
#include <hip/hip_runtime.h>
#include <stdint.h>
#include <math.h>
#include <stdio.h>

#define LAS __attribute__((address_space(3)))
typedef unsigned short bf16_t;
typedef short bf16x8 __attribute__((ext_vector_type(8)));
typedef short s16x4 __attribute__((ext_vector_type(4)));
typedef float f32x4 __attribute__((ext_vector_type(4)));
typedef float f32x2 __attribute__((ext_vector_type(2)));
typedef float f32x16 __attribute__((ext_vector_type(16)));
typedef unsigned u32x4 __attribute__((ext_vector_type(4)));
typedef unsigned u32x2 __attribute__((ext_vector_type(2)));

constexpr int D_ = 2048, SEQ = 16384, LC = 256, MT = 16640, NP = 6400, DFF = 5632, NEXP = 8, DIN = 6288;
constexpr int PC_GQKV = 0, PC_GZ = 1536, PC_HY = 2048, PC_RQKV = 3584, PC_RG = 5120, PC_CQ = 5632, PC_CKV = 6144, PC_KR = 6272, PC_A = 6336, PC_B = 6344;
constexpr int MLAK = 640, MLAN = 1792;
constexpr float EPS = 1e-6f;
constexpr int MAXROWS_MOE = 2 * SEQ + NEXP * 256;
enum { I_X, I_C, I_CTX, I_CCTX, I_N1W, I_N2W, I_MODW, I_MODB, I_WIN, I_WOUT, I_GCONV, I_GALOG, I_GDT, I_GNW, I_MQN, I_MUQ, I_MKVN, I_MUKV,
       I_HCONV, I_HW1, I_HB1, I_HW2, I_HB2, I_HW3, I_HB3, I_HW4, I_HFREQ, I_HBIAS, I_FW1, I_FW3, I_FW2, I_ROUTER, I_MW1, I_MW3, I_MW2, I_FNW, N_IN };

constexpr int NCHUNK_ = MT / 64;
constexpr size_t REC_BYTES_ = 73984, HY_SCR_FLOATS_ = 2 * 2 * (size_t)16384 + (size_t)SEQ;
constexpr int WS_GRID = 256;
constexpr int WAM_F13 = 0, WAM_F2 = 2 * DFF, WAM_M13 = WAM_F2 + D_, WAM_M2 = WAM_M13 + NEXP * 2 * DFF, WAM_IN = WAM_M2 + NEXP * D_, WAM_WORDS = WAM_IN + 2 * NP;
struct WsLayout { size_t bar, cnt, wam, hs, acts, hsg, modv, xcur, hbuf, tok_r, tok_w, tok_e, tok_p, gidx, tailidx, wq_m13, wq_m2, wb_in, wb_out, wb_mla, wb_f13, wb_f2, hfilt, hsum, hfc, hsc, Pp, gqkv, ggb, rqk, mrs, krr, qkvup, go, ro, recs, hys, ocat,
                  act, wb_m13, wb_m2, hg, yb, act_moe, hyT, hyO, partG, partF, attp, actq, actq_moe, need; };
constexpr size_t ws_al(size_t x) { return (x + 255) & ~(size_t)255; }
constexpr WsLayout make_ws_layout() {
    WsLayout L{}; size_t off = 0;
    L.bar = off; off = ws_al(off + 16384); L.cnt = off; off = ws_al(off + 256);
    L.wam = off; off = ws_al(off + (size_t)WAM_WORDS * 4);
    L.hs = off; off = ws_al(off + (size_t)MT * 4); L.acts = off; off = ws_al(off + (size_t)MAXROWS_MOE * 4); L.hsg = off; off = ws_al(off + (size_t)MAXROWS_MOE * 4);
    L.modv = off; off = ws_al(off + (size_t)2 * 2 * 6 * D_ * 4);
    L.xcur = off; off = ws_al(off + (size_t)MT * D_ * 4);
    L.hbuf = off; off = ws_al(off + (size_t)MT * D_);
    L.tok_r = off; off = ws_al(off + (size_t)2 * SEQ * 4); L.tok_w = off; off = ws_al(off + (size_t)2 * SEQ * 4); L.tok_e = off; off = ws_al(off + (size_t)2 * SEQ * 4); L.tok_p = off; off = ws_al(off + (size_t)2 * SEQ * 4); L.gidx = off; off = ws_al(off + (size_t)MAXROWS_MOE * 4); L.tailidx = off; off = ws_al(off + (size_t)(MAXROWS_MOE / 256) * 8 * 4);
    L.wq_m13 = off; off = ws_al(off + (size_t)NEXP * 2 * DFF * D_); L.wq_m2 = off; off = ws_al(off + (size_t)NEXP * D_ * DFF);
    const size_t region = off;
    L.wb_in = off; off = ws_al(off + (size_t)2 * NP * D_); L.wb_out = off; off = ws_al(off + (size_t)2 * D_ * D_ * 2); L.wb_mla = off; off = ws_al(off + (size_t)2 * MLAN * MLAK * 2);
    L.wb_f13 = off; off = ws_al(off + (size_t)2 * DFF * D_); L.wb_f2 = off; off = ws_al(off + (size_t)D_ * DFF);
    L.hfilt = off; off = ws_al(off + (size_t)2 * 1024 * SEQ * 4); L.hsum = off; off = ws_al(off + (size_t)2 * 1024 * 256 * 4); L.hfc = off; off = ws_al(off + (size_t)1024 * 256 * 4); L.hsc = off; off = ws_al(off + (size_t)1024 * 4 * 4);
    const size_t arena = off;
    L.Pp = off; off = ws_al(off + (size_t)MT * NP * 2);
    L.gqkv = off; off = ws_al(off + (size_t)MT * 1536 * 2); L.ggb = off; off = ws_al(off + (size_t)MT * 16 * 4); L.rqk = off; off = ws_al(off + (size_t)MT * 1024 * 2);
    L.mrs = off; off = ws_al(off + (size_t)MT * 2 * 4); L.krr = off; off = ws_al(off + (size_t)MT * 64 * 2); L.qkvup = off; off = ws_al(off + (size_t)MT * MLAN * 2);
    L.go = off; off = ws_al(off + (size_t)2 * MT * 512 * 4); L.ro = off; off = ws_al(off + (size_t)2 * MT * 512 * 4);
    L.recs = off; off = ws_al(off + (size_t)16 * NCHUNK_ * REC_BYTES_);
    L.hys = off; off = ws_al(off + (size_t)WS_GRID * HY_SCR_FLOATS_ * 4);
    L.hyT = off; off = ws_al(off + (size_t)1536 * SEQ * 4); L.hyO = off; off = ws_al(off + (size_t)512 * SEQ * 2);
    L.attp = off; off = ws_al(off + (size_t)64 * (256 * 128 + 512) * 4);
    L.ocat = L.gqkv;
    L.partG = L.recs; L.partF = L.recs + ws_al((size_t)4 * LC * D_ * 4);
    const size_t end1 = off;
    L.act = arena;
    L.actq = L.gqkv;
    off = region;
    L.wb_m13 = L.wq_m13; L.wb_m2 = L.wq_m2;
    L.hg = off; L.yb = off; off = ws_al(off + (size_t)MAXROWS_MOE * D_ * 2);
    L.act_moe = off; off = ws_al(off + (size_t)MAXROWS_MOE * DFF * 2);
    L.actq_moe = off; off = ws_al(off + (size_t)MAXROWS_MOE * DFF);
    const size_t end2 = off;
    L.need = end1 > end2 ? end1 : end2;
    return L;
}
constexpr WsLayout WSL = make_ws_layout();
struct Params {
    const float* in[N_IN];
    float* out;
    char* ws;
    __device__ __forceinline__ unsigned* bar() const { return (unsigned*)(ws + WSL.bar); }
    __device__ __forceinline__ unsigned* cnt() const { return (unsigned*)(ws + WSL.cnt); }
    __device__ __forceinline__ unsigned* wam() const { return (unsigned*)(ws + WSL.wam); }
    __device__ __forceinline__ float* hs() const { return (float*)(ws + WSL.hs); }
    __device__ __forceinline__ float* acts() const { return (float*)(ws + WSL.acts); }
    __device__ __forceinline__ float* hsg() const { return (float*)(ws + WSL.hsg); }
    __device__ __forceinline__ float* modv() const { return (float*)(ws + WSL.modv); }
    __device__ __forceinline__ bf16_t* wb_in() const { return (bf16_t*)(ws + WSL.wb_in); }
    __device__ __forceinline__ bf16_t* wb_out() const { return (bf16_t*)(ws + WSL.wb_out); }
    __device__ __forceinline__ bf16_t* wb_mla() const { return (bf16_t*)(ws + WSL.wb_mla); }
    __device__ __forceinline__ bf16_t* wb_f13() const { return (bf16_t*)(ws + WSL.wb_f13); }
    __device__ __forceinline__ bf16_t* wb_f2() const { return (bf16_t*)(ws + WSL.wb_f2); }
    __device__ __forceinline__ bf16_t* wb_m13() const { return (bf16_t*)(ws + WSL.wb_m13); }
    __device__ __forceinline__ bf16_t* wb_m2() const { return (bf16_t*)(ws + WSL.wb_m2); }
    __device__ __forceinline__ float* hfilt() const { return (float*)(ws + WSL.hfilt); }
    __device__ __forceinline__ float* hsum() const { return (float*)(ws + WSL.hsum); }
    __device__ __forceinline__ float* hfc() const { return (float*)(ws + WSL.hfc); }
    __device__ __forceinline__ float* hsc() const { return (float*)(ws + WSL.hsc); }
    __device__ __forceinline__ float* xcur() const { return (float*)(ws + WSL.xcur); }
    __device__ __forceinline__ bf16_t* hbuf() const { return (bf16_t*)(ws + WSL.hbuf); }
    __device__ __forceinline__ bf16_t* Pp() const { return (bf16_t*)(ws + WSL.Pp); }
    __device__ __forceinline__ bf16_t* gqkv() const { return (bf16_t*)(ws + WSL.gqkv); }
    __device__ __forceinline__ float* ggb() const { return (float*)(ws + WSL.ggb); }
    __device__ __forceinline__ bf16_t* rqk() const { return (bf16_t*)(ws + WSL.rqk); }
    __device__ __forceinline__ float* mrs() const { return (float*)(ws + WSL.mrs); }
    __device__ __forceinline__ bf16_t* krr() const { return (bf16_t*)(ws + WSL.krr); }
    __device__ __forceinline__ bf16_t* qkvup() const { return (bf16_t*)(ws + WSL.qkvup); }
    __device__ __forceinline__ float* go() const { return (float*)(ws + WSL.go); }
    __device__ __forceinline__ float* ro() const { return (float*)(ws + WSL.ro); }
    __device__ __forceinline__ char* recs() const { return (char*)(ws + WSL.recs); }
    __device__ __forceinline__ float* hys() const { return (float*)(ws + WSL.hys); }
    __device__ __forceinline__ float* hyT() const { return (float*)(ws + WSL.hyT); }
    __device__ __forceinline__ bf16_t* hyO() const { return (bf16_t*)(ws + WSL.hyO); }
    __device__ __forceinline__ float* partG() const { return (float*)(ws + WSL.partG); }
    __device__ __forceinline__ float* partF() const { return (float*)(ws + WSL.partF); }
    __device__ __forceinline__ float* attp() const { return (float*)(ws + WSL.attp); }
    __device__ __forceinline__ signed char* actq() const { return (signed char*)(ws + WSL.actq); }
    __device__ __forceinline__ signed char* actq_moe() const { return (signed char*)(ws + WSL.actq_moe); }
    __device__ __forceinline__ bf16_t* ocat() const { return (bf16_t*)(ws + WSL.ocat); }
    __device__ __forceinline__ bf16_t* act() const { return (bf16_t*)(ws + WSL.act); }
    __device__ __forceinline__ bf16_t* act_moe() const { return (bf16_t*)(ws + WSL.act_moe); }
    __device__ __forceinline__ bf16_t* hg() const { return (bf16_t*)(ws + WSL.hg); }
    __device__ __forceinline__ bf16_t* yb() const { return (bf16_t*)(ws + WSL.yb); }
    __device__ __forceinline__ int* tok_r() const { return (int*)(ws + WSL.tok_r); }
    __device__ __forceinline__ float* tok_w() const { return (float*)(ws + WSL.tok_w); }
    __device__ __forceinline__ int* tok_e() const { return (int*)(ws + WSL.tok_e); }
    __device__ __forceinline__ int* tok_p() const { return (int*)(ws + WSL.tok_p); }
    __device__ __forceinline__ int* gidx() const { return (int*)(ws + WSL.gidx); }
    __device__ __forceinline__ int* tailidx() const { return (int*)(ws + WSL.tailidx); }
    __device__ __forceinline__ float* ypart() const { return (float*)(ws + WSL.wb_m13); }
};

__device__ __forceinline__ int otid() { int t = threadIdx.x; asm volatile("" : "+v"(t)); return t; }
__device__ __forceinline__ unsigned cvt_pk_bf16(float lo, float hi) { unsigned r; asm volatile("v_cvt_pk_bf16_f32 %0, %1, %2" : "=v"(r) : "v"(lo), "v"(hi)); return r; }
__device__ __forceinline__ bf16_t f2bf(float x) { return (bf16_t)(cvt_pk_bf16(x, 0.f) & 0xffffu); }
__device__ __forceinline__ float bf2f(bf16_t b) { return __uint_as_float(((unsigned)b) << 16); }
__device__ __forceinline__ float bflo(unsigned w) { return __uint_as_float(w << 16); }
__device__ __forceinline__ float bfhi(unsigned w) { return __uint_as_float(w & 0xffff0000u); }
__device__ __forceinline__ float silu_f(float x) { return x / (1.f + __expf(-x)); }
__device__ __forceinline__ float sigmoid_f(float x) { return 1.f / (1.f + __expf(-x)); }
__device__ __forceinline__ float softplus_f(float x) { return fmaxf(x, 0.f) + __logf(1.f + __expf(-fabsf(x))); }
__device__ __forceinline__ float shflx(float v, int o, int lane) { return __int_as_float(__builtin_amdgcn_ds_bpermute((lane ^ o) << 2, __float_as_int(v))); }
__device__ __forceinline__ float wave_sum(float v) {
    const int lane = otid() & 63;
#pragma unroll
    for (int o = 32; o >= 1; o >>= 1) v += shflx(v, o, lane);
    return v;
}
__device__ __forceinline__ float sum16(float v) {
    const int lane = otid() & 63;
#pragma unroll
    for (int o = 8; o >= 1; o >>= 1) v += shflx(v, o, lane);
    return v;
}
__device__ __forceinline__ void unpack8(u32x4 w, float (&f)[8]) {
    f[0] = bflo(w.x); f[1] = bfhi(w.x); f[2] = bflo(w.y); f[3] = bfhi(w.y); f[4] = bflo(w.z); f[5] = bfhi(w.z); f[6] = bflo(w.w); f[7] = bfhi(w.w);
}
__device__ __forceinline__ u32x4 pack8(const float (&f)[8]) {
    u32x4 w; w.x = cvt_pk_bf16(f[0], f[1]); w.y = cvt_pk_bf16(f[2], f[3]); w.z = cvt_pk_bf16(f[4], f[5]); w.w = cvt_pk_bf16(f[6], f[7]); return w;
}

namespace pg8 {
constexpr int BM = 256, BK = 64, HALF = 128, HTB = HALF * BK * 2, STAGE_BYTES = 8 * HTB, NXCD = 8, WGM = 4;
__host__ __device__ __forceinline__ int lds_byte(int r, int c) { const int st = (r >> 4) * 2 + (c >> 5), rr = r & 15, cc = c & 31, ob = rr * 64 + cc * 2; return st * 1024 + (ob ^ (((ob >> 9) & 1) << 5)); }
__host__ __device__ __forceinline__ void stage_rc(int b, int& R, int& C) { const int st = b / 1024, sb = b % 1024, swz = sb ^ (((sb >> 9) & 1) << 5); R = (st >> 1) * 16 + swz / 64; C = (st & 1) * 32 + (swz % 64) / 2; }
__host__ __device__ __forceinline__ int perm32(int rho) { const int n = rho >> 4, i = rho & 15; return 8 * (i >> 2) + 4 * n + (i & 3); }
struct Unit { int pm, pn, e, kt0, nt, ks, tu; };
struct Gemm { const bf16_t* A; const bf16_t* Bt; int K, lda, ldb; size_t estride; const int* gidx; };

struct StaticOrder {
    int nM, nN, nwg, G, c, ntk;
    __device__ void init(int M, int N, int G_, int c_, int K) { nM = M / BM; nN = N / BM; nwg = nM * nN; G = G_; c = c_; ntk = K / BK; }
    __device__ bool next(int i, Unit& u) const {
        const long L = (long)i * G + c; if (L >= nwg) return false;
        int wgid = (int)L; { const int q = nwg / NXCD, r = nwg % NXCD, xcd = wgid % NXCD, off = wgid / NXCD; wgid = (xcd < r ? xcd * (q + 1) : r * (q + 1) + (xcd - r) * q) + off; }
        const int nig = WGM * nN, gid = wgid / nig, fm = gid * WGM, gsz = (nM - fm) < WGM ? (nM - fm) : WGM;
        u.pm = fm + ((wgid % nig) % gsz); u.pn = (wgid % nig) / gsz; u.e = 0; u.kt0 = 0; u.nt = ntk; u.ks = -1; u.tu = 0; return true;
    }
    __device__ __forceinline__ void a_ready(const Unit&) const {}
    __device__ __forceinline__ void done(const Unit&) const {}
};
struct CtxSplitOrder {
    StaticOrder S; int ns, G, c;
    __device__ void init(int G_, int c_, int K, int NS) { S.init(SEQ, D_, G_, c_, K); ns = NS; G = G_; c = c_; }
    __device__ bool next(int i, Unit& u) const {
        const long L = (long)i * G + c;
        if (L < S.nwg) { S.next(i, u); u.pm += 1; return true; }
        const int s = (int)(L - S.nwg); if (s >= 8 * ns) return false;
        u.pm = 0; u.pn = s & 7; u.e = 0; u.ks = s >> 3; u.tu = 0; u.nt = S.ntk / ns; u.kt0 = u.ks * u.nt; return true;
    }
    __device__ __forceinline__ void a_ready(const Unit&) const {}
    __device__ __forceinline__ void done(const Unit&) const {}
};
struct GroupedOrder {
    int pb[NEXP + 1]; int ub[NEXP + 1]; int nN, nwg, G, c, ntk, nfull, ntail;
    __device__ void init(const unsigned* cnt, int N, int G_, int c_, int K, bool split_tail = false) {
        ntk = K / BK; nN = N / BM; int acc = 0, ua = 0;
#pragma unroll
        for (int e = 0; e < NEXP; ++e) { pb[e] = acc; ub[e] = ua; const int np = ((int)cnt[e] + 255) >> 8; acc += np; ua += np * nN; }
        pb[NEXP] = acc; ub[NEXP] = ua; nwg = ua; G = G_; c = c_;
        const int rem = nwg % G; ntail = (split_tail && rem > 0 && rem <= 64) ? rem : 0; nfull = nwg - ntail;
    }
    __device__ bool next(int i, Unit& u) const {
        long L = (long)i * G + c; int ks = -1, tu = 0;
        if (L >= nfull) { const long t = L - nfull; if (t >= (long)ntail * 4) return false; tu = (int)(t >> 2); ks = (int)(t & 3); L = nfull + tu; }
        int wgid = (int)L; { const int q = nwg / NXCD, r = nwg % NXCD, xcd = wgid % NXCD, off = wgid / NXCD; wgid = (xcd < r ? xcd * (q + 1) : r * (q + 1) + (xcd - r) * q) + off; }
        int e = 0;
#pragma unroll
        for (int k = 1; k < NEXP; ++k) e += (wgid >= ub[k]) ? 1 : 0;
        int ube = 0, pbe = 0, npe = 0;
#pragma unroll
        for (int k = 0; k < NEXP; ++k) if (e == k) { ube = ub[k]; pbe = pb[k]; npe = pb[k + 1] - pb[k]; }
        const int l = wgid - ube, nig = WGM * nN, gid = l / nig, fm = gid * WGM, gsz = (npe - fm) < WGM ? (npe - fm) : WGM;
        u.pm = pbe + fm + ((l % nig) % gsz); u.pn = (l % nig) / gsz; u.e = e; u.ks = ks; u.tu = tu;
        const int ntq = ntk >> 2; u.nt = ks < 0 ? ntk : ntq; u.kt0 = ks < 0 ? 0 : ks * ntq;
        return true;
    }
    __device__ __forceinline__ void a_ready(const Unit&) const {}
    __device__ __forceinline__ void done(const Unit&) const {}
};

typedef int i32x4 __attribute__((ext_vector_type(4)));
template <class Epi, class Sched, bool GATHER = false, bool I8 = false>
__device__ __forceinline__ void gemm_phase(LAS unsigned char* lds, const Gemm g, const Sched& S, const Epi& E) {
    const int tid = otid(), wid = __builtin_amdgcn_readfirstlane(tid >> 6), lane = tid & 63, wr = wid >> 2, wc = wid & 3, fr = lane & 15, fq = lane >> 4;
    unsigned voffA[2], voffB[2]; int rA[2], cA2[2];
#pragma unroll
    for (int i = 0; i < 2; ++i) { int R, C; stage_rc(tid * 16 + i * 8192, R, C); const int Rb = Epi::PERM ? ((R & ~31) + perm32(R & 31)) : R;
        voffA[i] = (unsigned)(R * g.lda + C) * 2u; voffB[i] = (unsigned)(Rb * g.ldb + C) * 2u; rA[i] = R; cA2[i] = C * 2; }
    unsigned gA[2][2], gN[2][2];
#define PG8_GIDX(dst, pm_) do { _Pragma("unroll") for (int h_ = 0; h_ < 2; ++h_) _Pragma("unroll") for (int i_ = 0; i_ < 2; ++i_) \
        dst[h_][i_] = (unsigned)g.gidx[(pm_) * BM + h_ * HALF + rA[i_]] * (unsigned)(g.lda * 2) + (unsigned)cA2[i_]; } while (0)
#define PG8_STAGE_A(bufoff, kptr, h, useN) do { if constexpr (GATHER) { _Pragma("unroll") for (int _i = 0; _i < 2; ++_i) \
        __builtin_amdgcn_global_load_lds((const unsigned*)((const char*)(kptr) + ((useN) ? gN[h][_i] : gA[h][_i])), (LAS unsigned*)(lds + (bufoff) + ldsw + _i * 8192), 16, 0, 0); } \
        else PG8_STAGE(bufoff, (kptr) + (h) * hstepA, voffA); } while (0)
    const size_t kstep = (size_t)(BK * 2);
    const size_t hstepA = (size_t)HALF * g.lda * 2, hstepB = (size_t)HALF * g.ldb * 2;
    const size_t tstepA = 2 * hstepA, tstepB = 2 * hstepB;
    const unsigned ldsw = (unsigned)wid * 1024u;
    const int aoff = lds_byte(wr * 64 + fr, fq * 8), boff = lds_byte(wc * 32 + fr, fq * 8);
#define PG8_SA(b, h) (((b) * 2 + (h)) * HTB)
#define PG8_SB(b, h) ((4 + (b) * 2 + (h)) * HTB)
#define PG8_STAGE(bufoff, gbase, voff) do { _Pragma("unroll") for (int _i = 0; _i < 2; ++_i) \
        __builtin_amdgcn_global_load_lds((const unsigned*)((const char*)(gbase) + (voff)[_i]), (LAS unsigned*)(lds + (bufoff) + ldsw + _i * 8192), 16, 0, 0); } while (0)
#define PG8_LDA(dst, b, h) do { _Pragma("unroll") for (int m = 0; m < 4; ++m) _Pragma("unroll") for (int k = 0; k < 2; ++k) dst[m][k] = *(const LAS bf16x8*)(lds + PG8_SA(b, h) + aoff + m * 2048 + k * 1024); } while (0)
#define PG8_LDB(dst, b, h) do { _Pragma("unroll") for (int n = 0; n < 2; ++n) _Pragma("unroll") for (int k = 0; k < 2; ++k) dst[n][k] = *(const LAS bf16x8*)(lds + PG8_SB(b, h) + boff + n * 2048 + k * 1024); } while (0)
#define PG8_MMA(ai, bj, At, Bt) do { __builtin_amdgcn_s_setprio(1); _Pragma("unroll") for (int m = 0; m < 4; ++m) _Pragma("unroll") for (int n = 0; n < 2; ++n) _Pragma("unroll") for (int k = 0; k < 2; ++k) \
        { if constexpr (I8) acc[ai][bj][m][n] = __builtin_bit_cast(f32x4, __builtin_amdgcn_mfma_i32_16x16x64_i8(__builtin_bit_cast(i32x4, Bt[n][k]), __builtin_bit_cast(i32x4, At[m][k]), __builtin_bit_cast(i32x4, acc[ai][bj][m][n]), 0, 0, 0)); \
          else acc[ai][bj][m][n] = __builtin_amdgcn_mfma_f32_16x16x32_bf16(Bt[n][k], At[m][k], acc[ai][bj][m][n], 0, 0, 0); } __builtin_amdgcn_s_setprio(0); } while (0)
#define PG8_WAIT_V(n) asm volatile("s_waitcnt vmcnt(" #n ")" ::: "memory")
#define PG8_WAIT_L(n) asm volatile("s_waitcnt lgkmcnt(" #n ")" ::: "memory")
#define PG8_BAR __builtin_amdgcn_s_barrier()
#define PG8_SCHED __builtin_amdgcn_sched_barrier(0)
    Unit cur, nxt; int ui = 0; typename Epi::Regs er;
    if (!S.next(0, cur)) return;
    f32x4 acc[2][2][4][2];
#pragma unroll
    for (int a = 0; a < 2; ++a)
#pragma unroll
        for (int b = 0; b < 2; ++b)
#pragma unroll
            for (int m = 0; m < 4; ++m)
#pragma unroll
                for (int n = 0; n < 2; ++n) acc[a][b][m][n] = (f32x4){0.f, 0.f, 0.f, 0.f};
    bf16x8 At[4][2], B0[2][2], B1[2][2];
    const char* cA = (const char*)g.A + (GATHER ? (size_t)0 : (size_t)cur.pm * tstepA) + (size_t)cur.kt0 * kstep; const char* cB = (const char*)g.Bt + (size_t)cur.pn * tstepB + (size_t)cur.e * g.estride * 2 + (size_t)cur.kt0 * kstep;
    S.a_ready(cur);
    if constexpr (GATHER) { PG8_GIDX(gA, cur.pm); }
    PG8_STAGE(PG8_SB(0, 0), cB, voffB); PG8_STAGE_A(PG8_SA(0, 0), cA, 0, false); PG8_STAGE(PG8_SB(0, 1), cB + hstepB, voffB); PG8_STAGE_A(PG8_SA(0, 1), cA, 1, false);
    if (wr == 1) PG8_BAR;
    PG8_WAIT_V(4); PG8_BAR;
    PG8_STAGE(PG8_SB(1, 0), cB + kstep, voffB); PG8_STAGE_A(PG8_SA(1, 0), cA + kstep, 0, false); PG8_STAGE(PG8_SB(1, 1), cB + hstepB + kstep, voffB);
    PG8_WAIT_V(6); PG8_BAR;
    for (;;) {
        const bool has_next = S.next(ui + 1, nxt);
        const char* nA = has_next ? (const char*)g.A + (GATHER ? (size_t)0 : (size_t)nxt.pm * tstepA) + (size_t)nxt.kt0 * kstep : cA;
        if constexpr (GATHER) { if (has_next) { PG8_GIDX(gN, nxt.pm); } else { _Pragma("unroll") for (int h_ = 0; h_ < 2; ++h_) _Pragma("unroll") for (int i_ = 0; i_ < 2; ++i_) gN[h_][i_] = gA[h_][i_]; } }
        const char* nB = has_next ? (const char*)g.Bt + (size_t)nxt.pn * tstepB + (size_t)nxt.e * g.estride * 2 + (size_t)nxt.kt0 * kstep : cB;
        const int nt = cur.nt;
        for (int t = 0; t < nt; t += 2) {
            const bool last = (t == nt - 2);
            const char* a1 = cA + (size_t)(t + 1) * kstep;
            const char* a2 = last ? nA : cA + (size_t)(t + 2) * kstep; const char* b2 = last ? nB : cB + (size_t)(t + 2) * kstep;
            const char* a3 = a2 + kstep; const char* b3 = b2 + kstep;
            if (last && has_next) S.a_ready(nxt);
            PG8_LDB(B0, 0, 0); PG8_SCHED; PG8_LDA(At, 0, 0); PG8_STAGE_A(PG8_SA(1, 1), a1, 1, false);
            PG8_WAIT_L(8); PG8_BAR; PG8_WAIT_L(0); PG8_MMA(0, 0, At, B0); PG8_BAR; PG8_SCHED;
            PG8_LDB(B1, 0, 1); PG8_STAGE(PG8_SB(0, 0), b2, voffB);
            PG8_BAR; PG8_WAIT_L(0); PG8_MMA(0, 1, At, B1); PG8_BAR;
            PG8_LDA(At, 0, 1); PG8_STAGE_A(PG8_SA(0, 0), a2, 0, last);
            PG8_BAR; PG8_WAIT_L(0); PG8_MMA(1, 0, At, B0); PG8_BAR; PG8_SCHED;
            PG8_STAGE(PG8_SB(0, 1), b2 + hstepB, voffB);
            PG8_WAIT_V(6); PG8_BAR; PG8_MMA(1, 1, At, B1); PG8_BAR;
            PG8_LDB(B0, 1, 0); PG8_SCHED; PG8_LDA(At, 1, 0); PG8_STAGE_A(PG8_SA(0, 1), a2, 1, last);
            PG8_WAIT_L(8); PG8_BAR; PG8_WAIT_L(0); PG8_MMA(0, 0, At, B0); PG8_BAR; PG8_SCHED;
            PG8_LDB(B1, 1, 1); PG8_STAGE(PG8_SB(1, 0), b3, voffB);
            PG8_BAR; PG8_WAIT_L(0); PG8_MMA(0, 1, At, B1); PG8_BAR;
            PG8_LDA(At, 1, 1); PG8_STAGE_A(PG8_SA(1, 0), a3, 0, last);
            PG8_BAR; PG8_WAIT_L(0); PG8_MMA(1, 0, At, B0); PG8_BAR; PG8_SCHED;
            PG8_STAGE(PG8_SB(1, 1), b3 + hstepB, voffB);
            PG8_WAIT_V(6); PG8_BAR; PG8_MMA(1, 1, At, B1); PG8_BAR;
        }
        E.pre(er, cur, wr, wc, fr, fq);
        if constexpr (I8) {
#pragma unroll
            for (int a = 0; a < 2; ++a)
#pragma unroll
                for (int b = 0; b < 2; ++b)
#pragma unroll
                    for (int m = 0; m < 4; ++m)
#pragma unroll
                        for (int n = 0; n < 2; ++n) { const i32x4 iv = __builtin_bit_cast(i32x4, acc[a][b][m][n]); acc[a][b][m][n] = (f32x4){(float)iv[0], (float)iv[1], (float)iv[2], (float)iv[3]}; }
        }
        E(acc, cur, wr, wc, fr, fq, er); S.done(cur);
        if (!has_next) break;
#pragma unroll
        for (int a = 0; a < 2; ++a)
#pragma unroll
            for (int b = 0; b < 2; ++b)
#pragma unroll
                for (int m = 0; m < 4; ++m)
#pragma unroll
                    for (int n = 0; n < 2; ++n) acc[a][b][m][n] = (f32x4){0.f, 0.f, 0.f, 0.f};
        cur = nxt; cA = nA; cB = nB; ++ui;
        if constexpr (GATHER) { _Pragma("unroll") for (int h_ = 0; h_ < 2; ++h_) _Pragma("unroll") for (int i_ = 0; i_ < 2; ++i_) gA[h_][i_] = gN[h_][i_]; }
    }
    PG8_WAIT_V(0);
    if (wr == 0) PG8_BAR;
    PG8_BAR;
#undef PG8_SA
#undef PG8_GIDX
#undef PG8_STAGE_A
#undef PG8_SB
#undef PG8_STAGE
#undef PG8_LDA
#undef PG8_LDB
#undef PG8_MMA
#undef PG8_WAIT_V
#undef PG8_WAIT_L
#undef PG8_BAR
#undef PG8_SCHED
}

struct EpiStoreBf16 {
    static constexpr bool PERM = true;
    bf16_t* O; int ldc; const float* rs; int rs_split; float* part; int* tailidx; const float* sa; const unsigned* sb;
    struct Regs { float scr[8]; f32x4 cs[2][2]; };
    __device__ __forceinline__ void pre(Regs& R, const Unit& u, int wr, int wc, int fr, int fq) const {
        const int row0 = u.pm * BM + wr * 64 + fr, col0 = u.pn * BM + wc * 32 + 8 * fq; const int sel = (u.pn >= rs_split) ? 1 : 0;
#pragma unroll
        for (int i = 0; i < 8; ++i) { const int row = row0 + (i >> 2) * HALF + (i & 3) * 16; R.scr[i] = (rs ? rs[row * 2 + sel] : 1.f) * (sa ? sa[row] : 1.f); }
#pragma unroll
        for (int bj = 0; bj < 2; ++bj) { if (sb) { const u32x4* sp = (const u32x4*)(sb + (size_t)u.e * D_ + col0 + bj * HALF); const u32x4 a = sp[0], b = sp[1];
                R.cs[bj][0] = (f32x4){__uint_as_float(a.x), __uint_as_float(a.y), __uint_as_float(a.z), __uint_as_float(a.w)} * (1.0f / 127.f);
                R.cs[bj][1] = (f32x4){__uint_as_float(b.x), __uint_as_float(b.y), __uint_as_float(b.z), __uint_as_float(b.w)} * (1.0f / 127.f); }
            else { R.cs[bj][0] = (f32x4){1.f, 1.f, 1.f, 1.f}; R.cs[bj][1] = R.cs[bj][0]; } }
    }
    __device__ __forceinline__ void operator()(const f32x4 (&acc)[2][2][4][2], const Unit& u, int wr, int wc, int fr, int fq, const Regs& R) const {
        if (u.ks >= 0) {
            float* pp = part + ((size_t)(u.tu * 4 + u.ks) * BM + wr * 64 + fr) * BM + wc * 32 + 8 * fq;
#pragma unroll
            for (int ai = 0; ai < 2; ++ai)
#pragma unroll
                for (int m = 0; m < 4; ++m)
#pragma unroll
                    for (int bj = 0; bj < 2; ++bj)
#pragma unroll
                        for (int n = 0; n < 2; ++n) *(f32x4*)(pp + (size_t)(ai * HALF + m * 16) * BM + bj * HALF + 4 * n) = acc[ai][bj][m][n];
            if (wr == 0 && wc == 0 && fr == 0 && fq == 0) tailidx[u.pm * 8 + u.pn] = u.tu;
            return;
        }
        const int row0 = u.pm * BM + wr * 64 + fr, col0 = u.pn * BM + wc * 32 + 8 * fq;
        const int sel = (u.pn >= rs_split) ? 1 : 0;
#pragma unroll
        for (int ai = 0; ai < 2; ++ai)
#pragma unroll
            for (int m = 0; m < 4; ++m) { const int row = row0 + ai * HALF + m * 16; bf16_t* rowp = O + (size_t)row * ldc + col0;
                const float sc = R.scr[ai * 4 + m];
#pragma unroll
                for (int bj = 0; bj < 2; ++bj) { f32x4 v0 = acc[ai][bj][m][0] * sc, v1 = acc[ai][bj][m][1] * sc;
                    if (sb) { v0 *= R.cs[bj][0]; v1 *= R.cs[bj][1]; }
                    u32x4 w; w.x = cvt_pk_bf16(v0[0], v0[1]); w.y = cvt_pk_bf16(v0[2], v0[3]); w.z = cvt_pk_bf16(v1[0], v1[1]); w.w = cvt_pk_bf16(v1[2], v1[3]);
                    *(u32x4*)(rowp + bj * HALF) = w; } }
    }
};
struct EpiResGate {
    static constexpr bool PERM = false;
    float* out; const float* res_ctx; const float* res_lat; const float* gate_ctx; const float* gate_lat; int rowbase; float* part;
    const float* sa; const unsigned* sb;
    struct Regs { float ra[8]; };
    __device__ __forceinline__ void pre(Regs& R, const Unit& u, int wr, int wc, int fr, int fq) const {
        const int r0 = u.pm * BM + wr * 64 + fr;
#pragma unroll
        for (int i = 0; i < 8; ++i) R.ra[i] = sa ? sa[r0 + (i >> 2) * HALF + (i & 3) * 16] : 1.f;
    }
    __device__ __forceinline__ void operator()(const f32x4 (&acc)[2][2][4][2], const Unit& u, int wr, int wc, int fr, int fq, const Regs& R) const {
        const int row0 = rowbase + u.pm * BM + wr * 64 + fr, col0 = u.pn * BM + wc * 32 + 4 * fq;
        f32x4 cs[2][2];
#pragma unroll
        for (int bj = 0; bj < 2; ++bj)
#pragma unroll
            for (int n = 0; n < 2; ++n) { if (sb) { const unsigned* sp = sb + col0 + bj * HALF + n * 16; cs[bj][n] = (f32x4){__uint_as_float(sp[0]), __uint_as_float(sp[1]), __uint_as_float(sp[2]), __uint_as_float(sp[3])} * (1.0f / 127.f); }
                else cs[bj][n] = (f32x4){1.f, 1.f, 1.f, 1.f}; }
        if (u.ks >= 0) {
            float* pp = part + ((size_t)u.ks * LC + wr * 64 + fr) * D_ + col0;
#pragma unroll
            for (int ai = 0; ai < 2; ++ai)
#pragma unroll
                for (int m = 0; m < 4; ++m)
#pragma unroll
                    for (int bj = 0; bj < 2; ++bj)
#pragma unroll
                        for (int n = 0; n < 2; ++n) *(f32x4*)(pp + (size_t)(ai * HALF + m * 16) * D_ + bj * HALF + n * 16) = acc[ai][bj][m][n] * cs[bj][n] * R.ra[ai * 4 + m];
            return;
        }
        f32x4 g4[2][2];
#pragma unroll
        for (int bj = 0; bj < 2; ++bj)
#pragma unroll
            for (int n = 0; n < 2; ++n) g4[bj][n] = *(const f32x4*)(gate_lat + col0 + bj * HALF + n * 16) * cs[bj][n];
#pragma unroll
        for (int hb = 0; hb < 4; ++hb) { f32x4 r4[2][2][2];
#pragma unroll
            for (int mm = 0; mm < 2; ++mm) { const int ai = hb >> 1, m = (hb & 1) * 2 + mm; const float* rp = res_lat + (size_t)(row0 + ai * HALF + m * 16 - LC) * D_;
#pragma unroll
                for (int bj = 0; bj < 2; ++bj)
#pragma unroll
                    for (int n = 0; n < 2; ++n) r4[mm][bj][n] = *(const f32x4*)(rp + col0 + bj * HALF + n * 16); }
#pragma unroll
            for (int mm = 0; mm < 2; ++mm) { const int ai = hb >> 1, m = (hb & 1) * 2 + mm; float* op = out + (size_t)(row0 + ai * HALF + m * 16) * D_;
#pragma unroll
                for (int bj = 0; bj < 2; ++bj)
#pragma unroll
                    for (int n = 0; n < 2; ++n) *(f32x4*)(op + col0 + bj * HALF + n * 16) = r4[mm][bj][n] + g4[bj][n] * (acc[ai][bj][m][n] * R.ra[ai * 4 + m]); } }
    }
};
struct EpiSwiGLU {
    static constexpr bool PERM = true;
    bf16_t* O; int ldc; const float* sa; const unsigned* sb; unsigned* rmax;
    struct Regs { float rav[8]; u32x4 sg[2], su[2]; };
    __device__ __forceinline__ void pre(Regs& R, const Unit& u, int wr, int wc, int fr, int fq) const {
        const int row0 = u.pm * BM + wr * 64 + fr;
#pragma unroll
        for (int i = 0; i < 8; ++i) R.rav[i] = sa ? sa[row0 + (i >> 2) * HALF + (i & 3) * 16] : 1.f;
        if (sb) { const unsigned* sp = sb + (size_t)u.e * (2 * DFF) + u.pn * BM + wc * 32 + 8 * fq;
            R.sg[0] = *(const u32x4*)sp; R.sg[1] = *(const u32x4*)(sp + 4); R.su[0] = *(const u32x4*)(sp + HALF); R.su[1] = *(const u32x4*)(sp + HALF + 4); }
    }
    __device__ __forceinline__ void operator()(const f32x4 (&acc)[2][2][4][2], const Unit& u, int wr, int wc, int fr, int fq, const Regs& R) const {
        const int row0 = u.pm * BM + wr * 64 + fr, col0 = u.pn * HALF + wc * 32 + 8 * fq;
        float sg[8], su[8];
#pragma unroll
        for (int j = 0; j < 8; ++j) { sg[j] = 1.f; su[j] = 1.f; }
        if (sb) {
#pragma unroll
            for (int j = 0; j < 8; ++j) { sg[j] = __uint_as_float(R.sg[j >> 2][j & 3]) * (1.0f / 127.f); su[j] = __uint_as_float(R.su[j >> 2][j & 3]) * (1.0f / 127.f); } }
#pragma unroll
        for (int ai = 0; ai < 2; ++ai)
#pragma unroll
            for (int m = 0; m < 4; ++m) { const int row = row0 + ai * HALF + m * 16; bf16_t* rowp = O + (size_t)row * ldc + col0;
                const float ra = R.rav[ai * 4 + m];
                float o[8];
#pragma unroll
                for (int n = 0; n < 2; ++n)
#pragma unroll
                    for (int j = 0; j < 4; ++j) { const float gte = acc[ai][0][m][n][j] * (ra * sg[n * 4 + j]), up = acc[ai][1][m][n][j] * (ra * su[n * 4 + j]); o[n * 4 + j] = gte * __builtin_amdgcn_rcpf(1.f + __expf(-gte)) * up; }
                *(u32x4*)rowp = pack8(o);
                if (rmax) { float mx = fmaxf(fmaxf(fmaxf(fabsf(o[0]), fabsf(o[1])), fmaxf(fabsf(o[2]), fabsf(o[3]))), fmaxf(fmaxf(fabsf(o[4]), fabsf(o[5])), fmaxf(fabsf(o[6]), fabsf(o[7]))));
                    const int ln = otid() & 63; mx = fmaxf(mx, shflx(mx, 16, ln)); mx = fmaxf(mx, shflx(mx, 32, ln));
                    if (fq == 0) atomicMax(rmax + row, __float_as_uint(mx)); } }
    }
};
}
#ifndef FFT_DEV_H
#define FFT_DEV_H
#ifndef FFT_HOST
#define FFT_FN __device__ __forceinline__
struct cpx { float x, y; };
FFT_FN void tw(float frac, float& c, float& s) { c = __builtin_amdgcn_cosf(frac); s = __builtin_amdgcn_sinf(frac); }
#else
#include <cmath>
#define FFT_FN static inline
struct cpx { float x, y; };
FFT_FN void tw(float frac, float& c, float& s) { c = (float)cos(6.283185307179586 * (double)frac); s = (float)sin(6.283185307179586 * (double)frac); }
#endif
#define ZP(i) ((i) + (((i) >> 6) << 2))
constexpr int FFT_N = 16384;
constexpr int FFT_ZN = FFT_N + 4 * (FFT_N / 64);

FFT_FN void bf_dif(cpx& a, cpx& b, float c, float s) {
    const float dx = a.x - b.x, dy = a.y - b.y;
    a.x += b.x; a.y += b.y;
    b.x = dx * c + dy * s; b.y = dy * c - dx * s;
}
FFT_FN void bf_dit(cpx& a, cpx& b, float c, float s) {
    const float tx = b.x * c - b.y * s, ty = b.x * s + b.y * c;
    b.x = a.x - tx; b.y = a.y - ty; a.x += tx; a.y += ty;
}
template <int K16> FFT_FN void rot16(float c0, float s0, float& c, float& s) {
    constexpr float CR[16] = {1.f, 0.9238795325112867f, 0.7071067811865476f, 0.3826834323650898f, 0.f, -0.3826834323650898f, -0.7071067811865476f, -0.9238795325112867f,
                              -1.f, -0.9238795325112867f, -0.7071067811865476f, -0.3826834323650898f, 0.f, 0.3826834323650898f, 0.7071067811865476f, 0.9238795325112867f};
    constexpr float SR[16] = {0.f, 0.3826834323650898f, 0.7071067811865476f, 0.9238795325112867f, 1.f, 0.9238795325112867f, 0.7071067811865476f, 0.3826834323650898f,
                              0.f, -0.3826834323650898f, -0.7071067811865476f, -0.9238795325112867f, -1.f, -0.9238795325112867f, -0.7071067811865476f, -0.3826834323650898f};
    constexpr float cr = CR[K16 & 15], sr = SR[K16 & 15];
    if constexpr ((K16 & 15) == 0) { c = c0; s = s0; }
    else if constexpr ((K16 & 15) == 4) { c = -s0; s = c0; }
    else if constexpr ((K16 & 15) == 8) { c = -c0; s = -s0; }
    else if constexpr ((K16 & 15) == 12) { c = s0; s = -c0; }
    else { c = c0 * cr - s0 * sr; s = s0 * cr + c0 * sr; }
}
#define FFT_BF(DIFDIT, ra, rb, K16, cb, sb) do { float _c, _s; rot16<K16>(cb, sb, _c, _s); DIFDIT(v[ra], v[rb], _c, _s); } while (0)
template <bool INV> FFT_FN void fft_pass16(cpx* Z, int g, int lm) {
    const int mp = 1 << lm, ilo = g & (mp - 1), ihi = g >> lm, base = (ihi << (lm + 4)) + ilo;
    const int zb = ZP(base), st = (lm >= 6) ? mp + (mp >> 4) : mp;
    cpx v[16];
#pragma unroll
    for (int r = 0; r < 16; ++r) v[r] = Z[zb + r * st];
#ifndef FFT_HOST
    const float th = __builtin_amdgcn_ldexpf((float)ilo, -(lm + 4));
#else
    const float th = (float)ilo / (float)(16 * mp);
#endif
    float cA, sA, cB, sB, cC, sC, cD, sD;
    tw(th, cA, sA); tw(2.f * th, cB, sB); tw(4.f * th, cC, sC); tw(8.f * th, cD, sD);
    if (!INV) {
        FFT_BF(bf_dif, 0, 8, 0, cA, sA); FFT_BF(bf_dif, 1, 9, 1, cA, sA); FFT_BF(bf_dif, 2, 10, 2, cA, sA); FFT_BF(bf_dif, 3, 11, 3, cA, sA);
        FFT_BF(bf_dif, 4, 12, 4, cA, sA); FFT_BF(bf_dif, 5, 13, 5, cA, sA); FFT_BF(bf_dif, 6, 14, 6, cA, sA); FFT_BF(bf_dif, 7, 15, 7, cA, sA);
        FFT_BF(bf_dif, 0, 4, 0, cB, sB); FFT_BF(bf_dif, 1, 5, 2, cB, sB); FFT_BF(bf_dif, 2, 6, 4, cB, sB); FFT_BF(bf_dif, 3, 7, 6, cB, sB);
        FFT_BF(bf_dif, 8, 12, 0, cB, sB); FFT_BF(bf_dif, 9, 13, 2, cB, sB); FFT_BF(bf_dif, 10, 14, 4, cB, sB); FFT_BF(bf_dif, 11, 15, 6, cB, sB);
        FFT_BF(bf_dif, 0, 2, 0, cC, sC); FFT_BF(bf_dif, 1, 3, 4, cC, sC); FFT_BF(bf_dif, 4, 6, 0, cC, sC); FFT_BF(bf_dif, 5, 7, 4, cC, sC);
        FFT_BF(bf_dif, 8, 10, 0, cC, sC); FFT_BF(bf_dif, 9, 11, 4, cC, sC); FFT_BF(bf_dif, 12, 14, 0, cC, sC); FFT_BF(bf_dif, 13, 15, 4, cC, sC);
#pragma unroll
        for (int r = 0; r < 16; r += 2) bf_dif(v[r], v[r + 1], cD, sD);
    } else {
#pragma unroll
        for (int r = 0; r < 16; r += 2) bf_dit(v[r], v[r + 1], cD, sD);
        FFT_BF(bf_dit, 0, 2, 0, cC, sC); FFT_BF(bf_dit, 1, 3, 4, cC, sC); FFT_BF(bf_dit, 4, 6, 0, cC, sC); FFT_BF(bf_dit, 5, 7, 4, cC, sC);
        FFT_BF(bf_dit, 8, 10, 0, cC, sC); FFT_BF(bf_dit, 9, 11, 4, cC, sC); FFT_BF(bf_dit, 12, 14, 0, cC, sC); FFT_BF(bf_dit, 13, 15, 4, cC, sC);
        FFT_BF(bf_dit, 0, 4, 0, cB, sB); FFT_BF(bf_dit, 1, 5, 2, cB, sB); FFT_BF(bf_dit, 2, 6, 4, cB, sB); FFT_BF(bf_dit, 3, 7, 6, cB, sB);
        FFT_BF(bf_dit, 8, 12, 0, cB, sB); FFT_BF(bf_dit, 9, 13, 2, cB, sB); FFT_BF(bf_dit, 10, 14, 4, cB, sB); FFT_BF(bf_dit, 11, 15, 6, cB, sB);
        FFT_BF(bf_dit, 0, 8, 0, cA, sA); FFT_BF(bf_dit, 1, 9, 1, cA, sA); FFT_BF(bf_dit, 2, 10, 2, cA, sA); FFT_BF(bf_dit, 3, 11, 3, cA, sA);
        FFT_BF(bf_dit, 4, 12, 4, cA, sA); FFT_BF(bf_dit, 5, 13, 5, cA, sA); FFT_BF(bf_dit, 6, 14, 6, cA, sA); FFT_BF(bf_dit, 7, 15, 7, cA, sA);
    }
#pragma unroll
    for (int r = 0; r < 16; ++r) Z[zb + r * st] = v[r];
}
template <bool INV> FFT_FN void fft_pass4(cpx* Z, int g) {
    const int base = 4 * g;
#ifndef FFT_HOST
    typedef float f4_t __attribute__((ext_vector_type(4)));
    f4_t* zv = (f4_t*)(Z + ZP(base)); const f4_t q0 = zv[0], q1 = zv[1];
    cpx a = {q0[0], q0[1]}, b = {q0[2], q0[3]}, c = {q1[0], q1[1]}, d = {q1[2], q1[3]};
#else
    cpx a = Z[ZP(base)], b = Z[ZP(base + 1)], c = Z[ZP(base + 2)], d = Z[ZP(base + 3)];
#endif
    if (!INV) {
        cpx a2 = {a.x + c.x, a.y + c.y}, c2 = {a.x - c.x, a.y - c.y};
        cpx b2 = {b.x + d.x, b.y + d.y}, t = {b.x - d.x, b.y - d.y}; cpx d2 = {t.y, -t.x};
        a = {a2.x + b2.x, a2.y + b2.y}; b = {a2.x - b2.x, a2.y - b2.y};
        c = {c2.x + d2.x, c2.y + d2.y}; d = {c2.x - d2.x, c2.y - d2.y};
    } else {
        cpx a2 = {a.x + b.x, a.y + b.y}, b2 = {a.x - b.x, a.y - b.y};
        cpx c2 = {c.x + d.x, c.y + d.y}, d2 = {c.x - d.x, c.y - d.y};
        a = {a2.x + c2.x, a2.y + c2.y}; c = {a2.x - c2.x, a2.y - c2.y};
        cpx t = {-d2.y, d2.x};
        b = {b2.x + t.x, b2.y + t.y}; d = {b2.x - t.x, b2.y - t.y};
    }
#ifndef FFT_HOST
    zv[0] = (f4_t){a.x, a.y, b.x, b.y}; zv[1] = (f4_t){c.x, c.y, d.x, d.y};
#else
    Z[ZP(base)] = a; Z[ZP(base + 1)] = b; Z[ZP(base + 2)] = c; Z[ZP(base + 3)] = d;
#endif
}
FFT_FN int rev14(int p) {
#ifndef FFT_HOST
    return (int)(__builtin_bitreverse32((unsigned)p) >> 18);
#else
    int r = 0; for (int b = 0; b < 14; ++b) r |= ((p >> b) & 1) << (13 - b); return r;
#endif
}
FFT_FN int ilog2(int q) {
#ifndef FFT_HOST
    return 31 - __builtin_clz((unsigned)q);
#else
    int b = 0; while ((1 << (b + 1)) <= q) ++b; return b;
#endif
}
FFT_FN void fft_pw_idx(int q, int& pp, int& pq) { if (q == 0) { pp = 0; pq = 1; return; } const int b = ilog2(q); pp = (2 << b) + (q - (1 << b)); pq = 3 * (2 << b) - 1 - pp; }
FFT_FN void fft_pointwise_pre(cpx* Z, const cpx HA, const cpx HB, int q) {
    if (q == 0) {
        { const cpx a = Z[ZP(0)]; Z[ZP(0)] = cpx{a.x * HA.x + a.y * HA.y, a.x * HA.y + a.y * HA.x}; }
        { const cpx a = Z[ZP(1)]; Z[ZP(1)] = cpx{a.x * HB.x - a.y * HB.y, a.x * HB.y + a.y * HB.x}; }
        return;
    }
    const int b = ilog2(q), pp = (2 << b) + (q - (1 << b)), pq = 3 * (2 << b) - 1 - pp;
    const int kk = rev14(pp);
    float wc, ws; tw((float)kk * (1.0f / (float)FFT_N), wc, ws);
    const cpx A = Z[ZP(pp)], B = Z[ZP(pq)];
    const cpx Ue = {0.5f * (A.x + B.x), 0.5f * (A.y - B.y)};
    const cpx dU = {A.x - B.x, A.y + B.y};
    const cpx Uo = {0.5f * dU.y, -0.5f * dU.x};
    const cpx He = {0.5f * (HA.x + HB.x), 0.5f * (HA.y - HB.y)};
    const cpx dH = {HA.x - HB.x, HA.y + HB.y};
    const cpx Ho = {0.5f * dH.y, -0.5f * dH.x};
    const cpx UoHo = {Uo.x * Ho.x - Uo.y * Ho.y, Uo.x * Ho.y + Uo.y * Ho.x};
    const cpx wUH = {wc * UoHo.x + ws * UoHo.y, wc * UoHo.y - ws * UoHo.x};
    const cpx Ye = {Ue.x * He.x - Ue.y * He.y + wUH.x, Ue.x * He.y + Ue.y * He.x + wUH.y};
    const cpx Yo = {Ue.x * Ho.x - Ue.y * Ho.y + Uo.x * He.x - Uo.y * He.y, Ue.x * Ho.y + Ue.y * Ho.x + Uo.x * He.y + Uo.y * He.x};
    cpx o1 = {Ye.x - Yo.y, Ye.y + Yo.x};
    cpx o2 = {Ye.x + Yo.y, -Ye.y + Yo.x};
    Z[ZP(pp)] = o1; Z[ZP(pq)] = o2;
}
FFT_FN void fft_pointwise(cpx* Z, const cpx* Zh, int q) {
    if (q == 0) {
#pragma unroll
        for (int p0 = 0; p0 < 2; ++p0) {
            const cpx a = Z[ZP(p0)], h = Zh[p0];
            const float ue = a.x, uo = a.y, he = h.x, ho = h.y, sg = p0 ? -1.f : 1.f;
            cpx o = {ue * he + sg * uo * ho, ue * ho + uo * he};
            Z[ZP(p0)] = o;
        }
        return;
    }
    const int b = ilog2(q), pp = (2 << b) + (q - (1 << b)), pq = 3 * (2 << b) - 1 - pp;
    const int kk = rev14(pp);
    float wc, ws; tw((float)kk * (1.0f / (float)FFT_N), wc, ws);
    const cpx A = Z[ZP(pp)], B = Z[ZP(pq)], HA = Zh[pp], HB = Zh[pq];
    const cpx Ue = {0.5f * (A.x + B.x), 0.5f * (A.y - B.y)};
    const cpx dU = {A.x - B.x, A.y + B.y};
    const cpx Uo = {0.5f * dU.y, -0.5f * dU.x};
    const cpx He = {0.5f * (HA.x + HB.x), 0.5f * (HA.y - HB.y)};
    const cpx dH = {HA.x - HB.x, HA.y + HB.y};
    const cpx Ho = {0.5f * dH.y, -0.5f * dH.x};
    const cpx UoHo = {Uo.x * Ho.x - Uo.y * Ho.y, Uo.x * Ho.y + Uo.y * Ho.x};
    const cpx wUH = {wc * UoHo.x + ws * UoHo.y, wc * UoHo.y - ws * UoHo.x};
    const cpx Ye = {Ue.x * He.x - Ue.y * He.y + wUH.x, Ue.x * He.y + Ue.y * He.x + wUH.y};
    const cpx Yo = {Ue.x * Ho.x - Ue.y * Ho.y + Uo.x * He.x - Uo.y * He.y, Ue.x * Ho.y + Ue.y * Ho.x + Uo.x * He.y + Uo.y * He.x};
    cpx o1 = {Ye.x - Yo.y, Ye.y + Yo.x};
    cpx o2 = {Ye.x + Yo.y, -Ye.y + Yo.x};
    Z[ZP(pp)] = o1; Z[ZP(pq)] = o2;
}
#endif
template <class F> __device__ __forceinline__ void tconv_tile(const F& f, bf16_t* dst, int K, int k0, int n0, float* tile  , int lane) {
    f32x4 v[16];
    const int n4 = (lane & 15) * 4, kr = lane >> 4;
#pragma unroll
    for (int i = 0; i < 16; ++i) v[i] = f.ld4(k0 + kr + 4 * i, n0 + n4);
#pragma unroll
    for (int i = 0; i < 16; ++i) { float* t = tile + (kr + 4 * i) * 65 + n4; t[0] = v[i][0]; t[1] = v[i][1]; t[2] = v[i][2]; t[3] = v[i][3]; }
    __builtin_amdgcn_fence(__ATOMIC_RELEASE, "wavefront"); __builtin_amdgcn_wave_barrier(); __builtin_amdgcn_fence(__ATOMIC_ACQUIRE, "wavefront");
    const int kq = (lane & 7) * 8, nr = lane >> 3;
#pragma unroll
    for (int i = 0; i < 8; ++i) { const int nn = nr + 8 * i; float o[8];
#pragma unroll
        for (int e = 0; e < 8; ++e) o[e] = tile[(kq + e) * 65 + nn];
        *(u32x4*)(dst + (size_t)(n0 + nn) * K + k0 + kq) = pack8(o); }
    __builtin_amdgcn_fence(__ATOMIC_RELEASE, "wavefront"); __builtin_amdgcn_wave_barrier(); __builtin_amdgcn_fence(__ATOMIC_ACQUIRE, "wavefront");
}
__device__ __forceinline__ int in_src_col(int n) {
    if (n < 2048) return n;
    if (n < 3584) return 2704 + (n - 2048);
    if (n < 5120) return 4240 + (n - 3584);
    if (n < 5632) return 5776 + (n - 5120);
    if (n < 6080) return 2064 + (n - 5632);
    if (n < 6144) return -1;
    if (n < 6272) return 2512 + (n - 6144);
    if (n < 6336) return 2640 + (n - 6272);
    if (n < 6344) return 2048 + (n - 6336);
    if (n < 6352) return 2056 + (n - 6344);
    return -1;
}
struct FWin { const float* src;
    __device__ __forceinline__ f32x4 ld4(int k, int n) const {
        if (n < 6336) { const int c = in_src_col(n); return c < 0 ? (f32x4){0.f, 0.f, 0.f, 0.f} : *(const f32x4*)(src + (size_t)k * DIN + c); }
        f32x4 r;
#pragma unroll
        for (int e = 0; e < 4; ++e) { const int c = in_src_col(n + e); r[e] = c < 0 ? 0.f : src[(size_t)k * DIN + c]; }
        return r; } };
struct FPlain { const float* src; int ld; __device__ __forceinline__ f32x4 ld4(int k, int n) const { return *(const f32x4*)(src + (size_t)k * ld + n); } };
struct FMla { const float *uq, *ukv, *qn, *kvn;
    __device__ __forceinline__ f32x4 ld4(int k, int n) const {
        if (n < 768) { if (k >= 448) return (f32x4){0.f, 0.f, 0.f, 0.f}; return *(const f32x4*)(uq + (size_t)k * 768 + n) * qn[k]; }
        if (k < 512) return (f32x4){0.f, 0.f, 0.f, 0.f};
        return *(const f32x4*)(ukv + (size_t)(k - 512) * 1024 + (n - 768)) * kvn[k - 512]; } };
struct FW13 { const float *w1, *w3;
    __device__ __forceinline__ f32x4 ld4(int k, int n) const { const int col = (n >> 8) * 128 + (n & 127);
        const uintptr_t d = (uintptr_t)w3 - (uintptr_t)w1; const float* b = (const float*)((uintptr_t)w1 + (((n >> 7) & 1) ? d : (uintptr_t)0));
        return *(const f32x4*)(b + (size_t)k * DFF + col); } };

constexpr int T_WIN = (NP / 64) * (D_ / 64), T_WOUT = 32 * 32, T_MLA = (MLAN / 64) * (MLAK / 64), T_F13 = (2 * DFF / 64) * 32, T_F2 = 32 * (DFF / 64);
constexpr int U_MOD = 96, U_HF = 516, U_TR = 2 * T_WOUT + 2 * T_MLA;
constexpr int XBW_OFF_ = 147456 - 16;
constexpr int U_WABS_IN = 2 * (NP / 32);
constexpr int U_TRB = (U_TR + 7) / 8;
constexpr int U_S13 = 2 * (DFF / 32), U_S2 = D_ / 16, U_SBIG = 9 * U_S2, U_SSMALL = 9 * U_S13;
constexpr int U_STREAM = U_MOD + U_SBIG + U_SSMALL + U_WABS_IN + U_TRB, U_QTOT = U_HF + U_STREAM, Q_STRIDE = 9;

__device__ __forceinline__ void pro_mod_unit(const Params& p, int u, float* lds) {
    const int tid = otid(), wid = tid >> 6, lane = tid & 63;
    const int l = u / 48, cb = u % 48, col = cb * 256 + lane * 4;
    const float* W = p.in[I_MODW] + (size_t)l * D_ * (6 * D_) + col;
    const float* c = p.in[I_C]; const float* cc = p.in[I_CCTX];
    f32x4 al = {0, 0, 0, 0}, ac = {0, 0, 0, 0};
    const int k0 = wid * 256;
#pragma unroll 16
    for (int k = k0; k < k0 + 256; ++k) {
        const f32x4 w4 = *(const f32x4*)(W + (size_t)k * (6 * D_));
        const float sl = silu_f(c[k]), sc = silu_f(cc[k]);
        al += w4 * sl; ac += w4 * sc;
    }
    f32x4* red = (f32x4*)lds;
    red[(wid * 64 + lane) * 2] = al; red[(wid * 64 + lane) * 2 + 1] = ac;
    __syncthreads();
    if (wid == 0) {
        f32x4 sl = {0, 0, 0, 0}, sc = {0, 0, 0, 0};
#pragma unroll
        for (int w = 0; w < 8; ++w) { sl += red[(w * 64 + lane) * 2]; sc += red[(w * 64 + lane) * 2 + 1]; }
        const f32x4 b4 = *(const f32x4*)(p.in[I_MODB] + (size_t)l * 6 * D_ + col);
        *(f32x4*)(p.modv() + ((size_t)l * 2 + 0) * 6 * D_ + col) = sl + b4;
        *(f32x4*)(p.modv() + ((size_t)l * 2 + 1) * 6 * D_ + col) = sc + b4;
    }
    __syncthreads();
}

__device__ __forceinline__ void pro_hfilt_unit(const Params& p, int l, int Lf, int tb, float* hout, float* hsumo, float* lds) {
    const int tid = otid(), wid = tid >> 6, lane = tid & 63;
    float* zb = lds;
    float* H1 = lds + 64 * 36;
    float* H2 = H1 + 64 * 68;
    float* tl = H2 + 64 * 68 + wid * (64 * 33);
    const int t0 = tb * 64;
    const float* w1 = p.in[I_HW1] + (size_t)l * 33 * 64; const float* b1 = p.in[I_HB1] + l * 64;
    const float* w2 = p.in[I_HW2] + (size_t)l * 64 * 64; const float* b2 = p.in[I_HB2] + l * 64;
    const float* w3 = p.in[I_HW3] + (size_t)l * 64 * 64; const float* b3 = p.in[I_HB3] + l * 64;
    const float* w4 = p.in[I_HW4] + (size_t)l * 64 * 1024; const float* fq = p.in[I_HFREQ] + l * 64;
    {
        const int tp = lane, part = wid; const float pf = (float)(t0 + tp);
        const float c0 = (float)(6.283185307179586 / (double)Lf);
#pragma unroll 1
        for (int e = part; e < 33; e += 8) {
            float v;
            if (e == 0) v = pf / (float)(Lf - 1);
            else { const int b = (e - 1) & 15; const float fr = 1e-4f + (float)b * ((15.0f - 1e-4f) / 15.0f); const float ang = (c0 * pf) * fr; v = (e <= 16) ? cosf(ang) : -sinf(ang); }
            zb[tp * 36 + e] = v;
        }
    }
    __syncthreads();
    {   const int tp = lane, j0 = wid * 8; float s[8];
#pragma unroll
        for (int jj = 0; jj < 8; ++jj) s[jj] = b1[j0 + jj];
#pragma unroll 3
        for (int e = 0; e < 33; ++e) { const float z = zb[tp * 36 + e];
#pragma unroll
            for (int jj = 0; jj < 8; ++jj) s[jj] += z * w1[e * 64 + j0 + jj]; }
#pragma unroll 1
        for (int jj = 0; jj < 8; ++jj) H1[tp * 68 + j0 + jj] = sinf(fq[j0 + jj] * s[jj]);
    }
    __syncthreads();
    {   const int tp = lane, j0 = wid * 8; float s[8];
#pragma unroll
        for (int jj = 0; jj < 8; ++jj) s[jj] = b2[j0 + jj];
#pragma unroll 4
        for (int i = 0; i < 64; ++i) { const float z = H1[tp * 68 + i];
#pragma unroll
            for (int jj = 0; jj < 8; ++jj) s[jj] += z * w2[i * 64 + j0 + jj]; }
#pragma unroll 1
        for (int jj = 0; jj < 8; ++jj) H2[tp * 68 + j0 + jj] = sinf(fq[j0 + jj] * s[jj]);
    }
    __syncthreads();
    {   const int tp = lane, j0 = wid * 8; float s[8];
#pragma unroll
        for (int jj = 0; jj < 8; ++jj) s[jj] = b3[j0 + jj];
#pragma unroll 4
        for (int i = 0; i < 64; ++i) { const float z = H2[tp * 68 + i];
#pragma unroll
            for (int jj = 0; jj < 8; ++jj) s[jj] += z * w3[i * 64 + j0 + jj]; }
        __syncthreads();
#pragma unroll 1
        for (int jj = 0; jj < 8; ++jj) H1[tp * 68 + j0 + jj] = sinf(fq[j0 + jj] * s[jj]);
    }
    __syncthreads();
    const int nblk = Lf / 64;
#pragma unroll 1
    for (int i = 0; i < 2; ++i) {
        const int cg = wid + 8 * i, c = cg * 64 + lane;
        float wreg[64];
#pragma unroll
        for (int j = 0; j < 64; ++j) wreg[j] = w4[j * 1024 + c];
        const float a0 = -120.39728043259361f, a1 = 40.546510810816436f;
        const float delta = fabsf(a0 + (float)c * ((a1 - a0) / 1023.0f));
        float asum = 0.f; const float rLf = 1.0f / (float)Lf;
#pragma unroll 1
        for (int hh = 0; hh < 2; ++hh) {
#pragma unroll 2
            for (int tq = 0; tq < 32; ++tq) { const int tp = hh * 32 + tq;
                float s = 0.f;
#pragma unroll
                for (int j4 = 0; j4 < 16; ++j4) { const f32x4 h4 = *(const f32x4*)(H1 + tp * 68 + 4 * j4);
                    s += h4[0] * wreg[4 * j4] + h4[1] * wreg[4 * j4 + 1] + h4[2] * wreg[4 * j4 + 2] + h4[3] * wreg[4 * j4 + 3]; }
                const float pf = (float)(t0 + tp), dist = fabsf(pf - (float)(Lf / 2)) * rLf;
                const float val = s * expf(-dist * delta);
                tl[lane * 33 + tq] = val; asum += fabsf(val);
            }
            __builtin_amdgcn_fence(__ATOMIC_RELEASE, "wavefront"); __builtin_amdgcn_wave_barrier(); __builtin_amdgcn_fence(__ATOMIC_ACQUIRE, "wavefront");
#pragma unroll
            for (int ps = 0; ps < 2; ++ps) { const int rr = (lane >> 1) + 32 * ps, tq0 = (lane & 1) * 16;
                float* dst = hout + (size_t)(cg * 64 + rr) * Lf + t0 + hh * 32 + tq0;
#pragma unroll
                for (int k = 0; k < 4; ++k) { f32x4 v;
#pragma unroll
                    for (int e = 0; e < 4; ++e) v[e] = tl[rr * 33 + tq0 + 4 * k + e];
                    *(f32x4*)(dst + 4 * k) = v; } }
            __builtin_amdgcn_fence(__ATOMIC_RELEASE, "wavefront"); __builtin_amdgcn_wave_barrier(); __builtin_amdgcn_fence(__ATOMIC_ACQUIRE, "wavefront");
        }
        hsumo[(size_t)c * nblk + tb] = asum;
    }
    __syncthreads();
}

template <class M> __device__ __forceinline__ void wabs_unit(const float* src, int ld, int c0, int k0, unsigned* wam, const M& map, float* lds) {
    const int tid = otid(), wid = tid >> 6, lane = tid & 63;
    const float* sp = src + (size_t)(k0 + wid * 64) * ld + c0 + lane * 4;
    f32x4 m4 = {0.f, 0.f, 0.f, 0.f};
#pragma unroll 8
    for (int k = 0; k < 64; ++k) { const f32x4 v = *(const f32x4*)(sp + (size_t)k * ld); m4 = __builtin_elementwise_max(m4, __builtin_elementwise_abs(v)); }
    f32x4* red = (f32x4*)lds; red[wid * 64 + lane] = m4;
    __syncthreads();
    if (wid == 0) {
#pragma unroll
        for (int w = 1; w < 8; ++w) m4 = __builtin_elementwise_max(m4, red[w * 64 + lane]);
#pragma unroll
        for (int e = 0; e < 4; ++e) atomicMax(wam + map(c0 + lane * 4 + e), __float_as_uint(m4[e]));
    }
    __syncthreads();
}
struct ColId { __device__ __forceinline__ int operator()(int n) const { return n; } };
struct ColWin { __device__ __forceinline__ int operator()(int n) const { return in_src_col(n); } };
template <int K, int NCH, class M, class C = ColId> __device__ __forceinline__ void strip_unit(const float* src, int ld, int n0, signed char* dst, unsigned* wam, const M& map, char* lds, const C& colmap = C()) {
    constexpr int LPR = NCH / 4, RPP = 512 / LPR, NPASS = K / RPP, KS = K + 16, CH = 8;
    static_assert(NPASS % 4 == 0 && NPASS % CH == 0 || NPASS % 4 == 0, "strip geometry");
    const int tid = otid(), wid = tid >> 6, lane = tid & 63, tr = tid / LPR, m = tid % LPR;
    const int c4 = colmap(n0 + m * 4); const bool zcol = c4 < 0;
    const float* sp = src + (size_t)(tr * 4) * ld + (c4 < 0 ? 0 : c4);
    unsigned pk[NPASS][2]; f32x4 m4 = {0.f, 0.f, 0.f, 0.f};
    constexpr int NCK = (NPASS + CH - 1) / CH;
    f32x4 v[2][CH];
#pragma unroll
    for (int j = 0; j < CH; ++j) v[0][j] = *(const f32x4*)(sp + (size_t)((j >> 2) * (4 * RPP) + (j & 3)) * ld);
#pragma unroll
    for (int ck = 0; ck < NCK; ++ck) {
        if (ck + 1 < NCK) {
#pragma unroll
            for (int j = 0; j < CH; ++j) { const int i = (ck + 1) * CH + j; if (i < NPASS) v[(ck + 1) & 1][j] = *(const f32x4*)(sp + (size_t)((i >> 2) * (4 * RPP) + (i & 3)) * ld); }
        }
        __builtin_amdgcn_sched_barrier(0);
#pragma unroll
        for (int j = 0; j < CH; ++j) { const int i = ck * CH + j; if (i < NPASS) { const f32x4 x = zcol ? (f32x4){0.f, 0.f, 0.f, 0.f} : v[ck & 1][j]; m4 = __builtin_elementwise_max(m4, __builtin_elementwise_abs(x)); pk[i][0] = cvt_pk_bf16(x[0], x[1]); pk[i][1] = cvt_pk_bf16(x[2], x[3]); } }
        __builtin_amdgcn_sched_barrier(0);
    }
    float* red = (float*)(lds + NCH * KS);
#pragma unroll
    for (int e = 0; e < 4; ++e) { float a = m4[e];
#pragma unroll
        for (int o = LPR; o < 64; o <<= 1) a = fmaxf(a, shflx(a, o, lane));
        m4[e] = a; }
    if (lane < LPR) *(f32x4*)(red + (wid * LPR + m) * 4) = m4;
    __syncthreads();
    f32x4 mx = *(const f32x4*)(red + m * 4);
#pragma unroll
    for (int w = 1; w < 8; ++w) mx = __builtin_elementwise_max(mx, *(const f32x4*)(red + (w * LPR + m) * 4));
    if (tid < LPR) {
#pragma unroll
        for (int e = 0; e < 4; ++e) wam[map(n0 + m * 4 + e)] = __float_as_uint(mx[e]); }
    float inv[4];
#pragma unroll
    for (int e = 0; e < 4; ++e) inv[e] = 127.f / fmaxf(mx[e], 1e-30f);
    {   char* wb = lds + (size_t)(m * 4) * KS + tr * 4;
#pragma unroll
        for (int g = 0; g < NPASS / 4; ++g) {
#pragma unroll
            for (int e = 0; e < 4; ++e) { unsigned acc = 0u;
#pragma unroll
                for (int q4 = 0; q4 < 4; ++q4) { const unsigned w = pk[4 * g + q4][e >> 1]; const float f = __uint_as_float((e & 1) ? (w & 0xffff0000u) : (w << 16));
                    acc |= (unsigned)((int)rintf(f * inv[e]) & 255) << (8 * q4); }
                *(unsigned*)(wb + e * KS + g * (4 * RPP)) = acc; }
        }
    }
    __syncthreads();
#pragma unroll 1
    for (int j = tid; j < NCH * (K / 16); j += 512) { const int c = j / (K / 16), ch = j % (K / 16);
        *(u32x4*)(dst + (size_t)map(n0 + c) * K + ch * 16) = *(const u32x4*)(lds + (size_t)c * KS + ch * 16); }
    __syncthreads();
}
template <class F> __device__ __forceinline__ void wabsf_unit(const F& f, int n0, int k0, unsigned* wam, float* lds) {
    const int tid = otid(), wid = tid >> 6, lane = tid & 63;
    f32x4 m4 = {0.f, 0.f, 0.f, 0.f};
#pragma unroll 8
    for (int k = 0; k < 64; ++k) { const f32x4 v = f.ld4(k0 + wid * 64 + k, n0 + lane * 4); m4 = __builtin_elementwise_max(m4, __builtin_elementwise_abs(v)); }
    f32x4* red = (f32x4*)lds; red[wid * 64 + lane] = m4;
    __syncthreads();
    if (wid == 0) {
#pragma unroll
        for (int w = 1; w < 8; ++w) m4 = __builtin_elementwise_max(m4, red[w * 64 + lane]);
#pragma unroll
        for (int e = 0; e < 4; ++e) atomicMax(wam + n0 + lane * 4 + e, __float_as_uint(m4[e]));
    }
    __syncthreads();
}
struct MapW13 { int which; __device__ __forceinline__ int operator()(int col) const { return (col >> 7) * 256 + which * 128 + (col & 127); } };
struct MapId { __device__ __forceinline__ int operator()(int col) const { return col; } };
template <class F> __device__ __forceinline__ void tconv8_tile(const F& f, signed char* dst, int K, int k0, int n0, const unsigned* wam, float* tile, int lane) {
    f32x4 v[16];
    const int n4 = (lane & 15) * 4, kr = lane >> 4;
#pragma unroll
    for (int i = 0; i < 16; ++i) v[i] = f.ld4(k0 + kr + 4 * i, n0 + n4);
#pragma unroll
    for (int i = 0; i < 16; ++i) { float* t = tile + (kr + 4 * i) * 65 + n4; t[0] = v[i][0]; t[1] = v[i][1]; t[2] = v[i][2]; t[3] = v[i][3]; }
    __builtin_amdgcn_fence(__ATOMIC_RELEASE, "wavefront"); __builtin_amdgcn_wave_barrier(); __builtin_amdgcn_fence(__ATOMIC_ACQUIRE, "wavefront");
    const int kq = (lane & 3) * 16, nr = lane >> 2;
#pragma unroll
    for (int i = 0; i < 4; ++i) { const int nn = nr + 16 * i; const float inv = 127.f / fmaxf(__uint_as_float(wam[n0 + nn]), 1e-30f);
        unsigned w[4];
#pragma unroll
        for (int g4 = 0; g4 < 4; ++g4) { unsigned acc = 0u;
#pragma unroll
            for (int e = 0; e < 4; ++e) { const int q = (int)rintf(tile[(kq + g4 * 4 + e) * 65 + nn] * inv); acc |= (unsigned)(q & 255) << (8 * e); }
            w[g4] = acc; }
        *(u32x4*)(dst + (size_t)(n0 + nn) * K + k0 + kq) = (u32x4){w[0], w[1], w[2], w[3]}; }
    __builtin_amdgcn_fence(__ATOMIC_RELEASE, "wavefront"); __builtin_amdgcn_wave_barrier(); __builtin_amdgcn_fence(__ATOMIC_ACQUIRE, "wavefront");
}
__device__ __forceinline__ void tr_unit(const Params& p, int v, float* tile, int lane) {
    if (v < 2 * T_WOUT) { const int l = v / T_WOUT, t = v % T_WOUT, nt = t / 32, kt = t % 32;
        FPlain f{p.in[I_WOUT] + (size_t)l * D_ * D_, D_}; tconv_tile(f, p.wb_out() + (size_t)l * D_ * D_, D_, kt * 64, nt * 64, tile, lane); return; }
    v -= 2 * T_WOUT;
    if (v < 2 * T_MLA) { const int l = v / T_MLA, t = v % T_MLA, nt = t / 10, kt = t % 10;
        FMla f{p.in[I_MUQ] + (size_t)l * 448 * 768, p.in[I_MUKV] + (size_t)l * 128 * 1024, p.in[I_MQN] + l * 448, p.in[I_MKVN] + l * 128};
        tconv_tile(f, p.wb_mla() + (size_t)l * MLAN * MLAK, MLAK, kt * 64, nt * 64, tile, lane); return; }
}
__device__ __forceinline__ void pro_stream_unit(const Params& p, int v, float* lds) {
    if (v < U_MOD) { pro_mod_unit(p, v, lds); return; }
    v -= U_MOD;
    if (v < U_SBIG) { const int set = v / U_S2, s = v % U_S2; MapId mp;
        const float* src = set == 0 ? p.in[I_FW2] : p.in[I_MW2] + (size_t)(set - 1) * DFF * D_;
        signed char* dst = set == 0 ? (signed char*)p.wb_f2() : (signed char*)p.wb_m2() + (size_t)(set - 1) * D_ * DFF;
        strip_unit<DFF, 16>(src, D_, s * 16, dst, p.wam() + (set == 0 ? WAM_F2 : WAM_M2 + (set - 1) * D_), mp, (char*)lds); return; }
    v -= U_SBIG;
    if (v < U_SSMALL) { const int set = v / U_S13, w = v % U_S13, which = w / (DFF / 32), s = w % (DFF / 32); MapW13 mp{which};
        const float* src = set == 0 ? p.in[which ? I_FW3 : I_FW1] : p.in[which ? I_MW3 : I_MW1] + (size_t)(set - 1) * D_ * DFF;
        signed char* dst = set == 0 ? (signed char*)p.wb_f13() : (signed char*)p.wb_m13() + (size_t)(set - 1) * 2 * DFF * D_;
        strip_unit<D_, 32>(src, DFF, s * 32, dst, p.wam() + (set == 0 ? WAM_F13 : WAM_M13 + (set - 1) * 2 * DFF), mp, (char*)lds); return; }
    v -= U_SSMALL;
    if (v < U_WABS_IN) { const int l = v / (NP / 32), s = v % (NP / 32); MapId mp; ColWin cw;
        strip_unit<D_, 32>(p.in[I_WIN] + (size_t)l * D_ * DIN, DIN, s * 32, (signed char*)p.wb_in() + (size_t)l * NP * D_, p.wam() + WAM_IN + l * NP, mp, (char*)lds, cw); return; }
    v -= U_WABS_IN;
    { const int tid = otid(), wid = tid >> 6, lane = tid & 63; float* tile = lds + wid * (64 * 68);
      if (v * 8 + wid < U_TR) tr_unit(p, v * 8 + wid, tile, lane);
      __syncthreads(); }
}
__device__ __forceinline__ void phase_prologue(const Params& p, float* lds) {
    static_assert((U_HF - 1) * Q_STRIDE < U_QTOT, "every filter unit needs a queue slot");
    unsigned* qctr = p.cnt() + 24; volatile LAS unsigned* qw = (volatile LAS unsigned*)(LAS unsigned char*)((unsigned char*)lds + XBW_OFF_ - 32);
#pragma unroll 1
    for (;;) {
        __syncthreads();
        if (otid() == 0) qw[0] = atomicAdd(qctr, 1u);
        __syncthreads();
        const int q = (int)qw[0];
        if (q >= U_QTOT) break;
        const int nf = (q + Q_STRIDE - 1) / Q_STRIDE, nfb = nf < U_HF ? nf : U_HF;
        if (q % Q_STRIDE == 0 && q / Q_STRIDE < U_HF) { const int u = q / Q_STRIDE;
            if (u < 512) { const int l = u >> 8, tb = u & 255; pro_hfilt_unit(p, l, SEQ, tb, p.hfilt() + (size_t)l * 1024 * SEQ, p.hsum() + (size_t)l * 1024 * 256, lds); }
            else pro_hfilt_unit(p, 0, LC, u - 512, p.hfc(), p.hsc(), lds); }
        else pro_stream_unit(p, q - nfb, lds);
    }
    __syncthreads();
}
__device__ __forceinline__ void f13q_unit(const Params& p, int v, float* tile, int lane) {
    const int nt = v / 32, kt = v % 32; FW13 f{p.in[I_FW1], p.in[I_FW3]}; tconv8_tile(f, (signed char*)p.wb_f13(), D_, kt * 64, nt * 64, p.wam() + WAM_F13, tile, lane);
}
__device__ __forceinline__ void f2q_unit(const Params& p, int v, float* tile, int lane) {
    const int nt = v / 88, kt = v % 88; FPlain f{p.in[I_FW2], D_}; tconv8_tile(f, (signed char*)p.wb_f2(), DFF, kt * 64, nt * 64, p.wam() + WAM_F2, tile, lane);
}
__device__ __forceinline__ void winq_unit(const Params& p, int v, float* tile, int lane) {
    const int l = v / T_WIN, t = v % T_WIN, nt = t / 32, kt = t % 32; FWin f{p.in[I_WIN] + (size_t)l * D_ * DIN};
    tconv8_tile(f, (signed char*)p.wb_in() + (size_t)l * NP * D_, D_, kt * 64, nt * 64, p.wam() + WAM_IN + l * NP, tile, lane);
}
constexpr int T_M13 = NEXP * T_F13, T_M2 = NEXP * T_F2, U_MOEW = T_M13 + T_M2;
__device__ __forceinline__ void moe_w_unit(const Params& p, int v, float* tile, int lane) {
    if (v < T_M13) { const int e = v / T_F13, t = v % T_F13, nt = t / 32, kt = t % 32;
        FW13 f{p.in[I_MW1] + (size_t)e * D_ * DFF, p.in[I_MW3] + (size_t)e * D_ * DFF};
        tconv8_tile(f, (signed char*)p.wb_m13() + (size_t)e * 2 * DFF * D_, D_, kt * 64, nt * 64, p.wam() + WAM_M13 + e * 2 * DFF, tile, lane); return; }
    v -= T_M13;
    { const int e = v / T_F2, t = v % T_F2, nt = t / 88, kt = t % 88;
      FPlain f{p.in[I_MW2] + (size_t)e * DFF * D_, D_};
      tconv8_tile(f, (signed char*)p.wb_m2() + (size_t)e * D_ * DFF, DFF, kt * 64, nt * 64, p.wam() + WAM_M2 + e * D_, tile, lane); }
}

__device__ __forceinline__ void phase_norm(const Params& p, int layer, int which, int row_lo, unsigned char* shm) {
    const int tid = otid(), wid = tid >> 6, lane = tid & 63;
    const float* nw = p.in[which == 1 ? I_N1W : I_N2W] + (size_t)layer * D_;
    const int csh = (which == 1 ? 0 : 3) * D_, csc = (which == 1 ? 1 : 4) * D_;
    const bool route = (layer == 1 && which == 2);
    unsigned* lcnt = (unsigned*)shm; unsigned* lbase = lcnt + 8; int* recE = (int*)(lcnt + 16); int* recP = recE + 128;
    int kk = 0;
    if (route) { if (tid < 8) lcnt[tid] = 0u; __syncthreads(); }
    for (int r = row_lo + blockIdx.x * 8 + wid; r < MT; r += gridDim.x * 8) {
        const bool isc = r < LC;
        const float* src = (layer == 0 && which == 1) ? (isc ? p.in[I_CTX] + (size_t)r * D_ : p.in[I_X] + (size_t)(r - LC) * D_)
                         : ((layer == 0 && isc) ? p.in[I_CTX] + (size_t)r * D_ : p.xcur() + (size_t)r * D_);
        const float* mv = p.modv() + ((size_t)layer * 2 + (isc ? 1 : 0)) * 6 * D_;
        const bool fixG = isc && layer == 0 && which == 2, fixF = isc && layer == 1 && which == 1;
        f32x4 xv[8]; float ss = 0.f;
#pragma unroll
        for (int i = 0; i < 8; ++i) { const int col = (i * 64 + lane) * 4; xv[i] = *(const f32x4*)(src + col);
            if (fixG || fixF) {
                const float* pp = (fixG ? p.partG() : p.partF()) + (size_t)r * D_ + col; const int ns = fixG ? 4 : 11;
                f32x4 a = {0.f, 0.f, 0.f, 0.f};
                for (int s2 = 0; s2 < ns; ++s2) a += *(const f32x4*)(pp + (size_t)s2 * LC * D_);
                const f32x4 g4 = *(const f32x4*)(p.modv() + ((size_t)(fixG ? 0 : 0) * 2 + 1) * 6 * D_ + (fixG ? 2 : 5) * D_ + col);
                xv[i] += g4 * a;
                if (fixG) *(f32x4*)(p.xcur() + (size_t)r * D_ + col) = xv[i];
            }
            ss += xv[i][0] * xv[i][0] + xv[i][1] * xv[i][1] + xv[i][2] * xv[i][2] + xv[i][3] * xv[i][3]; }
        ss = wave_sum(ss);
        const float rstd = rsqrtf(ss * (1.0f / D_) + EPS);
        float lg[NEXP];
#pragma unroll
        for (int e = 0; e < NEXP; ++e) lg[e] = 0.f;
        float qinv = 0.f;
        {   float am = 0.f;
#pragma unroll
            for (int i = 0; i < 8; ++i) { const int col = (i * 64 + lane) * 4;
                const f32x4 w4 = *(const f32x4*)(nw + col), sh = *(const f32x4*)(mv + csh + col), sc = *(const f32x4*)(mv + csc + col);
                xv[i] = (xv[i] * rstd) * w4 * (sc + 1.0f) + sh;
                am = fmaxf(am, fmaxf(fmaxf(fabsf(xv[i][0]), fabsf(xv[i][1])), fmaxf(fabsf(xv[i][2]), fabsf(xv[i][3])))); }
#pragma unroll
            for (int o = 32; o >= 1; o >>= 1) am = fmaxf(am, shflx(am, o, lane));
            am = fmaxf(am, 1e-20f); qinv = 127.f / am;
            if (lane == 0) p.hs()[r] = am * (1.0f / 127.f);
        }
#pragma unroll
        for (int i = 0; i < 8; ++i) { const int col = (i * 64 + lane) * 4;
            const f32x4 hv = xv[i];
            {
                const int q0 = (int)rintf(hv[0] * qinv), q1 = (int)rintf(hv[1] * qinv), q2 = (int)rintf(hv[2] * qinv), q3 = (int)rintf(hv[3] * qinv);
                *(unsigned*)((char*)p.hbuf() + (size_t)r * D_ + col) = (unsigned)(q0 & 255) | ((unsigned)(q1 & 255) << 8) | ((unsigned)(q2 & 255) << 16) | ((unsigned)(q3 & 255) << 24);
            }
            if (route) { const float* rt = p.in[I_ROUTER] + (size_t)col * NEXP;
#pragma unroll
                for (int j = 0; j < 4; ++j) { const f32x4 r0 = *(const f32x4*)(rt + j * NEXP), r1 = *(const f32x4*)(rt + j * NEXP + 4);
                    lg[0] += hv[j] * r0[0]; lg[1] += hv[j] * r0[1]; lg[2] += hv[j] * r0[2]; lg[3] += hv[j] * r0[3];
                    lg[4] += hv[j] * r1[0]; lg[5] += hv[j] * r1[1]; lg[6] += hv[j] * r1[2]; lg[7] += hv[j] * r1[3]; } }
        }
        if (route && !isc) {
#pragma unroll
            for (int e = 0; e < NEXP; ++e) lg[e] = wave_sum(lg[e]);
            if (lane == 0) {
                int e0 = 0; float v0 = lg[0];
#pragma unroll
                for (int e = 1; e < NEXP; ++e) if (lg[e] > v0) { v0 = lg[e]; e0 = e; }
                int e1 = -1; float v1 = -3.0e38f;
#pragma unroll
                for (int e = 0; e < NEXP; ++e) if (e != e0 && lg[e] > v1) { v1 = lg[e]; e1 = e; }
                const float w0 = 1.f / (1.f + expf(v1 - v0)), w1 = 1.f - w0;
                const int t = r - LC;
                const int p0 = (int)__hip_atomic_fetch_add(lcnt + e0, 1u, __ATOMIC_RELAXED, __HIP_MEMORY_SCOPE_WORKGROUP), p1 = (int)__hip_atomic_fetch_add(lcnt + e1, 1u, __ATOMIC_RELAXED, __HIP_MEMORY_SCOPE_WORKGROUP);
                const int ri = (wid * 8 + (kk & 7)) * 2;
                recE[ri] = e0; recE[ri + 1] = e1; recP[ri] = p0; recP[ri + 1] = p1;
                p.tok_e()[t * 2] = e0; p.tok_e()[t * 2 + 1] = e1; p.tok_w()[t * 2] = w0; p.tok_w()[t * 2 + 1] = w1;
            }
        }
        ++kk;
    }
    if (route) {
        __syncthreads();
        if (tid < 8) lbase[tid] = atomicAdd(&p.cnt()[tid], lcnt[tid]);
        __syncthreads();
        if (tid < 128) { const int w = (tid >> 1) & 7, k = tid >> 4, s = tid & 1; const int tt = (int)blockIdx.x * 8 + w + k * (int)gridDim.x * 8;
            if (tt < SEQ && k < kk) { const int ri = (w * 8 + k) * 2 + s; p.tok_p()[tt * 2 + s] = (int)lbase[recE[ri]] + recP[ri]; } }
        __syncthreads();
    }
}

__device__ __forceinline__ void phase_prep(const Params& p, int layer) {
    const int tid = otid(), wid = tid >> 6, lane = tid & 63;
    const float* gcw = p.in[I_GCONV] + (size_t)layer * 3 * 1536;
    const float LN1E4 = 9.210340371976184f;
    for (int r = blockIdx.x * 8 + wid; r < MT; r += gridDim.x * 8) {
        const bool isc = r < LC; const int t = r - LC;
        const bool hasp = isc ? (r > 0) : (r > LC), hasn = isc ? (r < LC - 1) : (r < MT - 1);
        const bf16_t* P0 = p.Pp() + (size_t)r * NP;
        const bf16_t* Pm = hasp ? P0 - NP : P0; const bf16_t* Pn = hasn ? P0 + NP : P0;
        u32x4 gx[3][3];
#pragma unroll
        for (int i = 0; i < 3; ++i) { const int ch = i * 512 + lane * 8; gx[i][0] = *(const u32x4*)(Pm + PC_GQKV + ch); gx[i][1] = *(const u32x4*)(P0 + PC_GQKV + ch); gx[i][2] = *(const u32x4*)(Pn + PC_GQKV + ch); }
        const bf16_t gab = P0[PC_A + (lane & 7)], gbb = P0[PC_B + (lane & 7)];
        const u32x4 cqr = *(const u32x4*)(P0 + PC_CQ + (lane < 56 ? lane : 55) * 8), ckr = *(const u32x4*)(P0 + PC_CKV + (lane & 15) * 8);
        const bf16_t kr1 = P0[PC_KR + ((lane >> 4) & 1) * 32 + (lane & 15)], kr2 = P0[PC_KR + ((lane >> 4) & 1) * 32 + (lane & 15) + 16];
        bf16_t rq[8][2];
#pragma unroll
        for (int it = 0; it < 8; ++it) { const int o = (it >> 2) * 512 + (it & 3) * 128 + lane; rq[it][0] = P0[PC_RQKV + o]; rq[it][1] = P0[PC_RQKV + o + 64]; }
#pragma unroll
        for (int i = 0; i < 3; ++i) {
            const int ch = i * 512 + lane * 8;
            float x0[8], xm[8], xn[8], y[8];
            unpack8(gx[i][1], x0); unpack8(gx[i][0], xm); unpack8(gx[i][2], xn);
            const float fm = hasp ? 1.f : 0.f, fn = hasn ? 1.f : 0.f;
            float ss = 0.f;
#pragma unroll
            for (int e = 0; e < 8; ++e) { const float v = gcw[ch + e] * (xm[e] * fm) + gcw[1536 + ch + e] * x0[e] + gcw[3072 + ch + e] * (xn[e] * fn); y[e] = silu_f(v); ss += y[e] * y[e]; }
            if (i < 2) { ss = sum16(ss); const float rn = rsqrtf(ss + EPS) * (i == 0 ? 0.08838834764831845f : 1.f);
#pragma unroll
                for (int e = 0; e < 8; ++e) y[e] *= rn; }
            *(u32x4*)(p.gqkv() + (size_t)r * 1536 + ch) = pack8(y);
        }
        if (lane < 8) {
            const float a = bf2f(gab), b = bf2f(gbb);
            const float g = -expf(p.in[I_GALOG][layer * 8 + lane]) * softplus_f(a + p.in[I_GDT][layer * 8 + lane]);
            p.ggb()[(size_t)r * 16 + lane] = g; p.ggb()[(size_t)r * 16 + 8 + lane] = sigmoid_f(b);
        }
        {   float sq = 0.f, sk = 0.f;
            if (lane < 56) { float f[8]; unpack8(cqr, f);
#pragma unroll
                for (int e = 0; e < 8; ++e) sq += f[e] * f[e]; }
            if (lane < 16) { float f[8]; unpack8(ckr, f);
#pragma unroll
                for (int e = 0; e < 8; ++e) sk += f[e] * f[e]; }
            sq = wave_sum(sq); sk = wave_sum(sk);
            if (lane == 0) { p.mrs()[(size_t)r * 2] = rsqrtf(sq * (1.0f / 448.f) + EPS); p.mrs()[(size_t)r * 2 + 1] = rsqrtf(sk * (1.0f / 128.f) + EPS); }
        }
        if (lane < 32) {
            const int i = lane & 15, half = lane >> 4;
            const float x1 = bf2f(kr1), x2 = bf2f(kr2);
            float o1 = x1, o2 = x2;
            if (!isc) { const float pos = (float)(half ? (t & 63) : (t >> 6)); const float inv = expf(-(float)i * (LN1E4 / 16.f)); float s, c; sincosf(pos * inv, &s, &c);
                o1 = x1 * c - x2 * s; o2 = x2 * c + x1 * s; }
            p.krr()[(size_t)r * 64 + half * 32 + i] = f2bf(o1); p.krr()[(size_t)r * 64 + half * 32 + i + 16] = f2bf(o2);
        }
        {   float s = 0.f, c = 1.f;
            if (!isc) { const float inv = expf(-(float)lane * (LN1E4 / 64.f)); sincosf((float)t * inv, &s, &c); }
#pragma unroll
            for (int it = 0; it < 8; ++it) { const int which = it >> 2, hd = it & 3; const int o = which * 512 + hd * 128 + lane;
                const float x1 = bf2f(rq[it][0]), x2 = bf2f(rq[it][1]); const float sc = which ? 0.08838834764831845f : 1.f;
                p.rqk()[(size_t)r * 1024 + o] = f2bf((x1 * c - x2 * s) * sc); p.rqk()[(size_t)r * 1024 + o + 64] = f2bf((x2 * c + x1 * s) * sc); }
        }
    }
}
namespace att {
constexpr int NW = 8, QBLK = 32, KVBLK = 64, DK = 192, DV = 128;
constexpr float SCALE = 0.07216878364870322f;
constexpr float THR = 8.f;
constexpr int LDQ = MLAN, LDKN = MLAN, LDKR = 64, LDV = MLAN, LDO = D_;
constexpr int SHM_V = KVBLK * DV * 2, SHM_K = KVBLK * DK * 2, SHM_ATTN = 2 * SHM_V + 2 * SHM_K + NW * 64 * 4;
#define KSWZ(row, colB) ((row) * 384 + ((colB) ^ ((((row) >> 1) & 7) << 4)))
#define SBAR() __builtin_amdgcn_sched_barrier(0)
__device__ __forceinline__ int crow(int r, int hi) { return (r & 3) + 8 * (r >> 2) + 4 * hi; }
__device__ __forceinline__ void partialSM(f32x16& p0, f32x16& p1, float& m_reg, float& mn, float& alpha) {
    constexpr float C = SCALE * 1.4426950408889634f;
    float pmax = p0[0];
#pragma unroll
    for (int r = 1; r < 16; ++r) pmax = fmaxf(pmax, p0[r]);
#pragma unroll
    for (int r = 0; r < 16; ++r) pmax = fmaxf(pmax, p1[r]);
    { auto rr = __builtin_amdgcn_permlane32_swap(__float_as_uint(pmax), __float_as_uint(pmax), false, false);
      pmax = fmaxf(__uint_as_float(rr[0]), __uint_as_float(rr[1])); }
    if (__builtin_expect(__all(pmax - m_reg <= THR / SCALE), 1)) { mn = m_reg; alpha = 1.f; }
    else { mn = fmaxf(m_reg, pmax); alpha = __builtin_amdgcn_exp2f((m_reg - mn) * C); m_reg = mn; }
    const float mnC = -mn * C;
#pragma unroll
    for (int r = 0; r < 16; ++r) p0[r] = fmaf(p0[r], C, mnC);
#pragma unroll
    for (int r = 0; r < 16; ++r) p1[r] = fmaf(p1[r], C, mnC);
#pragma unroll
    for (int r = 0; r < 16; ++r) p0[r] = __builtin_amdgcn_exp2f(p0[r]);
}
__device__ __forceinline__ void finishSM(f32x16& p0, f32x16& p1, float alpha, float& l_reg, bf16x8& pa0, bf16x8& pa1, bf16x8& pa2, bf16x8& pa3) {
#pragma unroll
    for (int r = 0; r < 16; ++r) p1[r] = __builtin_amdgcn_exp2f(p1[r]);
    float ps = 0;
#pragma unroll
    for (int r = 0; r < 16; ++r) ps += p0[r];
#pragma unroll
    for (int r = 0; r < 16; ++r) ps += p1[r];
    { auto rr = __builtin_amdgcn_permlane32_swap(__float_as_uint(ps), __float_as_uint(ps), false, false);
      ps = __uint_as_float(rr[0]) + __uint_as_float(rr[1]); }
    l_reg = l_reg * alpha + ps;
#define PK4(P, BASE, OUT) do { unsigned a0 = cvt_pk_bf16(P[BASE + 0], P[BASE + 1]), a1 = cvt_pk_bf16(P[BASE + 2], P[BASE + 3]);   \
    unsigned b0 = cvt_pk_bf16(P[BASE + 4], P[BASE + 5]), b1 = cvt_pk_bf16(P[BASE + 6], P[BASE + 7]);                              \
    auto r0 = __builtin_amdgcn_permlane32_swap(a0, b0, false, false); auto r1 = __builtin_amdgcn_permlane32_swap(a1, b1, false, false); \
    u32x4 w = {r0[0], r1[0], r0[1], r1[1]}; OUT = *reinterpret_cast<bf16x8*>(&w); } while (0)
    PK4(p0, 0, pa0); PK4(p0, 8, pa1); PK4(p1, 0, pa2); PK4(p1, 8, pa3);
#undef PK4
}
__device__ __forceinline__ void qkt(f32x16& p0, f32x16& p1, const int (&ka)[4], int boff, const bf16x8* qr) {
    p0 = f32x16{}; p1 = f32x16{};
    bf16x8 kb[3][2];
#define QK_LD(D0) do { const int dl_ = (D0) & 3, dh_ = (D0) >> 2; kb[(D0) % 3][0] = *(const LAS bf16x8*)(unsigned)(ka[dl_] + (boff + dh_ * 128)); \
        kb[(D0) % 3][1] = *(const LAS bf16x8*)(unsigned)(ka[dl_] + (boff + dh_ * 128 + 32 * 384)); } while (0)
    QK_LD(0); QK_LD(1);
#pragma unroll
    for (int d0 = 0; d0 < 12; ++d0) {
        if (d0 + 2 < 12) QK_LD(d0 + 2);
        p0 = __builtin_amdgcn_mfma_f32_32x32x16_bf16(kb[d0 % 3][0], qr[d0], p0, 0, 0, 0);
        p1 = __builtin_amdgcn_mfma_f32_32x32x16_bf16(kb[d0 % 3][1], qr[d0], p1, 0, 0, 0);
    }
#undef QK_LD
}
__device__ __forceinline__ int v_st(int k, int c) { const int kk = (k & ~0xC) | ((k & 4) << 1) | ((k & 8) >> 1); return ((kk >> 3) * 4 + (c >> 5)) * 512 + ((kk & 7) * 32 + (c & 31)) * 2; }
__device__ __forceinline__ int v_rd_base(int lane) { return ((lane & 3) << 3) | (((lane >> 2) & 3) << 6) | (((lane >> 4) & 1) << 5) | (((lane >> 5) & 1) << 8); }
constexpr int v_rd_off(int d0, int ks, int half) { return d0 * 512 + ks * 4096 + half * 2048; }
template <int OFF> __device__ __forceinline__ s16x4 tr_read(int vb) {
    s16x4 r; asm volatile("ds_read_b64_tr_b16 %0, %1 offset:%2" : "=&v"(r) : "v"(vb), "i"(OFF) : "memory"); return r;
}
template <int D0> __device__ __forceinline__ void pv_one(f32x16& od, int vb, bf16x8 pa0, bf16x8 pa1, bf16x8 pa2, bf16x8 pa3) {
    const s16x4 l0 = tr_read<v_rd_off(D0, 0, 0)>(vb), h0 = tr_read<v_rd_off(D0, 0, 1)>(vb), l1 = tr_read<v_rd_off(D0, 1, 0)>(vb), h1 = tr_read<v_rd_off(D0, 1, 1)>(vb);
    const s16x4 l2 = tr_read<v_rd_off(D0, 2, 0)>(vb), h2 = tr_read<v_rd_off(D0, 2, 1)>(vb), l3 = tr_read<v_rd_off(D0, 3, 0)>(vb), h3 = tr_read<v_rd_off(D0, 3, 1)>(vb);
    asm volatile("s_waitcnt lgkmcnt(0)" ::: "memory"); SBAR();
#define PK(L, H) (bf16x8){L[0], L[1], L[2], L[3], H[0], H[1], H[2], H[3]}
    od = __builtin_amdgcn_mfma_f32_32x32x16_bf16(pa0, PK(l0, h0), od, 0, 0, 0);
    od = __builtin_amdgcn_mfma_f32_32x32x16_bf16(pa1, PK(l1, h1), od, 0, 0, 0);
    od = __builtin_amdgcn_mfma_f32_32x32x16_bf16(pa2, PK(l2, h2), od, 0, 0, 0);
    od = __builtin_amdgcn_mfma_f32_32x32x16_bf16(pa3, PK(l3, h3), od, 0, 0, 0);
#undef PK
}
__device__ __forceinline__ void pv_d0(f32x16* o, int vb, bf16x8 pa0, bf16x8 pa1, bf16x8 pa2, bf16x8 pa3) {
    pv_one<0>(o[0], vb, pa0, pa1, pa2, pa3); pv_one<1>(o[1], vb, pa0, pa1, pa2, pa3); pv_one<2>(o[2], vb, pa0, pa1, pa2, pa3); pv_one<3>(o[3], vb, pa0, pa1, pa2, pa3);
}
__device__ __forceinline__ void attn_body(const bf16_t* __restrict__ Qb, const bf16_t* __restrict__ Kn, const bf16_t* __restrict__ Kr, const bf16_t* __restrict__ Vh,
                                          bf16_t* __restrict__ Ob, int seq, int rope_t0, char* lds, float* __restrict__ Opart, float* __restrict__ MLpart) {
    const int tid = otid(), wid = tid >> 6, lane = tid & 63, r32 = lane & 31, hi = lane >> 5;
    char* V_lds = lds; char* K_lds = lds + 2 * SHM_V;
    float* ws = (float*)(lds + 2 * SHM_V + 2 * SHM_K) + wid * 64; float* li_l = ws; float* al_l = ws + 32;
    float m_reg = -1e30f, l_reg = 0; f32x16 o[4] = {}; bf16x8 qr[12];
    const bf16_t* Qw = Qb + (long)(wid * QBLK + r32) * LDQ + hi * 8;
#pragma unroll
    for (int d0 = 0; d0 < 8; ++d0) qr[d0] = *reinterpret_cast<const bf16x8*>(Qw + d0 * 16);
    {
        bf16_t* Qr = (bf16_t*)(lds + SHM_ATTN);
        bf16_t qa[16][2];
#pragma unroll
        for (int it = 0; it < 16; ++it) { const int item = tid + it * 512, row = item >> 5, pr = item & 31; const bf16_t* qp = Qb + (long)row * LDQ + 128 + (pr >> 4) * 32 + (pr & 15); qa[it][0] = qp[0]; qa[it][1] = qp[16]; }
#pragma unroll
        for (int it = 0; it < 16; ++it) { const int item = tid + it * 512, row = item >> 5, pr = item & 31, half = pr >> 4, i = pr & 15;
            const float x1 = bf2f(qa[it][0]), x2 = bf2f(qa[it][1]); float o1 = x1, o2 = x2;
            if (rope_t0 >= 0) { const int t = rope_t0 + row; const float pos = (float)(half ? (t & 63) : (t >> 6));
                const float inv = expf(-(float)i * (9.210340371976184f / 16.f)); float s, c; sincosf(pos * inv, &s, &c);
                o1 = x1 * c - x2 * s; o2 = x2 * c + x1 * s; }
            Qr[row * 64 + half * 32 + i] = f2bf(o1); Qr[row * 64 + half * 32 + i + 16] = f2bf(o2); }
        __syncthreads();
#pragma unroll
        for (int dd = 0; dd < 4; ++dd) qr[8 + dd] = *reinterpret_cast<const bf16x8*>(Qr + (wid * QBLK + r32) * 64 + dd * 16 + hi * 8);
    }
    const int sr = tid >> 4, sc = (tid & 15) * 8, vst0 = v_st(sr, sc), vst1 = v_st(32 + sr, sc);
    const int rr = tid >> 3, rc = (tid & 7) * 8;
    const int vb0 = (int)(uintptr_t)V_lds + v_rd_base(lane);
    int ka[4];
#pragma unroll
    for (int dl = 0; dl < 4; ++dl) ka[dl] = (int)(uintptr_t)K_lds + r32 * 384 + ((dl * 32 + hi * 16) ^ (((r32 >> 1) & 7) << 4));
    struct { bf16x8 vs0, vs1, ks0, ks1, kr; } sr_[1];
    const unsigned ovA = (unsigned)(sr * LDV + sc) * 2u, ovB = (unsigned)((32 + sr) * LDV + sc) * 2u, orr = (unsigned)(rr * LDKR + rc) * 2u;
#define SLOAD(i, k0) do { const char* vbp = (const char*)Vh + (size_t)(k0) * (LDV * 2); const char* kbp = (const char*)Kn + (size_t)(k0) * (LDKN * 2); const char* rbp = (const char*)Kr + (size_t)(k0) * (LDKR * 2); \
    sr_[i].vs0 = *(const bf16x8*)(vbp + ovA); sr_[i].vs1 = *(const bf16x8*)(vbp + ovB); \
    sr_[i].ks0 = *(const bf16x8*)(kbp + ovA); sr_[i].ks1 = *(const bf16x8*)(kbp + ovB); \
    sr_[i].kr = *(const bf16x8*)(rbp + orr); } while (0)
#define SWRITE(b, i) do { *(bf16x8*)(V_lds + (b) * SHM_V + vst0) = sr_[i].vs0; *(bf16x8*)(V_lds + (b) * SHM_V + vst1) = sr_[i].vs1; const int kc = sc * 2; \
    *(bf16x8*)(K_lds + (b) * SHM_K + KSWZ(sr, kc)) = sr_[i].ks0; *(bf16x8*)(K_lds + (b) * SHM_K + KSWZ(32 + sr, kc)) = sr_[i].ks1; \
    *(bf16x8*)(K_lds + (b) * SHM_K + KSWZ(rr, 256 + rc * 2)) = sr_[i].kr; } while (0)
#define SWAIT() asm volatile("s_waitcnt vmcnt(0)" ::: "memory")
#define RESC(a) do { if (__any((a) < 1.f)) { if (hi == 0) al_l[r32] = (a); asm volatile("s_waitcnt lgkmcnt(0)" ::: "memory"); \
    _Pragma("unroll") for (int d = 0; d < 4; ++d) _Pragma("unroll") for (int r = 0; r < 16; ++r) o[d][r] *= al_l[crow(r, hi)]; } } while (0)
    f32x16 pA0, pA1, pB0, pB1; float mnA, mnB, alA, alB; bf16x8 pa0, pa1, pa2, pa3; const int NT = seq / KVBLK;
    constexpr int SE = 0, SO = 0;
    SLOAD(SE, 0); asm volatile("s_waitcnt vmcnt(0)" ::: "memory"); SWRITE(0, SE); __syncthreads();
    qkt(pA0, pA1, ka, 0, qr); partialSM(pA0, pA1, m_reg, mnA, alA);
    SLOAD(SO, KVBLK);
    SWAIT(); SWRITE(1, SO); __syncthreads();
    for (int j = 1; j + 1 < NT; j += 2) {
        SBAR(); qkt(pB0, pB1, ka, SHM_K, qr);
        finishSM(pA0, pA1, alA, l_reg, pa0, pa1, pa2, pa3); SBAR();
        SLOAD(SO, (j + 1) * KVBLK); SBAR();
        pv_d0(o, vb0, pa0, pa1, pa2, pa3); partialSM(pB0, pB1, m_reg, mnB, alB);
        __syncthreads(); SWAIT(); SWRITE(0, SE);
        RESC(alB); __syncthreads();
        SBAR(); qkt(pA0, pA1, ka, 0, qr);
        finishSM(pB0, pB1, alB, l_reg, pa0, pa1, pa2, pa3); SBAR();
        SLOAD(SE, (j + 2) * KVBLK); SBAR();
        pv_d0(o, vb0 + SHM_V, pa0, pa1, pa2, pa3); partialSM(pA0, pA1, m_reg, mnA, alA);
        __syncthreads(); SWAIT(); SWRITE(1, SO);
        RESC(alA); __syncthreads();
    }
    SBAR(); qkt(pB0, pB1, ka, SHM_K, qr);
    finishSM(pA0, pA1, alA, l_reg, pa0, pa1, pa2, pa3); SBAR();
    pv_d0(o, vb0, pa0, pa1, pa2, pa3); partialSM(pB0, pB1, m_reg, mnB, alB);
    __syncthreads(); RESC(alB);
    finishSM(pB0, pB1, alB, l_reg, pa0, pa1, pa2, pa3); SBAR();
    pv_d0(o, vb0 + SHM_V, pa0, pa1, pa2, pa3);
    if (Opart != nullptr) {
        if (hi == 0) { MLpart[(wid * QBLK + r32) * 2] = m_reg; MLpart[(wid * QBLK + r32) * 2 + 1] = l_reg; }
#pragma unroll
        for (int r = 0; r < 16; ++r) { const int orow = wid * QBLK + crow(r, hi);
#pragma unroll
            for (int d0 = 0; d0 < 4; ++d0) Opart[orow * 128 + d0 * 32 + r32] = o[d0][r]; }
        __syncthreads();
        return;
    }
    if (hi == 0) li_l[r32] = l_reg; asm volatile("s_waitcnt lgkmcnt(0)" ::: "memory");
    float rli[16];
#pragma unroll
    for (int r = 0; r < 16; ++r) rli[r] = __builtin_amdgcn_rcpf(li_l[crow(r, hi)]);
    bf16_t* Ow = Ob + (long)(wid * QBLK) * LDO;
#pragma unroll
    for (int r = 0; r < 16; ++r) { const int orow = crow(r, hi);
#pragma unroll
        for (int d0 = 0; d0 < 4; ++d0) Ow[(long)orow * LDO + d0 * 32 + r32] = f2bf(o[d0][r] * rli[r]); }
    __syncthreads();
#undef SLOAD
#undef SWRITE
#undef SWAIT
#undef RESC
}
}

constexpr int ATT_SPLIT_K0[4] = {0, 4096, 8192, 12416};
constexpr size_t ATT_PART_FLOATS = 256 * 128 + 512;
__device__ __forceinline__ void attn_unit(const Params& p, int u, int sp, char* lds) {
    const bool lat = u < 256;
    const int xcd = u & 7, h = lat ? (xcd >> 1) : (u - 256), qb = (u >> 3) * 2 + (xcd & 1);
    const int row0 = lat ? LC + qb * 256 : 0;
    const int k0 = sp < 0 ? 0 : (sp == 0 ? 0 : (sp == 1 ? 4096 : (sp == 2 ? 8192 : 12416)));
    const int nk = sp < 0 ? (lat ? MT : LC) : (sp < 2 ? 4096 : 4224);
    float* part = sp < 0 ? nullptr : p.attp() + (size_t)(u * 4 + sp) * ATT_PART_FLOATS;
    att::attn_body(p.qkvup() + (size_t)row0 * MLAN + h * 192, p.qkvup() + (size_t)k0 * MLAN + 768 + h * 256, p.krr() + (size_t)k0 * 64, p.qkvup() + (size_t)k0 * MLAN + 768 + h * 256 + 128,
                   p.ocat() + (size_t)row0 * D_ + 512 + h * 128, nk, lat ? qb * 256 : -1, lds, part, part ? part + 256 * 128 : nullptr);
}
__device__ __forceinline__ void phase_attn(const Params& p, int layer, char* lds) {
    const int nunits = 256 + (layer == 0 ? 4 : 0);
#pragma unroll 1
    for (int u = blockIdx.x; u < nunits; u += gridDim.x) attn_unit(p, u, -1, lds);
}

__device__ __forceinline__ void phase_rec_naive(const Params& p, int layer, float* lds) {
    const int tid = otid();
    float* kq = lds;
    float* vv = lds + 32 * 256;
    float* ab = vv + 32 * 128;
    for (int u = blockIdx.x; u < 16; u += gridDim.x) {
        const int kind = u >> 3, dir = (u >> 2) & 1, h = u & 3;
        float S[128];
#pragma unroll
        for (int i = 0; i < 128; ++i) S[i] = 0.f;
        const float gam = 1.0f - exp2f(-(float)((dir ? 6 : 5) + 2 * h));
        float* outp = (kind == 0 ? p.go() : p.ro()) + (size_t)dir * MT * 512 + h * 128;
        for (int s0 = 0; s0 < MT; s0 += 32) {
            __syncthreads();
            {   const int tk = tid >> 4, seg = (tid & 15) * 16; const int s = s0 + tk;
                const int row = dir == 0 ? s : (s < LC ? LC - 1 - s : MT + LC - 1 - s);
                const bf16_t* src;
                if (kind == 0) src = p.gqkv() + (size_t)row * 1536 + (seg < 128 ? 512 + h * 128 + seg : h * 128 + (seg - 128));
                else           src = p.rqk() + (size_t)row * 1024 + (seg < 128 ? 512 + h * 128 + seg : h * 128 + (seg - 128));
                float f[8]; unpack8(*(const u32x4*)src, f);
#pragma unroll
                for (int e = 0; e < 8; ++e) kq[tk * 256 + seg + e] = f[e];
                unpack8(*(const u32x4*)(src + 8), f);
#pragma unroll
                for (int e = 0; e < 8; ++e) kq[tk * 256 + seg + 8 + e] = f[e];
                const int vseg = (tid & 15) * 8;
                const bf16_t* vsrc = kind == 0 ? p.gqkv() + (size_t)row * 1536 + 1024 + h * 128 + vseg : p.Pp() + (size_t)row * NP + PC_RQKV + 1024 + h * 128 + vseg;
                unpack8(*(const u32x4*)vsrc, f);
#pragma unroll
                for (int e = 0; e < 8; ++e) vv[tk * 128 + vseg + e] = f[e];
                if (tid < 32) { const int s2 = s0 + tid; const int row2 = dir == 0 ? s2 : (s2 < LC ? LC - 1 - s2 : MT + LC - 1 - s2);
                    if (kind == 0) { ab[tid * 2] = expf(p.ggb()[(size_t)row2 * 16 + dir * 4 + h]); ab[tid * 2 + 1] = p.ggb()[(size_t)row2 * 16 + 8 + dir * 4 + h]; }
                    else { ab[tid * 2] = gam; ab[tid * 2 + 1] = 1.f; } }
            }
            __syncthreads();
            if (tid < 128) {
                for (int tk = 0; tk < 32; ++tk) {
                    const f32x4* kp = (const f32x4*)(kq + tk * 256); const f32x4* qp = kp + 32;
                    const float a = ab[tk * 2], b = ab[tk * 2 + 1], v = vv[tk * 128 + tid];
                    float dv;
                    if (kind == 0) { float ks = 0.f;
#pragma unroll
                        for (int i = 0; i < 32; ++i) { const f32x4 k4 = kp[i]; ks += k4[0] * S[4 * i] + k4[1] * S[4 * i + 1] + k4[2] * S[4 * i + 2] + k4[3] * S[4 * i + 3]; }
                        dv = b * (v - a * ks); }
                    else dv = v;
                    float o = 0.f;
#pragma unroll
                    for (int i = 0; i < 32; ++i) { const f32x4 k4 = kp[i], q4 = qp[i];
                        S[4 * i] = a * S[4 * i] + k4[0] * dv; S[4 * i + 1] = a * S[4 * i + 1] + k4[1] * dv; S[4 * i + 2] = a * S[4 * i + 2] + k4[2] * dv; S[4 * i + 3] = a * S[4 * i + 3] + k4[3] * dv;
                        o += q4[0] * S[4 * i] + q4[1] * S[4 * i + 1] + q4[2] * S[4 * i + 2] + q4[3] * S[4 * i + 3]; }
                    const int s = s0 + tk; const int row = dir == 0 ? s : (s < LC ? LC - 1 - s : MT + LC - 1 - s);
                    outp[(size_t)row * 512 + tid] = o;
                }
            }
        }
        __syncthreads();
    }
}

__device__ __forceinline__ void phase_mixout(const Params& p, int layer) {
    const int tid = otid(), wid = tid >> 6, lane = tid & 63;
    const float* gnw = p.in[I_GNW] + layer * 128;
    for (int r = blockIdx.x * 8 + wid; r < MT; r += gridDim.x * 8) {
        const int idx = lane * 8;
        f32x4 ga[2][4]; u32x4 zr[2]; float gw8[8];
        { const f32x4 g0 = *(const f32x4*)(gnw + (idx & 127)), g1 = *(const f32x4*)(gnw + (idx & 127) + 4); gw8[0] = g0[0]; gw8[1] = g0[1]; gw8[2] = g0[2]; gw8[3] = g0[3]; gw8[4] = g1[0]; gw8[5] = g1[1]; gw8[6] = g1[2]; gw8[7] = g1[3]; }
#pragma unroll
        for (int kind = 0; kind < 2; ++kind) {
            const float* o0 = (kind == 0 ? p.go() : p.ro()) + (size_t)r * 512 + idx; const float* o1 = o0 + (size_t)MT * 512;
            ga[kind][0] = *(const f32x4*)o0; ga[kind][1] = *(const f32x4*)(o0 + 4); ga[kind][2] = *(const f32x4*)o1; ga[kind][3] = *(const f32x4*)(o1 + 4);
            zr[kind] = *(const u32x4*)(p.Pp() + (size_t)r * NP + (kind == 0 ? PC_GZ : PC_RG) + idx); }
        if (r >= LC && r < LC + 1024) {
            const int qb = (r - LC) >> 8, rl = (r - LC) & 255, hh = lane >> 4, col = (lane & 15) * 8;
            const int uu = (qb >> 1) * 8 + 2 * hh + (qb & 1);
            const float* pb = p.attp() + (size_t)(uu * 4) * ATT_PART_FLOATS;
            float mm[4], ll[4], M = -3.0e38f;
#pragma unroll
            for (int s4 = 0; s4 < 4; ++s4) { mm[s4] = pb[s4 * ATT_PART_FLOATS + 256 * 128 + rl * 2]; ll[s4] = pb[s4 * ATT_PART_FLOATS + 256 * 128 + rl * 2 + 1]; M = fmaxf(M, mm[s4]); }
            float acc[8] = {0.f, 0.f, 0.f, 0.f, 0.f, 0.f, 0.f, 0.f}, L = 0.f;
#pragma unroll
            for (int s4 = 0; s4 < 4; ++s4) { const float w = __builtin_amdgcn_exp2f((mm[s4] - M) * (att::SCALE * 1.4426950408889634f)); L += w * ll[s4];
                const f32x4 o0 = *(const f32x4*)(pb + s4 * ATT_PART_FLOATS + rl * 128 + col), o1 = *(const f32x4*)(pb + s4 * ATT_PART_FLOATS + rl * 128 + col + 4);
#pragma unroll
                for (int e = 0; e < 4; ++e) { acc[e] += w * o0[e]; acc[4 + e] += w * o1[e]; } }
            const float il = 1.0f / L;
#pragma unroll
            for (int e = 0; e < 8; ++e) acc[e] *= il;
            *(u32x4*)(p.ocat() + (size_t)r * D_ + 512 + hh * 128 + col) = pack8(acc);
        }
#pragma unroll
        for (int kind = 0; kind < 2; ++kind) {
            float o[8]; float ss = 0.f;
#pragma unroll
            for (int e = 0; e < 4; ++e) { o[e] = ga[kind][0][e] + ga[kind][2][e]; o[4 + e] = ga[kind][1][e] + ga[kind][3][e]; }
#pragma unroll
            for (int e = 0; e < 8; ++e) ss += o[e] * o[e];
            ss = sum16(ss);
            const float rn = rsqrtf(ss * (1.0f / 128.f) + EPS);
            float z[8]; unpack8(zr[kind], z);
            float y[8];
#pragma unroll
            for (int e = 0; e < 8; ++e) { const float w = kind == 0 ? gw8[e] : 1.f; y[e] = o[e] * rn * w * silu_f(z[e]); }
            *(u32x4*)(p.ocat() + (size_t)r * D_ + (kind == 0 ? 0 : 1536) + idx) = pack8(y);
        }
    }
}
constexpr int NCHUNK = MT / 64;
constexpr size_t REC_Q = 0, REC_KT = 16384, REC_A = 32768, REC_W = 40960, REC_U = 57344, REC_DL = 73728, REC_BYTES = 73984;
__device__ __forceinline__ int scan_row(int dir, int s) { return dir == 0 ? s : (s < LC ? LC - 1 - s : MT + LC - 1 - s); }
__device__ __forceinline__ int crow32(int r, int hi) { return (r & 3) + 8 * (r >> 2) + 4 * hi; }

constexpr int CP_LDS = 70656;
__device__ __forceinline__ void chunkprep_pair(const Params& p, int layer, int u0, char* lds0) {
    const int tid = otid(), half = tid >> 8, t = tid & 255, hw = (tid >> 6) & 3, lane = tid & 63, r32 = lane & 31, hi = lane >> 5;
    const int u = u0 + half; const bool valid = u < 16 * NCHUNK;
    const int c = valid ? (u & 15) : 0, n = valid ? (u >> 4) : 0;
    const int kind = c >> 3, dir = (c >> 2) & 1, h = c & 3;
    char* lds = lds0 + half * CP_LDS;
    char* qL = lds; char* kL = lds + 17408; char* vL = lds + 34816; float* AM = (float*)(lds + 52224); float* scv = (float*)(lds + 69632);
    float* gcL = scv; float* btL = scv + 64; float* egL = scv + 128; float* ekL = scv + 192;
    char* rec = p.recs() + ((size_t)c * NCHUNK + n) * REC_BYTES;
    if (valid) {
        const int tk = t >> 2, seg = (t & 3) * 32; const int row = scan_row(dir, n * 64 + tk);
        const bf16_t *qs, *ks, *vs;
        if (kind == 0) { const bf16_t* b = p.gqkv() + (size_t)row * 1536 + h * 128 + seg; qs = b; ks = b + 512; vs = b + 1024; }
        else { const bf16_t* b = p.rqk() + (size_t)row * 1024 + h * 128 + seg; qs = b; ks = b + 512; vs = p.Pp() + (size_t)row * NP + PC_RQKV + 1024 + h * 128 + seg; }
        u32x4 qv[4], kv[4], vv[4];
#pragma unroll
        for (int k = 0; k < 4; ++k) { qv[k] = *(const u32x4*)(qs + 8 * k); kv[k] = *(const u32x4*)(ks + 8 * k); vv[k] = *(const u32x4*)(vs + 8 * k); }
        const int lo = tk * 272 + seg * 2;
#pragma unroll
        for (int k = 0; k < 4; ++k) { *(u32x4*)(qL + lo + 16 * k) = qv[k]; *(u32x4*)(kL + lo + 16 * k) = kv[k]; *(u32x4*)(vL + lo + 16 * k) = vv[k]; }
    }
    if (hw == 0) {
        float g, b;
        if (kind == 0) { const int row = scan_row(dir, n * 64 + lane); g = p.ggb()[(size_t)row * 16 + dir * 4 + h]; b = p.ggb()[(size_t)row * 16 + 8 + dir * 4 + h]; }
        else { const int ei = dir + 2 * h; g = (ei == 0 ? -3.1748698315e-02f : (ei == 1 ? -1.5748356968e-02f : (ei == 2 ? -7.8431774610e-03f : (ei == 3 ? -3.9138993211e-03f : (ei == 4 ? -1.9550348358e-03f : (ei == 5 ? -9.7703964783e-04f : (ei == 6 ? -4.8840049811e-04f : -2.4417043217e-04f))))))); b = 1.f; }
        float gc = g;
#pragma unroll
        for (int o = 1; o < 64; o <<= 1) { const float tt = __int_as_float(__builtin_amdgcn_ds_bpermute(((lane - o) & 63) << 2, __float_as_int(gc))); if (lane >= o) gc += tt; }
        const float gl = __int_as_float(__builtin_amdgcn_readlane(__float_as_int(gc), 63));
        gcL[lane] = gc; btL[lane] = b; egL[lane] = expf(gc); ekL[lane] = expf(gl - gc);
        if (lane == 63 && valid) *(float*)(rec + REC_DL) = expf(gc);
    }
    __syncthreads();
    {   const int mi = hw >> 1, ni = hw & 1;
#pragma unroll
        for (int mat = 0; mat < 2; ++mat) {
            if (mat == 1 || kind == 0) {
                f32x16 acc = {};
                if (!(mi == 0 && ni == 1)) {
                    const char* XL = mat ? qL : kL;
#pragma unroll
                    for (int ks = 0; ks < 8; ++ks) {
                        const bf16x8 a = *(const bf16x8*)(XL + (32 * mi + r32) * 272 + (16 * ks + 8 * hi) * 2);
                        const bf16x8 b = *(const bf16x8*)(kL + (32 * ni + r32) * 272 + (16 * ks + 8 * hi) * 2);
                        acc = __builtin_amdgcn_mfma_f32_32x32x16_bf16(a, b, acc, 0, 0, 0);
                    }
                }
                const int j = 32 * ni + r32; const float gj = gcL[j];
#pragma unroll
                for (int r = 0; r < 16; ++r) { const int i = 32 * mi + crow32(r, hi);
                    const float dec = __expf(fminf(gcL[i] - gj, 0.f));
                    if (mat == 0) AM[i * 68 + j] = (j < i) ? btL[i] * acc[r] * dec : 0.f;
                    else if (valid) *(bf16_t*)(rec + REC_A + (size_t)(i * 64 + j) * 2) = f2bf((j <= i) ? acc[r] * dec : 0.f); }
            }
        }
    }
    __syncthreads();
    if (valid) {
        if (kind == 0) {
            const int cc = t & 127; const bool isw = t >= 128; const char* src = isw ? kL : vL;
            float x[64];
#pragma unroll
            for (int i = 0; i < 64; ++i) x[i] = bf2f(*(const bf16_t*)(src + i * 272 + cc * 2)) * (isw ? btL[i] * egL[i] : btL[i]);
            f32x4 ar[2][16];
#pragma unroll
            for (int i = 1; i < 64; ++i) {
                if (i == 1) { ar[1][0] = *(const f32x4*)(AM + 68); }
                if (i + 1 < 64) {
#pragma unroll
                    for (int j4 = 0; j4 < (i + 4) / 4; ++j4) ar[(i + 1) & 1][j4] = *(const f32x4*)(AM + (i + 1) * 68 + j4 * 4);
                }
                __builtin_amdgcn_sched_barrier(0);
                float a = x[i];
#pragma unroll
                for (int j4 = 0; j4 < (i + 3) / 4; ++j4) { const f32x4 a4 = ar[i & 1][j4];
                    if (4 * j4 + 0 < i) a -= a4[0] * x[4 * j4 + 0]; if (4 * j4 + 1 < i) a -= a4[1] * x[4 * j4 + 1];
                    if (4 * j4 + 2 < i) a -= a4[2] * x[4 * j4 + 2]; if (4 * j4 + 3 < i) a -= a4[3] * x[4 * j4 + 3]; }
                x[i] = a;
                __builtin_amdgcn_sched_barrier(0);
            }
            bf16_t* dstp = (bf16_t*)(rec + (isw ? REC_W : REC_U)) + cc;
#pragma unroll
            for (int i = 0; i < 64; ++i) dstp[i * 128] = f2bf(x[i]);
        } else if (t < 128) {
#pragma unroll 8
            for (int i = 0; i < 64; ++i) *(bf16_t*)(rec + REC_U + (size_t)(i * 128 + t) * 2) = *(const bf16_t*)(vL + i * 272 + t * 2);
        }
        {   const int i = t >> 2, seg = (t & 3) * 32; const float e = egL[i];
#pragma unroll
            for (int k8 = 0; k8 < 4; ++k8) { float f[8]; unpack8(*(const u32x4*)(qL + i * 272 + (seg + k8 * 8) * 2), f);
#pragma unroll
                for (int e8 = 0; e8 < 8; ++e8) f[e8] *= e;
                *(u32x4*)(rec + REC_Q + (size_t)(i * 128 + seg + k8 * 8) * 2) = pack8(f); } }
        {   const int d = t >> 1, hf = t & 1;
#pragma unroll
            for (int k8 = 0; k8 < 4; ++k8) { float f[8];
#pragma unroll
                for (int e8 = 0; e8 < 8; ++e8) { const int i = hf * 32 + k8 * 8 + e8; f[e8] = bf2f(*(const bf16_t*)(kL + i * 272 + d * 2)) * ekL[i]; }
                *(u32x4*)(rec + REC_KT + (size_t)(d * 64 + hf * 32 + k8 * 8) * 2) = pack8(f); } }
    }
    __syncthreads();
}
__device__ __forceinline__ void phase_chunkprep(const Params& p, int layer, char* lds) {
    int k = 0;
#pragma unroll 1
    for (int id = blockIdx.x; id < 8 * NCHUNK; id += gridDim.x, ++k) { const int j = ((id & 7) + 4 * (k & 1)) & 7; chunkprep_pair(p, layer, ((id >> 3) * 8 + j) * 2, lds); }
}

constexpr int CH_W = 0, CH_Q = 16896, CH_A = 33792, CH_K = 42496, CH_BUF = 59904;
constexpr int CH_U = 2 * CH_BUF, CH_DL = CH_U + 16896;
__device__ __forceinline__ bf16x8 frag_rd(const char* base, int row, int stride, int ks, int hi) {
    const char* a = base + row * stride + (16 * ks + 4 * hi) * 2;
    const u32x2 lo = *(const u32x2*)a, hi2 = *(const u32x2*)(a + 16);
    u32x4 w = {lo.x, lo.y, hi2.x, hi2.y}; return *reinterpret_cast<bf16x8*>(&w);
}
__device__ __forceinline__ bf16x8 acc_frag(const f32x16& x, int s) {
    u32x4 w = {cvt_pk_bf16(x[8 * s + 0], x[8 * s + 1]), cvt_pk_bf16(x[8 * s + 2], x[8 * s + 3]), cvt_pk_bf16(x[8 * s + 4], x[8 * s + 5]), cvt_pk_bf16(x[8 * s + 6], x[8 * s + 7])};
    return *reinterpret_cast<bf16x8*>(&w);
}
struct ChainRegs { u32x4 q[4], k[4], a[2], w[4], u[4]; float dl; };
__device__ __forceinline__ void chain_ld(ChainRegs& R, const char* rec, int t, bool gdn) {
#pragma unroll
    for (int it = 0; it < 4; ++it) R.q[it] = *(const u32x4*)(rec + REC_Q + (size_t)(t + it * 256) * 16);
#pragma unroll
    for (int it = 0; it < 4; ++it) R.k[it] = *(const u32x4*)(rec + REC_KT + (size_t)(t + it * 256) * 16);
#pragma unroll
    for (int it = 0; it < 2; ++it) R.a[it] = *(const u32x4*)(rec + REC_A + (size_t)(t + it * 256) * 16);
#pragma unroll
    for (int it = 0; it < 4; ++it) R.u[it] = *(const u32x4*)(rec + REC_U + (size_t)(t + it * 256) * 16);
    R.dl = *(const float*)(rec + REC_DL);
    if (gdn) {
#pragma unroll
        for (int it = 0; it < 4; ++it) R.w[it] = *(const u32x4*)(rec + REC_W + (size_t)(t + it * 256) * 16);
    }
}
#define CH_ST16(DST, V) do { char* d_ = (DST); *(u32x2*)d_ = (u32x2){(V).x, (V).y}; *(u32x2*)(d_ + 8) = (u32x2){(V).z, (V).w}; } while (0)
__device__ __forceinline__ void chain_st(const ChainRegs& R, char* lds, int b, int t, bool gdn) {
    char* buf = lds + b * CH_BUF;
#pragma unroll
    for (int it = 0; it < 4; ++it) { const int pc = t + it * 256; CH_ST16(buf + CH_Q + (pc >> 4) * 264 + (pc & 15) * 16, R.q[it]); }
#pragma unroll
    for (int it = 0; it < 4; ++it) { const int pc = t + it * 256; CH_ST16(buf + CH_K + (pc >> 3) * 136 + (pc & 7) * 16, R.k[it]); }
#pragma unroll
    for (int it = 0; it < 2; ++it) { const int pc = t + it * 256; CH_ST16(buf + CH_A + (pc >> 3) * 136 + (pc & 7) * 16, R.a[it]); }
#pragma unroll
    for (int it = 0; it < 4; ++it) { const int pc = t + it * 256; CH_ST16(lds + CH_U + (pc >> 4) * 264 + (pc & 15) * 16, R.u[it]); }
    if (t == 0) *(float*)(lds + CH_DL + b * 4) = R.dl;
    if (gdn) {
#pragma unroll
        for (int it = 0; it < 4; ++it) { const int pc = t + it * 256; CH_ST16(buf + CH_W + (pc >> 4) * 264 + (pc & 15) * 16, R.w[it]); }
    }
}
#define CH_BAR() do { asm volatile("s_waitcnt lgkmcnt(0)" ::: "memory"); __builtin_amdgcn_s_barrier(); asm volatile("" ::: "memory"); } while (0)
__device__ __forceinline__ void chain_unit(const Params& p, int c, char* lds) {
    const int tid = otid(), wid = tid >> 6, lane = tid & 63, r32 = lane & 31, hi = lane >> 5;
    const int kind = c >> 3, dir = (c >> 2) & 1, h = c & 3; const bool gdn = kind == 0;
    const char* rec0 = p.recs() + (size_t)c * NCHUNK * REC_BYTES;
    float* outp = (gdn ? p.go() : p.ro()) + (size_t)dir * MT * 512 + h * 128;
    const bool comp = wid < 4; const int sl = wid & 3;
    if (!comp) {
        const int t = tid - 256; ChainRegs R0, R1;
        chain_ld(R0, rec0, t, gdn); chain_st(R0, lds, 0, t, gdn);
        chain_ld(R1, rec0 + REC_BYTES, t, gdn); chain_ld(R0, rec0 + 2 * REC_BYTES, t, gdn);
        CH_BAR();
#define CH_LSTEP(R, N) do { CH_BAR(); if ((N) + 1 < NCHUNK) { chain_st(R, lds, ((N) + 1) & 1, t, gdn); if ((N) + 3 < NCHUNK) chain_ld(R, rec0 + (size_t)((N) + 3) * REC_BYTES, t, gdn); } CH_BAR(); } while (0)
#pragma unroll 1
        for (int n = 0; n < NCHUNK; n += 2) { CH_LSTEP(R1, n); CH_LSTEP(R0, n + 1); }
#undef CH_LSTEP
    } else {
        f32x16 S[4] = {};
        unsigned warm = 0u; const char* wbase = rec0 + (size_t)((wid * 3) * 64 + lane) * 128;
        CH_BAR();
#define CH_FR8(BASE, STRIDE, ROWA, ROWB, KS0) do { _Pragma("unroll") for (int k_ = 0; k_ < 4; ++k_) { fr[k_] = frag_rd(BASE, ROWA, STRIDE, (KS0) + k_, hi); fr[4 + k_] = frag_rd(BASE, ROWB, STRIDE, (KS0) + k_, hi); } \
        __builtin_amdgcn_sched_barrier(0); } while (0)
#define CH_MM8(ACC0, ACC1, B, KS0) do { _Pragma("unroll") for (int k_ = 0; k_ < 4; ++k_) { \
        ACC0 = __builtin_amdgcn_mfma_f32_32x32x16_bf16(fr[k_], B[((KS0) + k_) >> 1][((KS0) + k_) & 1], ACC0, 0, 0, 0); \
        ACC1 = __builtin_amdgcn_mfma_f32_32x32x16_bf16(fr[4 + k_], B[((KS0) + k_) >> 1][((KS0) + k_) & 1], ACC1, 0, 0, 0); } \
        __builtin_amdgcn_sched_barrier(0); } while (0)
#pragma unroll 1
        for (int n = 0; n < NCHUNK; ++n) {
            const char* buf = lds + (n & 1) * CH_BUF;
            {   const char* wp = wbase + (size_t)(n + 6 < NCHUNK ? n + 6 : NCHUNK - 1) * REC_BYTES;
                const char* wp1 = wp + 8192; const char* wp2 = wp + 16384;
                asm volatile("global_load_dword %0, %1, off\n\tglobal_load_dword %0, %2, off\n\tglobal_load_dword %0, %3, off" : "+v"(warm) : "v"(wp), "v"(wp1), "v"(wp2) : "memory"); }
            f32x16 un[2];
#pragma unroll
            for (int mt = 0; mt < 2; ++mt)
#pragma unroll
                for (int r = 0; r < 16; ++r) un[mt][r] = bf2f(*(const bf16_t*)(lds + CH_U + (32 * mt + crow32(r, hi)) * 264 + (32 * sl + r32) * 2));
            const float dl = *(const float*)(lds + CH_DL + (n & 1) * 4);
            CH_BAR();
            bf16x8 Sb[4][2], Vb[2][2], fr[8];
#pragma unroll
            for (int kt = 0; kt < 4; ++kt) { Sb[kt][0] = acc_frag(S[kt], 0); Sb[kt][1] = acc_frag(S[kt], 1); }
            {   f32x16 X0 = {}, X1 = {};
                if (gdn) {
                    CH_FR8(buf + CH_W, 264, r32, 32 + r32, 0); CH_MM8(X0, X1, Sb, 0);
                    CH_FR8(buf + CH_W, 264, r32, 32 + r32, 4); CH_MM8(X0, X1, Sb, 4);
                }
                const f32x16 v0 = un[0] - X0, v1 = un[1] - X1;
                Vb[0][0] = acc_frag(v0, 0); Vb[0][1] = acc_frag(v0, 1); Vb[1][0] = acc_frag(v1, 0); Vb[1][1] = acc_frag(v1, 1);
            }
            {   f32x16 O0 = {}, O1 = {};
                CH_FR8(buf + CH_Q, 264, r32, 32 + r32, 0); CH_MM8(O0, O1, Sb, 0);
                CH_FR8(buf + CH_Q, 264, r32, 32 + r32, 4); CH_MM8(O0, O1, Sb, 4);
                CH_FR8(buf + CH_A, 136, r32, 32 + r32, 0); CH_MM8(O0, O1, Vb, 0);
#pragma unroll
                for (int r = 0; r < 16; ++r) { const int row = scan_row(dir, n * 64 + crow32(r, hi)); outp[(size_t)row * 512 + 32 * sl + r32] = O0[r]; }
#pragma unroll
                for (int r = 0; r < 16; ++r) { const int row = scan_row(dir, n * 64 + 32 + crow32(r, hi)); outp[(size_t)row * 512 + 32 * sl + r32] = O1[r]; }
            }
            S[0] *= dl; S[1] *= dl; S[2] *= dl; S[3] *= dl;
            CH_FR8(buf + CH_K, 136, r32, 32 + r32, 0); CH_MM8(S[0], S[1], Vb, 0);
            CH_FR8(buf + CH_K, 136, 64 + r32, 96 + r32, 0); CH_MM8(S[2], S[3], Vb, 0);
            CH_BAR();
        }
#undef CH_FR8
#undef CH_MM8
        asm volatile("s_waitcnt vmcnt(0)" : "+v"(warm) :: "memory");
    }
    __syncthreads();
}
__device__ __forceinline__ void phase_chain(const Params& p, char* lds) {
#pragma unroll 1
    for (int c = blockIdx.x; c < 16; c += gridDim.x) chain_unit(p, c, lds);
}
__device__ __forceinline__ void fft_fwd(cpx* Z, int tid) {
#pragma unroll 1
    for (int pass = 0; pass < 3; ++pass) { const int lm = pass == 0 ? 10 : (pass == 1 ? 6 : 2);

#pragma unroll 1
        for (int gi = 0; gi < 2; ++gi) fft_pass16<false>(Z, tid + gi * 512, lm);
        __syncthreads(); }
#pragma unroll 1
    for (int it = 0; it < 8; ++it) fft_pass4<false>(Z, tid + it * 512);
    __syncthreads();
}
__device__ __forceinline__ void fft_inv(cpx* Z, int tid) {
#pragma unroll 1
    for (int it = 0; it < 8; ++it) fft_pass4<true>(Z, tid + it * 512);
    __syncthreads();
#pragma unroll 1
    for (int pass = 0; pass < 3; ++pass) { const int lm = pass == 0 ? 2 : (pass == 1 ? 6 : 10);

#pragma unroll 1
        for (int gi = 0; gi < 2; ++gi) fft_pass16<true>(Z, tid + gi * 512, lm);
        __syncthreads(); }
}
constexpr size_t HY_SCR_FLOATS = 2 * 2 * (size_t)FFT_N + (size_t)SEQ;
__device__ __forceinline__ void hyena_latent_unit(const Params& p, int layer, int c, char* lds) {
    cpx* Z = (cpx*)lds; const int tid = otid(), lane = tid & 63;
    float* scr = p.hys() + (size_t)blockIdx.x * HY_SCR_FLOATS;
    cpx* Zh1 = (cpx*)scr; cpx* Zh2 = Zh1 + FFT_N; float* z1s = (float*)(Zh2 + FFT_N);
    const float* vs = p.hyT() + (size_t)c * SEQ; const float* x1s = p.hyT() + (size_t)(512 + c) * SEQ; const float* x2s = p.hyT() + (size_t)(1024 + c) * SEQ;
#pragma unroll 1
    for (int f = 0; f < 2; ++f) {
        const size_t ch = (size_t)layer * 1024 + f * 512 + c;
        const float* hsrc = p.hfilt() + ch * SEQ;
        const f32x4 ps = *(const f32x4*)(p.hsum() + ch * 256 + lane * 4);
        const float tot = wave_sum((ps[0] + ps[1]) + (ps[2] + ps[3]));
        const float scale = (1.0f / (tot + EPS)) * (1.0f / (float)FFT_N);
        {   f32x2 hv[16];
#pragma unroll
            for (int it = 0; it < 16; ++it) hv[it] = *(const f32x2*)(hsrc + 2 * (tid + it * 512));
#pragma unroll
            for (int it = 0; it < 16; ++it) { const int j = tid + it * 512; Z[ZP(j)] = cpx{hv[it][0] * scale, hv[it][1] * scale}; Z[ZP(j + 8192)] = cpx{0.f, 0.f}; } }
        __syncthreads();
        fft_fwd(Z, tid);
        cpx* Zh = f ? Zh2 : Zh1;
#pragma unroll 4
        for (int it = 0; it < 32; ++it) { const int q = tid + it * 512; Zh[q] = Z[ZP(q)]; }
        __syncthreads();
    }
    const float b0 = p.in[I_HBIAS][(size_t)layer * 1024 + c], b1 = p.in[I_HBIAS][(size_t)layer * 1024 + 512 + c];
    {   f32x2 hv[16];
#pragma unroll
        for (int it = 0; it < 16; ++it) hv[it] = *(const f32x2*)(vs + 2 * (tid + it * 512));
#pragma unroll
        for (int it = 0; it < 16; ++it) { const int j = tid + it * 512; Z[ZP(j)] = cpx{hv[it][0], hv[it][1]}; Z[ZP(j + 8192)] = cpx{0.f, 0.f}; } }
    __syncthreads();
    fft_fwd(Z, tid);
    {   cpx ha[16], hb[16];
#pragma unroll
        for (int it = 0; it < 16; ++it) { int pp, pq; fft_pw_idx(tid + it * 512, pp, pq); ha[it] = Zh1[pp]; hb[it] = Zh1[pq]; }
#pragma unroll
        for (int it = 0; it < 16; ++it) fft_pointwise_pre(Z, ha[it], hb[it], tid + it * 512); }
    __syncthreads();
    fft_inv(Z, tid);
#pragma unroll 1
    for (int half = 0; half < 2; ++half) {
        f32x2 va[8], xa[8];
#pragma unroll
        for (int it = 0; it < 8; ++it) { const int j = half * 4096 + tid + it * 512; va[it] = *(const f32x2*)(vs + 2 * j); xa[it] = *(const f32x2*)(x1s + 2 * j); }
#pragma unroll
        for (int it = 0; it < 8; ++it) { const int j = half * 4096 + tid + it * 512;
            const cpx y = Z[ZP(4096 + j)];
            const f32x2 v2 = va[it], xx = xa[it];
            const f32x2 z = {xx[0] * (y.x + b0 * v2[0]), xx[1] * (y.y + b0 * v2[1])};
            *(f32x2*)(z1s + 2 * j) = z; Z[ZP(j)] = cpx{z[0], z[1]};
            if (half) Z[ZP(4096 + j)] = cpx{0.f, 0.f};
            else Z[ZP(12288 + j)] = cpx{0.f, 0.f}; }
        __syncthreads();
    }
    __syncthreads();
    fft_fwd(Z, tid);
    {   cpx ha[16], hb[16];
#pragma unroll
        for (int it = 0; it < 16; ++it) { int pp, pq; fft_pw_idx(tid + it * 512, pp, pq); ha[it] = Zh2[pp]; hb[it] = Zh2[pq]; }
#pragma unroll
        for (int it = 0; it < 16; ++it) fft_pointwise_pre(Z, ha[it], hb[it], tid + it * 512); }
    __syncthreads();
    fft_inv(Z, tid);
    f32x2 za[16], xb[16];
#pragma unroll
    for (int it = 0; it < 16; ++it) { const int j = tid + it * 512; za[it] = *(const f32x2*)(z1s + 2 * j); xb[it] = *(const f32x2*)(x2s + 2 * j); }
#pragma unroll
    for (int it = 0; it < 16; ++it) { const int j = tid + it * 512; const cpx y = Z[ZP(4096 + j)];
        const f32x2 z = za[it], x2 = xb[it];
        *(unsigned*)(p.hyO() + (size_t)c * SEQ + 2 * j) = cvt_pk_bf16(x2[0] * (y.x + b1 * z[0]), x2[1] * (y.y + b1 * z[1])); }
    __syncthreads();
}
__device__ __forceinline__ void hyena_ctx_unit(const Params& p, int c, float* lds) {
    const int tid = otid();
    float* vv = lds; float* x1 = vv + 256; float* x2 = x1 + 256; float* h1 = x2 + 256; float* h2 = h1 + 256; float* z1 = h2 + 256;
    const float* cw = p.in[I_HCONV];
    if (tid < 256) { const int t = tid;
#pragma unroll
        for (int part = 0; part < 3; ++part) {
            const float w0 = cw[part * 512 + c], w1 = cw[1536 + part * 512 + c], w2 = cw[3072 + part * 512 + c];
            const bf16_t* col = p.Pp() + PC_HY + part * 512 + c;
            const float x0 = bf2f(col[(size_t)t * NP]), xm = t > 0 ? bf2f(col[(size_t)(t - 1) * NP]) : 0.f, xn = t < LC - 1 ? bf2f(col[(size_t)(t + 1) * NP]) : 0.f;
            (part == 0 ? vv : (part == 1 ? x1 : x2))[t] = w0 * xm + w1 * x0 + w2 * xn;
        }
        const float s1 = (p.hsc()[c * 4] + p.hsc()[c * 4 + 1]) + (p.hsc()[c * 4 + 2] + p.hsc()[c * 4 + 3]);
        const float s2 = (p.hsc()[(512 + c) * 4] + p.hsc()[(512 + c) * 4 + 1]) + (p.hsc()[(512 + c) * 4 + 2] + p.hsc()[(512 + c) * 4 + 3]);
        h1[t] = p.hfc()[(size_t)c * 256 + t] / (s1 + EPS); h2[t] = p.hfc()[(size_t)(512 + c) * 256 + t] / (s2 + EPS);
    }
    __syncthreads();
    const float b0 = p.in[I_HBIAS][c], b1 = p.in[I_HBIAS][512 + c];
    if (tid < 256) { const int t = tid; float y = 0.f;
        for (int s = 0; s < 256; ++s) { const int m = t - s + 128; if (m >= 0 && m < 256) y += vv[s] * h1[m]; }
        z1[t] = x1[t] * (y + b0 * vv[t]); }
    __syncthreads();
    if (tid < 256) { const int t = tid; float y = 0.f;
        for (int s = 0; s < 256; ++s) { const int m = t - s + 128; if (m >= 0 && m < 256) y += z1[s] * h2[m]; }
        p.ocat()[(size_t)t * D_ + 1024 + c] = f2bf(x2[t] * (y + b1 * z1[t])); }
    __syncthreads();
}
__device__ __forceinline__ void phase_hyena(const Params& p, int layer, char* lds) {
    const int nunits = 512 + (layer == 0 ? 512 : 0);
    for (int u = blockIdx.x; u < nunits; u += gridDim.x) {
        if (u < 512) hyena_latent_unit(p, layer, u, lds); else hyena_ctx_unit(p, u - 512, (float*)lds);
    }
}

__device__ __forceinline__ void phase_gather(const Params& p) {
    const int tid = otid();
    int base[NEXP], cn[NEXP]; { int acc = 0;
#pragma unroll
        for (int e = 0; e < NEXP; ++e) { base[e] = acc * 256; cn[e] = (int)p.cnt()[e]; acc += (cn[e] + 255) >> 8; } }
    for (int i = blockIdx.x * 512 + tid; i < 2 * SEQ; i += gridDim.x * 512) {
        const int t = i >> 1, e = p.tok_e()[i], pos = p.tok_p()[i];
        int b = 0;
#pragma unroll
        for (int k = 0; k < NEXP; ++k) b = (e == k) ? base[k] : b;
        const int row = b + pos;
        p.gidx()[row] = LC + t; p.tok_r()[i] = row; p.hsg()[row] = p.hs()[LC + t];
    }
    for (int i = blockIdx.x * 512 + tid; i < (MAXROWS_MOE / 256) * 8; i += gridDim.x * 512) p.tailidx()[i] = -1;
    for (int i = blockIdx.x * 512 + tid; i < MAXROWS_MOE; i += gridDim.x * 512) ((unsigned*)p.acts())[i] = 0u;
    if (blockIdx.x < NEXP && tid < 256) {
        int b = 0, cc = 0;
#pragma unroll
        for (int k = 0; k < NEXP; ++k) if ((int)blockIdx.x == k) { b = base[k]; cc = cn[k]; }
        const int r = cc + tid; if (r < ((cc + 255) & ~255)) { p.gidx()[b + r] = LC; p.hsg()[b + r] = 0.f; }
    }
}
__device__ __forceinline__ void phase_final(const Params& p) {
    const int tid = otid(), wid = tid >> 6, lane = tid & 63;
    const float* g2 = p.modv() + ((size_t)1 * 2 + 0) * 6 * D_ + 5 * D_;
    const float* fw = p.in[I_FNW];
#ifdef PROBE
    const float prc = ((const float*)(p.cnt() + 32))[0], pre = ((const float*)(p.cnt() + 32))[1];
#endif
    int tn = blockIdx.x * 8 + wid;
    int r0n = p.tok_r()[tn * 2], r1n = p.tok_r()[tn * 2 + 1]; float w0n = p.tok_w()[tn * 2], w1n = p.tok_w()[tn * 2 + 1];
    for (int t = tn; t < SEQ; t += gridDim.x * 8) {
        const int r0 = r0n, r1 = r1n; const float w0 = w0n, w1 = w1n;
        tn = t + gridDim.x * 8; if (tn < SEQ) { r0n = p.tok_r()[tn * 2]; r1n = p.tok_r()[tn * 2 + 1]; w0n = p.tok_w()[tn * 2]; w1n = p.tok_w()[tn * 2 + 1]; }
        const float* xr = p.xcur() + (size_t)(LC + t) * D_;
        f32x4 xv[8]; float ss = 0.f; u32x2 ya[8], yc[8];
#pragma unroll
        for (int i = 0; i < 8; ++i) { const int col = (i * 64 + lane) * 4; ya[i] = *(const u32x2*)(p.yb() + (size_t)r0 * D_ + col); yc[i] = *(const u32x2*)(p.yb() + (size_t)r1 * D_ + col); xv[i] = *(const f32x4*)(xr + col); }
#pragma unroll
        for (int i = 0; i < 8; ++i) { const int col = (i * 64 + lane) * 4;
            const f32x4 y0 = (f32x4){bflo(ya[i].x), bfhi(ya[i].x), bflo(ya[i].y), bfhi(ya[i].y)}, y1 = (f32x4){bflo(yc[i].x), bfhi(yc[i].x), bflo(yc[i].y), bfhi(yc[i].y)};
            const f32x4 y = y0 * w0 + y1 * w1;
            xv[i] = xv[i] + *(const f32x4*)(g2 + col) * y;
            ss += xv[i][0] * xv[i][0] + xv[i][1] * xv[i][1] + xv[i][2] * xv[i][2] + xv[i][3] * xv[i][3]; }
        ss = wave_sum(ss);
        const float rstd = rsqrtf(ss * (1.0f / D_) + EPS);
        f32x4 fwv[8];
#pragma unroll
        for (int i = 0; i < 8; ++i) fwv[i] = *(const f32x4*)(fw + (i * 64 + lane) * 4);
#pragma unroll
        for (int i = 0; i < 8; ++i) { const int col = (i * 64 + lane) * 4; const f32x4 ov = (xv[i] * rstd) * fwv[i];
            *(f32x4*)(p.out + (size_t)t * D_ + col) = ov; }
    }
}

__device__ __forceinline__ void hyprep_unit(const Params& p, int layer, int u, float* tile  ) {
    const int tid = otid(); const int rb = u / 24, cg = u % 24, t0 = rb * 128, ch0 = cg * 64;
    const float* cw = p.in[I_HCONV] + (size_t)layer * 3 * 1536 + ch0;
    {   const int c8 = (tid & 7) * 8; float w0[8], w1[8], w2[8];
#pragma unroll
        for (int e = 0; e < 8; ++e) { w0[e] = cw[c8 + e]; w1[e] = cw[1536 + c8 + e]; w2[e] = cw[3072 + c8 + e]; }
        u32x4 raw[2][3];
#pragma unroll
        for (int i = 0; i < 2; ++i) { const int t = t0 + (tid >> 3) + 64 * i;
            const bf16_t* P0 = p.Pp() + (size_t)(LC + t) * NP + PC_HY + ch0 + c8;
            raw[i][1] = *(const u32x4*)P0; raw[i][0] = *(const u32x4*)(t > 0 ? P0 - NP : P0); raw[i][2] = *(const u32x4*)(t < SEQ - 1 ? P0 + NP : P0); }
#pragma unroll
        for (int i = 0; i < 2; ++i) { const int tl = (tid >> 3) + 64 * i, t = t0 + tl;
            float x0[8], xm[8], xn[8];
            unpack8(raw[i][1], x0); unpack8(raw[i][0], xm); unpack8(raw[i][2], xn);
            const float fm = t > 0 ? 1.f : 0.f, fn = t < SEQ - 1 ? 1.f : 0.f;
#pragma unroll
            for (int e = 0; e < 8; ++e) tile[tl * 65 + c8 + e] = w0[e] * (xm[e] * fm) + w1[e] * x0[e] + w2[e] * (xn[e] * fn); }
    }
    __syncthreads();
    {   const int cl = tid >> 3, tq = (tid & 7) * 16; float* dst = p.hyT() + (size_t)(ch0 + cl) * SEQ + t0 + tq;
#pragma unroll
        for (int k = 0; k < 4; ++k) { f32x4 v;
#pragma unroll
            for (int e = 0; e < 4; ++e) v[e] = tile[(tq + 4 * k + e) * 65 + cl];
            *(f32x4*)(dst + 4 * k) = v; }
    }
    __syncthreads();
}
__device__ __forceinline__ void hyout_unit(const Params& p, int u, float* tile  ) {
    const int tid = otid(); const int rb = u >> 3, cg = u & 7, t0 = rb * 128, c0 = cg * 64;
    {   const int cl = tid >> 3, tq = (tid & 7) * 16; const bf16_t* src = p.hyO() + (size_t)(c0 + cl) * SEQ + t0 + tq;
        float f[8];
        unpack8(*(const u32x4*)src, f);
#pragma unroll
        for (int e = 0; e < 8; ++e) tile[cl * 129 + tq + e] = f[e];
        unpack8(*(const u32x4*)(src + 8), f);
#pragma unroll
        for (int e = 0; e < 8; ++e) tile[cl * 129 + tq + 8 + e] = f[e];
    }
    __syncthreads();
    {   const int c8 = (tid & 7) * 8;
#pragma unroll
        for (int i = 0; i < 2; ++i) { const int tl = (tid >> 3) + 64 * i; float f[8];
#pragma unroll
            for (int e = 0; e < 8; ++e) f[e] = tile[(c8 + e) * 129 + tl];
            *(u32x4*)(p.ocat() + (size_t)(LC + t0 + tl) * D_ + 1024 + c0 + c8) = pack8(f); }
    }
    __syncthreads();
}

__device__ __forceinline__ void phase_quant(const Params& p, const bf16_t* act, signed char* actq, float* rs, int nrows) {
    const int tid = otid(), wid = tid >> 6, lane = tid & 63;
    for (int r = blockIdx.x * 8 + wid; r < nrows; r += gridDim.x * 8) {
        const float am = fmaxf(__uint_as_float(((const unsigned*)rs)[r]), 1e-20f), inv = 127.f / am;
        const bf16_t* src = act + (size_t)r * DFF; signed char* dst = actq + (size_t)r * DFF;
        u32x4 raw[11];
#pragma unroll
        for (int it = 0; it < 11; ++it) raw[it] = *(const u32x4*)(src + (it * 64 + lane) * 8);
#pragma unroll
        for (int it = 0; it < 11; ++it) { float f[8]; unpack8(raw[it], f);
            unsigned w0 = 0u, w1 = 0u;
#pragma unroll
            for (int e = 0; e < 4; ++e) { w0 |= (unsigned)((int)rintf(f[e] * inv) & 255) << (8 * e); w1 |= (unsigned)((int)rintf(f[4 + e] * inv) & 255) << (8 * e); }
            *(u32x2*)(dst + (it * 64 + lane) * 8) = (u32x2){w0, w1}; }
        __builtin_amdgcn_wave_barrier();
        if (lane == 0) rs[r] = am * (1.0f / 127.f);
    }
}
#define XB_TMO      128
#define XB_XCNT(j)  (256  + 64 * (j))
#define XB_XSUB(j)  (1280 + 64 * (j))
#define XB_XGEN(j)  (2304 + 64 * (j))
#define XB_TOP      3328
#define XB_TOPGEN   3392
#define XCD_BAR_WORDS 3456
#define XB_SPIN_CAP (1u << 26)

__device__ __forceinline__ unsigned xb_ld(unsigned* p)              { return __hip_atomic_load(p, __ATOMIC_RELAXED, __HIP_MEMORY_SCOPE_AGENT); }
__device__ __forceinline__ unsigned xb_add(unsigned* p, unsigned v) { return __hip_atomic_fetch_add(p, v, __ATOMIC_RELAXED, __HIP_MEMORY_SCOPE_AGENT); }
__device__ __forceinline__ unsigned xb_xcc_id() { return (unsigned)__builtin_amdgcn_s_getreg((3 << 11) | 20) & 0xFu; }
#define XB_SPIN(cond, bar) do { unsigned _sp = 0; while (cond) { __builtin_amdgcn_s_sleep(1); \
    if ((++_sp & 255u) == 0u) { if (xb_ld(&(bar)[XB_TMO])) break; if (_sp > XB_SPIN_CAP) { atomicAdd(&(bar)[XB_TMO], 1u); break; } } } } while (0)

struct XcdBarrier {
    unsigned* bar; unsigned x;
    volatile LAS unsigned* st;
};

__device__ __forceinline__ XcdBarrier xcd_barrier_post(unsigned* bar, volatile LAS unsigned* st) {
    XcdBarrier b; b.bar = bar; b.x = xb_xcc_id(); b.st = st;
    if (threadIdx.x == 0) (void)xb_add(&bar[XB_XCNT(b.x)], 1u);
    return b;
}
__device__ __forceinline__ void xcd_barrier_complete(unsigned* bar, unsigned x, unsigned& nloc, unsigned& nx) {
    const unsigned G = gridDim.x * gridDim.y * gridDim.z;
    unsigned sum, cnt, mine, sp = 0u;
    for (;;) {
        sum = 0u; cnt = 0u; mine = 0u;
#pragma unroll
        for (unsigned j = 0; j < 16; ++j) { const unsigned c = xb_ld(&bar[XB_XCNT(j)]); sum += c; cnt += (c > 0u) ? 1u : 0u; mine = (j == x) ? c : mine; }
        if (sum == G) break;
        __builtin_amdgcn_s_sleep(1);
        if ((++sp & 255u) == 0u) { if (xb_ld(&bar[XB_TMO])) break; if (sp > XB_SPIN_CAP) { atomicAdd(&bar[XB_TMO], 1u); break; } }
    }
    nloc = mine > 0u ? mine : 1u; nx = cnt > 0u ? cnt : 1u;
}

__device__ __forceinline__ void xcd_barrier(const XcdBarrier& b) {
    asm volatile("s_waitcnt vmcnt(0)" ::: "memory");
    __syncthreads();
    if (threadIdx.x == 0) {
        unsigned* bar = b.bar;
        __builtin_amdgcn_s_waitcnt(0);
        unsigned nloc = b.st[0], nx = b.st[1];
        if (nloc == 0u) { xcd_barrier_complete(bar, b.x, nloc, nx); b.st[0] = nloc; b.st[1] = nx; }
        const unsigned old = xb_add(&bar[XB_XSUB(b.x)], 1u);
        const unsigned gen = old / nloc;
        if (old + 1u == (gen + 1u) * nloc) {
            __builtin_amdgcn_fence(__ATOMIC_RELEASE, "agent");
            asm volatile("s_waitcnt vmcnt(0)" ::: "memory");
            const unsigned og = xb_add(&bar[XB_TOP], 1u);
            const unsigned tg = og / nx;
            if (og + 1u == (tg + 1u) * nx) xb_add(&bar[XB_TOPGEN], 1u);
            else XB_SPIN(xb_ld(&bar[XB_TOPGEN]) == tg, bar);
            __builtin_amdgcn_fence(__ATOMIC_ACQUIRE, "agent");
            xb_add(&bar[XB_XGEN(b.x)], 1u);
            asm volatile("s_waitcnt vmcnt(0)" ::: "memory");
        } else {
            XB_SPIN(xb_ld(&bar[XB_XGEN(b.x)]) == gen, bar);
            __builtin_amdgcn_fence(__ATOMIC_ACQUIRE, "agent");
            asm volatile("s_waitcnt vmcnt(0)" ::: "memory");
        }
    }
    __syncthreads();
}

enum { PH_PRO, PH_NORM1, PH_GIN, PH_PREP, PH_GMLA, PH_ATT, PH_REC, PH_CPREP, PH_CHAIN, PH_MIX3, PH_HY, PH_MIXOUT, PH_GOUT, PH_NORM2, PH_F1, PH_Q1, PH_F2, PH_GATHER, PH_MG1, PH_Q2, PH_MG2, PH_FINAL };
constexpr int LDS_BYTES = 147456;
constexpr int XBW_OFF = LDS_BYTES - 16;

template <int PH> __device__ __forceinline__ void run_phase(const Params& p, int layer, unsigned char* shm) {
    LAS unsigned char* lds3 = (LAS unsigned char*)shm;
    const int G = gridDim.x, c = blockIdx.x;
    if constexpr (PH == PH_PRO) phase_prologue(p, (float*)shm);
    else if constexpr (PH == PH_NORM1) {
        phase_norm(p, layer, 1, 0, shm);
    }
    else if constexpr (PH == PH_GIN) {
        pg8::Gemm g{p.hbuf(), p.wb_in() + (size_t)layer * NP * (D_ / 2), D_ / 2, D_ / 2, D_ / 2, 0, nullptr};
        pg8::StaticOrder S; S.init(MT, NP, G, c, D_ / 2);
        pg8::EpiStoreBf16 E{p.Pp(), NP, nullptr, 1 << 30, nullptr, nullptr, p.hs(), p.wam() + WAM_IN + layer * NP};
        pg8::gemm_phase<pg8::EpiStoreBf16, pg8::StaticOrder, false, true>(lds3, g, S, E);
    }
    else if constexpr (PH == PH_PREP) phase_prep(p, layer);
    else if constexpr (PH == PH_GMLA) {
        pg8::Gemm g{p.Pp() + PC_CQ, p.wb_mla() + (size_t)layer * MLAN * MLAK, MLAK, NP, MLAK, 0, nullptr};
        pg8::StaticOrder S; S.init(MT, MLAN, G, c, MLAK);
        pg8::EpiStoreBf16 E{p.qkvup(), MLAN, p.mrs(), 3, nullptr, nullptr, nullptr, nullptr};
        pg8::gemm_phase(lds3, g, S, E);
    }
    else if constexpr (PH == PH_ATT) phase_attn(p, layer, (char*)shm);
    else if constexpr (PH == PH_REC) phase_rec_naive(p, layer, (float*)shm);
    else if constexpr (PH == PH_CPREP) {
        phase_chunkprep(p, layer, (char*)shm);
#pragma unroll 1
        for (int u = c; u < 128 * 24; u += G) hyprep_unit(p, layer, u, (float*)shm);
    }
    else if constexpr (PH == PH_CHAIN) phase_chain(p, (char*)shm);
    else if constexpr (PH == PH_MIX3) {
        const int nctx = layer == 0 ? 4 : 0, nq = 64 + nctx + 512 + (layer == 0 ? 512 : 0);
        unsigned* qctr = p.cnt() + 16 + layer; volatile LAS unsigned* qw = (volatile LAS unsigned*)(LAS unsigned char*)(shm + XBW_OFF - 32);
        int code = c < 16 ? c : (c < 256 ? 16 + c : -1);
#pragma unroll 1
        for (;;) {
            if (code < 0) {
                __syncthreads();
                if (otid() == 0) qw[0] = atomicAdd(qctr, 1u);
                __syncthreads();
                const int q = (int)qw[0];
                if (q >= nq) break;
                code = q < 64 ? 1300 + q : (q < 64 + nctx ? 16 + 256 + (q - 64) : (q < 64 + nctx + 512 ? 276 + (q - 64 - nctx) : 788 + (q - 64 - nctx - 512)));
            }
            if (code < 16) chain_unit(p, code, (char*)shm);
            else if (code < 276 || code >= 1300) { const bool spl = code >= 1300; attn_unit(p, spl ? (code - 1300) >> 2 : code - 16, spl ? (code - 1300) & 3 : -1, (char*)shm); }
            else if (code < 788) hyena_latent_unit(p, layer, code - 276, (char*)shm);
            else hyena_ctx_unit(p, code - 788, (float*)shm);
            code = -1;
        }
    }
    else if constexpr (PH == PH_HY) phase_hyena(p, layer, (char*)shm);
    else if constexpr (PH == PH_MIXOUT) {
        phase_mixout(p, layer);
        __syncthreads();
#pragma unroll 1
        for (int u = c; u < 128 * 8; u += G) hyout_unit(p, u, (float*)shm);
    }
    else if constexpr (PH == PH_GOUT) {
        const float* mv = p.modv() + (size_t)layer * 2 * 6 * D_;
        if (layer == 0) {
            pg8::Gemm g{p.ocat(), p.wb_out(), D_, D_, D_, 0, nullptr};
            pg8::CtxSplitOrder S; S.init(G, c, D_, 4);
            pg8::EpiResGate E{p.xcur(), p.in[I_CTX], p.in[I_X], mv + 6 * D_ + 2 * D_, mv + 2 * D_, 0, p.partG(), nullptr, nullptr};
            pg8::gemm_phase(lds3, g, S, E);
        } else {
            pg8::Gemm g{p.ocat() + (size_t)LC * D_, p.wb_out() + (size_t)D_ * D_, D_, D_, D_, 0, nullptr};
            pg8::StaticOrder S; S.init(SEQ, D_, G, c, D_);
            pg8::EpiResGate E{p.xcur(), p.xcur(), p.xcur() + (size_t)LC * D_, mv + 6 * D_ + 2 * D_, mv + 2 * D_, LC, nullptr, nullptr, nullptr};
            pg8::gemm_phase(lds3, g, S, E);
        }
    }
    else if constexpr (PH == PH_NORM2) {
        phase_norm(p, layer, 2, layer == 0 ? 0 : LC, shm);
    }
    else if constexpr (PH == PH_F1) {
        pg8::Gemm g{p.hbuf(), p.wb_f13(), D_ / 2, D_ / 2, D_ / 2, 0, nullptr};
        pg8::StaticOrder S; S.init(MT, 2 * DFF, G, c, D_ / 2);
        pg8::EpiSwiGLU E{p.act(), DFF, p.hs(), p.wam() + WAM_F13, (unsigned*)p.acts()};
        pg8::gemm_phase<pg8::EpiSwiGLU, pg8::StaticOrder, false, true>(lds3, g, S, E);
    }
    else if constexpr (PH == PH_Q1) phase_quant(p, p.act(), p.actq(), p.acts(), MT);
    else if constexpr (PH == PH_F2) {
        const float* mv = p.modv();
        pg8::Gemm g{(const bf16_t*)p.actq(), p.wb_f2(), DFF / 2, DFF / 2, DFF / 2, 0, nullptr};
        pg8::CtxSplitOrder S; S.init(G, c, DFF / 2, 11);
        pg8::EpiResGate E{p.xcur(), p.xcur(), p.xcur() + (size_t)LC * D_, mv + 6 * D_ + 5 * D_, mv + 5 * D_, 0, p.partF(), p.acts(), p.wam() + WAM_F2};
        pg8::gemm_phase<pg8::EpiResGate, pg8::CtxSplitOrder, false, true>(lds3, g, S, E);
    }
    else if constexpr (PH == PH_GATHER) phase_gather(p);
    else if constexpr (PH == PH_MG1) {
        pg8::Gemm g{p.hbuf(), p.wb_m13(), D_ / 2, D_ / 2, D_ / 2, (size_t)2 * DFF * (D_ / 2), p.gidx()};
        pg8::GroupedOrder S; S.init(p.cnt(), 2 * DFF, G, c, D_ / 2);
        pg8::EpiSwiGLU E{p.act_moe(), DFF, p.hsg(), p.wam() + WAM_M13, (unsigned*)p.acts()};
        pg8::gemm_phase<pg8::EpiSwiGLU, pg8::GroupedOrder, true, true>(lds3, g, S, E);
    }
    else if constexpr (PH == PH_Q2) { int np = 0;
#pragma unroll
        for (int e = 0; e < NEXP; ++e) np += ((int)p.cnt()[e] + 255) >> 8;
        phase_quant(p, p.act_moe(), p.actq_moe(), p.acts(), np * 256); }
    else if constexpr (PH == PH_MG2) {
        pg8::Gemm g{(const bf16_t*)p.actq_moe(), p.wb_m2(), DFF / 2, DFF / 2, DFF / 2, (size_t)D_ * (DFF / 2), nullptr};
        pg8::GroupedOrder S; S.init(p.cnt(), D_, G, c, DFF / 2, false);
        pg8::EpiStoreBf16 E{p.yb(), D_, nullptr, 1 << 30, p.ypart(), p.tailidx(), p.acts(), p.wam() + WAM_M2};
        pg8::gemm_phase<pg8::EpiStoreBf16, pg8::GroupedOrder, false, true>(lds3, g, S, E);
    }
    else if constexpr (PH == PH_FINAL) phase_final(p);
}

#ifndef MEGA
#define MEGA 1
#endif
template <int PH> __global__ __launch_bounds__(512, 2) void k_ph(Params p, int layer) {
    extern __shared__ __attribute__((aligned(16))) unsigned char shm[];
    run_phase<PH>(p, layer, shm);
}
#ifdef PROBE
#ifndef PROBE_A0
#define PROBE_A0 0
#define PROBE_A1 1
#define PROBE_B0 0
#define PROBE_B1 1
#endif
#define STAMP(k) do { if (blockIdx.x == 0 && otid() == 0) tsl[k] = (unsigned long long)wall_clock64(); } while (0)
#else
#define STAMP(k) do {} while (0)
#endif
__global__ __launch_bounds__(512, 2) void k_mega(Params p) {
    extern __shared__ __attribute__((aligned(16))) unsigned char shm[];
    volatile LAS unsigned* xbw = (volatile LAS unsigned*)(LAS unsigned char*)(shm + XBW_OFF);
#ifdef PROBE
    volatile LAS unsigned long long* tsl = (volatile LAS unsigned long long*)(LAS unsigned char*)(shm + XBW_OFF - 512);
#endif
    if (otid() == 0) { xbw[0] = 0u; xbw[1] = 0u; xbw[2] = 0u; xbw[3] = 0u; }
    __syncthreads();
    STAMP(0);
    (void)xcd_barrier_post(p.bar(), xbw);
#define GBAR() do { XcdBarrier _b; _b.bar = p.bar(); _b.x = xb_xcc_id(); _b.st = xbw; xcd_barrier(_b); } while (0)
    run_phase<PH_PRO>(p, 0, shm); GBAR(); STAMP(1);
#pragma unroll 1
    for (int l = 0; l < 2; ++l) {
        const int sb = 2 + 16 * l; (void)sb;
        run_phase<PH_NORM1>(p, l, shm); GBAR(); STAMP(sb + 0);
        run_phase<PH_GIN>(p, l, shm); GBAR(); STAMP(sb + 1);
        run_phase<PH_PREP>(p, l, shm); GBAR(); STAMP(sb + 2);
        run_phase<PH_GMLA>(p, l, shm); __syncthreads();
        run_phase<PH_CPREP>(p, l, shm); GBAR(); STAMP(sb + 3);
        run_phase<PH_MIX3>(p, l, shm); GBAR(); STAMP(sb + 6);
        run_phase<PH_MIXOUT>(p, l, shm); GBAR(); STAMP(sb + 7);
        run_phase<PH_GOUT>(p, l, shm); GBAR(); STAMP(sb + 8);
        run_phase<PH_NORM2>(p, l, shm); GBAR(); STAMP(sb + 9);
        if (l == 0) {
            run_phase<PH_F1>(p, l, shm); GBAR(); STAMP(sb + 10);
            run_phase<PH_Q1>(p, l, shm); GBAR();
            run_phase<PH_F2>(p, l, shm); GBAR(); STAMP(sb + 11);
        } else {
            run_phase<PH_GATHER>(p, l, shm); GBAR(); STAMP(sb + 10);
            run_phase<PH_MG1>(p, l, shm); GBAR(); STAMP(sb + 11);
            run_phase<PH_Q2>(p, l, shm); GBAR();
            run_phase<PH_MG2>(p, l, shm); GBAR(); STAMP(sb + 12);
#ifdef PROBE
            if (blockIdx.x == 0 && otid() == 0) {
                float* pw = (float*)(p.cnt() + 32);
                pw[0] = (float)(tsl[PROBE_A1] - tsl[PROBE_A0]) * 1e-5f; pw[1] = (float)(tsl[PROBE_B1] - tsl[PROBE_B0]) * 0.0025f;
            }
            GBAR();
#endif
            run_phase<PH_FINAL>(p, l, shm);
        }
    }
}
template <int PH> static void launch_ph(const Params& p, int layer, int grid, hipStream_t st) {
    static bool attr = false;
    if (!attr) { (void)hipFuncSetAttribute((const void*)k_ph<PH>, hipFuncAttributeMaxDynamicSharedMemorySize, LDS_BYTES); attr = true; }
    hipLaunchKernelGGL((k_ph<PH>), dim3(grid), dim3(512), LDS_BYTES, st, p, layer);
}

static size_t align_up(size_t x) { return (x + 255) & ~(size_t)255; }
extern "C" void kernel_launch(void* const* d_in, const int* in_sizes, int n_in, void* d_out, int out_size, void* d_ws, size_t ws_size, hipStream_t stream) {
    Params p{};
    for (int i = 0; i < N_IN; ++i) p.in[i] = (const float*)d_in[i];
    p.out = (float*)d_out;
    static int GRID = 0;
    if (!GRID) {
#if MEGA
        int dev = 0, cus = 0, per_cu = 0;
        (void)hipGetDevice(&dev);
        (void)hipDeviceGetAttribute(&cus, hipDeviceAttributeMultiprocessorCount, dev);
        (void)hipFuncSetAttribute((const void*)k_mega, hipFuncAttributeMaxDynamicSharedMemorySize, LDS_BYTES);
        (void)hipOccupancyMaxActiveBlocksPerMultiprocessor(&per_cu, k_mega, 512, LDS_BYTES);
        if (per_cu < 1 || cus < 1) { fprintf(stderr, "kernel_launch: occupancy query failed (%d blocks/CU, %d CUs)\n", per_cu, cus); return; }
        GRID = cus < WS_GRID ? cus : WS_GRID;
#else
        GRID = 256;
#endif
    }
    p.ws = (char*)d_ws;
    if (ws_size < WSL.need) { fprintf(stderr, "kernel_launch: workspace too small: %zu < %zu\n", ws_size, (size_t)WSL.need); return; }
#if MEGA
    (void)hipMemsetAsync((char*)d_ws + WSL.bar, 0, WSL.modv - WSL.bar, stream);
    hipLaunchKernelGGL(k_mega, dim3(GRID), dim3(512), LDS_BYTES, stream, p);
#else
    launch_ph<PH_PRO>(p, 0, GRID, stream);
    for (int l = 0; l < 2; ++l) {
        launch_ph<PH_NORM1>(p, l, GRID, stream);
        launch_ph<PH_GIN>(p, l, GRID, stream);
        launch_ph<PH_PREP>(p, l, GRID, stream);
        launch_ph<PH_GMLA>(p, l, GRID, stream);
        launch_ph<PH_ATT>(p, l, GRID, stream);
        launch_ph<PH_CPREP>(p, l, GRID, stream);
        launch_ph<PH_CHAIN>(p, l, GRID, stream);
        launch_ph<PH_HY>(p, l, GRID, stream);
        launch_ph<PH_MIXOUT>(p, l, GRID, stream);
        launch_ph<PH_GOUT>(p, l, GRID, stream);
        launch_ph<PH_NORM2>(p, l, GRID, stream);
        if (l == 0) { launch_ph<PH_F1>(p, l, GRID, stream); launch_ph<PH_F2>(p, l, GRID, stream); }
        else { launch_ph<PH_GATHER>(p, l, GRID, stream); launch_ph<PH_MG1>(p, l, GRID, stream); launch_ph<PH_MG2>(p, l, GRID, stream); launch_ph<PH_FINAL>(p, l, GRID, stream); }
    }
#endif
}
```

```cpp
#include <hip/hip_runtime.h>
#include <stdint.h>
#include <math.h>
#include <stdio.h>

#define LAS __attribute__((address_space(3)))
typedef unsigned short bf16_t;
typedef short bf16x8 __attribute__((ext_vector_type(8)));
typedef short s16x4 __attribute__((ext_vector_type(4)));
typedef float f32x4 __attribute__((ext_vector_type(4)));
typedef float f32x2 __attribute__((ext_vector_type(2)));
typedef float f32x16 __attribute__((ext_vector_type(16)));
typedef unsigned u32x4 __attribute__((ext_vector_type(4)));
typedef unsigned u32x2 __attribute__((ext_vector_type(2)));

constexpr int D_ = 2048, SEQ = 16384, LC = 256, MT = 16640, NP = 6400, DFF = 5632, NEXP = 8, DIN = 6288;
constexpr int PC_GQKV = 0, PC_GZ = 1536, PC_HY = 2048, PC_RQKV = 3584, PC_RG = 5120, PC_CQ = 5632, PC_CKV = 6144, PC_KR = 6272, PC_A = 6336, PC_B = 6344;
constexpr int MLAK = 640, MLAN = 1792;
constexpr float EPS = 1e-6f;
constexpr int MAXROWS_MOE = 2 * SEQ + NEXP * 256;
enum { I_X, I_C, I_CTX, I_CCTX, I_N1W, I_N2W, I_MODW, I_MODB, I_WIN, I_WOUT, I_GCONV, I_GALOG, I_GDT, I_GNW, I_MQN, I_MUQ, I_MKVN, I_MUKV,
       I_HCONV, I_HW1, I_HB1, I_HW2, I_HB2, I_HW3, I_HB3, I_HW4, I_HFREQ, I_HBIAS, I_FW1, I_FW3, I_FW2, I_ROUTER, I_MW1, I_MW3, I_MW2, I_FNW, N_IN };

constexpr int NCHUNK_ = MT / 64;
constexpr size_t REC_BYTES_ = 73984, HY_SCR_FLOATS_ = 2 * 2 * (size_t)16384 + (size_t)SEQ;
constexpr int WS_GRID = 256;
constexpr int WAM_F13 = 0, WAM_F2 = 2 * DFF, WAM_M13 = WAM_F2 + D_, WAM_M2 = WAM_M13 + NEXP * 2 * DFF, WAM_IN = WAM_M2 + NEXP * D_, WAM_WORDS = WAM_IN + 2 * NP;
struct WsLayout { size_t bar, cnt, wam, hs, acts, hsg, modv, xcur, hbuf, tok_r, tok_w, tok_e, tok_p, gidx, tailidx, wq_m13, wq_m2, wb_in, wb_out, wb_mla, wb_f13, wb_f2, hfilt, hsum, hfc, hsc, Pp, gqkv, ggb, rqk, mrs, krr, qkvup, go, ro, recs, hys, ocat,
                  act, wb_m13, wb_m2, hg, yb, act_moe, hyT, hyO, partG, partF, attp, actq, actq_moe, need; };
constexpr size_t ws_al(size_t x) { return (x + 255) & ~(size_t)255; }
constexpr WsLayout make_ws_layout() {
    WsLayout L{}; size_t off = 0;
    L.bar = off; off = ws_al(off + 16384); L.cnt = off; off = ws_al(off + 256);
    L.wam = off; off = ws_al(off + (size_t)WAM_WORDS * 4);
    L.hs = off; off = ws_al(off + (size_t)MT * 4); L.acts = off; off = ws_al(off + (size_t)MAXROWS_MOE * 4); L.hsg = off; off = ws_al(off + (size_t)MAXROWS_MOE * 4);
    L.modv = off; off = ws_al(off + (size_t)2 * 2 * 6 * D_ * 4);
    L.xcur = off; off = ws_al(off + (size_t)MT * D_ * 4);
    L.hbuf = off; off = ws_al(off + (size_t)MT * D_);
    L.tok_r = off; off = ws_al(off + (size_t)2 * SEQ * 4); L.tok_w = off; off = ws_al(off + (size_t)2 * SEQ * 4); L.tok_e = off; off = ws_al(off + (size_t)2 * SEQ * 4); L.tok_p = off; off = ws_al(off + (size_t)2 * SEQ * 4); L.gidx = off; off = ws_al(off + (size_t)MAXROWS_MOE * 4); L.tailidx = off; off = ws_al(off + (size_t)(MAXROWS_MOE / 256) * 8 * 4);
    L.wq_m13 = off; off = ws_al(off + (size_t)NEXP * 2 * DFF * D_); L.wq_m2 = off; off = ws_al(off + (size_t)NEXP * D_ * DFF);
    const size_t region = off;
    L.wb_in = off; off = ws_al(off + (size_t)2 * NP * D_); L.wb_out = off; off = ws_al(off + (size_t)2 * D_ * D_ * 2); L.wb_mla = off; off = ws_al(off + (size_t)2 * MLAN * MLAK * 2);
    L.wb_f13 = off; off = ws_al(off + (size_t)2 * DFF * D_); L.wb_f2 = off; off = ws_al(off + (size_t)D_ * DFF);
    L.hfilt = off; off = ws_al(off + (size_t)2 * 1024 * SEQ * 4); L.hsum = off; off = ws_al(off + (size_t)2 * 1024 * 256 * 4); L.hfc = off; off = ws_al(off + (size_t)1024 * 256 * 4); L.hsc = off; off = ws_al(off + (size_t)1024 * 4 * 4);
    const size_t arena = off;
    L.Pp = off; off = ws_al(off + (size_t)MT * NP * 2);
    L.gqkv = off; off = ws_al(off + (size_t)MT * 1536 * 2); L.ggb = off; off = ws_al(off + (size_t)MT * 16 * 4); L.rqk = off; off = ws_al(off + (size_t)MT * 1024 * 2);
    L.mrs = off; off = ws_al(off + (size_t)MT * 2 * 4); L.krr = off; off = ws_al(off + (size_t)MT * 64 * 2); L.qkvup = off; off = ws_al(off + (size_t)MT * MLAN * 2);
    L.go = off; off = ws_al(off + (size_t)2 * MT * 512 * 4); L.ro = off; off = ws_al(off + (size_t)2 * MT * 512 * 4);
    L.recs = off; off = ws_al(off + (size_t)16 * NCHUNK_ * REC_BYTES_);
    L.hys = off; off = ws_al(off + (size_t)WS_GRID * HY_SCR_FLOATS_ * 4);
    L.hyT = off; off = ws_al(off + (size_t)1536 * SEQ * 4); L.hyO = off; off = ws_al(off + (size_t)512 * SEQ * 2);
    L.attp = off; off = ws_al(off + (size_t)64 * (256 * 128 + 512) * 4);
    L.ocat = L.gqkv;
    L.partG = L.recs; L.partF = L.recs + ws_al((size_t)4 * LC * D_ * 4);
    const size_t end1 = off;
    L.act = arena;
    L.actq = L.gqkv;
    off = region;
    L.wb_m13 = L.wq_m13; L.wb_m2 = L.wq_m2;
    L.hg = off; L.yb = off; off = ws_al(off + (size_t)MAXROWS_MOE * D_ * 2);
    L.act_moe = off; off = ws_al(off + (size_t)MAXROWS_MOE * DFF * 2);
    L.actq_moe = off; off = ws_al(off + (size_t)MAXROWS_MOE * DFF);
    const size_t end2 = off;
    L.need = end1 > end2 ? end1 : end2;
    return L;
}
constexpr WsLayout WSL = make_ws_layout();
struct Params {
    const float* in[N_IN];
    float* out;
    char* ws;
    __device__ __forceinline__ unsigned* bar() const { return (unsigned*)(ws + WSL.bar); }
    __device__ __forceinline__ unsigned* cnt() const { return (unsigned*)(ws + WSL.cnt); }
    __device__ __forceinline__ unsigned* wam() const { return (unsigned*)(ws + WSL.wam); }
    __device__ __forceinline__ float* hs() const { return (float*)(ws + WSL.hs); }
    __device__ __forceinline__ float* acts() const { return (float*)(ws + WSL.acts); }
    __device__ __forceinline__ float* hsg() const { return (float*)(ws + WSL.hsg); }
    __device__ __forceinline__ float* modv() const { return (float*)(ws + WSL.modv); }
    __device__ __forceinline__ bf16_t* wb_in() const { return (bf16_t*)(ws + WSL.wb_in); }
    __device__ __forceinline__ bf16_t* wb_out() const { return (bf16_t*)(ws + WSL.wb_out); }
    __device__ __forceinline__ bf16_t* wb_mla() const { return (bf16_t*)(ws + WSL.wb_mla); }
    __device__ __forceinline__ bf16_t* wb_f13() const { return (bf16_t*)(ws + WSL.wb_f13); }
    __device__ __forceinline__ bf16_t* wb_f2() const { return (bf16_t*)(ws + WSL.wb_f2); }
    __device__ __forceinline__ bf16_t* wb_m13() const { return (bf16_t*)(ws + WSL.wb_m13); }
    __device__ __forceinline__ bf16_t* wb_m2() const { return (bf16_t*)(ws + WSL.wb_m2); }
    __device__ __forceinline__ float* hfilt() const { return (float*)(ws + WSL.hfilt); }
    __device__ __forceinline__ float* hsum() const { return (float*)(ws + WSL.hsum); }
    __device__ __forceinline__ float* hfc() const { return (float*)(ws + WSL.hfc); }
    __device__ __forceinline__ float* hsc() const { return (float*)(ws + WSL.hsc); }
    __device__ __forceinline__ float* xcur() const { return (float*)(ws + WSL.xcur); }
    __device__ __forceinline__ bf16_t* hbuf() const { return (bf16_t*)(ws + WSL.hbuf); }
    __device__ __forceinline__ bf16_t* Pp() const { return (bf16_t*)(ws + WSL.Pp); }
    __device__ __forceinline__ bf16_t* gqkv() const { return (bf16_t*)(ws + WSL.gqkv); }
    __device__ __forceinline__ float* ggb() const { return (float*)(ws + WSL.ggb); }
    __device__ __forceinline__ bf16_t* rqk() const { return (bf16_t*)(ws + WSL.rqk); }
    __device__ __forceinline__ float* mrs() const { return (float*)(ws + WSL.mrs); }
    __device__ __forceinline__ bf16_t* krr() const { return (bf16_t*)(ws + WSL.krr); }
    __device__ __forceinline__ bf16_t* qkvup() const { return (bf16_t*)(ws + WSL.qkvup); }
    __device__ __forceinline__ float* go() const { return (float*)(ws + WSL.go); }
    __device__ __forceinline__ float* ro() const { return (float*)(ws + WSL.ro); }
    __device__ __forceinline__ char* recs() const { return (char*)(ws + WSL.recs); }
    __device__ __forceinline__ float* hys() const { return (float*)(ws + WSL.hys); }
    __device__ __forceinline__ float* hyT() const { return (float*)(ws + WSL.hyT); }
    __device__ __forceinline__ bf16_t* hyO() const { return (bf16_t*)(ws + WSL.hyO); }
    __device__ __forceinline__ float* partG() const { return (float*)(ws + WSL.partG); }
    __device__ __forceinline__ float* partF() const { return (float*)(ws + WSL.partF); }
    __device__ __forceinline__ float* attp() const { return (float*)(ws + WSL.attp); }
    __device__ __forceinline__ signed char* actq() const { return (signed char*)(ws + WSL.actq); }
    __device__ __forceinline__ signed char* actq_moe() const { return (signed char*)(ws + WSL.actq_moe); }
    __device__ __forceinline__ bf16_t* ocat() const { return (bf16_t*)(ws + WSL.ocat); }
    __device__ __forceinline__ bf16_t* act() const { return (bf16_t*)(ws + WSL.act); }
    __device__ __forceinline__ bf16_t* act_moe() const { return (bf16_t*)(ws + WSL.act_moe); }
    __device__ __forceinline__ bf16_t* hg() const { return (bf16_t*)(ws + WSL.hg); }
    __device__ __forceinline__ bf16_t* yb() const { return (bf16_t*)(ws + WSL.yb); }
    __device__ __forceinline__ int* tok_r() const { return (int*)(ws + WSL.tok_r); }
    __device__ __forceinline__ float* tok_w() const { return (float*)(ws + WSL.tok_w); }
    __device__ __forceinline__ int* tok_e() const { return (int*)(ws + WSL.tok_e); }
    __device__ __forceinline__ int* tok_p() const { return (int*)(ws + WSL.tok_p); }
    __device__ __forceinline__ int* gidx() const { return (int*)(ws + WSL.gidx); }
    __device__ __forceinline__ int* tailidx() const { return (int*)(ws + WSL.tailidx); }
    __device__ __forceinline__ float* ypart() const { return (float*)(ws + WSL.wb_m13); }
};

__device__ __forceinline__ int otid() { int t = threadIdx.x; asm volatile("" : "+v"(t)); return t; }
__device__ __forceinline__ unsigned cvt_pk_bf16(float lo, float hi) { unsigned r; asm volatile("v_cvt_pk_bf16_f32 %0, %1, %2" : "=v"(r) : "v"(lo), "v"(hi)); return r; }
__device__ __forceinline__ bf16_t f2bf(float x) { return (bf16_t)(cvt_pk_bf16(x, 0.f) & 0xffffu); }
__device__ __forceinline__ float bf2f(bf16_t b) { return __uint_as_float(((unsigned)b) << 16); }
__device__ __forceinline__ float bflo(unsigned w) { return __uint_as_float(w << 16); }
__device__ __forceinline__ float bfhi(unsigned w) { return __uint_as_float(w & 0xffff0000u); }
__device__ __forceinline__ float silu_f(float x) { return x / (1.f + __expf(-x)); }
__device__ __forceinline__ float sigmoid_f(float x) { return 1.f / (1.f + __expf(-x)); }
__device__ __forceinline__ float softplus_f(float x) { return fmaxf(x, 0.f) + __logf(1.f + __expf(-fabsf(x))); }
__device__ __forceinline__ float shflx(float v, int o, int lane) { return __int_as_float(__builtin_amdgcn_ds_bpermute((lane ^ o) << 2, __float_as_int(v))); }
__device__ __forceinline__ float wave_sum(float v) {
    const int lane = otid() & 63;
#pragma unroll
    for (int o = 32; o >= 1; o >>= 1) v += shflx(v, o, lane);
    return v;
}
__device__ __forceinline__ float sum16(float v) {
    const int lane = otid() & 63;
#pragma unroll
    for (int o = 8; o >= 1; o >>= 1) v += shflx(v, o, lane);
    return v;
}
__device__ __forceinline__ void unpack8(u32x4 w, float (&f)[8]) {
    f[0] = bflo(w.x); f[1] = bfhi(w.x); f[2] = bflo(w.y); f[3] = bfhi(w.y); f[4] = bflo(w.z); f[5] = bfhi(w.z); f[6] = bflo(w.w); f[7] = bfhi(w.w);
}
__device__ __forceinline__ u32x4 pack8(const float (&f)[8]) {
    u32x4 w; w.x = cvt_pk_bf16(f[0], f[1]); w.y = cvt_pk_bf16(f[2], f[3]); w.z = cvt_pk_bf16(f[4], f[5]); w.w = cvt_pk_bf16(f[6], f[7]); return w;
}

namespace pg8 {
constexpr int BM = 256, BK = 64, HALF = 128, HTB = HALF * BK * 2, STAGE_BYTES = 8 * HTB, NXCD = 8, WGM = 4;
__host__ __device__ __forceinline__ int lds_byte(int r, int c) { const int st = (r >> 4) * 2 + (c >> 5), rr = r & 15, cc = c & 31, ob = rr * 64 + cc * 2; return st * 1024 + (ob ^ (((ob >> 9) & 1) << 5)); }
__host__ __device__ __forceinline__ void stage_rc(int b, int& R, int& C) { const int st = b / 1024, sb = b % 1024, swz = sb ^ (((sb >> 9) & 1) << 5); R = (st >> 1) * 16 + swz / 64; C = (st & 1) * 32 + (swz % 64) / 2; }
__host__ __device__ __forceinline__ int perm32(int rho) { const int n = rho >> 4, i = rho & 15; return 8 * (i >> 2) + 4 * n + (i & 3); }
struct Unit { int pm, pn, e, kt0, nt, ks, tu; };
struct Gemm { const bf16_t* A; const bf16_t* Bt; int K, lda, ldb; size_t estride; const int* gidx; };

struct StaticOrder {
    int nM, nN, nwg, G, c, ntk;
    __device__ void init(int M, int N, int G_, int c_, int K) { nM = M / BM; nN = N / BM; nwg = nM * nN; G = G_; c = c_; ntk = K / BK; }
    __device__ bool next(int i, Unit& u) const {
        const long L = (long)i * G + c; if (L >= nwg) return false;
        int wgid = (int)L; { const int q = nwg / NXCD, r = nwg % NXCD, xcd = wgid % NXCD, off = wgid / NXCD; wgid = (xcd < r ? xcd * (q + 1) : r * (q + 1) + (xcd - r) * q) + off; }
        const int nig = WGM * nN, gid = wgid / nig, fm = gid * WGM, gsz = (nM - fm) < WGM ? (nM - fm) : WGM;
        u.pm = fm + ((wgid % nig) % gsz); u.pn = (wgid % nig) / gsz; u.e = 0; u.kt0 = 0; u.nt = ntk; u.ks = -1; u.tu = 0; return true;
    }
    __device__ __forceinline__ void a_ready(const Unit&) const {}
    __device__ __forceinline__ void done(const Unit&) const {}
};
struct CtxSplitOrder {
    StaticOrder S; int ns, G, c;
    __device__ void init(int G_, int c_, int K, int NS) { S.init(SEQ, D_, G_, c_, K); ns = NS; G = G_; c = c_; }
    __device__ bool next(int i, Unit& u) const {
        const long L = (long)i * G + c;
        if (L < S.nwg) { S.next(i, u); u.pm += 1; return true; }
        const int s = (int)(L - S.nwg); if (s >= 8 * ns) return false;
        u.pm = 0; u.pn = s & 7; u.e = 0; u.ks = s >> 3; u.tu = 0; u.nt = S.ntk / ns; u.kt0 = u.ks * u.nt; return true;
    }
    __device__ __forceinline__ void a_ready(const Unit&) const {}
    __device__ __forceinline__ void done(const Unit&) const {}
};
struct GroupedOrder {
    int pb[NEXP + 1]; int ub[NEXP + 1]; int nN, nwg, G, c, ntk, nfull, ntail;
    __device__ void init(const unsigned* cnt, int N, int G_, int c_, int K, bool split_tail = false) {
        ntk = K / BK; nN = N / BM; int acc = 0, ua = 0;
#pragma unroll
        for (int e = 0; e < NEXP; ++e) { pb[e] = acc; ub[e] = ua; const int np = ((int)cnt[e] + 255) >> 8; acc += np; ua += np * nN; }
        pb[NEXP] = acc; ub[NEXP] = ua; nwg = ua; G = G_; c = c_;
        const int rem = nwg % G; ntail = (split_tail && rem > 0 && rem <= 64) ? rem : 0; nfull = nwg - ntail;
    }
    __device__ bool next(int i, Unit& u) const {
        long L = (long)i * G + c; int ks = -1, tu = 0;
        if (L >= nfull) { const long t = L - nfull; if (t >= (long)ntail * 4) return false; tu = (int)(t >> 2); ks = (int)(t & 3); L = nfull + tu; }
        int wgid = (int)L; { const int q = nwg / NXCD, r = nwg % NXCD, xcd = wgid % NXCD, off = wgid / NXCD; wgid = (xcd < r ? xcd * (q + 1) : r * (q + 1) + (xcd - r) * q) + off; }
        int e = 0;
#pragma unroll
        for (int k = 1; k < NEXP; ++k) e += (wgid >= ub[k]) ? 1 : 0;
        int ube = 0, pbe = 0, npe = 0;
#pragma unroll
        for (int k = 0; k < NEXP; ++k) if (e == k) { ube = ub[k]; pbe = pb[k]; npe = pb[k + 1] - pb[k]; }
        const int l = wgid - ube, nig = WGM * nN, gid = l / nig, fm = gid * WGM, gsz = (npe - fm) < WGM ? (npe - fm) : WGM;
        u.pm = pbe + fm + ((l % nig) % gsz); u.pn = (l % nig) / gsz; u.e = e; u.ks = ks; u.tu = tu;
        const int ntq = ntk >> 2; u.nt = ks < 0 ? ntk : ntq; u.kt0 = ks < 0 ? 0 : ks * ntq;
        return true;
    }
    __device__ __forceinline__ void a_ready(const Unit&) const {}
    __device__ __forceinline__ void done(const Unit&) const {}
};

typedef int i32x4 __attribute__((ext_vector_type(4)));
template <class Epi, class Sched, bool GATHER = false, bool I8 = false>
__device__ __forceinline__ void gemm_phase(LAS unsigned char* lds, const Gemm g, const Sched& S, const Epi& E) {
    const int tid = otid(), wid = __builtin_amdgcn_readfirstlane(tid >> 6), lane = tid & 63, wr = wid >> 2, wc = wid & 3, fr = lane & 15, fq = lane >> 4;
    unsigned voffA[2], voffB[2]; int rA[2], cA2[2];
#pragma unroll
    for (int i = 0; i < 2; ++i) { int R, C; stage_rc(tid * 16 + i * 8192, R, C); const int Rb = Epi::PERM ? ((R & ~31) + perm32(R & 31)) : R;
        voffA[i] = (unsigned)(R * g.lda + C) * 2u; voffB[i] = (unsigned)(Rb * g.ldb + C) * 2u; rA[i] = R; cA2[i] = C * 2; }
    unsigned gA[2][2], gN[2][2];
#define PG8_GIDX(dst, pm_) do { _Pragma("unroll") for (int h_ = 0; h_ < 2; ++h_) _Pragma("unroll") for (int i_ = 0; i_ < 2; ++i_) \
        dst[h_][i_] = (unsigned)g.gidx[(pm_) * BM + h_ * HALF + rA[i_]] * (unsigned)(g.lda * 2) + (unsigned)cA2[i_]; } while (0)
#define PG8_STAGE_A(bufoff, kptr, h, useN) do { if constexpr (GATHER) { _Pragma("unroll") for (int _i = 0; _i < 2; ++_i) \
        __builtin_amdgcn_global_load_lds((const unsigned*)((const char*)(kptr) + ((useN) ? gN[h][_i] : gA[h][_i])), (LAS unsigned*)(lds + (bufoff) + ldsw + _i * 8192), 16, 0, 0); } \
        else PG8_STAGE(bufoff, (kptr) + (h) * hstepA, voffA); } while (0)
    const size_t kstep = (size_t)(BK * 2);
    const size_t hstepA = (size_t)HALF * g.lda * 2, hstepB = (size_t)HALF * g.ldb * 2;
    const size_t tstepA = 2 * hstepA, tstepB = 2 * hstepB;
    const unsigned ldsw = (unsigned)wid * 1024u;
    const int aoff = lds_byte(wr * 64 + fr, fq * 8), boff = lds_byte(wc * 32 + fr, fq * 8);
#define PG8_SA(b, h) (((b) * 2 + (h)) * HTB)
#define PG8_SB(b, h) ((4 + (b) * 2 + (h)) * HTB)
#define PG8_STAGE(bufoff, gbase, voff) do { _Pragma("unroll") for (int _i = 0; _i < 2; ++_i) \
        __builtin_amdgcn_global_load_lds((const unsigned*)((const char*)(gbase) + (voff)[_i]), (LAS unsigned*)(lds + (bufoff) + ldsw + _i * 8192), 16, 0, 0); } while (0)
#define PG8_LDA(dst, b, h) do { _Pragma("unroll") for (int m = 0; m < 4; ++m) _Pragma("unroll") for (int k = 0; k < 2; ++k) dst[m][k] = *(const LAS bf16x8*)(lds + PG8_SA(b, h) + aoff + m * 2048 + k * 1024); } while (0)
#define PG8_LDB(dst, b, h) do { _Pragma("unroll") for (int n = 0; n < 2; ++n) _Pragma("unroll") for (int k = 0; k < 2; ++k) dst[n][k] = *(const LAS bf16x8*)(lds + PG8_SB(b, h) + boff + n * 2048 + k * 1024); } while (0)
#define PG8_MMA(ai, bj, At, Bt) do { __builtin_amdgcn_s_setprio(1); _Pragma("unroll") for (int m = 0; m < 4; ++m) _Pragma("unroll") for (int n = 0; n < 2; ++n) _Pragma("unroll") for (int k = 0; k < 2; ++k) \
        { if constexpr (I8) acc[ai][bj][m][n] = __builtin_bit_cast(f32x4, __builtin_amdgcn_mfma_i32_16x16x64_i8(__builtin_bit_cast(i32x4, Bt[n][k]), __builtin_bit_cast(i32x4, At[m][k]), __builtin_bit_cast(i32x4, acc[ai][bj][m][n]), 0, 0, 0)); \
          else acc[ai][bj][m][n] = __builtin_amdgcn_mfma_f32_16x16x32_bf16(Bt[n][k], At[m][k], acc[ai][bj][m][n], 0, 0, 0); } __builtin_amdgcn_s_setprio(0); } while (0)
#define PG8_WAIT_V(n) asm volatile("s_waitcnt vmcnt(" #n ")" ::: "memory")
#define PG8_WAIT_L(n) asm volatile("s_waitcnt lgkmcnt(" #n ")" ::: "memory")
#define PG8_BAR __builtin_amdgcn_s_barrier()
#define PG8_SCHED __builtin_amdgcn_sched_barrier(0)
    Unit cur, nxt; int ui = 0; typename Epi::Regs er;
    if (!S.next(0, cur)) return;
    f32x4 acc[2][2][4][2];
#pragma unroll
    for (int a = 0; a < 2; ++a)
#pragma unroll
        for (int b = 0; b < 2; ++b)
#pragma unroll
            for (int m = 0; m < 4; ++m)
#pragma unroll
                for (int n = 0; n < 2; ++n) acc[a][b][m][n] = (f32x4){0.f, 0.f, 0.f, 0.f};
    bf16x8 At[4][2], B0[2][2], B1[2][2];
    const char* cA = (const char*)g.A + (GATHER ? (size_t)0 : (size_t)cur.pm * tstepA) + (size_t)cur.kt0 * kstep; const char* cB = (const char*)g.Bt + (size_t)cur.pn * tstepB + (size_t)cur.e * g.estride * 2 + (size_t)cur.kt0 * kstep;
    S.a_ready(cur);
    if constexpr (GATHER) { PG8_GIDX(gA, cur.pm); }
    PG8_STAGE(PG8_SB(0, 0), cB, voffB); PG8_STAGE_A(PG8_SA(0, 0), cA, 0, false); PG8_STAGE(PG8_SB(0, 1), cB + hstepB, voffB); PG8_STAGE_A(PG8_SA(0, 1), cA, 1, false);
    if (wr == 1) PG8_BAR;
    PG8_WAIT_V(4); PG8_BAR;
    PG8_STAGE(PG8_SB(1, 0), cB + kstep, voffB); PG8_STAGE_A(PG8_SA(1, 0), cA + kstep, 0, false); PG8_STAGE(PG8_SB(1, 1), cB + hstepB + kstep, voffB);
    PG8_WAIT_V(6); PG8_BAR;
    for (;;) {
        const bool has_next = S.next(ui + 1, nxt);
        const char* nA = has_next ? (const char*)g.A + (GATHER ? (size_t)0 : (size_t)nxt.pm * tstepA) + (size_t)nxt.kt0 * kstep : cA;
        if constexpr (GATHER) { if (has_next) { PG8_GIDX(gN, nxt.pm); } else { _Pragma("unroll") for (int h_ = 0; h_ < 2; ++h_) _Pragma("unroll") for (int i_ = 0; i_ < 2; ++i_) gN[h_][i_] = gA[h_][i_]; } }
        const char* nB = has_next ? (const char*)g.Bt + (size_t)nxt.pn * tstepB + (size_t)nxt.e * g.estride * 2 + (size_t)nxt.kt0 * kstep : cB;
        const int nt = cur.nt;
        for (int t = 0; t < nt; t += 2) {
            const bool last = (t == nt - 2);
            const char* a1 = cA + (size_t)(t + 1) * kstep;
            const char* a2 = last ? nA : cA + (size_t)(t + 2) * kstep; const char* b2 = last ? nB : cB + (size_t)(t + 2) * kstep;
            const char* a3 = a2 + kstep; const char* b3 = b2 + kstep;
            if (last && has_next) S.a_ready(nxt);
            PG8_LDB(B0, 0, 0); PG8_SCHED; PG8_LDA(At, 0, 0); PG8_STAGE_A(PG8_SA(1, 1), a1, 1, false);
            PG8_WAIT_L(8); PG8_BAR; PG8_WAIT_L(0); PG8_MMA(0, 0, At, B0); PG8_BAR; PG8_SCHED;
            PG8_LDB(B1, 0, 1); PG8_STAGE(PG8_SB(0, 0), b2, voffB);
            PG8_BAR; PG8_WAIT_L(0); PG8_MMA(0, 1, At, B1); PG8_BAR;
            PG8_LDA(At, 0, 1); PG8_STAGE_A(PG8_SA(0, 0), a2, 0, last);
            PG8_BAR; PG8_WAIT_L(0); PG8_MMA(1, 0, At, B0); PG8_BAR; PG8_SCHED;
            PG8_STAGE(PG8_SB(0, 1), b2 + hstepB, voffB);
            PG8_WAIT_V(6); PG8_BAR; PG8_MMA(1, 1, At, B1); PG8_BAR;
            PG8_LDB(B0, 1, 0); PG8_SCHED; PG8_LDA(At, 1, 0); PG8_STAGE_A(PG8_SA(0, 1), a2, 1, last);
            PG8_WAIT_L(8); PG8_BAR; PG8_WAIT_L(0); PG8_MMA(0, 0, At, B0); PG8_BAR; PG8_SCHED;
            PG8_LDB(B1, 1, 1); PG8_STAGE(PG8_SB(1, 0), b3, voffB);
            PG8_BAR; PG8_WAIT_L(0); PG8_MMA(0, 1, At, B1); PG8_BAR;
            PG8_LDA(At, 1, 1); PG8_STAGE_A(PG8_SA(1, 0), a3, 0, last);
            PG8_BAR; PG8_WAIT_L(0); PG8_MMA(1, 0, At, B0); PG8_BAR; PG8_SCHED;
            PG8_STAGE(PG8_SB(1, 1), b3 + hstepB, voffB);
            PG8_WAIT_V(6); PG8_BAR; PG8_MMA(1, 1, At, B1); PG8_BAR;
        }
        E.pre(er, cur, wr, wc, fr, fq);
        if constexpr (I8) {
#pragma unroll
            for (int a = 0; a < 2; ++a)
#pragma unroll
                for (int b = 0; b < 2; ++b)
#pragma unroll
                    for (int m = 0; m < 4; ++m)
#pragma unroll
                        for (int n = 0; n < 2; ++n) { const i32x4 iv = __builtin_bit_cast(i32x4, acc[a][b][m][n]); acc[a][b][m][n] = (f32x4){(float)iv[0], (float)iv[1], (float)iv[2], (float)iv[3]}; }
        }
        E(acc, cur, wr, wc, fr, fq, er); S.done(cur);
        if (!has_next) break;
#pragma unroll
        for (int a = 0; a < 2; ++a)
#pragma unroll
            for (int b = 0; b < 2; ++b)
#pragma unroll
                for (int m = 0; m < 4; ++m)
#pragma unroll
                    for (int n = 0; n < 2; ++n) acc[a][b][m][n] = (f32x4){0.f, 0.f, 0.f, 0.f};
        cur = nxt; cA = nA; cB = nB; ++ui;
        if constexpr (GATHER) { _Pragma("unroll") for (int h_ = 0; h_ < 2; ++h_) _Pragma("unroll") for (int i_ = 0; i_ < 2; ++i_) gA[h_][i_] = gN[h_][i_]; }
    }
    PG8_WAIT_V(0);
    if (wr == 0) PG8_BAR;
    PG8_BAR;
#undef PG8_SA
#undef PG8_GIDX
#undef PG8_STAGE_A
#undef PG8_SB
#undef PG8_STAGE
#undef PG8_LDA
#undef PG8_LDB
#undef PG8_MMA
#undef PG8_WAIT_V
#undef PG8_WAIT_L
#undef PG8_BAR
#undef PG8_SCHED
}

struct EpiStoreBf16 {
    static constexpr bool PERM = true;
    bf16_t* O; int ldc; const float* rs; int rs_split; float* part; int* tailidx; const float* sa; const unsigned* sb;
    struct Regs { float scr[8]; f32x4 cs[2][2]; };
    __device__ __forceinline__ void pre(Regs& R, const Unit& u, int wr, int wc, int fr, int fq) const {
        const int row0 = u.pm * BM + wr * 64 + fr, col0 = u.pn * BM + wc * 32 + 8 * fq; const int sel = (u.pn >= rs_split) ? 1 : 0;
#pragma unroll
        for (int i = 0; i < 8; ++i) { const int row = row0 + (i >> 2) * HALF + (i & 3) * 16; R.scr[i] = (rs ? rs[row * 2 + sel] : 1.f) * (sa ? sa[row] : 1.f); }
#pragma unroll
        for (int bj = 0; bj < 2; ++bj) { if (sb) { const u32x4* sp = (const u32x4*)(sb + (size_t)u.e * D_ + col0 + bj * HALF); const u32x4 a = sp[0], b = sp[1];
                R.cs[bj][0] = (f32x4){__uint_as_float(a.x), __uint_as_float(a.y), __uint_as_float(a.z), __uint_as_float(a.w)} * (1.0f / 127.f);
                R.cs[bj][1] = (f32x4){__uint_as_float(b.x), __uint_as_float(b.y), __uint_as_float(b.z), __uint_as_float(b.w)} * (1.0f / 127.f); }
            else { R.cs[bj][0] = (f32x4){1.f, 1.f, 1.f, 1.f}; R.cs[bj][1] = R.cs[bj][0]; } }
    }
    __device__ __forceinline__ void operator()(const f32x4 (&acc)[2][2][4][2], const Unit& u, int wr, int wc, int fr, int fq, const Regs& R) const {
        if (u.ks >= 0) {
            float* pp = part + ((size_t)(u.tu * 4 + u.ks) * BM + wr * 64 + fr) * BM + wc * 32 + 8 * fq;
#pragma unroll
            for (int ai = 0; ai < 2; ++ai)
#pragma unroll
                for (int m = 0; m < 4; ++m)
#pragma unroll
                    for (int bj = 0; bj < 2; ++bj)
#pragma unroll
                        for (int n = 0; n < 2; ++n) *(f32x4*)(pp + (size_t)(ai * HALF + m * 16) * BM + bj * HALF + 4 * n) = acc[ai][bj][m][n];
            if (wr == 0 && wc == 0 && fr == 0 && fq == 0) tailidx[u.pm * 8 + u.pn] = u.tu;
            return;
        }
        const int row0 = u.pm * BM + wr * 64 + fr, col0 = u.pn * BM + wc * 32 + 8 * fq;
        const int sel = (u.pn >= rs_split) ? 1 : 0;
#pragma unroll
        for (int ai = 0; ai < 2; ++ai)
#pragma unroll
            for (int m = 0; m < 4; ++m) { const int row = row0 + ai * HALF + m * 16; bf16_t* rowp = O + (size_t)row * ldc + col0;
                const float sc = R.scr[ai * 4 + m];
#pragma unroll
                for (int bj = 0; bj < 2; ++bj) { f32x4 v0 = acc[ai][bj][m][0] * sc, v1 = acc[ai][bj][m][1] * sc;
                    if (sb) { v0 *= R.cs[bj][0]; v1 *= R.cs[bj][1]; }
                    u32x4 w; w.x = cvt_pk_bf16(v0[0], v0[1]); w.y = cvt_pk_bf16(v0[2], v0[3]); w.z = cvt_pk_bf16(v1[0], v1[1]); w.w = cvt_pk_bf16(v1[2], v1[3]);
                    *(u32x4*)(rowp + bj * HALF) = w; } }
    }
};
struct EpiResGate {
    static constexpr bool PERM = false;
    float* out; const float* res_ctx; const float* res_lat; const float* gate_ctx; const float* gate_lat; int rowbase; float* part;
    const float* sa; const unsigned* sb;
    struct Regs { float ra[8]; };
    __device__ __forceinline__ void pre(Regs& R, const Unit& u, int wr, int wc, int fr, int fq) const {
        const int r0 = u.pm * BM + wr * 64 + fr;
#pragma unroll
        for (int i = 0; i < 8; ++i) R.ra[i] = sa ? sa[r0 + (i >> 2) * HALF + (i & 3) * 16] : 1.f;
    }
    __device__ __forceinline__ void operator()(const f32x4 (&acc)[2][2][4][2], const Unit& u, int wr, int wc, int fr, int fq, const Regs& R) const {
        const int row0 = rowbase + u.pm * BM + wr * 64 + fr, col0 = u.pn * BM + wc * 32 + 4 * fq;
        f32x4 cs[2][2];
#pragma unroll
        for (int bj = 0; bj < 2; ++bj)
#pragma unroll
            for (int n = 0; n < 2; ++n) { if (sb) { const unsigned* sp = sb + col0 + bj * HALF + n * 16; cs[bj][n] = (f32x4){__uint_as_float(sp[0]), __uint_as_float(sp[1]), __uint_as_float(sp[2]), __uint_as_float(sp[3])} * (1.0f / 127.f); }
                else cs[bj][n] = (f32x4){1.f, 1.f, 1.f, 1.f}; }
        if (u.ks >= 0) {
            float* pp = part + ((size_t)u.ks * LC + wr * 64 + fr) * D_ + col0;
#pragma unroll
            for (int ai = 0; ai < 2; ++ai)
#pragma unroll
                for (int m = 0; m < 4; ++m)
#pragma unroll
                    for (int bj = 0; bj < 2; ++bj)
#pragma unroll
                        for (int n = 0; n < 2; ++n) *(f32x4*)(pp + (size_t)(ai * HALF + m * 16) * D_ + bj * HALF + n * 16) = acc[ai][bj][m][n] * cs[bj][n] * R.ra[ai * 4 + m];
            return;
        }
        f32x4 g4[2][2];
#pragma unroll
        for (int bj = 0; bj < 2; ++bj)
#pragma unroll
            for (int n = 0; n < 2; ++n) g4[bj][n] = *(const f32x4*)(gate_lat + col0 + bj * HALF + n * 16) * cs[bj][n];
#pragma unroll
        for (int hb = 0; hb < 4; ++hb) { f32x4 r4[2][2][2];
#pragma unroll
            for (int mm = 0; mm < 2; ++mm) { const int ai = hb >> 1, m = (hb & 1) * 2 + mm; const float* rp = res_lat + (size_t)(row0 + ai * HALF + m * 16 - LC) * D_;
#pragma unroll
                for (int bj = 0; bj < 2; ++bj)
#pragma unroll
                    for (int n = 0; n < 2; ++n) r4[mm][bj][n] = *(const f32x4*)(rp + col0 + bj * HALF + n * 16); }
#pragma unroll
            for (int mm = 0; mm < 2; ++mm) { const int ai = hb >> 1, m = (hb & 1) * 2 + mm; float* op = out + (size_t)(row0 + ai * HALF + m * 16) * D_;
#pragma unroll
                for (int bj = 0; bj < 2; ++bj)
#pragma unroll
                    for (int n = 0; n < 2; ++n) *(f32x4*)(op + col0 + bj * HALF + n * 16) = r4[mm][bj][n] + g4[bj][n] * (acc[ai][bj][m][n] * R.ra[ai * 4 + m]); } }
    }
};
struct EpiSwiGLU {
    static constexpr bool PERM = true;
    bf16_t* O; int ldc; const float* sa; const unsigned* sb; unsigned* rmax;
    struct Regs { float rav[8]; u32x4 sg[2], su[2]; };
    __device__ __forceinline__ void pre(Regs& R, const Unit& u, int wr, int wc, int fr, int fq) const {
        const int row0 = u.pm * BM + wr * 64 + fr;
#pragma unroll
        for (int i = 0; i < 8; ++i) R.rav[i] = sa ? sa[row0 + (i >> 2) * HALF + (i & 3) * 16] : 1.f;
        if (sb) { const unsigned* sp = sb + (size_t)u.e * (2 * DFF) + u.pn * BM + wc * 32 + 8 * fq;
            R.sg[0] = *(const u32x4*)sp; R.sg[1] = *(const u32x4*)(sp + 4); R.su[0] = *(const u32x4*)(sp + HALF); R.su[1] = *(const u32x4*)(sp + HALF + 4); }
    }
    __device__ __forceinline__ void operator()(const f32x4 (&acc)[2][2][4][2], const Unit& u, int wr, int wc, int fr, int fq, const Regs& R) const {
        const int row0 = u.pm * BM + wr * 64 + fr, col0 = u.pn * HALF + wc * 32 + 8 * fq;
        float sg[8], su[8];
#pragma unroll
        for (int j = 0; j < 8; ++j) { sg[j] = 1.f; su[j] = 1.f; }
        if (sb) {
#pragma unroll
            for (int j = 0; j < 8; ++j) { sg[j] = __uint_as_float(R.sg[j >> 2][j & 3]) * (1.0f / 127.f); su[j] = __uint_as_float(R.su[j >> 2][j & 3]) * (1.0f / 127.f); } }
#pragma unroll
        for (int ai = 0; ai < 2; ++ai)
#pragma unroll
            for (int m = 0; m < 4; ++m) { const int row = row0 + ai * HALF + m * 16; bf16_t* rowp = O + (size_t)row * ldc + col0;
                const float ra = R.rav[ai * 4 + m];
                float o[8];
#pragma unroll
                for (int n = 0; n < 2; ++n)
#pragma unroll
                    for (int j = 0; j < 4; ++j) { const float gte = acc[ai][0][m][n][j] * (ra * sg[n * 4 + j]), up = acc[ai][1][m][n][j] * (ra * su[n * 4 + j]); o[n * 4 + j] = gte * __builtin_amdgcn_rcpf(1.f + __expf(-gte)) * up; }
                *(u32x4*)rowp = pack8(o);
                if (rmax) { float mx = fmaxf(fmaxf(fmaxf(fabsf(o[0]), fabsf(o[1])), fmaxf(fabsf(o[2]), fabsf(o[3]))), fmaxf(fmaxf(fabsf(o[4]), fabsf(o[5])), fmaxf(fabsf(o[6]), fabsf(o[7]))));
                    const int ln = otid() & 63; mx = fmaxf(mx, shflx(mx, 16, ln)); mx = fmaxf(mx, shflx(mx, 32, ln));
                    if (fq == 0) atomicMax(rmax + row, __float_as_uint(mx)); } }
    }
};
}
#ifndef FFT_DEV_H
#define FFT_DEV_H
#ifndef FFT_HOST
#define FFT_FN __device__ __forceinline__
struct cpx { float x, y; };
FFT_FN void tw(float frac, float& c, float& s) { c = __builtin_amdgcn_cosf(frac); s = __builtin_amdgcn_sinf(frac); }
#else
#include <cmath>
#define FFT_FN static inline
struct cpx { float x, y; };
FFT_FN void tw(float frac, float& c, float& s) { c = (float)cos(6.283185307179586 * (double)frac); s = (float)sin(6.283185307179586 * (double)frac); }
#endif
#define ZP(i) ((i) + (((i) >> 6) << 2))
constexpr int FFT_N = 16384;
constexpr int FFT_ZN = FFT_N + 4 * (FFT_N / 64);

FFT_FN void bf_dif(cpx& a, cpx& b, float c, float s) {
    const float dx = a.x - b.x, dy = a.y - b.y;
    a.x += b.x; a.y += b.y;
    b.x = dx * c + dy * s; b.y = dy * c - dx * s;
}
FFT_FN void bf_dit(cpx& a, cpx& b, float c, float s) {
    const float tx = b.x * c - b.y * s, ty = b.x * s + b.y * c;
    b.x = a.x - tx; b.y = a.y - ty; a.x += tx; a.y += ty;
}
template <int K16> FFT_FN void rot16(float c0, float s0, float& c, float& s) {
    constexpr float CR[16] = {1.f, 0.9238795325112867f, 0.7071067811865476f, 0.3826834323650898f, 0.f, -0.3826834323650898f, -0.7071067811865476f, -0.9238795325112867f,
                              -1.f, -0.9238795325112867f, -0.7071067811865476f, -0.3826834323650898f, 0.f, 0.3826834323650898f, 0.7071067811865476f, 0.9238795325112867f};
    constexpr float SR[16] = {0.f, 0.3826834323650898f, 0.7071067811865476f, 0.9238795325112867f, 1.f, 0.9238795325112867f, 0.7071067811865476f, 0.3826834323650898f,
                              0.f, -0.3826834323650898f, -0.7071067811865476f, -0.9238795325112867f, -1.f, -0.9238795325112867f, -0.7071067811865476f, -0.3826834323650898f};
    constexpr float cr = CR[K16 & 15], sr = SR[K16 & 15];
    if constexpr ((K16 & 15) == 0) { c = c0; s = s0; }
    else if constexpr ((K16 & 15) == 4) { c = -s0; s = c0; }
    else if constexpr ((K16 & 15) == 8) { c = -c0; s = -s0; }
    else if constexpr ((K16 & 15) == 12) { c = s0; s = -c0; }
    else { c = c0 * cr - s0 * sr; s = s0 * cr + c0 * sr; }
}
#define FFT_BF(DIFDIT, ra, rb, K16, cb, sb) do { float _c, _s; rot16<K16>(cb, sb, _c, _s); DIFDIT(v[ra], v[rb], _c, _s); } while (0)
template <bool INV> FFT_FN void fft_pass16(cpx* Z, int g, int lm) {
    const int mp = 1 << lm, ilo = g & (mp - 1), ihi = g >> lm, base = (ihi << (lm + 4)) + ilo;
    const int zb = ZP(base), st = (lm >= 6) ? mp + (mp >> 4) : mp;
    cpx v[16];
#pragma unroll
    for (int r = 0; r < 16; ++r) v[r] = Z[zb + r * st];
#ifndef FFT_HOST
    const float th = __builtin_amdgcn_ldexpf((float)ilo, -(lm + 4));
#else
    const float th = (float)ilo / (float)(16 * mp);
#endif
    float cA, sA, cB, sB, cC, sC, cD, sD;
    tw(th, cA, sA); tw(2.f * th, cB, sB); tw(4.f * th, cC, sC); tw(8.f * th, cD, sD);
    if (!INV) {
        FFT_BF(bf_dif, 0, 8, 0, cA, sA); FFT_BF(bf_dif, 1, 9, 1, cA, sA); FFT_BF(bf_dif, 2, 10, 2, cA, sA); FFT_BF(bf_dif, 3, 11, 3, cA, sA);
        FFT_BF(bf_dif, 4, 12, 4, cA, sA); FFT_BF(bf_dif, 5, 13, 5, cA, sA); FFT_BF(bf_dif, 6, 14, 6, cA, sA); FFT_BF(bf_dif, 7, 15, 7, cA, sA);
        FFT_BF(bf_dif, 0, 4, 0, cB, sB); FFT_BF(bf_dif, 1, 5, 2, cB, sB); FFT_BF(bf_dif, 2, 6, 4, cB, sB); FFT_BF(bf_dif, 3, 7, 6, cB, sB);
        FFT_BF(bf_dif, 8, 12, 0, cB, sB); FFT_BF(bf_dif, 9, 13, 2, cB, sB); FFT_BF(bf_dif, 10, 14, 4, cB, sB); FFT_BF(bf_dif, 11, 15, 6, cB, sB);
        FFT_BF(bf_dif, 0, 2, 0, cC, sC); FFT_BF(bf_dif, 1, 3, 4, cC, sC); FFT_BF(bf_dif, 4, 6, 0, cC, sC); FFT_BF(bf_dif, 5, 7, 4, cC, sC);
        FFT_BF(bf_dif, 8, 10, 0, cC, sC); FFT_BF(bf_dif, 9, 11, 4, cC, sC); FFT_BF(bf_dif, 12, 14, 0, cC, sC); FFT_BF(bf_dif, 13, 15, 4, cC, sC);
#pragma unroll
        for (int r = 0; r < 16; r += 2) bf_dif(v[r], v[r + 1], cD, sD);
    } else {
#pragma unroll
        for (int r = 0; r < 16; r += 2) bf_dit(v[r], v[r + 1], cD, sD);
        FFT_BF(bf_dit, 0, 2, 0, cC, sC); FFT_BF(bf_dit, 1, 3, 4, cC, sC); FFT_BF(bf_dit, 4, 6, 0, cC, sC); FFT_BF(bf_dit, 5, 7, 4, cC, sC);
        FFT_BF(bf_dit, 8, 10, 0, cC, sC); FFT_BF(bf_dit, 9, 11, 4, cC, sC); FFT_BF(bf_dit, 12, 14, 0, cC, sC); FFT_BF(bf_dit, 13, 15, 4, cC, sC);
        FFT_BF(bf_dit, 0, 4, 0, cB, sB); FFT_BF(bf_dit, 1, 5, 2, cB, sB); FFT_BF(bf_dit, 2, 6, 4, cB, sB); FFT_BF(bf_dit, 3, 7, 6, cB, sB);
        FFT_BF(bf_dit, 8, 12, 0, cB, sB); FFT_BF(bf_dit, 9, 13, 2, cB, sB); FFT_BF(bf_dit, 10, 14, 4, cB, sB); FFT_BF(bf_dit, 11, 15, 6, cB, sB);
        FFT_BF(bf_dit, 0, 8, 0, cA, sA); FFT_BF(bf_dit, 1, 9, 1, cA, sA); FFT_BF(bf_dit, 2, 10, 2, cA, sA); FFT_BF(bf_dit, 3, 11, 3, cA, sA);
        FFT_BF(bf_dit, 4, 12, 4, cA, sA); FFT_BF(bf_dit, 5, 13, 5, cA, sA); FFT_BF(bf_dit, 6, 14, 6, cA, sA); FFT_BF(bf_dit, 7, 15, 7, cA, sA);
    }
#pragma unroll
    for (int r = 0; r < 16; ++r) Z[zb + r * st] = v[r];
}
template <bool INV> FFT_FN void fft_pass4(cpx* Z, int g) {
    const int base = 4 * g;
#ifndef FFT_HOST
    typedef float f4_t __attribute__((ext_vector_type(4)));
    f4_t* zv = (f4_t*)(Z + ZP(base)); const f4_t q0 = zv[0], q1 = zv[1];
    cpx a = {q0[0], q0[1]}, b = {q0[2], q0[3]}, c = {q1[0], q1[1]}, d = {q1[2], q1[3]};
#else
    cpx a = Z[ZP(base)], b = Z[ZP(base + 1)], c = Z[ZP(base + 2)], d = Z[ZP(base + 3)];
#endif
    if (!INV) {
        cpx a2 = {a.x + c.x, a.y + c.y}, c2 = {a.x - c.x, a.y - c.y};
        cpx b2 = {b.x + d.x, b.y + d.y}, t = {b.x - d.x, b.y - d.y}; cpx d2 = {t.y, -t.x};
        a = {a2.x + b2.x, a2.y + b2.y}; b = {a2.x - b2.x, a2.y - b2.y};
        c = {c2.x + d2.x, c2.y + d2.y}; d = {c2.x - d2.x, c2.y - d2.y};
    } else {
        cpx a2 = {a.x + b.x, a.y + b.y}, b2 = {a.x - b.x, a.y - b.y};
        cpx c2 = {c.x + d.x, c.y + d.y}, d2 = {c.x - d.x, c.y - d.y};
        a = {a2.x + c2.x, a2.y + c2.y}; c = {a2.x - c2.x, a2.y - c2.y};
        cpx t = {-d2.y, d2.x};
        b = {b2.x + t.x, b2.y + t.y}; d = {b2.x - t.x, b2.y - t.y};
    }
#ifndef FFT_HOST
    zv[0] = (f4_t){a.x, a.y, b.x, b.y}; zv[1] = (f4_t){c.x, c.y, d.x, d.y};
#else
    Z[ZP(base)] = a; Z[ZP(base + 1)] = b; Z[ZP(base + 2)] = c; Z[ZP(base + 3)] = d;
#endif
}
FFT_FN int rev14(int p) {
#ifndef FFT_HOST
    return (int)(__builtin_bitreverse32((unsigned)p) >> 18);
#else
    int r = 0; for (int b = 0; b < 14; ++b) r |= ((p >> b) & 1) << (13 - b); return r;
#endif
}
FFT_FN int ilog2(int q) {
#ifndef FFT_HOST
    return 31 - __builtin_clz((unsigned)q);
#else
    int b = 0; while ((1 << (b + 1)) <= q) ++b; return b;
#endif
}
FFT_FN void fft_pw_idx(int q, int& pp, int& pq) { if (q == 0) { pp = 0; pq = 1; return; } const int b = ilog2(q); pp = (2 << b) + (q - (1 << b)); pq = 3 * (2 << b) - 1 - pp; }
FFT_FN void fft_pointwise_pre(cpx* Z, const cpx HA, const cpx HB, int q) {
    if (q == 0) {
        { const cpx a = Z[ZP(0)]; Z[ZP(0)] = cpx{a.x * HA.x + a.y * HA.y, a.x * HA.y + a.y * HA.x}; }
        { const cpx a = Z[ZP(1)]; Z[ZP(1)] = cpx{a.x * HB.x - a.y * HB.y, a.x * HB.y + a.y * HB.x}; }
        return;
    }
    const int b = ilog2(q), pp = (2 << b) + (q - (1 << b)), pq = 3 * (2 << b) - 1 - pp;
    const int kk = rev14(pp);
    float wc, ws; tw((float)kk * (1.0f / (float)FFT_N), wc, ws);
    const cpx A = Z[ZP(pp)], B = Z[ZP(pq)];
    const cpx Ue = {0.5f * (A.x + B.x), 0.5f * (A.y - B.y)};
    const cpx dU = {A.x - B.x, A.y + B.y};
    const cpx Uo = {0.5f * dU.y, -0.5f * dU.x};
    const cpx He = {0.5f * (HA.x + HB.x), 0.5f * (HA.y - HB.y)};
    const cpx dH = {HA.x - HB.x, HA.y + HB.y};
    const cpx Ho = {0.5f * dH.y, -0.5f * dH.x};
    const cpx UoHo = {Uo.x * Ho.x - Uo.y * Ho.y, Uo.x * Ho.y + Uo.y * Ho.x};
    const cpx wUH = {wc * UoHo.x + ws * UoHo.y, wc * UoHo.y - ws * UoHo.x};
    const cpx Ye = {Ue.x * He.x - Ue.y * He.y + wUH.x, Ue.x * He.y + Ue.y * He.x + wUH.y};
    const cpx Yo = {Ue.x * Ho.x - Ue.y * Ho.y + Uo.x * He.x - Uo.y * He.y, Ue.x * Ho.y + Ue.y * Ho.x + Uo.x * He.y + Uo.y * He.x};
    cpx o1 = {Ye.x - Yo.y, Ye.y + Yo.x};
    cpx o2 = {Ye.x + Yo.y, -Ye.y + Yo.x};
    Z[ZP(pp)] = o1; Z[ZP(pq)] = o2;
}
FFT_FN void fft_pointwise(cpx* Z, const cpx* Zh, int q) {
    if (q == 0) {
#pragma unroll
        for (int p0 = 0; p0 < 2; ++p0) {
            const cpx a = Z[ZP(p0)], h = Zh[p0];
            const float ue = a.x, uo = a.y, he = h.x, ho = h.y, sg = p0 ? -1.f : 1.f;
            cpx o = {ue * he + sg * uo * ho, ue * ho + uo * he};
            Z[ZP(p0)] = o;
        }
        return;
    }
    const int b = ilog2(q), pp = (2 << b) + (q - (1 << b)), pq = 3 * (2 << b) - 1 - pp;
    const int kk = rev14(pp);
    float wc, ws; tw((float)kk * (1.0f / (float)FFT_N), wc, ws);
    const cpx A = Z[ZP(pp)], B = Z[ZP(pq)], HA = Zh[pp], HB = Zh[pq];
    const cpx Ue = {0.5f * (A.x + B.x), 0.5f * (A.y - B.y)};
    const cpx dU = {A.x - B.x, A.y + B.y};
    const cpx Uo = {0.5f * dU.y, -0.5f * dU.x};
    const cpx He = {0.5f * (HA.x + HB.x), 0.5f * (HA.y - HB.y)};
    const cpx dH = {HA.x - HB.x, HA.y + HB.y};
    const cpx Ho = {0.5f * dH.y, -0.5f * dH.x};
    const cpx UoHo = {Uo.x * Ho.x - Uo.y * Ho.y, Uo.x * Ho.y + Uo.y * Ho.x};
    const cpx wUH = {wc * UoHo.x + ws * UoHo.y, wc * UoHo.y - ws * UoHo.x};
    const cpx Ye = {Ue.x * He.x - Ue.y * He.y + wUH.x, Ue.x * He.y + Ue.y * He.x + wUH.y};
    const cpx Yo = {Ue.x * Ho.x - Ue.y * Ho.y + Uo.x * He.x - Uo.y * He.y, Ue.x * Ho.y + Ue.y * Ho.x + Uo.x * He.y + Uo.y * He.x};
    cpx o1 = {Ye.x - Yo.y, Ye.y + Yo.x};
    cpx o2 = {Ye.x + Yo.y, -Ye.y + Yo.x};
    Z[ZP(pp)] = o1; Z[ZP(pq)] = o2;
}
#endif
template <class F> __device__ __forceinline__ void tconv_tile(const F& f, bf16_t* dst, int K, int k0, int n0, float* tile  , int lane) {
    f32x4 v[16];
    const int n4 = (lane & 15) * 4, kr = lane >> 4;
#pragma unroll
    for (int i = 0; i < 16; ++i) v[i] = f.ld4(k0 + kr + 4 * i, n0 + n4);
#pragma unroll
    for (int i = 0; i < 16; ++i) { float* t = tile + (kr + 4 * i) * 65 + n4; t[0] = v[i][0]; t[1] = v[i][1]; t[2] = v[i][2]; t[3] = v[i][3]; }
    __builtin_amdgcn_fence(__ATOMIC_RELEASE, "wavefront"); __builtin_amdgcn_wave_barrier(); __builtin_amdgcn_fence(__ATOMIC_ACQUIRE, "wavefront");
    const int kq = (lane & 7) * 8, nr = lane >> 3;
#pragma unroll
    for (int i = 0; i < 8; ++i) { const int nn = nr + 8 * i; float o[8];
#pragma unroll
        for (int e = 0; e < 8; ++e) o[e] = tile[(kq + e) * 65 + nn];
        *(u32x4*)(dst + (size_t)(n0 + nn) * K + k0 + kq) = pack8(o); }
    __builtin_amdgcn_fence(__ATOMIC_RELEASE, "wavefront"); __builtin_amdgcn_wave_barrier(); __builtin_amdgcn_fence(__ATOMIC_ACQUIRE, "wavefront");
}
__device__ __forceinline__ int in_src_col(int n) {
    if (n < 2048) return n;
    if (n < 3584) return 2704 + (n - 2048);
    if (n < 5120) return 4240 + (n - 3584);
    if (n < 5632) return 5776 + (n - 5120);
    if (n < 6080) return 2064 + (n - 5632);
    if (n < 6144) return -1;
    if (n < 6272) return 2512 + (n - 6144);
    if (n < 6336) return 2640 + (n - 6272);
    if (n < 6344) return 2048 + (n - 6336);
    if (n < 6352) return 2056 + (n - 6344);
    return -1;
}
struct FWin { const float* src;
    __device__ __forceinline__ f32x4 ld4(int k, int n) const {
        if (n < 6336) { const int c = in_src_col(n); return c < 0 ? (f32x4){0.f, 0.f, 0.f, 0.f} : *(const f32x4*)(src + (size_t)k * DIN + c); }
        f32x4 r;
#pragma unroll
        for (int e = 0; e < 4; ++e) { const int c = in_src_col(n + e); r[e] = c < 0 ? 0.f : src[(size_t)k * DIN + c]; }
        return r; } };
struct FPlain { const float* src; int ld; __device__ __forceinline__ f32x4 ld4(int k, int n) const { return *(const f32x4*)(src + (size_t)k * ld + n); } };
struct FMla { const float *uq, *ukv, *qn, *kvn;
    __device__ __forceinline__ f32x4 ld4(int k, int n) const {
        if (n < 768) { if (k >= 448) return (f32x4){0.f, 0.f, 0.f, 0.f}; return *(const f32x4*)(uq + (size_t)k * 768 + n) * qn[k]; }
        if (k < 512) return (f32x4){0.f, 0.f, 0.f, 0.f};
        return *(const f32x4*)(ukv + (size_t)(k - 512) * 1024 + (n - 768)) * kvn[k - 512]; } };
struct FW13 { const float *w1, *w3;
    __device__ __forceinline__ f32x4 ld4(int k, int n) const { const int col = (n >> 8) * 128 + (n & 127);
        const uintptr_t d = (uintptr_t)w3 - (uintptr_t)w1; const float* b = (const float*)((uintptr_t)w1 + (((n >> 7) & 1) ? d : (uintptr_t)0));
        return *(const f32x4*)(b + (size_t)k * DFF + col); } };

constexpr int T_WIN = (NP / 64) * (D_ / 64), T_WOUT = 32 * 32, T_MLA = (MLAN / 64) * (MLAK / 64), T_F13 = (2 * DFF / 64) * 32, T_F2 = 32 * (DFF / 64);
constexpr int U_MOD = 96, U_HF = 516, U_TR = 2 * T_WOUT + 2 * T_MLA;
constexpr int XBW_OFF_ = 147456 - 16;
constexpr int U_WABS_IN = 2 * (NP / 32);
constexpr int U_TRB = (U_TR + 7) / 8;
constexpr int U_S13 = 2 * (DFF / 32), U_S2 = D_ / 16, U_SBIG = 9 * U_S2, U_SSMALL = 9 * U_S13;
constexpr int U_STREAM = U_MOD + U_SBIG + U_SSMALL + U_WABS_IN + U_TRB, U_QTOT = U_HF + U_STREAM, Q_STRIDE = 9;

__device__ __forceinline__ void pro_mod_unit(const Params& p, int u, float* lds) {
    const int tid = otid(), wid = tid >> 6, lane = tid & 63;
    const int l = u / 48, cb = u % 48, col = cb * 256 + lane * 4;
    const float* W = p.in[I_MODW] + (size_t)l * D_ * (6 * D_) + col;
    const float* c = p.in[I_C]; const float* cc = p.in[I_CCTX];
    f32x4 al = {0, 0, 0, 0}, ac = {0, 0, 0, 0};
    const int k0 = wid * 256;
#pragma unroll 16
    for (int k = k0; k < k0 + 256; ++k) {
        const f32x4 w4 = *(const f32x4*)(W + (size_t)k * (6 * D_));
        const float sl = silu_f(c[k]), sc = silu_f(cc[k]);
        al += w4 * sl; ac += w4 * sc;
    }
    f32x4* red = (f32x4*)lds;
    red[(wid * 64 + lane) * 2] = al; red[(wid * 64 + lane) * 2 + 1] = ac;
    __syncthreads();
    if (wid == 0) {
        f32x4 sl = {0, 0, 0, 0}, sc = {0, 0, 0, 0};
#pragma unroll
        for (int w = 0; w < 8; ++w) { sl += red[(w * 64 + lane) * 2]; sc += red[(w * 64 + lane) * 2 + 1]; }
        const f32x4 b4 = *(const f32x4*)(p.in[I_MODB] + (size_t)l * 6 * D_ + col);
        *(f32x4*)(p.modv() + ((size_t)l * 2 + 0) * 6 * D_ + col) = sl + b4;
        *(f32x4*)(p.modv() + ((size_t)l * 2 + 1) * 6 * D_ + col) = sc + b4;
    }
    __syncthreads();
}

__device__ __forceinline__ void pro_hfilt_unit(const Params& p, int l, int Lf, int tb, float* hout, float* hsumo, float* lds) {
    const int tid = otid(), wid = tid >> 6, lane = tid & 63;
    float* zb = lds;
    float* H1 = lds + 64 * 36;
    float* H2 = H1 + 64 * 68;
    float* tl = H2 + 64 * 68 + wid * (64 * 33);
    const int t0 = tb * 64;
    const float* w1 = p.in[I_HW1] + (size_t)l * 33 * 64; const float* b1 = p.in[I_HB1] + l * 64;
    const float* w2 = p.in[I_HW2] + (size_t)l * 64 * 64; const float* b2 = p.in[I_HB2] + l * 64;
    const float* w3 = p.in[I_HW3] + (size_t)l * 64 * 64; const float* b3 = p.in[I_HB3] + l * 64;
    const float* w4 = p.in[I_HW4] + (size_t)l * 64 * 1024; const float* fq = p.in[I_HFREQ] + l * 64;
    {
        const int tp = lane, part = wid; const float pf = (float)(t0 + tp);
        const float c0 = (float)(6.283185307179586 / (double)Lf);
#pragma unroll 1
        for (int e = part; e < 33; e += 8) {
            float v;
            if (e == 0) v = pf / (float)(Lf - 1);
            else { const int b = (e - 1) & 15; const float fr = 1e-4f + (float)b * ((15.0f - 1e-4f) / 15.0f); const float ang = (c0 * pf) * fr; v = (e <= 16) ? cosf(ang) : -sinf(ang); }
            zb[tp * 36 + e] = v;
        }
    }
    __syncthreads();
    {   const int tp = lane, j0 = wid * 8; float s[8];
#pragma unroll
        for (int jj = 0; jj < 8; ++jj) s[jj] = b1[j0 + jj];
#pragma unroll 3
        for (int e = 0; e < 33; ++e) { const float z = zb[tp * 36 + e];
#pragma unroll
            for (int jj = 0; jj < 8; ++jj) s[jj] += z * w1[e * 64 + j0 + jj]; }
#pragma unroll 1
        for (int jj = 0; jj < 8; ++jj) H1[tp * 68 + j0 + jj] = sinf(fq[j0 + jj] * s[jj]);
    }
    __syncthreads();
    {   const int tp = lane, j0 = wid * 8; float s[8];
#pragma unroll
        for (int jj = 0; jj < 8; ++jj) s[jj] = b2[j0 + jj];
#pragma unroll 4
        for (int i = 0; i < 64; ++i) { const float z = H1[tp * 68 + i];
#pragma unroll
            for (int jj = 0; jj < 8; ++jj) s[jj] += z * w2[i * 64 + j0 + jj]; }
#pragma unroll 1
        for (int jj = 0; jj < 8; ++jj) H2[tp * 68 + j0 + jj] = sinf(fq[j0 + jj] * s[jj]);
    }
    __syncthreads();
    {   const int tp = lane, j0 = wid * 8; float s[8];
#pragma unroll
        for (int jj = 0; jj < 8; ++jj) s[jj] = b3[j0 + jj];
#pragma unroll 4
        for (int i = 0; i < 64; ++i) { const float z = H2[tp * 68 + i];
#pragma unroll
            for (int jj = 0; jj < 8; ++jj) s[jj] += z * w3[i * 64 + j0 + jj]; }
        __syncthreads();
#pragma unroll 1
        for (int jj = 0; jj < 8; ++jj) H1[tp * 68 + j0 + jj] = sinf(fq[j0 + jj] * s[jj]);
    }
    __syncthreads();
    const int nblk = Lf / 64;
#pragma unroll 1
    for (int i = 0; i < 2; ++i) {
        const int cg = wid + 8 * i, c = cg * 64 + lane;
        float wreg[64];
#pragma unroll
        for (int j = 0; j < 64; ++j) wreg[j] = w4[j * 1024 + c];
        const float a0 = -120.39728043259361f, a1 = 40.546510810816436f;
        const float delta = fabsf(a0 + (float)c * ((a1 - a0) / 1023.0f));
        float asum = 0.f; const float rLf = 1.0f / (float)Lf;
#pragma unroll 1
        for (int hh = 0; hh < 2; ++hh) {
#pragma unroll 2
            for (int tq = 0; tq < 32; ++tq) { const int tp = hh * 32 + tq;
                float s = 0.f;
#pragma unroll
                for (int j4 = 0; j4 < 16; ++j4) { const f32x4 h4 = *(const f32x4*)(H1 + tp * 68 + 4 * j4);
                    s += h4[0] * wreg[4 * j4] + h4[1] * wreg[4 * j4 + 1] + h4[2] * wreg[4 * j4 + 2] + h4[3] * wreg[4 * j4 + 3]; }
                const float pf = (float)(t0 + tp), dist = fabsf(pf - (float)(Lf / 2)) * rLf;
                const float val = s * expf(-dist * delta);
                tl[lane * 33 + tq] = val; asum += fabsf(val);
            }
            __builtin_amdgcn_fence(__ATOMIC_RELEASE, "wavefront"); __builtin_amdgcn_wave_barrier(); __builtin_amdgcn_fence(__ATOMIC_ACQUIRE, "wavefront");
#pragma unroll
            for (int ps = 0; ps < 2; ++ps) { const int rr = (lane >> 1) + 32 * ps, tq0 = (lane & 1) * 16;
                float* dst = hout + (size_t)(cg * 64 + rr) * Lf + t0 + hh * 32 + tq0;
#pragma unroll
                for (int k = 0; k < 4; ++k) { f32x4 v;
#pragma unroll
                    for (int e = 0; e < 4; ++e) v[e] = tl[rr * 33 + tq0 + 4 * k + e];
                    *(f32x4*)(dst + 4 * k) = v; } }
            __builtin_amdgcn_fence(__ATOMIC_RELEASE, "wavefront"); __builtin_amdgcn_wave_barrier(); __builtin_amdgcn_fence(__ATOMIC_ACQUIRE, "wavefront");
        }
        hsumo[(size_t)c * nblk + tb] = asum;
    }
    __syncthreads();
}

template <class M> __device__ __forceinline__ void wabs_unit(const float* src, int ld, int c0, int k0, unsigned* wam, const M& map, float* lds) {
    const int tid = otid(), wid = tid >> 6, lane = tid & 63;
    const float* sp = src + (size_t)(k0 + wid * 64) * ld + c0 + lane * 4;
    f32x4 m4 = {0.f, 0.f, 0.f, 0.f};
#pragma unroll 8
    for (int k = 0; k < 64; ++k) { const f32x4 v = *(const f32x4*)(sp + (size_t)k * ld); m4 = __builtin_elementwise_max(m4, __builtin_elementwise_abs(v)); }
    f32x4* red = (f32x4*)lds; red[wid * 64 + lane] = m4;
    __syncthreads();
    if (wid == 0) {
#pragma unroll
        for (int w = 1; w < 8; ++w) m4 = __builtin_elementwise_max(m4, red[w * 64 + lane]);
#pragma unroll
        for (int e = 0; e < 4; ++e) atomicMax(wam + map(c0 + lane * 4 + e), __float_as_uint(m4[e]));
    }
    __syncthreads();
}
struct ColId { __device__ __forceinline__ int operator()(int n) const { return n; } };
struct ColWin { __device__ __forceinline__ int operator()(int n) const { return in_src_col(n); } };
template <int K, int NCH, class M, class C = ColId> __device__ __forceinline__ void strip_unit(const float* src, int ld, int n0, signed char* dst, unsigned* wam, const M& map, char* lds, const C& colmap = C()) {
    constexpr int LPR = NCH / 4, RPP = 512 / LPR, NPASS = K / RPP, KS = K + 16, CH = 8;
    static_assert(NPASS % 4 == 0 && NPASS % CH == 0 || NPASS % 4 == 0, "strip geometry");
    const int tid = otid(), wid = tid >> 6, lane = tid & 63, tr = tid / LPR, m = tid % LPR;
    const int c4 = colmap(n0 + m * 4); const bool zcol = c4 < 0;
    const float* sp = src + (size_t)(tr * 4) * ld + (c4 < 0 ? 0 : c4);
    unsigned pk[NPASS][2]; f32x4 m4 = {0.f, 0.f, 0.f, 0.f};
    constexpr int NCK = (NPASS + CH - 1) / CH;
    f32x4 v[2][CH];
#pragma unroll
    for (int j = 0; j < CH; ++j) v[0][j] = *(const f32x4*)(sp + (size_t)((j >> 2) * (4 * RPP) + (j & 3)) * ld);
#pragma unroll
    for (int ck = 0; ck < NCK; ++ck) {
        if (ck + 1 < NCK) {
#pragma unroll
            for (int j = 0; j < CH; ++j) { const int i = (ck + 1) * CH + j; if (i < NPASS) v[(ck + 1) & 1][j] = *(const f32x4*)(sp + (size_t)((i >> 2) * (4 * RPP) + (i & 3)) * ld); }
        }
        __builtin_amdgcn_sched_barrier(0);
#pragma unroll
        for (int j = 0; j < CH; ++j) { const int i = ck * CH + j; if (i < NPASS) { const f32x4 x = zcol ? (f32x4){0.f, 0.f, 0.f, 0.f} : v[ck & 1][j]; m4 = __builtin_elementwise_max(m4, __builtin_elementwise_abs(x)); pk[i][0] = cvt_pk_bf16(x[0], x[1]); pk[i][1] = cvt_pk_bf16(x[2], x[3]); } }
        __builtin_amdgcn_sched_barrier(0);
    }
    float* red = (float*)(lds + NCH * KS);
#pragma unroll
    for (int e = 0; e < 4; ++e) { float a = m4[e];
#pragma unroll
        for (int o = LPR; o < 64; o <<= 1) a = fmaxf(a, shflx(a, o, lane));
        m4[e] = a; }
    if (lane < LPR) *(f32x4*)(red + (wid * LPR + m) * 4) = m4;
    __syncthreads();
    f32x4 mx = *(const f32x4*)(red + m * 4);
#pragma unroll
    for (int w = 1; w < 8; ++w) mx = __builtin_elementwise_max(mx, *(const f32x4*)(red + (w * LPR + m) * 4));
    if (tid < LPR) {
#pragma unroll
        for (int e = 0; e < 4; ++e) wam[map(n0 + m * 4 + e)] = __float_as_uint(mx[e]); }
    float inv[4];
#pragma unroll
    for (int e = 0; e < 4; ++e) inv[e] = 127.f / fmaxf(mx[e], 1e-30f);
    {   char* wb = lds + (size_t)(m * 4) * KS + tr * 4;
#pragma unroll
        for (int g = 0; g < NPASS / 4; ++g) {
#pragma unroll
            for (int e = 0; e < 4; ++e) { unsigned acc = 0u;
#pragma unroll
                for (int q4 = 0; q4 < 4; ++q4) { const unsigned w = pk[4 * g + q4][e >> 1]; const float f = __uint_as_float((e & 1) ? (w & 0xffff0000u) : (w << 16));
                    acc |= (unsigned)((int)rintf(f * inv[e]) & 255) << (8 * q4); }
                *(unsigned*)(wb + e * KS + g * (4 * RPP)) = acc; }
        }
    }
    __syncthreads();
#pragma unroll 1
    for (int j = tid; j < NCH * (K / 16); j += 512) { const int c = j / (K / 16), ch = j % (K / 16);
        *(u32x4*)(dst + (size_t)map(n0 + c) * K + ch * 16) = *(const u32x4*)(lds + (size_t)c * KS + ch * 16); }
    __syncthreads();
}
template <class F> __device__ __forceinline__ void wabsf_unit(const F& f, int n0, int k0, unsigned* wam, float* lds) {
    const int tid = otid(), wid = tid >> 6, lane = tid & 63;
    f32x4 m4 = {0.f, 0.f, 0.f, 0.f};
#pragma unroll 8
    for (int k = 0; k < 64; ++k) { const f32x4 v = f.ld4(k0 + wid * 64 + k, n0 + lane * 4); m4 = __builtin_elementwise_max(m4, __builtin_elementwise_abs(v)); }
    f32x4* red = (f32x4*)lds; red[wid * 64 + lane] = m4;
    __syncthreads();
    if (wid == 0) {
#pragma unroll
        for (int w = 1; w < 8; ++w) m4 = __builtin_elementwise_max(m4, red[w * 64 + lane]);
#pragma unroll
        for (int e = 0; e < 4; ++e) atomicMax(wam + n0 + lane * 4 + e, __float_as_uint(m4[e]));
    }
    __syncthreads();
}
struct MapW13 { int which; __device__ __forceinline__ int operator()(int col) const { return (col >> 7) * 256 + which * 128 + (col & 127); } };
struct MapId { __device__ __forceinline__ int operator()(int col) const { return col; } };
template <class F> __device__ __forceinline__ void tconv8_tile(const F& f, signed char* dst, int K, int k0, int n0, const unsigned* wam, float* tile, int lane) {
    f32x4 v[16];
    const int n4 = (lane & 15) * 4, kr = lane >> 4;
#pragma unroll
    for (int i = 0; i < 16; ++i) v[i] = f.ld4(k0 + kr + 4 * i, n0 + n4);
#pragma unroll
    for (int i = 0; i < 16; ++i) { float* t = tile + (kr + 4 * i) * 65 + n4; t[0] = v[i][0]; t[1] = v[i][1]; t[2] = v[i][2]; t[3] = v[i][3]; }
    __builtin_amdgcn_fence(__ATOMIC_RELEASE, "wavefront"); __builtin_amdgcn_wave_barrier(); __builtin_amdgcn_fence(__ATOMIC_ACQUIRE, "wavefront");
    const int kq = (lane & 3) * 16, nr = lane >> 2;
#pragma unroll
    for (int i = 0; i < 4; ++i) { const int nn = nr + 16 * i; const float inv = 127.f / fmaxf(__uint_as_float(wam[n0 + nn]), 1e-30f);
        unsigned w[4];
#pragma unroll
        for (int g4 = 0; g4 < 4; ++g4) { unsigned acc = 0u;
#pragma unroll
            for (int e = 0; e < 4; ++e) { const int q = (int)rintf(tile[(kq + g4 * 4 + e) * 65 + nn] * inv); acc |= (unsigned)(q & 255) << (8 * e); }
            w[g4] = acc; }
        *(u32x4*)(dst + (size_t)(n0 + nn) * K + k0 + kq) = (u32x4){w[0], w[1], w[2], w[3]}; }
    __builtin_amdgcn_fence(__ATOMIC_RELEASE, "wavefront"); __builtin_amdgcn_wave_barrier(); __builtin_amdgcn_fence(__ATOMIC_ACQUIRE, "wavefront");
}
__device__ __forceinline__ void tr_unit(const Params& p, int v, float* tile, int lane) {
    if (v < 2 * T_WOUT) { const int l = v / T_WOUT, t = v % T_WOUT, nt = t / 32, kt = t % 32;
        FPlain f{p.in[I_WOUT] + (size_t)l * D_ * D_, D_}; tconv_tile(f, p.wb_out() + (size_t)l * D_ * D_, D_, kt * 64, nt * 64, tile, lane); return; }
    v -= 2 * T_WOUT;
    if (v < 2 * T_MLA) { const int l = v / T_MLA, t = v % T_MLA, nt = t / 10, kt = t % 10;
        FMla f{p.in[I_MUQ] + (size_t)l * 448 * 768, p.in[I_MUKV] + (size_t)l * 128 * 1024, p.in[I_MQN] + l * 448, p.in[I_MKVN] + l * 128};
        tconv_tile(f, p.wb_mla() + (size_t)l * MLAN * MLAK, MLAK, kt * 64, nt * 64, tile, lane); return; }
}
__device__ __forceinline__ void pro_stream_unit(const Params& p, int v, float* lds) {
    if (v < U_MOD) { pro_mod_unit(p, v, lds); return; }
    v -= U_MOD;
    if (v < U_SBIG) { const int set = v / U_S2, s = v % U_S2; MapId mp;
        const float* src = set == 0 ? p.in[I_FW2] : p.in[I_MW2] + (size_t)(set - 1) * DFF * D_;
        signed char* dst = set == 0 ? (signed char*)p.wb_f2() : (signed char*)p.wb_m2() + (size_t)(set - 1) * D_ * DFF;
        strip_unit<DFF, 16>(src, D_, s * 16, dst, p.wam() + (set == 0 ? WAM_F2 : WAM_M2 + (set - 1) * D_), mp, (char*)lds); return; }
    v -= U_SBIG;
    if (v < U_SSMALL) { const int set = v / U_S13, w = v % U_S13, which = w / (DFF / 32), s = w % (DFF / 32); MapW13 mp{which};
        const float* src = set == 0 ? p.in[which ? I_FW3 : I_FW1] : p.in[which ? I_MW3 : I_MW1] + (size_t)(set - 1) * D_ * DFF;
        signed char* dst = set == 0 ? (signed char*)p.wb_f13() : (signed char*)p.wb_m13() + (size_t)(set - 1) * 2 * DFF * D_;
        strip_unit<D_, 32>(src, DFF, s * 32, dst, p.wam() + (set == 0 ? WAM_F13 : WAM_M13 + (set - 1) * 2 * DFF), mp, (char*)lds); return; }
    v -= U_SSMALL;
    if (v < U_WABS_IN) { const int l = v / (NP / 32), s = v % (NP / 32); MapId mp; ColWin cw;
        strip_unit<D_, 32>(p.in[I_WIN] + (size_t)l * D_ * DIN, DIN, s * 32, (signed char*)p.wb_in() + (size_t)l * NP * D_, p.wam() + WAM_IN + l * NP, mp, (char*)lds, cw); return; }
    v -= U_WABS_IN;
    { const int tid = otid(), wid = tid >> 6, lane = tid & 63; float* tile = lds + wid * (64 * 68);
      if (v * 8 + wid < U_TR) tr_unit(p, v * 8 + wid, tile, lane);
      __syncthreads(); }
}
__device__ __forceinline__ void phase_prologue(const Params& p, float* lds) {
    static_assert((U_HF - 1) * Q_STRIDE < U_QTOT, "every filter unit needs a queue slot");
    unsigned* qctr = p.cnt() + 24; volatile LAS unsigned* qw = (volatile LAS unsigned*)(LAS unsigned char*)((unsigned char*)lds + XBW_OFF_ - 32);
#pragma unroll 1
    for (;;) {
        __syncthreads();
        if (otid() == 0) qw[0] = atomicAdd(qctr, 1u);
        __syncthreads();
        const int q = (int)qw[0];
        if (q >= U_QTOT) break;
        const int nf = (q + Q_STRIDE - 1) / Q_STRIDE, nfb = nf < U_HF ? nf : U_HF;
        if (q % Q_STRIDE == 0 && q / Q_STRIDE < U_HF) { const int u = q / Q_STRIDE;
            if (u < 512) { const int l = u >> 8, tb = u & 255; pro_hfilt_unit(p, l, SEQ, tb, p.hfilt() + (size_t)l * 1024 * SEQ, p.hsum() + (size_t)l * 1024 * 256, lds); }
            else pro_hfilt_unit(p, 0, LC, u - 512, p.hfc(), p.hsc(), lds); }
        else pro_stream_unit(p, q - nfb, lds);
    }
    __syncthreads();
}
__device__ __forceinline__ void f13q_unit(const Params& p, int v, float* tile, int lane) {
    const int nt = v / 32, kt = v % 32; FW13 f{p.in[I_FW1], p.in[I_FW3]}; tconv8_tile(f, (signed char*)p.wb_f13(), D_, kt * 64, nt * 64, p.wam() + WAM_F13, tile, lane);
}
__device__ __forceinline__ void f2q_unit(const Params& p, int v, float* tile, int lane) {
    const int nt = v / 88, kt = v % 88; FPlain f{p.in[I_FW2], D_}; tconv8_tile(f, (signed char*)p.wb_f2(), DFF, kt * 64, nt * 64, p.wam() + WAM_F2, tile, lane);
}
__device__ __forceinline__ void winq_unit(const Params& p, int v, float* tile, int lane) {
    const int l = v / T_WIN, t = v % T_WIN, nt = t / 32, kt = t % 32; FWin f{p.in[I_WIN] + (size_t)l * D_ * DIN};
    tconv8_tile(f, (signed char*)p.wb_in() + (size_t)l * NP * D_, D_, kt * 64, nt * 64, p.wam() + WAM_IN + l * NP, tile, lane);
}
constexpr int T_M13 = NEXP * T_F13, T_M2 = NEXP * T_F2, U_MOEW = T_M13 + T_M2;
__device__ __forceinline__ void moe_w_unit(const Params& p, int v, float* tile, int lane) {
    if (v < T_M13) { const int e = v / T_F13, t = v % T_F13, nt = t / 32, kt = t % 32;
        FW13 f{p.in[I_MW1] + (size_t)e * D_ * DFF, p.in[I_MW3] + (size_t)e * D_ * DFF};
        tconv8_tile(f, (signed char*)p.wb_m13() + (size_t)e * 2 * DFF * D_, D_, kt * 64, nt * 64, p.wam() + WAM_M13 + e * 2 * DFF, tile, lane); return; }
    v -= T_M13;
    { const int e = v / T_F2, t = v % T_F2, nt = t / 88, kt = t % 88;
      FPlain f{p.in[I_MW2] + (size_t)e * DFF * D_, D_};
      tconv8_tile(f, (signed char*)p.wb_m2() + (size_t)e * D_ * DFF, DFF, kt * 64, nt * 64, p.wam() + WAM_M2 + e * D_, tile, lane); }
}

__device__ __forceinline__ void phase_norm(const Params& p, int layer, int which, int row_lo, unsigned char* shm) {
    const int tid = otid(), wid = tid >> 6, lane = tid & 63;
    const float* nw = p.in[which == 1 ? I_N1W : I_N2W] + (size_t)layer * D_;
    const int csh = (which == 1 ? 0 : 3) * D_, csc = (which == 1 ? 1 : 4) * D_;
    const bool route = (layer == 1 && which == 2);
    unsigned* lcnt = (unsigned*)shm; unsigned* lbase = lcnt + 8; int* recE = (int*)(lcnt + 16); int* recP = recE + 128;
    int kk = 0;
    f32x4* rtl = (f32x4*)(shm + 4096);
    if (route) { if (tid < 8) lcnt[tid] = 0u;
        const float* rt0 = p.in[I_ROUTER];
#pragma unroll
        for (int it = 0; it < 8; ++it) { const int pc = tid + it * 512;
            const int c = pc >> 1, hf = pc & 1; rtl[((c & 3) * 2 + hf) * 512 + (c >> 2)] = *(const f32x4*)(rt0 + (size_t)c * NEXP + hf * 4); }
        __syncthreads(); }
    for (int r = row_lo + blockIdx.x * 8 + wid; r < MT; r += gridDim.x * 8) {
        const bool isc = r < LC;
        const float* src = (layer == 0 && which == 1) ? (isc ? p.in[I_CTX] + (size_t)r * D_ : p.in[I_X] + (size_t)(r - LC) * D_)
                         : ((layer == 0 && isc) ? p.in[I_CTX] + (size_t)r * D_ : p.xcur() + (size_t)r * D_);
        const float* mv = p.modv() + ((size_t)layer * 2 + (isc ? 1 : 0)) * 6 * D_;
        const bool fixG = isc && layer == 0 && which == 2, fixF = isc && layer == 1 && which == 1;
        f32x4 xv[8]; float ss = 0.f;
#pragma unroll
        for (int i = 0; i < 8; ++i) { const int col = (i * 64 + lane) * 4; xv[i] = *(const f32x4*)(src + col);
            if (fixG || fixF) {
                const float* pp = (fixG ? p.partG() : p.partF()) + (size_t)r * D_ + col; const int ns = fixG ? 4 : 11;
                f32x4 a = {0.f, 0.f, 0.f, 0.f};
                for (int s2 = 0; s2 < ns; ++s2) a += *(const f32x4*)(pp + (size_t)s2 * LC * D_);
                const f32x4 g4 = *(const f32x4*)(p.modv() + ((size_t)(fixG ? 0 : 0) * 2 + 1) * 6 * D_ + (fixG ? 2 : 5) * D_ + col);
                xv[i] += g4 * a;
                if (fixG) *(f32x4*)(p.xcur() + (size_t)r * D_ + col) = xv[i];
            }
            ss += xv[i][0] * xv[i][0] + xv[i][1] * xv[i][1] + xv[i][2] * xv[i][2] + xv[i][3] * xv[i][3]; }
        ss = wave_sum(ss);
        const float rstd = rsqrtf(ss * (1.0f / D_) + EPS);
        float lg[NEXP];
#pragma unroll
        for (int e = 0; e < NEXP; ++e) lg[e] = 0.f;
        float qinv = 0.f;
        {   float am = 0.f;
#pragma unroll
            for (int i = 0; i < 8; ++i) { const int col = (i * 64 + lane) * 4;
                const f32x4 w4 = *(const f32x4*)(nw + col), sh = *(const f32x4*)(mv + csh + col), sc = *(const f32x4*)(mv + csc + col);
                xv[i] = (xv[i] * rstd) * w4 * (sc + 1.0f) + sh;
                am = fmaxf(am, fmaxf(fmaxf(fabsf(xv[i][0]), fabsf(xv[i][1])), fmaxf(fabsf(xv[i][2]), fabsf(xv[i][3])))); }
#pragma unroll
            for (int o = 32; o >= 1; o >>= 1) am = fmaxf(am, shflx(am, o, lane));
            am = fmaxf(am, 1e-20f); qinv = 127.f / am;
            if (lane == 0) p.hs()[r] = am * (1.0f / 127.f);
        }
#pragma unroll
        for (int i = 0; i < 8; ++i) { const int col = (i * 64 + lane) * 4;
            const f32x4 hv = xv[i];
            {
                const int q0 = (int)rintf(hv[0] * qinv), q1 = (int)rintf(hv[1] * qinv), q2 = (int)rintf(hv[2] * qinv), q3 = (int)rintf(hv[3] * qinv);
                *(unsigned*)((char*)p.hbuf() + (size_t)r * D_ + col) = (unsigned)(q0 & 255) | ((unsigned)(q1 & 255) << 8) | ((unsigned)(q2 & 255) << 16) | ((unsigned)(q3 & 255) << 24);
            }
            if (route) { const int cg = i * 64 + lane;
#pragma unroll
                for (int j = 0; j < 4; ++j) { const f32x4 r0 = rtl[(j * 2) * 512 + cg], r1 = rtl[(j * 2 + 1) * 512 + cg];
                    lg[0] += hv[j] * r0[0]; lg[1] += hv[j] * r0[1]; lg[2] += hv[j] * r0[2]; lg[3] += hv[j] * r0[3];
                    lg[4] += hv[j] * r1[0]; lg[5] += hv[j] * r1[1]; lg[6] += hv[j] * r1[2]; lg[7] += hv[j] * r1[3]; } }
        }
        if (route && !isc) {
#pragma unroll
            for (int e = 0; e < NEXP; ++e) lg[e] = wave_sum(lg[e]);
            if (lane == 0) {
                int e0 = 0; float v0 = lg[0];
#pragma unroll
                for (int e = 1; e < NEXP; ++e) if (lg[e] > v0) { v0 = lg[e]; e0 = e; }
                int e1 = -1; float v1 = -3.0e38f;
#pragma unroll
                for (int e = 0; e < NEXP; ++e) if (e != e0 && lg[e] > v1) { v1 = lg[e]; e1 = e; }
                const float w0 = 1.f / (1.f + expf(v1 - v0)), w1 = 1.f - w0;
                const int t = r - LC;
                const int p0 = (int)__hip_atomic_fetch_add(lcnt + e0, 1u, __ATOMIC_RELAXED, __HIP_MEMORY_SCOPE_WORKGROUP), p1 = (int)__hip_atomic_fetch_add(lcnt + e1, 1u, __ATOMIC_RELAXED, __HIP_MEMORY_SCOPE_WORKGROUP);
                const int ri = (wid * 8 + (kk & 7)) * 2;
                recE[ri] = e0; recE[ri + 1] = e1; recP[ri] = p0; recP[ri + 1] = p1;
                p.tok_e()[t * 2] = e0; p.tok_e()[t * 2 + 1] = e1; p.tok_w()[t * 2] = w0; p.tok_w()[t * 2 + 1] = w1;
            }
        }
        ++kk;
    }
    if (route) {
        __syncthreads();
        if (tid < 8) lbase[tid] = atomicAdd(&p.cnt()[tid], lcnt[tid]);
        __syncthreads();
        if (tid < 128) { const int w = (tid >> 1) & 7, k = tid >> 4, s = tid & 1; const int tt = (int)blockIdx.x * 8 + w + k * (int)gridDim.x * 8;
            if (tt < SEQ && k < kk) { const int ri = (w * 8 + k) * 2 + s; p.tok_p()[tt * 2 + s] = (int)lbase[recE[ri]] + recP[ri]; } }
        __syncthreads();
    }
}

__device__ __forceinline__ void phase_prep(const Params& p, int layer) {
    const int tid = otid(), wid = tid >> 6, lane = tid & 63;
    const float* gcw = p.in[I_GCONV] + (size_t)layer * 3 * 1536;
    const float LN1E4 = 9.210340371976184f;
    for (int r = blockIdx.x * 8 + wid; r < MT; r += gridDim.x * 8) {
        const bool isc = r < LC; const int t = r - LC;
        const bool hasp = isc ? (r > 0) : (r > LC), hasn = isc ? (r < LC - 1) : (r < MT - 1);
        const bf16_t* P0 = p.Pp() + (size_t)r * NP;
        const bf16_t* Pm = hasp ? P0 - NP : P0; const bf16_t* Pn = hasn ? P0 + NP : P0;
        u32x4 gx[3][3];
#pragma unroll
        for (int i = 0; i < 3; ++i) { const int ch = i * 512 + lane * 8; gx[i][0] = *(const u32x4*)(Pm + PC_GQKV + ch); gx[i][1] = *(const u32x4*)(P0 + PC_GQKV + ch); gx[i][2] = *(const u32x4*)(Pn + PC_GQKV + ch); }
        const bf16_t gab = P0[PC_A + (lane & 7)], gbb = P0[PC_B + (lane & 7)];
        const u32x4 cqr = *(const u32x4*)(P0 + PC_CQ + (lane < 56 ? lane : 55) * 8), ckr = *(const u32x4*)(P0 + PC_CKV + (lane & 15) * 8);
        const bf16_t kr1 = P0[PC_KR + ((lane >> 4) & 1) * 32 + (lane & 15)], kr2 = P0[PC_KR + ((lane >> 4) & 1) * 32 + (lane & 15) + 16];
        bf16_t rq[8][2];
#pragma unroll
        for (int it = 0; it < 8; ++it) { const int o = (it >> 2) * 512 + (it & 3) * 128 + lane; rq[it][0] = P0[PC_RQKV + o]; rq[it][1] = P0[PC_RQKV + o + 64]; }
#pragma unroll
        for (int i = 0; i < 3; ++i) {
            const int ch = i * 512 + lane * 8;
            float x0[8], xm[8], xn[8], y[8];
            unpack8(gx[i][1], x0); unpack8(gx[i][0], xm); unpack8(gx[i][2], xn);
            const float fm = hasp ? 1.f : 0.f, fn = hasn ? 1.f : 0.f;
            float ss = 0.f;
#pragma unroll
            for (int e = 0; e < 8; ++e) { const float v = gcw[ch + e] * (xm[e] * fm) + gcw[1536 + ch + e] * x0[e] + gcw[3072 + ch + e] * (xn[e] * fn); y[e] = silu_f(v); ss += y[e] * y[e]; }
            if (i < 2) { ss = sum16(ss); const float rn = rsqrtf(ss + EPS) * (i == 0 ? 0.08838834764831845f : 1.f);
#pragma unroll
                for (int e = 0; e < 8; ++e) y[e] *= rn; }
            *(u32x4*)(p.gqkv() + (size_t)r * 1536 + ch) = pack8(y);
        }
        if (lane < 8) {
            const float a = bf2f(gab), b = bf2f(gbb);
            const float g = -expf(p.in[I_GALOG][layer * 8 + lane]) * softplus_f(a + p.in[I_GDT][layer * 8 + lane]);
            p.ggb()[(size_t)r * 16 + lane] = g; p.ggb()[(size_t)r * 16 + 8 + lane] = sigmoid_f(b);
        }
        {   float sq = 0.f, sk = 0.f;
            if (lane < 56) { float f[8]; unpack8(cqr, f);
#pragma unroll
                for (int e = 0; e < 8; ++e) sq += f[e] * f[e]; }
            if (lane < 16) { float f[8]; unpack8(ckr, f);
#pragma unroll
                for (int e = 0; e < 8; ++e) sk += f[e] * f[e]; }
            sq = wave_sum(sq); sk = wave_sum(sk);
            if (lane == 0) { p.mrs()[(size_t)r * 2] = rsqrtf(sq * (1.0f / 448.f) + EPS); p.mrs()[(size_t)r * 2 + 1] = rsqrtf(sk * (1.0f / 128.f) + EPS); }
        }
        if (lane < 32) {
            const int i = lane & 15, half = lane >> 4;
            const float x1 = bf2f(kr1), x2 = bf2f(kr2);
            float o1 = x1, o2 = x2;
            if (!isc) { const float pos = (float)(half ? (t & 63) : (t >> 6)); const float inv = expf(-(float)i * (LN1E4 / 16.f)); float s, c; sincosf(pos * inv, &s, &c);
                o1 = x1 * c - x2 * s; o2 = x2 * c + x1 * s; }
            p.krr()[(size_t)r * 64 + half * 32 + i] = f2bf(o1); p.krr()[(size_t)r * 64 + half * 32 + i + 16] = f2bf(o2);
        }
        {   float s = 0.f, c = 1.f;
            if (!isc) { const float inv = expf(-(float)lane * (LN1E4 / 64.f)); sincosf((float)t * inv, &s, &c); }
#pragma unroll
            for (int it = 0; it < 8; ++it) { const int which = it >> 2, hd = it & 3; const int o = which * 512 + hd * 128 + lane;
                const float x1 = bf2f(rq[it][0]), x2 = bf2f(rq[it][1]); const float sc = which ? 0.08838834764831845f : 1.f;
                p.rqk()[(size_t)r * 1024 + o] = f2bf((x1 * c - x2 * s) * sc); p.rqk()[(size_t)r * 1024 + o + 64] = f2bf((x2 * c + x1 * s) * sc); }
        }
    }
}
namespace att {
constexpr int NW = 8, QBLK = 32, KVBLK = 64, DK = 192, DV = 128;
constexpr float SCALE = 0.07216878364870322f;
constexpr float THR = 8.f;
constexpr int LDQ = MLAN, LDKN = MLAN, LDKR = 64, LDV = MLAN, LDO = D_;
constexpr int SHM_V = KVBLK * DV * 2, SHM_K = KVBLK * DK * 2, SHM_ATTN = 2 * SHM_V + 2 * SHM_K + NW * 64 * 4;
#define KSWZ(row, colB) ((row) * 384 + ((colB) ^ ((((row) >> 1) & 7) << 4)))
#define SBAR() __builtin_amdgcn_sched_barrier(0)
__device__ __forceinline__ int crow(int r, int hi) { return (r & 3) + 8 * (r >> 2) + 4 * hi; }
__device__ __forceinline__ void partialSM(f32x16& p0, f32x16& p1, float& m_reg, float& mn, float& alpha) {
    constexpr float C = SCALE * 1.4426950408889634f;
    float pmax = p0[0];
#pragma unroll
    for (int r = 1; r < 16; ++r) pmax = fmaxf(pmax, p0[r]);
#pragma unroll
    for (int r = 0; r < 16; ++r) pmax = fmaxf(pmax, p1[r]);
    { auto rr = __builtin_amdgcn_permlane32_swap(__float_as_uint(pmax), __float_as_uint(pmax), false, false);
      pmax = fmaxf(__uint_as_float(rr[0]), __uint_as_float(rr[1])); }
    if (__builtin_expect(__all(pmax - m_reg <= THR / SCALE), 1)) { mn = m_reg; alpha = 1.f; }
    else { mn = fmaxf(m_reg, pmax); alpha = __builtin_amdgcn_exp2f((m_reg - mn) * C); m_reg = mn; }
    const float mnC = -mn * C;
#pragma unroll
    for (int r = 0; r < 16; ++r) p0[r] = fmaf(p0[r], C, mnC);
#pragma unroll
    for (int r = 0; r < 16; ++r) p1[r] = fmaf(p1[r], C, mnC);
#pragma unroll
    for (int r = 0; r < 16; ++r) p0[r] = __builtin_amdgcn_exp2f(p0[r]);
}
__device__ __forceinline__ void finishSM(f32x16& p0, f32x16& p1, float alpha, float& l_reg, bf16x8& pa0, bf16x8& pa1, bf16x8& pa2, bf16x8& pa3) {
#pragma unroll
    for (int r = 0; r < 16; ++r) p1[r] = __builtin_amdgcn_exp2f(p1[r]);
    float ps = 0;
#pragma unroll
    for (int r = 0; r < 16; ++r) ps += p0[r];
#pragma unroll
    for (int r = 0; r < 16; ++r) ps += p1[r];
    { auto rr = __builtin_amdgcn_permlane32_swap(__float_as_uint(ps), __float_as_uint(ps), false, false);
      ps = __uint_as_float(rr[0]) + __uint_as_float(rr[1]); }
    l_reg = l_reg * alpha + ps;
#define PK4(P, BASE, OUT) do { unsigned a0 = cvt_pk_bf16(P[BASE + 0], P[BASE + 1]), a1 = cvt_pk_bf16(P[BASE + 2], P[BASE + 3]);   \
    unsigned b0 = cvt_pk_bf16(P[BASE + 4], P[BASE + 5]), b1 = cvt_pk_bf16(P[BASE + 6], P[BASE + 7]);                              \
    auto r0 = __builtin_amdgcn_permlane32_swap(a0, b0, false, false); auto r1 = __builtin_amdgcn_permlane32_swap(a1, b1, false, false); \
    u32x4 w = {r0[0], r1[0], r0[1], r1[1]}; OUT = *reinterpret_cast<bf16x8*>(&w); } while (0)
    PK4(p0, 0, pa0); PK4(p0, 8, pa1); PK4(p1, 0, pa2); PK4(p1, 8, pa3);
#undef PK4
}
__device__ __forceinline__ void qkt(f32x16& p0, f32x16& p1, const int (&ka)[4], int boff, const bf16x8* qr) {
    p0 = f32x16{}; p1 = f32x16{};
    bf16x8 kb[3][2];
#define QK_LD(D0) do { const int dl_ = (D0) & 3, dh_ = (D0) >> 2; kb[(D0) % 3][0] = *(const LAS bf16x8*)(unsigned)(ka[dl_] + (boff + dh_ * 128)); \
        kb[(D0) % 3][1] = *(const LAS bf16x8*)(unsigned)(ka[dl_] + (boff + dh_ * 128 + 32 * 384)); } while (0)
    QK_LD(0); QK_LD(1);
#pragma unroll
    for (int d0 = 0; d0 < 12; ++d0) {
        if (d0 + 2 < 12) QK_LD(d0 + 2);
        p0 = __builtin_amdgcn_mfma_f32_32x32x16_bf16(kb[d0 % 3][0], qr[d0], p0, 0, 0, 0);
        p1 = __builtin_amdgcn_mfma_f32_32x32x16_bf16(kb[d0 % 3][1], qr[d0], p1, 0, 0, 0);
    }
#undef QK_LD
}
__device__ __forceinline__ int v_st(int k, int c) { const int kk = (k & ~0xC) | ((k & 4) << 1) | ((k & 8) >> 1); return ((kk >> 3) * 4 + (c >> 5)) * 512 + ((kk & 7) * 32 + (c & 31)) * 2; }
__device__ __forceinline__ int v_rd_base(int lane) { return ((lane & 3) << 3) | (((lane >> 2) & 3) << 6) | (((lane >> 4) & 1) << 5) | (((lane >> 5) & 1) << 8); }
constexpr int v_rd_off(int d0, int ks, int half) { return d0 * 512 + ks * 4096 + half * 2048; }
template <int OFF> __device__ __forceinline__ s16x4 tr_read(int vb) {
    s16x4 r; asm volatile("ds_read_b64_tr_b16 %0, %1 offset:%2" : "=&v"(r) : "v"(vb), "i"(OFF) : "memory"); return r;
}
template <int D0> __device__ __forceinline__ void pv_one(f32x16& od, int vb, bf16x8 pa0, bf16x8 pa1, bf16x8 pa2, bf16x8 pa3) {
    const s16x4 l0 = tr_read<v_rd_off(D0, 0, 0)>(vb), h0 = tr_read<v_rd_off(D0, 0, 1)>(vb), l1 = tr_read<v_rd_off(D0, 1, 0)>(vb), h1 = tr_read<v_rd_off(D0, 1, 1)>(vb);
    const s16x4 l2 = tr_read<v_rd_off(D0, 2, 0)>(vb), h2 = tr_read<v_rd_off(D0, 2, 1)>(vb), l3 = tr_read<v_rd_off(D0, 3, 0)>(vb), h3 = tr_read<v_rd_off(D0, 3, 1)>(vb);
    asm volatile("s_waitcnt lgkmcnt(0)" ::: "memory"); SBAR();
#define PK(L, H) (bf16x8){L[0], L[1], L[2], L[3], H[0], H[1], H[2], H[3]}
    od = __builtin_amdgcn_mfma_f32_32x32x16_bf16(pa0, PK(l0, h0), od, 0, 0, 0);
    od = __builtin_amdgcn_mfma_f32_32x32x16_bf16(pa1, PK(l1, h1), od, 0, 0, 0);
    od = __builtin_amdgcn_mfma_f32_32x32x16_bf16(pa2, PK(l2, h2), od, 0, 0, 0);
    od = __builtin_amdgcn_mfma_f32_32x32x16_bf16(pa3, PK(l3, h3), od, 0, 0, 0);
#undef PK
}
__device__ __forceinline__ void pv_d0(f32x16* o, int vb, bf16x8 pa0, bf16x8 pa1, bf16x8 pa2, bf16x8 pa3) {
    pv_one<0>(o[0], vb, pa0, pa1, pa2, pa3); pv_one<1>(o[1], vb, pa0, pa1, pa2, pa3); pv_one<2>(o[2], vb, pa0, pa1, pa2, pa3); pv_one<3>(o[3], vb, pa0, pa1, pa2, pa3);
}
__device__ __forceinline__ void attn_body(const bf16_t* __restrict__ Qb, const bf16_t* __restrict__ Kn, const bf16_t* __restrict__ Kr, const bf16_t* __restrict__ Vh,
                                          bf16_t* __restrict__ Ob, int seq, int rope_t0, char* lds, float* __restrict__ Opart, float* __restrict__ MLpart) {
    const int tid = otid(), wid = tid >> 6, lane = tid & 63, r32 = lane & 31, hi = lane >> 5;
    char* V_lds = lds; char* K_lds = lds + 2 * SHM_V;
    float* ws = (float*)(lds + 2 * SHM_V + 2 * SHM_K) + wid * 64; float* li_l = ws; float* al_l = ws + 32;
    float m_reg = -1e30f, l_reg = 0; f32x16 o[4] = {}; bf16x8 qr[12];
    const bf16_t* Qw = Qb + (long)(wid * QBLK + r32) * LDQ + hi * 8;
#pragma unroll
    for (int d0 = 0; d0 < 8; ++d0) qr[d0] = *reinterpret_cast<const bf16x8*>(Qw + d0 * 16);
    {
        bf16_t* Qr = (bf16_t*)(lds + SHM_ATTN);
        bf16_t qa[16][2];
#pragma unroll
        for (int it = 0; it < 16; ++it) { const int item = tid + it * 512, row = item >> 5, pr = item & 31; const bf16_t* qp = Qb + (long)row * LDQ + 128 + (pr >> 4) * 32 + (pr & 15); qa[it][0] = qp[0]; qa[it][1] = qp[16]; }
#pragma unroll
        for (int it = 0; it < 16; ++it) { const int item = tid + it * 512, row = item >> 5, pr = item & 31, half = pr >> 4, i = pr & 15;
            const float x1 = bf2f(qa[it][0]), x2 = bf2f(qa[it][1]); float o1 = x1, o2 = x2;
            if (rope_t0 >= 0) { const int t = rope_t0 + row; const float pos = (float)(half ? (t & 63) : (t >> 6));
                const float inv = expf(-(float)i * (9.210340371976184f / 16.f)); float s, c; sincosf(pos * inv, &s, &c);
                o1 = x1 * c - x2 * s; o2 = x2 * c + x1 * s; }
            Qr[row * 64 + half * 32 + i] = f2bf(o1); Qr[row * 64 + half * 32 + i + 16] = f2bf(o2); }
        __syncthreads();
#pragma unroll
        for (int dd = 0; dd < 4; ++dd) qr[8 + dd] = *reinterpret_cast<const bf16x8*>(Qr + (wid * QBLK + r32) * 64 + dd * 16 + hi * 8);
    }
    const int sr = tid >> 4, sc = (tid & 15) * 8, vst0 = v_st(sr, sc), vst1 = v_st(32 + sr, sc);
    const int rr = tid >> 3, rc = (tid & 7) * 8;
    const int vb0 = (int)(uintptr_t)V_lds + v_rd_base(lane);
    int ka[4];
#pragma unroll
    for (int dl = 0; dl < 4; ++dl) ka[dl] = (int)(uintptr_t)K_lds + r32 * 384 + ((dl * 32 + hi * 16) ^ (((r32 >> 1) & 7) << 4));
    struct { bf16x8 vs0, vs1, ks0, ks1, kr; } sr_[1];
    const unsigned ovA = (unsigned)(sr * LDV + sc) * 2u, ovB = (unsigned)((32 + sr) * LDV + sc) * 2u, orr = (unsigned)(rr * LDKR + rc) * 2u;
#define SLOAD(i, k0) do { const char* vbp = (const char*)Vh + (size_t)(k0) * (LDV * 2); const char* kbp = (const char*)Kn + (size_t)(k0) * (LDKN * 2); const char* rbp = (const char*)Kr + (size_t)(k0) * (LDKR * 2); \
    sr_[i].vs0 = *(const bf16x8*)(vbp + ovA); sr_[i].vs1 = *(const bf16x8*)(vbp + ovB); \
    sr_[i].ks0 = *(const bf16x8*)(kbp + ovA); sr_[i].ks1 = *(const bf16x8*)(kbp + ovB); \
    sr_[i].kr = *(const bf16x8*)(rbp + orr); } while (0)
#define SWRITE(b, i) do { *(bf16x8*)(V_lds + (b) * SHM_V + vst0) = sr_[i].vs0; *(bf16x8*)(V_lds + (b) * SHM_V + vst1) = sr_[i].vs1; const int kc = sc * 2; \
    *(bf16x8*)(K_lds + (b) * SHM_K + KSWZ(sr, kc)) = sr_[i].ks0; *(bf16x8*)(K_lds + (b) * SHM_K + KSWZ(32 + sr, kc)) = sr_[i].ks1; \
    *(bf16x8*)(K_lds + (b) * SHM_K + KSWZ(rr, 256 + rc * 2)) = sr_[i].kr; } while (0)
#define SWAIT() asm volatile("s_waitcnt vmcnt(0)" ::: "memory")
#define RESC(a) do { if (__any((a) < 1.f)) { if (hi == 0) al_l[r32] = (a); asm volatile("s_waitcnt lgkmcnt(0)" ::: "memory"); \
    _Pragma("unroll") for (int d = 0; d < 4; ++d) _Pragma("unroll") for (int r = 0; r < 16; ++r) o[d][r] *= al_l[crow(r, hi)]; } } while (0)
    f32x16 pA0, pA1, pB0, pB1; float mnA, mnB, alA, alB; bf16x8 pa0, pa1, pa2, pa3; const int NT = seq / KVBLK;
    constexpr int SE = 0, SO = 0;
    SLOAD(SE, 0); asm volatile("s_waitcnt vmcnt(0)" ::: "memory"); SWRITE(0, SE); __syncthreads();
    qkt(pA0, pA1, ka, 0, qr); partialSM(pA0, pA1, m_reg, mnA, alA);
    SLOAD(SO, KVBLK);
    SWAIT(); SWRITE(1, SO); __syncthreads();
    for (int j = 1; j + 1 < NT; j += 2) {
        SBAR(); qkt(pB0, pB1, ka, SHM_K, qr);
        finishSM(pA0, pA1, alA, l_reg, pa0, pa1, pa2, pa3); SBAR();
        SLOAD(SO, (j + 1) * KVBLK); SBAR();
        pv_d0(o, vb0, pa0, pa1, pa2, pa3); partialSM(pB0, pB1, m_reg, mnB, alB);
        __syncthreads(); SWAIT(); SWRITE(0, SE);
        RESC(alB); __syncthreads();
        SBAR(); qkt(pA0, pA1, ka, 0, qr);
        finishSM(pB0, pB1, alB, l_reg, pa0, pa1, pa2, pa3); SBAR();
        SLOAD(SE, (j + 2) * KVBLK); SBAR();
        pv_d0(o, vb0 + SHM_V, pa0, pa1, pa2, pa3); partialSM(pA0, pA1, m_reg, mnA, alA);
        __syncthreads(); SWAIT(); SWRITE(1, SO);
        RESC(alA); __syncthreads();
    }
    SBAR(); qkt(pB0, pB1, ka, SHM_K, qr);
    finishSM(pA0, pA1, alA, l_reg, pa0, pa1, pa2, pa3); SBAR();
    pv_d0(o, vb0, pa0, pa1, pa2, pa3); partialSM(pB0, pB1, m_reg, mnB, alB);
    __syncthreads(); RESC(alB);
    finishSM(pB0, pB1, alB, l_reg, pa0, pa1, pa2, pa3); SBAR();
    pv_d0(o, vb0 + SHM_V, pa0, pa1, pa2, pa3);
    if (Opart != nullptr) {
        if (hi == 0) { MLpart[(wid * QBLK + r32) * 2] = m_reg; MLpart[(wid * QBLK + r32) * 2 + 1] = l_reg; }
#pragma unroll
        for (int r = 0; r < 16; ++r) { const int orow = wid * QBLK + crow(r, hi);
#pragma unroll
            for (int d0 = 0; d0 < 4; ++d0) Opart[orow * 128 + d0 * 32 + r32] = o[d0][r]; }
        __syncthreads();
        return;
    }
    if (hi == 0) li_l[r32] = l_reg; asm volatile("s_waitcnt lgkmcnt(0)" ::: "memory");
    float rli[16];
#pragma unroll
    for (int r = 0; r < 16; ++r) rli[r] = __builtin_amdgcn_rcpf(li_l[crow(r, hi)]);
    bf16_t* Ow = Ob + (long)(wid * QBLK) * LDO;
#pragma unroll
    for (int r = 0; r < 16; ++r) { const int orow = crow(r, hi);
#pragma unroll
        for (int d0 = 0; d0 < 4; ++d0) Ow[(long)orow * LDO + d0 * 32 + r32] = f2bf(o[d0][r] * rli[r]); }
    __syncthreads();
#undef SLOAD
#undef SWRITE
#undef SWAIT
#undef RESC
}
}

constexpr int ATT_SPLIT_K0[4] = {0, 4096, 8192, 12416};
constexpr size_t ATT_PART_FLOATS = 256 * 128 + 512;
__device__ __forceinline__ void attn_unit(const Params& p, int u, int sp, char* lds) {
    const bool lat = u < 256;
    const int xcd = u & 7, h = lat ? (xcd >> 1) : (u - 256), qb = (u >> 3) * 2 + (xcd & 1);
    const int row0 = lat ? LC + qb * 256 : 0;
    const int k0 = sp < 0 ? 0 : (sp == 0 ? 0 : (sp == 1 ? 4096 : (sp == 2 ? 8192 : 12416)));
    const int nk = sp < 0 ? (lat ? MT : LC) : (sp < 2 ? 4096 : 4224);
    float* part = sp < 0 ? nullptr : p.attp() + (size_t)(u * 4 + sp) * ATT_PART_FLOATS;
    att::attn_body(p.qkvup() + (size_t)row0 * MLAN + h * 192, p.qkvup() + (size_t)k0 * MLAN + 768 + h * 256, p.krr() + (size_t)k0 * 64, p.qkvup() + (size_t)k0 * MLAN + 768 + h * 256 + 128,
                   p.ocat() + (size_t)row0 * D_ + 512 + h * 128, nk, lat ? qb * 256 : -1, lds, part, part ? part + 256 * 128 : nullptr);
}
__device__ __forceinline__ void phase_attn(const Params& p, int layer, char* lds) {
    const int nunits = 256 + (layer == 0 ? 4 : 0);
#pragma unroll 1
    for (int u = blockIdx.x; u < nunits; u += gridDim.x) attn_unit(p, u, -1, lds);
}

__device__ __forceinline__ void phase_rec_naive(const Params& p, int layer, float* lds) {
    const int tid = otid();
    float* kq = lds;
    float* vv = lds + 32 * 256;
    float* ab = vv + 32 * 128;
    for (int u = blockIdx.x; u < 16; u += gridDim.x) {
        const int kind = u >> 3, dir = (u >> 2) & 1, h = u & 3;
        float S[128];
#pragma unroll
        for (int i = 0; i < 128; ++i) S[i] = 0.f;
        const float gam = 1.0f - exp2f(-(float)((dir ? 6 : 5) + 2 * h));
        float* outp = (kind == 0 ? p.go() : p.ro()) + (size_t)dir * MT * 512 + h * 128;
        for (int s0 = 0; s0 < MT; s0 += 32) {
            __syncthreads();
            {   const int tk = tid >> 4, seg = (tid & 15) * 16; const int s = s0 + tk;
                const int row = dir == 0 ? s : (s < LC ? LC - 1 - s : MT + LC - 1 - s);
                const bf16_t* src;
                if (kind == 0) src = p.gqkv() + (size_t)row * 1536 + (seg < 128 ? 512 + h * 128 + seg : h * 128 + (seg - 128));
                else           src = p.rqk() + (size_t)row * 1024 + (seg < 128 ? 512 + h * 128 + seg : h * 128 + (seg - 128));
                float f[8]; unpack8(*(const u32x4*)src, f);
#pragma unroll
                for (int e = 0; e < 8; ++e) kq[tk * 256 + seg + e] = f[e];
                unpack8(*(const u32x4*)(src + 8), f);
#pragma unroll
                for (int e = 0; e < 8; ++e) kq[tk * 256 + seg + 8 + e] = f[e];
                const int vseg = (tid & 15) * 8;
                const bf16_t* vsrc = kind == 0 ? p.gqkv() + (size_t)row * 1536 + 1024 + h * 128 + vseg : p.Pp() + (size_t)row * NP + PC_RQKV + 1024 + h * 128 + vseg;
                unpack8(*(const u32x4*)vsrc, f);
#pragma unroll
                for (int e = 0; e < 8; ++e) vv[tk * 128 + vseg + e] = f[e];
                if (tid < 32) { const int s2 = s0 + tid; const int row2 = dir == 0 ? s2 : (s2 < LC ? LC - 1 - s2 : MT + LC - 1 - s2);
                    if (kind == 0) { ab[tid * 2] = expf(p.ggb()[(size_t)row2 * 16 + dir * 4 + h]); ab[tid * 2 + 1] = p.ggb()[(size_t)row2 * 16 + 8 + dir * 4 + h]; }
                    else { ab[tid * 2] = gam; ab[tid * 2 + 1] = 1.f; } }
            }
            __syncthreads();
            if (tid < 128) {
                for (int tk = 0; tk < 32; ++tk) {
                    const f32x4* kp = (const f32x4*)(kq + tk * 256); const f32x4* qp = kp + 32;
                    const float a = ab[tk * 2], b = ab[tk * 2 + 1], v = vv[tk * 128 + tid];
                    float dv;
                    if (kind == 0) { float ks = 0.f;
#pragma unroll
                        for (int i = 0; i < 32; ++i) { const f32x4 k4 = kp[i]; ks += k4[0] * S[4 * i] + k4[1] * S[4 * i + 1] + k4[2] * S[4 * i + 2] + k4[3] * S[4 * i + 3]; }
                        dv = b * (v - a * ks); }
                    else dv = v;
                    float o = 0.f;
#pragma unroll
                    for (int i = 0; i < 32; ++i) { const f32x4 k4 = kp[i], q4 = qp[i];
                        S[4 * i] = a * S[4 * i] + k4[0] * dv; S[4 * i + 1] = a * S[4 * i + 1] + k4[1] * dv; S[4 * i + 2] = a * S[4 * i + 2] + k4[2] * dv; S[4 * i + 3] = a * S[4 * i + 3] + k4[3] * dv;
                        o += q4[0] * S[4 * i] + q4[1] * S[4 * i + 1] + q4[2] * S[4 * i + 2] + q4[3] * S[4 * i + 3]; }
                    const int s = s0 + tk; const int row = dir == 0 ? s : (s < LC ? LC - 1 - s : MT + LC - 1 - s);
                    outp[(size_t)row * 512 + tid] = o;
                }
            }
        }
        __syncthreads();
    }
}

__device__ __forceinline__ void phase_mixout(const Params& p, int layer) {
    const int tid = otid(), wid = tid >> 6, lane = tid & 63;
    const float* gnw = p.in[I_GNW] + layer * 128;
    for (int r = blockIdx.x * 8 + wid; r < MT; r += gridDim.x * 8) {
        const int idx = lane * 8;
        f32x4 ga[2][4]; u32x4 zr[2]; float gw8[8];
        { const f32x4 g0 = *(const f32x4*)(gnw + (idx & 127)), g1 = *(const f32x4*)(gnw + (idx & 127) + 4); gw8[0] = g0[0]; gw8[1] = g0[1]; gw8[2] = g0[2]; gw8[3] = g0[3]; gw8[4] = g1[0]; gw8[5] = g1[1]; gw8[6] = g1[2]; gw8[7] = g1[3]; }
#pragma unroll
        for (int kind = 0; kind < 2; ++kind) {
            const float* o0 = (kind == 0 ? p.go() : p.ro()) + (size_t)r * 512 + idx; const float* o1 = o0 + (size_t)MT * 512;
            ga[kind][0] = *(const f32x4*)o0; ga[kind][1] = *(const f32x4*)(o0 + 4); ga[kind][2] = *(const f32x4*)o1; ga[kind][3] = *(const f32x4*)(o1 + 4);
            zr[kind] = *(const u32x4*)(p.Pp() + (size_t)r * NP + (kind == 0 ? PC_GZ : PC_RG) + idx); }
        if (r >= LC && r < LC + 1024) {
            const int qb = (r - LC) >> 8, rl = (r - LC) & 255, hh = lane >> 4, col = (lane & 15) * 8;
            const int uu = (qb >> 1) * 8 + 2 * hh + (qb & 1);
            const float* pb = p.attp() + (size_t)(uu * 4) * ATT_PART_FLOATS;
            float mm[4], ll[4], M = -3.0e38f;
#pragma unroll
            for (int s4 = 0; s4 < 4; ++s4) { mm[s4] = pb[s4 * ATT_PART_FLOATS + 256 * 128 + rl * 2]; ll[s4] = pb[s4 * ATT_PART_FLOATS + 256 * 128 + rl * 2 + 1]; M = fmaxf(M, mm[s4]); }
            float acc[8] = {0.f, 0.f, 0.f, 0.f, 0.f, 0.f, 0.f, 0.f}, L = 0.f;
#pragma unroll
            for (int s4 = 0; s4 < 4; ++s4) { const float w = __builtin_amdgcn_exp2f((mm[s4] - M) * (att::SCALE * 1.4426950408889634f)); L += w * ll[s4];
                const f32x4 o0 = *(const f32x4*)(pb + s4 * ATT_PART_FLOATS + rl * 128 + col), o1 = *(const f32x4*)(pb + s4 * ATT_PART_FLOATS + rl * 128 + col + 4);
#pragma unroll
                for (int e = 0; e < 4; ++e) { acc[e] += w * o0[e]; acc[4 + e] += w * o1[e]; } }
            const float il = 1.0f / L;
#pragma unroll
            for (int e = 0; e < 8; ++e) acc[e] *= il;
            *(u32x4*)(p.ocat() + (size_t)r * D_ + 512 + hh * 128 + col) = pack8(acc);
        }
#pragma unroll
        for (int kind = 0; kind < 2; ++kind) {
            float o[8]; float ss = 0.f;
#pragma unroll
            for (int e = 0; e < 4; ++e) { o[e] = ga[kind][0][e] + ga[kind][2][e]; o[4 + e] = ga[kind][1][e] + ga[kind][3][e]; }
#pragma unroll
            for (int e = 0; e < 8; ++e) ss += o[e] * o[e];
            ss = sum16(ss);
            const float rn = rsqrtf(ss * (1.0f / 128.f) + EPS);
            float z[8]; unpack8(zr[kind], z);
            float y[8];
#pragma unroll
            for (int e = 0; e < 8; ++e) { const float w = kind == 0 ? gw8[e] : 1.f; y[e] = o[e] * rn * w * silu_f(z[e]); }
            *(u32x4*)(p.ocat() + (size_t)r * D_ + (kind == 0 ? 0 : 1536) + idx) = pack8(y);
        }
    }
}
constexpr int NCHUNK = MT / 64;
constexpr size_t REC_Q = 0, REC_KT = 16384, REC_A = 32768, REC_W = 40960, REC_U = 57344, REC_DL = 73728, REC_BYTES = 73984;
__device__ __forceinline__ int scan_row(int dir, int s) { return dir == 0 ? s : (s < LC ? LC - 1 - s : MT + LC - 1 - s); }
__device__ __forceinline__ int crow32(int r, int hi) { return (r & 3) + 8 * (r >> 2) + 4 * hi; }

constexpr int CP_LDS = 70656;
__device__ __forceinline__ void chunkprep_pair(const Params& p, int layer, int u0, char* lds0) {
    const int tid = otid(), half = tid >> 8, t = tid & 255, hw = (tid >> 6) & 3, lane = tid & 63, r32 = lane & 31, hi = lane >> 5;
    const int u = u0 + half; const bool valid = u < 16 * NCHUNK;
    const int c = valid ? (u & 15) : 0, n = valid ? (u >> 4) : 0;
    const int kind = c >> 3, dir = (c >> 2) & 1, h = c & 3;
    char* lds = lds0 + half * CP_LDS;
    char* qL = lds; char* kL = lds + 17408; char* vL = lds + 34816; float* AM = (float*)(lds + 52224); float* scv = (float*)(lds + 69632);
    float* gcL = scv; float* btL = scv + 64; float* egL = scv + 128; float* ekL = scv + 192;
    char* rec = p.recs() + ((size_t)c * NCHUNK + n) * REC_BYTES;
    if (valid) {
        const int tk = t >> 2, seg = (t & 3) * 32; const int row = scan_row(dir, n * 64 + tk);
        const bf16_t *qs, *ks, *vs;
        if (kind == 0) { const bf16_t* b = p.gqkv() + (size_t)row * 1536 + h * 128 + seg; qs = b; ks = b + 512; vs = b + 1024; }
        else { const bf16_t* b = p.rqk() + (size_t)row * 1024 + h * 128 + seg; qs = b; ks = b + 512; vs = p.Pp() + (size_t)row * NP + PC_RQKV + 1024 + h * 128 + seg; }
        u32x4 qv[4], kv[4], vv[4];
#pragma unroll
        for (int k = 0; k < 4; ++k) { qv[k] = *(const u32x4*)(qs + 8 * k); kv[k] = *(const u32x4*)(ks + 8 * k); vv[k] = *(const u32x4*)(vs + 8 * k); }
        const int lo = tk * 272 + seg * 2;
#pragma unroll
        for (int k = 0; k < 4; ++k) { *(u32x4*)(qL + lo + 16 * k) = qv[k]; *(u32x4*)(kL + lo + 16 * k) = kv[k]; *(u32x4*)(vL + lo + 16 * k) = vv[k]; }
    }
    if (hw == 0) {
        float g, b;
        if (kind == 0) { const int row = scan_row(dir, n * 64 + lane); g = p.ggb()[(size_t)row * 16 + dir * 4 + h]; b = p.ggb()[(size_t)row * 16 + 8 + dir * 4 + h]; }
        else { const int ei = dir + 2 * h; g = (ei == 0 ? -3.1748698315e-02f : (ei == 1 ? -1.5748356968e-02f : (ei == 2 ? -7.8431774610e-03f : (ei == 3 ? -3.9138993211e-03f : (ei == 4 ? -1.9550348358e-03f : (ei == 5 ? -9.7703964783e-04f : (ei == 6 ? -4.8840049811e-04f : -2.4417043217e-04f))))))); b = 1.f; }
        float gc = g;
#pragma unroll
        for (int o = 1; o < 64; o <<= 1) { const float tt = __int_as_float(__builtin_amdgcn_ds_bpermute(((lane - o) & 63) << 2, __float_as_int(gc))); if (lane >= o) gc += tt; }
        const float gl = __int_as_float(__builtin_amdgcn_readlane(__float_as_int(gc), 63));
        gcL[lane] = gc; btL[lane] = b; egL[lane] = expf(gc); ekL[lane] = expf(gl - gc);
        if (lane == 63 && valid) *(float*)(rec + REC_DL) = expf(gc);
    }
    __syncthreads();
    {   const int mi = hw >> 1, ni = hw & 1;
#pragma unroll
        for (int mat = 0; mat < 2; ++mat) {
            if (mat == 1 || kind == 0) {
                f32x16 acc = {};
                if (!(mi == 0 && ni == 1)) {
                    const char* XL = mat ? qL : kL;
#pragma unroll
                    for (int ks = 0; ks < 8; ++ks) {
                        const bf16x8 a = *(const bf16x8*)(XL + (32 * mi + r32) * 272 + (16 * ks + 8 * hi) * 2);
                        const bf16x8 b = *(const bf16x8*)(kL + (32 * ni + r32) * 272 + (16 * ks + 8 * hi) * 2);
                        acc = __builtin_amdgcn_mfma_f32_32x32x16_bf16(a, b, acc, 0, 0, 0);
                    }
                }
                const int j = 32 * ni + r32; const float gj = gcL[j];
#pragma unroll
                for (int r = 0; r < 16; ++r) { const int i = 32 * mi + crow32(r, hi);
                    const float dec = __expf(fminf(gcL[i] - gj, 0.f));
                    if (mat == 0) AM[i * 68 + j] = (j < i) ? btL[i] * acc[r] * dec : 0.f;
                    else if (valid) *(bf16_t*)(rec + REC_A + (size_t)(i * 64 + j) * 2) = f2bf((j <= i) ? acc[r] * dec : 0.f); }
            }
        }
    }
    __syncthreads();
    if (valid) {
        if (kind == 0) {
            const int cc = t & 127; const bool isw = t >= 128; const char* src = isw ? kL : vL;
            float x[64];
#pragma unroll
            for (int i = 0; i < 64; ++i) x[i] = bf2f(*(const bf16_t*)(src + i * 272 + cc * 2)) * (isw ? btL[i] * egL[i] : btL[i]);
            f32x4 ar[2][16];
#pragma unroll
            for (int i = 1; i < 64; ++i) {
                if (i == 1) { ar[1][0] = *(const f32x4*)(AM + 68); }
                if (i + 1 < 64) {
#pragma unroll
                    for (int j4 = 0; j4 < (i + 4) / 4; ++j4) ar[(i + 1) & 1][j4] = *(const f32x4*)(AM + (i + 1) * 68 + j4 * 4);
                }
                __builtin_amdgcn_sched_barrier(0);
                float a = x[i];
#pragma unroll
                for (int j4 = 0; j4 < (i + 3) / 4; ++j4) { const f32x4 a4 = ar[i & 1][j4];
                    if (4 * j4 + 0 < i) a -= a4[0] * x[4 * j4 + 0]; if (4 * j4 + 1 < i) a -= a4[1] * x[4 * j4 + 1];
                    if (4 * j4 + 2 < i) a -= a4[2] * x[4 * j4 + 2]; if (4 * j4 + 3 < i) a -= a4[3] * x[4 * j4 + 3]; }
                x[i] = a;
                __builtin_amdgcn_sched_barrier(0);
            }
            bf16_t* dstp = (bf16_t*)(rec + (isw ? REC_W : REC_U)) + cc;
#pragma unroll
            for (int i = 0; i < 64; ++i) dstp[i * 128] = f2bf(x[i]);
        } else if (t < 128) {
#pragma unroll 8
            for (int i = 0; i < 64; ++i) *(bf16_t*)(rec + REC_U + (size_t)(i * 128 + t) * 2) = *(const bf16_t*)(vL + i * 272 + t * 2);
        }
        {   const int i = t >> 2, seg = (t & 3) * 32; const float e = egL[i];
#pragma unroll
            for (int k8 = 0; k8 < 4; ++k8) { float f[8]; unpack8(*(const u32x4*)(qL + i * 272 + (seg + k8 * 8) * 2), f);
#pragma unroll
                for (int e8 = 0; e8 < 8; ++e8) f[e8] *= e;
                *(u32x4*)(rec + REC_Q + (size_t)(i * 128 + seg + k8 * 8) * 2) = pack8(f); } }
        {   const int d = t >> 1, hf = t & 1;
#pragma unroll
            for (int k8 = 0; k8 < 4; ++k8) { float f[8];
#pragma unroll
                for (int e8 = 0; e8 < 8; ++e8) { const int i = hf * 32 + k8 * 8 + e8; f[e8] = bf2f(*(const bf16_t*)(kL + i * 272 + d * 2)) * ekL[i]; }
                *(u32x4*)(rec + REC_KT + (size_t)(d * 64 + hf * 32 + k8 * 8) * 2) = pack8(f); } }
    }
    __syncthreads();
}
__device__ __forceinline__ void phase_chunkprep(const Params& p, int layer, char* lds) {
    int k = 0;
#pragma unroll 1
    for (int id = blockIdx.x; id < 8 * NCHUNK; id += gridDim.x, ++k) { const int j = ((id & 7) + 4 * (k & 1)) & 7; chunkprep_pair(p, layer, ((id >> 3) * 8 + j) * 2, lds); }
}

constexpr int CH_W = 0, CH_Q = 16896, CH_A = 33792, CH_K = 42496, CH_BUF = 59904;
constexpr int CH_U = 2 * CH_BUF, CH_DL = CH_U + 16896;
__device__ __forceinline__ bf16x8 frag_rd(const char* base, int row, int stride, int ks, int hi) {
    const char* a = base + row * stride + (16 * ks + 4 * hi) * 2;
    const u32x2 lo = *(const u32x2*)a, hi2 = *(const u32x2*)(a + 16);
    u32x4 w = {lo.x, lo.y, hi2.x, hi2.y}; return *reinterpret_cast<bf16x8*>(&w);
}
__device__ __forceinline__ bf16x8 acc_frag(const f32x16& x, int s) {
    u32x4 w = {cvt_pk_bf16(x[8 * s + 0], x[8 * s + 1]), cvt_pk_bf16(x[8 * s + 2], x[8 * s + 3]), cvt_pk_bf16(x[8 * s + 4], x[8 * s + 5]), cvt_pk_bf16(x[8 * s + 6], x[8 * s + 7])};
    return *reinterpret_cast<bf16x8*>(&w);
}
struct ChainRegs { u32x4 q[4], k[4], a[2], w[4], u[4]; float dl; };
__device__ __forceinline__ void chain_ld(ChainRegs& R, const char* rec, int t, bool gdn) {
#pragma unroll
    for (int it = 0; it < 4; ++it) R.q[it] = *(const u32x4*)(rec + REC_Q + (size_t)(t + it * 256) * 16);
#pragma unroll
    for (int it = 0; it < 4; ++it) R.k[it] = *(const u32x4*)(rec + REC_KT + (size_t)(t + it * 256) * 16);
#pragma unroll
    for (int it = 0; it < 2; ++it) R.a[it] = *(const u32x4*)(rec + REC_A + (size_t)(t + it * 256) * 16);
#pragma unroll
    for (int it = 0; it < 4; ++it) R.u[it] = *(const u32x4*)(rec + REC_U + (size_t)(t + it * 256) * 16);
    R.dl = *(const float*)(rec + REC_DL);
    if (gdn) {
#pragma unroll
        for (int it = 0; it < 4; ++it) R.w[it] = *(const u32x4*)(rec + REC_W + (size_t)(t + it * 256) * 16);
    }
}
#define CH_ST16(DST, V) do { char* d_ = (DST); *(u32x2*)d_ = (u32x2){(V).x, (V).y}; *(u32x2*)(d_ + 8) = (u32x2){(V).z, (V).w}; } while (0)
__device__ __forceinline__ void chain_st(const ChainRegs& R, char* lds, int b, int t, bool gdn) {
    char* buf = lds + b * CH_BUF;
#pragma unroll
    for (int it = 0; it < 4; ++it) { const int pc = t + it * 256; CH_ST16(buf + CH_Q + (pc >> 4) * 264 + (pc & 15) * 16, R.q[it]); }
#pragma unroll
    for (int it = 0; it < 4; ++it) { const int pc = t + it * 256; CH_ST16(buf + CH_K + (pc >> 3) * 136 + (pc & 7) * 16, R.k[it]); }
#pragma unroll
    for (int it = 0; it < 2; ++it) { const int pc = t + it * 256; CH_ST16(buf + CH_A + (pc >> 3) * 136 + (pc & 7) * 16, R.a[it]); }
#pragma unroll
    for (int it = 0; it < 4; ++it) { const int pc = t + it * 256; CH_ST16(lds + CH_U + (pc >> 4) * 264 + (pc & 15) * 16, R.u[it]); }
    if (t == 0) *(float*)(lds + CH_DL + b * 4) = R.dl;
    if (gdn) {
#pragma unroll
        for (int it = 0; it < 4; ++it) { const int pc = t + it * 256; CH_ST16(buf + CH_W + (pc >> 4) * 264 + (pc & 15) * 16, R.w[it]); }
    }
}
#define CH_BAR() do { asm volatile("s_waitcnt lgkmcnt(0)" ::: "memory"); __builtin_amdgcn_s_barrier(); asm volatile("" ::: "memory"); } while (0)
__device__ __forceinline__ void chain_unit(const Params& p, int c, char* lds) {
    const int tid = otid(), wid = tid >> 6, lane = tid & 63, r32 = lane & 31, hi = lane >> 5;
    const int kind = c >> 3, dir = (c >> 2) & 1, h = c & 3; const bool gdn = kind == 0;
    const char* rec0 = p.recs() + (size_t)c * NCHUNK * REC_BYTES;
    float* outp = (gdn ? p.go() : p.ro()) + (size_t)dir * MT * 512 + h * 128;
    const bool comp = wid < 4; const int sl = wid & 3;
    if (!comp) {
        const int t = tid - 256; ChainRegs R0, R1;
        chain_ld(R0, rec0, t, gdn); chain_st(R0, lds, 0, t, gdn);
        chain_ld(R1, rec0 + REC_BYTES, t, gdn); chain_ld(R0, rec0 + 2 * REC_BYTES, t, gdn);
        CH_BAR();
#define CH_LSTEP(R, N) do { CH_BAR(); if ((N) + 1 < NCHUNK) { chain_st(R, lds, ((N) + 1) & 1, t, gdn); if ((N) + 3 < NCHUNK) chain_ld(R, rec0 + (size_t)((N) + 3) * REC_BYTES, t, gdn); } CH_BAR(); } while (0)
#pragma unroll 1
        for (int n = 0; n < NCHUNK; n += 2) { CH_LSTEP(R1, n); CH_LSTEP(R0, n + 1); }
#undef CH_LSTEP
    } else {
        f32x16 S[4] = {};
        unsigned warm = 0u; const char* wbase = rec0 + (size_t)((wid * 3) * 64 + lane) * 128;
        CH_BAR();
#define CH_FR8(BASE, STRIDE, ROWA, ROWB, KS0) do { _Pragma("unroll") for (int k_ = 0; k_ < 4; ++k_) { fr[k_] = frag_rd(BASE, ROWA, STRIDE, (KS0) + k_, hi); fr[4 + k_] = frag_rd(BASE, ROWB, STRIDE, (KS0) + k_, hi); } \
        __builtin_amdgcn_sched_barrier(0); } while (0)
#define CH_MM8(ACC0, ACC1, B, KS0) do { _Pragma("unroll") for (int k_ = 0; k_ < 4; ++k_) { \
        ACC0 = __builtin_amdgcn_mfma_f32_32x32x16_bf16(fr[k_], B[((KS0) + k_) >> 1][((KS0) + k_) & 1], ACC0, 0, 0, 0); \
        ACC1 = __builtin_amdgcn_mfma_f32_32x32x16_bf16(fr[4 + k_], B[((KS0) + k_) >> 1][((KS0) + k_) & 1], ACC1, 0, 0, 0); } \
        __builtin_amdgcn_sched_barrier(0); } while (0)
#pragma unroll 1
        for (int n = 0; n < NCHUNK; ++n) {
            const char* buf = lds + (n & 1) * CH_BUF;
            {   const char* wp = wbase + (size_t)(n + 6 < NCHUNK ? n + 6 : NCHUNK - 1) * REC_BYTES;
                const char* wp1 = wp + 8192; const char* wp2 = wp + 16384;
                asm volatile("global_load_dword %0, %1, off\n\tglobal_load_dword %0, %2, off\n\tglobal_load_dword %0, %3, off" : "+v"(warm) : "v"(wp), "v"(wp1), "v"(wp2) : "memory"); }
            f32x16 un[2];
#pragma unroll
            for (int mt = 0; mt < 2; ++mt)
#pragma unroll
                for (int r = 0; r < 16; ++r) un[mt][r] = bf2f(*(const bf16_t*)(lds + CH_U + (32 * mt + crow32(r, hi)) * 264 + (32 * sl + r32) * 2));
            const float dl = *(const float*)(lds + CH_DL + (n & 1) * 4);
            CH_BAR();
            bf16x8 Sb[4][2], Vb[2][2], fr[8];
#pragma unroll
            for (int kt = 0; kt < 4; ++kt) { Sb[kt][0] = acc_frag(S[kt], 0); Sb[kt][1] = acc_frag(S[kt], 1); }
            {   f32x16 X0 = {}, X1 = {};
                if (gdn) {
                    CH_FR8(buf + CH_W, 264, r32, 32 + r32, 0); CH_MM8(X0, X1, Sb, 0);
                    CH_FR8(buf + CH_W, 264, r32, 32 + r32, 4); CH_MM8(X0, X1, Sb, 4);
                }
                const f32x16 v0 = un[0] - X0, v1 = un[1] - X1;
                Vb[0][0] = acc_frag(v0, 0); Vb[0][1] = acc_frag(v0, 1); Vb[1][0] = acc_frag(v1, 0); Vb[1][1] = acc_frag(v1, 1);
            }
            {   f32x16 O0 = {}, O1 = {};
                CH_FR8(buf + CH_Q, 264, r32, 32 + r32, 0); CH_MM8(O0, O1, Sb, 0);
                CH_FR8(buf + CH_Q, 264, r32, 32 + r32, 4); CH_MM8(O0, O1, Sb, 4);
                CH_FR8(buf + CH_A, 136, r32, 32 + r32, 0); CH_MM8(O0, O1, Vb, 0);
#pragma unroll
                for (int r = 0; r < 16; ++r) { const int row = scan_row(dir, n * 64 + crow32(r, hi)); outp[(size_t)row * 512 + 32 * sl + r32] = O0[r]; }
#pragma unroll
                for (int r = 0; r < 16; ++r) { const int row = scan_row(dir, n * 64 + 32 + crow32(r, hi)); outp[(size_t)row * 512 + 32 * sl + r32] = O1[r]; }
            }
            S[0] *= dl; S[1] *= dl; S[2] *= dl; S[3] *= dl;
            CH_FR8(buf + CH_K, 136, r32, 32 + r32, 0); CH_MM8(S[0], S[1], Vb, 0);
            CH_FR8(buf + CH_K, 136, 64 + r32, 96 + r32, 0); CH_MM8(S[2], S[3], Vb, 0);
            CH_BAR();
        }
#undef CH_FR8
#undef CH_MM8
        asm volatile("s_waitcnt vmcnt(0)" : "+v"(warm) :: "memory");
    }
    __syncthreads();
}
__device__ __forceinline__ void phase_chain(const Params& p, char* lds) {
#pragma unroll 1
    for (int c = blockIdx.x; c < 16; c += gridDim.x) chain_unit(p, c, lds);
}
__device__ __forceinline__ void fft_fwd(cpx* Z, int tid) {
#pragma unroll 1
    for (int pass = 0; pass < 3; ++pass) { const int lm = pass == 0 ? 10 : (pass == 1 ? 6 : 2);

#pragma unroll 1
        for (int gi = 0; gi < 2; ++gi) fft_pass16<false>(Z, tid + gi * 512, lm);
        __syncthreads(); }
#pragma unroll 1
    for (int it = 0; it < 8; ++it) fft_pass4<false>(Z, tid + it * 512);
    __syncthreads();
}
__device__ __forceinline__ void fft_inv(cpx* Z, int tid) {
#pragma unroll 1
    for (int it = 0; it < 8; ++it) fft_pass4<true>(Z, tid + it * 512);
    __syncthreads();
#pragma unroll 1
    for (int pass = 0; pass < 3; ++pass) { const int lm = pass == 0 ? 2 : (pass == 1 ? 6 : 10);

#pragma unroll 1
        for (int gi = 0; gi < 2; ++gi) fft_pass16<true>(Z, tid + gi * 512, lm);
        __syncthreads(); }
}
constexpr size_t HY_SCR_FLOATS = 2 * 2 * (size_t)FFT_N + (size_t)SEQ;
__device__ __forceinline__ void hyena_latent_unit(const Params& p, int layer, int c, char* lds) {
    cpx* Z = (cpx*)lds; const int tid = otid(), lane = tid & 63;
    float* scr = p.hys() + (size_t)blockIdx.x * HY_SCR_FLOATS;
    cpx* Zh1 = (cpx*)scr; cpx* Zh2 = Zh1 + FFT_N; float* z1s = (float*)(Zh2 + FFT_N);
    const float* vs = p.hyT() + (size_t)c * SEQ; const float* x1s = p.hyT() + (size_t)(512 + c) * SEQ; const float* x2s = p.hyT() + (size_t)(1024 + c) * SEQ;
#pragma unroll 1
    for (int f = 0; f < 2; ++f) {
        const size_t ch = (size_t)layer * 1024 + f * 512 + c;
        const float* hsrc = p.hfilt() + ch * SEQ;
        const f32x4 ps = *(const f32x4*)(p.hsum() + ch * 256 + lane * 4);
        const float tot = wave_sum((ps[0] + ps[1]) + (ps[2] + ps[3]));
        const float scale = (1.0f / (tot + EPS)) * (1.0f / (float)FFT_N);
        {   f32x2 hv[16];
#pragma unroll
            for (int it = 0; it < 16; ++it) hv[it] = *(const f32x2*)(hsrc + 2 * (tid + it * 512));
#pragma unroll
            for (int it = 0; it < 16; ++it) { const int j = tid + it * 512; Z[ZP(j)] = cpx{hv[it][0] * scale, hv[it][1] * scale}; Z[ZP(j + 8192)] = cpx{0.f, 0.f}; } }
        __syncthreads();
        fft_fwd(Z, tid);
        cpx* Zh = f ? Zh2 : Zh1;
#pragma unroll 4
        for (int it = 0; it < 32; ++it) { const int q = tid + it * 512; Zh[q] = Z[ZP(q)]; }
        __syncthreads();
    }
    const float b0 = p.in[I_HBIAS][(size_t)layer * 1024 + c], b1 = p.in[I_HBIAS][(size_t)layer * 1024 + 512 + c];
    {   f32x2 hv[16];
#pragma unroll
        for (int it = 0; it < 16; ++it) hv[it] = *(const f32x2*)(vs + 2 * (tid + it * 512));
#pragma unroll
        for (int it = 0; it < 16; ++it) { const int j = tid + it * 512; Z[ZP(j)] = cpx{hv[it][0], hv[it][1]}; Z[ZP(j + 8192)] = cpx{0.f, 0.f}; } }
    __syncthreads();
    fft_fwd(Z, tid);
    {   cpx ha[16], hb[16];
#pragma unroll
        for (int it = 0; it < 16; ++it) { int pp, pq; fft_pw_idx(tid + it * 512, pp, pq); ha[it] = Zh1[pp]; hb[it] = Zh1[pq]; }
#pragma unroll
        for (int it = 0; it < 16; ++it) fft_pointwise_pre(Z, ha[it], hb[it], tid + it * 512); }
    __syncthreads();
    fft_inv(Z, tid);
#pragma unroll 1
    for (int half = 0; half < 2; ++half) {
        f32x2 va[8], xa[8];
#pragma unroll
        for (int it = 0; it < 8; ++it) { const int j = half * 4096 + tid + it * 512; va[it] = *(const f32x2*)(vs + 2 * j); xa[it] = *(const f32x2*)(x1s + 2 * j); }
#pragma unroll
        for (int it = 0; it < 8; ++it) { const int j = half * 4096 + tid + it * 512;
            const cpx y = Z[ZP(4096 + j)];
            const f32x2 v2 = va[it], xx = xa[it];
            const f32x2 z = {xx[0] * (y.x + b0 * v2[0]), xx[1] * (y.y + b0 * v2[1])};
            *(f32x2*)(z1s + 2 * j) = z; Z[ZP(j)] = cpx{z[0], z[1]};
            if (half) Z[ZP(4096 + j)] = cpx{0.f, 0.f};
            else Z[ZP(12288 + j)] = cpx{0.f, 0.f}; }
        __syncthreads();
    }
    __syncthreads();
    fft_fwd(Z, tid);
    {   cpx ha[16], hb[16];
#pragma unroll
        for (int it = 0; it < 16; ++it) { int pp, pq; fft_pw_idx(tid + it * 512, pp, pq); ha[it] = Zh2[pp]; hb[it] = Zh2[pq]; }
#pragma unroll
        for (int it = 0; it < 16; ++it) fft_pointwise_pre(Z, ha[it], hb[it], tid + it * 512); }
    __syncthreads();
    fft_inv(Z, tid);
    f32x2 za[16], xb[16];
#pragma unroll
    for (int it = 0; it < 16; ++it) { const int j = tid + it * 512; za[it] = *(const f32x2*)(z1s + 2 * j); xb[it] = *(const f32x2*)(x2s + 2 * j); }
#pragma unroll
    for (int it = 0; it < 16; ++it) { const int j = tid + it * 512; const cpx y = Z[ZP(4096 + j)];
        const f32x2 z = za[it], x2 = xb[it];
        *(unsigned*)(p.hyO() + (size_t)c * SEQ + 2 * j) = cvt_pk_bf16(x2[0] * (y.x + b1 * z[0]), x2[1] * (y.y + b1 * z[1])); }
    __syncthreads();
}
__device__ __forceinline__ void hyena_ctx_unit(const Params& p, int c, float* lds) {
    const int tid = otid();
    float* vv = lds; float* x1 = vv + 256; float* x2 = x1 + 256; float* h1 = x2 + 256; float* h2 = h1 + 256; float* z1 = h2 + 256;
    const float* cw = p.in[I_HCONV];
    if (tid < 256) { const int t = tid;
#pragma unroll
        for (int part = 0; part < 3; ++part) {
            const float w0 = cw[part * 512 + c], w1 = cw[1536 + part * 512 + c], w2 = cw[3072 + part * 512 + c];
            const bf16_t* col = p.Pp() + PC_HY + part * 512 + c;
            const float x0 = bf2f(col[(size_t)t * NP]), xm = t > 0 ? bf2f(col[(size_t)(t - 1) * NP]) : 0.f, xn = t < LC - 1 ? bf2f(col[(size_t)(t + 1) * NP]) : 0.f;
            (part == 0 ? vv : (part == 1 ? x1 : x2))[t] = w0 * xm + w1 * x0 + w2 * xn;
        }
        const float s1 = (p.hsc()[c * 4] + p.hsc()[c * 4 + 1]) + (p.hsc()[c * 4 + 2] + p.hsc()[c * 4 + 3]);
        const float s2 = (p.hsc()[(512 + c) * 4] + p.hsc()[(512 + c) * 4 + 1]) + (p.hsc()[(512 + c) * 4 + 2] + p.hsc()[(512 + c) * 4 + 3]);
        h1[t] = p.hfc()[(size_t)c * 256 + t] / (s1 + EPS); h2[t] = p.hfc()[(size_t)(512 + c) * 256 + t] / (s2 + EPS);
    }
    __syncthreads();
    const float b0 = p.in[I_HBIAS][c], b1 = p.in[I_HBIAS][512 + c];
    if (tid < 256) { const int t = tid; float y = 0.f;
        for (int s = 0; s < 256; ++s) { const int m = t - s + 128; if (m >= 0 && m < 256) y += vv[s] * h1[m]; }
        z1[t] = x1[t] * (y + b0 * vv[t]); }
    __syncthreads();
    if (tid < 256) { const int t = tid; float y = 0.f;
        for (int s = 0; s < 256; ++s) { const int m = t - s + 128; if (m >= 0 && m < 256) y += z1[s] * h2[m]; }
        p.ocat()[(size_t)t * D_ + 1024 + c] = f2bf(x2[t] * (y + b1 * z1[t])); }
    __syncthreads();
}
__device__ __forceinline__ void phase_hyena(const Params& p, int layer, char* lds) {
    const int nunits = 512 + (layer == 0 ? 512 : 0);
    for (int u = blockIdx.x; u < nunits; u += gridDim.x) {
        if (u < 512) hyena_latent_unit(p, layer, u, lds); else hyena_ctx_unit(p, u - 512, (float*)lds);
    }
}

__device__ __forceinline__ void phase_gather(const Params& p) {
    const int tid = otid();
    int base[NEXP], cn[NEXP]; { int acc = 0;
#pragma unroll
        for (int e = 0; e < NEXP; ++e) { base[e] = acc * 256; cn[e] = (int)p.cnt()[e]; acc += (cn[e] + 255) >> 8; } }
    for (int i = blockIdx.x * 512 + tid; i < 2 * SEQ; i += gridDim.x * 512) {
        const int t = i >> 1, e = p.tok_e()[i], pos = p.tok_p()[i];
        int b = 0;
#pragma unroll
        for (int k = 0; k < NEXP; ++k) b = (e == k) ? base[k] : b;
        const int row = b + pos;
        p.gidx()[row] = LC + t; p.tok_r()[i] = row; p.hsg()[row] = p.hs()[LC + t];
    }
    for (int i = blockIdx.x * 512 + tid; i < (MAXROWS_MOE / 256) * 8; i += gridDim.x * 512) p.tailidx()[i] = -1;
    for (int i = blockIdx.x * 512 + tid; i < MAXROWS_MOE; i += gridDim.x * 512) ((unsigned*)p.acts())[i] = 0u;
    if (blockIdx.x < NEXP && tid < 256) {
        int b = 0, cc = 0;
#pragma unroll
        for (int k = 0; k < NEXP; ++k) if ((int)blockIdx.x == k) { b = base[k]; cc = cn[k]; }
        const int r = cc + tid; if (r < ((cc + 255) & ~255)) { p.gidx()[b + r] = LC; p.hsg()[b + r] = 0.f; }
    }
}
__device__ __forceinline__ void phase_final(const Params& p) {
    const int tid = otid(), wid = tid >> 6, lane = tid & 63;
    const float* g2 = p.modv() + ((size_t)1 * 2 + 0) * 6 * D_ + 5 * D_;
    const float* fw = p.in[I_FNW];
#ifdef PROBE
    const float prc = ((const float*)(p.cnt() + 32))[0], pre = ((const float*)(p.cnt() + 32))[1];
#endif
    int tn = blockIdx.x * 8 + wid;
    int r0n = p.tok_r()[tn * 2], r1n = p.tok_r()[tn * 2 + 1]; float w0n = p.tok_w()[tn * 2], w1n = p.tok_w()[tn * 2 + 1];
    for (int t = tn; t < SEQ; t += gridDim.x * 8) {
        const int r0 = r0n, r1 = r1n; const float w0 = w0n, w1 = w1n;
        tn = t + gridDim.x * 8; if (tn < SEQ) { r0n = p.tok_r()[tn * 2]; r1n = p.tok_r()[tn * 2 + 1]; w0n = p.tok_w()[tn * 2]; w1n = p.tok_w()[tn * 2 + 1]; }
        const float* xr = p.xcur() + (size_t)(LC + t) * D_;
        f32x4 xv[8]; float ss = 0.f; u32x2 ya[8], yc[8];
#pragma unroll
        for (int i = 0; i < 8; ++i) { const int col = (i * 64 + lane) * 4; ya[i] = *(const u32x2*)(p.yb() + (size_t)r0 * D_ + col); yc[i] = *(const u32x2*)(p.yb() + (size_t)r1 * D_ + col); xv[i] = *(const f32x4*)(xr + col); }
#pragma unroll
        for (int i = 0; i < 8; ++i) { const int col = (i * 64 + lane) * 4;
            const f32x4 y0 = (f32x4){bflo(ya[i].x), bfhi(ya[i].x), bflo(ya[i].y), bfhi(ya[i].y)}, y1 = (f32x4){bflo(yc[i].x), bfhi(yc[i].x), bflo(yc[i].y), bfhi(yc[i].y)};
            const f32x4 y = y0 * w0 + y1 * w1;
            xv[i] = xv[i] + *(const f32x4*)(g2 + col) * y;
            ss += xv[i][0] * xv[i][0] + xv[i][1] * xv[i][1] + xv[i][2] * xv[i][2] + xv[i][3] * xv[i][3]; }
        ss = wave_sum(ss);
        const float rstd = rsqrtf(ss * (1.0f / D_) + EPS);
        f32x4 fwv[8];
#pragma unroll
        for (int i = 0; i < 8; ++i) fwv[i] = *(const f32x4*)(fw + (i * 64 + lane) * 4);
#pragma unroll
        for (int i = 0; i < 8; ++i) { const int col = (i * 64 + lane) * 4; const f32x4 ov = (xv[i] * rstd) * fwv[i];
            *(f32x4*)(p.out + (size_t)t * D_ + col) = ov; }
    }
}

__device__ __forceinline__ void hyprep_unit(const Params& p, int layer, int u, float* tile  ) {
    const int tid = otid(); const int rb = u / 24, cg = u % 24, t0 = rb * 128, ch0 = cg * 64;
    const float* cw = p.in[I_HCONV] + (size_t)layer * 3 * 1536 + ch0;
    {   const int c8 = (tid & 7) * 8; float w0[8], w1[8], w2[8];
#pragma unroll
        for (int e = 0; e < 8; ++e) { w0[e] = cw[c8 + e]; w1[e] = cw[1536 + c8 + e]; w2[e] = cw[3072 + c8 + e]; }
        u32x4 raw[2][3];
#pragma unroll
        for (int i = 0; i < 2; ++i) { const int t = t0 + (tid >> 3) + 64 * i;
            const bf16_t* P0 = p.Pp() + (size_t)(LC + t) * NP + PC_HY + ch0 + c8;
            raw[i][1] = *(const u32x4*)P0; raw[i][0] = *(const u32x4*)(t > 0 ? P0 - NP : P0); raw[i][2] = *(const u32x4*)(t < SEQ - 1 ? P0 + NP : P0); }
#pragma unroll
        for (int i = 0; i < 2; ++i) { const int tl = (tid >> 3) + 64 * i, t = t0 + tl;
            float x0[8], xm[8], xn[8];
            unpack8(raw[i][1], x0); unpack8(raw[i][0], xm); unpack8(raw[i][2], xn);
            const float fm = t > 0 ? 1.f : 0.f, fn = t < SEQ - 1 ? 1.f : 0.f;
#pragma unroll
            for (int e = 0; e < 8; ++e) tile[tl * 65 + c8 + e] = w0[e] * (xm[e] * fm) + w1[e] * x0[e] + w2[e] * (xn[e] * fn); }
    }
    __syncthreads();
    {   const int cl = tid >> 3, tq = (tid & 7) * 16; float* dst = p.hyT() + (size_t)(ch0 + cl) * SEQ + t0 + tq;
#pragma unroll
        for (int k = 0; k < 4; ++k) { f32x4 v;
#pragma unroll
            for (int e = 0; e < 4; ++e) v[e] = tile[(tq + 4 * k + e) * 65 + cl];
            *(f32x4*)(dst + 4 * k) = v; }
    }
    __syncthreads();
}
__device__ __forceinline__ void hyout_unit(const Params& p, int u, float* tile  ) {
    const int tid = otid(); const int rb = u >> 3, cg = u & 7, t0 = rb * 128, c0 = cg * 64;
    {   const int cl = tid >> 3, tq = (tid & 7) * 16; const bf16_t* src = p.hyO() + (size_t)(c0 + cl) * SEQ + t0 + tq;
        float f[8];
        unpack8(*(const u32x4*)src, f);
#pragma unroll
        for (int e = 0; e < 8; ++e) tile[cl * 129 + tq + e] = f[e];
        unpack8(*(const u32x4*)(src + 8), f);
#pragma unroll
        for (int e = 0; e < 8; ++e) tile[cl * 129 + tq + 8 + e] = f[e];
    }
    __syncthreads();
    {   const int c8 = (tid & 7) * 8;
#pragma unroll
        for (int i = 0; i < 2; ++i) { const int tl = (tid >> 3) + 64 * i; float f[8];
#pragma unroll
            for (int e = 0; e < 8; ++e) f[e] = tile[(c8 + e) * 129 + tl];
            *(u32x4*)(p.ocat() + (size_t)(LC + t0 + tl) * D_ + 1024 + c0 + c8) = pack8(f); }
    }
    __syncthreads();
}

__device__ __forceinline__ void phase_quant(const Params& p, const bf16_t* act, signed char* actq, float* rs, int nrows) {
    const int tid = otid(), wid = tid >> 6, lane = tid & 63;
    for (int r = blockIdx.x * 8 + wid; r < nrows; r += gridDim.x * 8) {
        const float am = fmaxf(__uint_as_float(((const unsigned*)rs)[r]), 1e-20f), inv = 127.f / am;
        const bf16_t* src = act + (size_t)r * DFF; signed char* dst = actq + (size_t)r * DFF;
        u32x4 raw[11];
#pragma unroll
        for (int it = 0; it < 11; ++it) raw[it] = *(const u32x4*)(src + (it * 64 + lane) * 8);
#pragma unroll
        for (int it = 0; it < 11; ++it) { float f[8]; unpack8(raw[it], f);
            unsigned w0 = 0u, w1 = 0u;
#pragma unroll
            for (int e = 0; e < 4; ++e) { w0 |= (unsigned)((int)rintf(f[e] * inv) & 255) << (8 * e); w1 |= (unsigned)((int)rintf(f[4 + e] * inv) & 255) << (8 * e); }
            *(u32x2*)(dst + (it * 64 + lane) * 8) = (u32x2){w0, w1}; }
        __builtin_amdgcn_wave_barrier();
        if (lane == 0) rs[r] = am * (1.0f / 127.f);
    }
}
#define XB_TMO      128
#define XB_XCNT(j)  (256  + 64 * (j))
#define XB_XSUB(j)  (1280 + 64 * (j))
#define XB_XGEN(j)  (2304 + 64 * (j))
#define XB_TOP      3328
#define XB_TOPGEN   3392
#define XCD_BAR_WORDS 3456
#define XB_SPIN_CAP (1u << 26)

__device__ __forceinline__ unsigned xb_ld(unsigned* p)              { return __hip_atomic_load(p, __ATOMIC_RELAXED, __HIP_MEMORY_SCOPE_AGENT); }
__device__ __forceinline__ unsigned xb_add(unsigned* p, unsigned v) { return __hip_atomic_fetch_add(p, v, __ATOMIC_RELAXED, __HIP_MEMORY_SCOPE_AGENT); }
__device__ __forceinline__ unsigned xb_xcc_id() { return (unsigned)__builtin_amdgcn_s_getreg((3 << 11) | 20) & 0xFu; }
#define XB_SPIN(cond, bar) do { unsigned _sp = 0; while (cond) { __builtin_amdgcn_s_sleep(1); \
    if ((++_sp & 255u) == 0u) { if (xb_ld(&(bar)[XB_TMO])) break; if (_sp > XB_SPIN_CAP) { atomicAdd(&(bar)[XB_TMO], 1u); break; } } } } while (0)

struct XcdBarrier {
    unsigned* bar; unsigned x;
    volatile LAS unsigned* st;
};

__device__ __forceinline__ XcdBarrier xcd_barrier_post(unsigned* bar, volatile LAS unsigned* st) {
    XcdBarrier b; b.bar = bar; b.x = xb_xcc_id(); b.st = st;
    if (threadIdx.x == 0) (void)xb_add(&bar[XB_XCNT(b.x)], 1u);
    return b;
}
__device__ __forceinline__ void xcd_barrier_complete(unsigned* bar, unsigned x, unsigned& nloc, unsigned& nx) {
    const unsigned G = gridDim.x * gridDim.y * gridDim.z;
    unsigned sum, cnt, mine, sp = 0u;
    for (;;) {
        sum = 0u; cnt = 0u; mine = 0u;
#pragma unroll
        for (unsigned j = 0; j < 16; ++j) { const unsigned c = xb_ld(&bar[XB_XCNT(j)]); sum += c; cnt += (c > 0u) ? 1u : 0u; mine = (j == x) ? c : mine; }
        if (sum == G) break;
        __builtin_amdgcn_s_sleep(1);
        if ((++sp & 255u) == 0u) { if (xb_ld(&bar[XB_TMO])) break; if (sp > XB_SPIN_CAP) { atomicAdd(&bar[XB_TMO], 1u); break; } }
    }
    nloc = mine > 0u ? mine : 1u; nx = cnt > 0u ? cnt : 1u;
}

__device__ __forceinline__ void xcd_barrier(const XcdBarrier& b) {
    asm volatile("s_waitcnt vmcnt(0)" ::: "memory");
    __syncthreads();
    if (threadIdx.x == 0) {
        unsigned* bar = b.bar;
        __builtin_amdgcn_s_waitcnt(0);
        unsigned nloc = b.st[0], nx = b.st[1];
        if (nloc == 0u) { xcd_barrier_complete(bar, b.x, nloc, nx); b.st[0] = nloc; b.st[1] = nx; }
        const unsigned old = xb_add(&bar[XB_XSUB(b.x)], 1u);
        const unsigned gen = old / nloc;
        if (old + 1u == (gen + 1u) * nloc) {
            __builtin_amdgcn_fence(__ATOMIC_RELEASE, "agent");
            asm volatile("s_waitcnt vmcnt(0)" ::: "memory");
            const unsigned og = xb_add(&bar[XB_TOP], 1u);
            const unsigned tg = og / nx;
            if (og + 1u == (tg + 1u) * nx) xb_add(&bar[XB_TOPGEN], 1u);
            else XB_SPIN(xb_ld(&bar[XB_TOPGEN]) == tg, bar);
            __builtin_amdgcn_fence(__ATOMIC_ACQUIRE, "agent");
            xb_add(&bar[XB_XGEN(b.x)], 1u);
            asm volatile("s_waitcnt vmcnt(0)" ::: "memory");
        } else {
            XB_SPIN(xb_ld(&bar[XB_XGEN(b.x)]) == gen, bar);
            __builtin_amdgcn_fence(__ATOMIC_ACQUIRE, "agent");
            asm volatile("s_waitcnt vmcnt(0)" ::: "memory");
        }
    }
    __syncthreads();
}

enum { PH_PRO, PH_NORM1, PH_GIN, PH_PREP, PH_GMLA, PH_ATT, PH_REC, PH_CPREP, PH_CHAIN, PH_MIX3, PH_HY, PH_MIXOUT, PH_GOUT, PH_NORM2, PH_F1, PH_Q1, PH_F2, PH_GATHER, PH_MG1, PH_Q2, PH_MG2, PH_FINAL };
constexpr int LDS_BYTES = 147456;
constexpr int XBW_OFF = LDS_BYTES - 16;

template <int PH> __device__ __forceinline__ void run_phase(const Params& p, int layer, unsigned char* shm) {
    LAS unsigned char* lds3 = (LAS unsigned char*)shm;
    const int G = gridDim.x, c = blockIdx.x;
    if constexpr (PH == PH_PRO) phase_prologue(p, (float*)shm);
    else if constexpr (PH == PH_NORM1) {
        phase_norm(p, layer, 1, 0, shm);
    }
    else if constexpr (PH == PH_GIN) {
        pg8::Gemm g{p.hbuf(), p.wb_in() + (size_t)layer * NP * (D_ / 2), D_ / 2, D_ / 2, D_ / 2, 0, nullptr};
        pg8::StaticOrder S; S.init(MT, NP, G, c, D_ / 2);
        pg8::EpiStoreBf16 E{p.Pp(), NP, nullptr, 1 << 30, nullptr, nullptr, p.hs(), p.wam() + WAM_IN + layer * NP};
        pg8::gemm_phase<pg8::EpiStoreBf16, pg8::StaticOrder, false, true>(lds3, g, S, E);
    }
    else if constexpr (PH == PH_PREP) phase_prep(p, layer);
    else if constexpr (PH == PH_GMLA) {
        pg8::Gemm g{p.Pp() + PC_CQ, p.wb_mla() + (size_t)layer * MLAN * MLAK, MLAK, NP, MLAK, 0, nullptr};
        pg8::StaticOrder S; S.init(MT, MLAN, G, c, MLAK);
        pg8::EpiStoreBf16 E{p.qkvup(), MLAN, p.mrs(), 3, nullptr, nullptr, nullptr, nullptr};
        pg8::gemm_phase(lds3, g, S, E);
    }
    else if constexpr (PH == PH_ATT) phase_attn(p, layer, (char*)shm);
    else if constexpr (PH == PH_REC) phase_rec_naive(p, layer, (float*)shm);
    else if constexpr (PH == PH_CPREP) {
        phase_chunkprep(p, layer, (char*)shm);
#pragma unroll 1
        for (int u = c; u < 128 * 24; u += G) hyprep_unit(p, layer, u, (float*)shm);
    }
    else if constexpr (PH == PH_CHAIN) phase_chain(p, (char*)shm);
    else if constexpr (PH == PH_MIX3) {
        const int nctx = layer == 0 ? 4 : 0, nq = 64 + nctx + 512 + (layer == 0 ? 512 : 0);
        unsigned* qctr = p.cnt() + 16 + layer; volatile LAS unsigned* qw = (volatile LAS unsigned*)(LAS unsigned char*)(shm + XBW_OFF - 32);
        int code = c < 16 ? c : (c < 256 ? 16 + c : -1);
#pragma unroll 1
        for (;;) {
            if (code < 0) {
                __syncthreads();
                if (otid() == 0) qw[0] = atomicAdd(qctr, 1u);
                __syncthreads();
                const int q = (int)qw[0];
                if (q >= nq) break;
                code = q < 64 ? 1300 + q : (q < 64 + nctx ? 16 + 256 + (q - 64) : (q < 64 + nctx + 512 ? 276 + (q - 64 - nctx) : 788 + (q - 64 - nctx - 512)));
            }
            if (code < 16) chain_unit(p, code, (char*)shm);
            else if (code < 276 || code >= 1300) { const bool spl = code >= 1300; attn_unit(p, spl ? (code - 1300) >> 2 : code - 16, spl ? (code - 1300) & 3 : -1, (char*)shm); }
            else if (code < 788) hyena_latent_unit(p, layer, code - 276, (char*)shm);
            else hyena_ctx_unit(p, code - 788, (float*)shm);
            code = -1;
        }
    }
    else if constexpr (PH == PH_HY) phase_hyena(p, layer, (char*)shm);
    else if constexpr (PH == PH_MIXOUT) {
        phase_mixout(p, layer);
        __syncthreads();
#pragma unroll 1
        for (int u = c; u < 128 * 8; u += G) hyout_unit(p, u, (float*)shm);
    }
    else if constexpr (PH == PH_GOUT) {
        const float* mv = p.modv() + (size_t)layer * 2 * 6 * D_;
        if (layer == 0) {
            pg8::Gemm g{p.ocat(), p.wb_out(), D_, D_, D_, 0, nullptr};
            pg8::CtxSplitOrder S; S.init(G, c, D_, 4);
            pg8::EpiResGate E{p.xcur(), p.in[I_CTX], p.in[I_X], mv + 6 * D_ + 2 * D_, mv + 2 * D_, 0, p.partG(), nullptr, nullptr};
            pg8::gemm_phase(lds3, g, S, E);
        } else {
            pg8::Gemm g{p.ocat() + (size_t)LC * D_, p.wb_out() + (size_t)D_ * D_, D_, D_, D_, 0, nullptr};
            pg8::StaticOrder S; S.init(SEQ, D_, G, c, D_);
            pg8::EpiResGate E{p.xcur(), p.xcur(), p.xcur() + (size_t)LC * D_, mv + 6 * D_ + 2 * D_, mv + 2 * D_, LC, nullptr, nullptr, nullptr};
            pg8::gemm_phase(lds3, g, S, E);
        }
    }
    else if constexpr (PH == PH_NORM2) {
        phase_norm(p, layer, 2, layer == 0 ? 0 : LC, shm);
    }
    else if constexpr (PH == PH_F1) {
        pg8::Gemm g{p.hbuf(), p.wb_f13(), D_ / 2, D_ / 2, D_ / 2, 0, nullptr};
        pg8::StaticOrder S; S.init(MT, 2 * DFF, G, c, D_ / 2);
        pg8::EpiSwiGLU E{p.act(), DFF, p.hs(), p.wam() + WAM_F13, (unsigned*)p.acts()};
        pg8::gemm_phase<pg8::EpiSwiGLU, pg8::StaticOrder, false, true>(lds3, g, S, E);
    }
    else if constexpr (PH == PH_Q1) phase_quant(p, p.act(), p.actq(), p.acts(), MT);
    else if constexpr (PH == PH_F2) {
        const float* mv = p.modv();
        pg8::Gemm g{(const bf16_t*)p.actq(), p.wb_f2(), DFF / 2, DFF / 2, DFF / 2, 0, nullptr};
        pg8::CtxSplitOrder S; S.init(G, c, DFF / 2, 11);
        pg8::EpiResGate E{p.xcur(), p.xcur(), p.xcur() + (size_t)LC * D_, mv + 6 * D_ + 5 * D_, mv + 5 * D_, 0, p.partF(), p.acts(), p.wam() + WAM_F2};
        pg8::gemm_phase<pg8::EpiResGate, pg8::CtxSplitOrder, false, true>(lds3, g, S, E);
    }
    else if constexpr (PH == PH_GATHER) phase_gather(p);
    else if constexpr (PH == PH_MG1) {
        pg8::Gemm g{p.hbuf(), p.wb_m13(), D_ / 2, D_ / 2, D_ / 2, (size_t)2 * DFF * (D_ / 2), p.gidx()};
        pg8::GroupedOrder S; S.init(p.cnt(), 2 * DFF, G, c, D_ / 2);
        pg8::EpiSwiGLU E{p.act_moe(), DFF, p.hsg(), p.wam() + WAM_M13, (unsigned*)p.acts()};
        pg8::gemm_phase<pg8::EpiSwiGLU, pg8::GroupedOrder, true, true>(lds3, g, S, E);
    }
    else if constexpr (PH == PH_Q2) { int np = 0;
#pragma unroll
        for (int e = 0; e < NEXP; ++e) np += ((int)p.cnt()[e] + 255) >> 8;
        phase_quant(p, p.act_moe(), p.actq_moe(), p.acts(), np * 256); }
    else if constexpr (PH == PH_MG2) {
        pg8::Gemm g{(const bf16_t*)p.actq_moe(), p.wb_m2(), DFF / 2, DFF / 2, DFF / 2, (size_t)D_ * (DFF / 2), nullptr};
        pg8::GroupedOrder S; S.init(p.cnt(), D_, G, c, DFF / 2, false);
        pg8::EpiStoreBf16 E{p.yb(), D_, nullptr, 1 << 30, p.ypart(), p.tailidx(), p.acts(), p.wam() + WAM_M2};
        pg8::gemm_phase<pg8::EpiStoreBf16, pg8::GroupedOrder, false, true>(lds3, g, S, E);
    }
    else if constexpr (PH == PH_FINAL) phase_final(p);
}

#ifndef MEGA
#define MEGA 1
#endif
template <int PH> __global__ __launch_bounds__(512, 2) void k_ph(Params p, int layer) {
    extern __shared__ __attribute__((aligned(16))) unsigned char shm[];
    run_phase<PH>(p, layer, shm);
}
#ifdef PROBE
#ifndef PROBE_A0
#define PROBE_A0 0
#define PROBE_A1 1
#define PROBE_B0 0
#define PROBE_B1 1
#endif
#define STAMP(k) do { if (blockIdx.x == 0 && otid() == 0) tsl[k] = (unsigned long long)wall_clock64(); } while (0)
#else
#define STAMP(k) do {} while (0)
#endif
__global__ __launch_bounds__(512, 2) void k_mega(Params p) {
    extern __shared__ __attribute__((aligned(16))) unsigned char shm[];
    volatile LAS unsigned* xbw = (volatile LAS unsigned*)(LAS unsigned char*)(shm + XBW_OFF);
#ifdef PROBE
    volatile LAS unsigned long long* tsl = (volatile LAS unsigned long long*)(LAS unsigned char*)(shm + XBW_OFF - 512);
#endif
    if (otid() == 0) { xbw[0] = 0u; xbw[1] = 0u; xbw[2] = 0u; xbw[3] = 0u; }
    __syncthreads();
    STAMP(0);
    (void)xcd_barrier_post(p.bar(), xbw);
#define GBAR() do { XcdBarrier _b; _b.bar = p.bar(); _b.x = xb_xcc_id(); _b.st = xbw; xcd_barrier(_b); } while (0)
    run_phase<PH_PRO>(p, 0, shm); GBAR(); STAMP(1);
#pragma unroll 1
    for (int l = 0; l < 2; ++l) {
        const int sb = 2 + 16 * l; (void)sb;
        run_phase<PH_NORM1>(p, l, shm); GBAR(); STAMP(sb + 0);
        run_phase<PH_GIN>(p, l, shm); GBAR(); STAMP(sb + 1);
        run_phase<PH_PREP>(p, l, shm); GBAR(); STAMP(sb + 2);
        run_phase<PH_GMLA>(p, l, shm); __syncthreads();
        run_phase<PH_CPREP>(p, l, shm); GBAR(); STAMP(sb + 3);
        run_phase<PH_MIX3>(p, l, shm); GBAR(); STAMP(sb + 6);
        run_phase<PH_MIXOUT>(p, l, shm); GBAR(); STAMP(sb + 7);
        run_phase<PH_GOUT>(p, l, shm); GBAR(); STAMP(sb + 8);
        run_phase<PH_NORM2>(p, l, shm); GBAR(); STAMP(sb + 9);
        if (l == 0) {
            run_phase<PH_F1>(p, l, shm); GBAR(); STAMP(sb + 10);
            run_phase<PH_Q1>(p, l, shm); GBAR();
            run_phase<PH_F2>(p, l, shm); GBAR(); STAMP(sb + 11);
        } else {
            run_phase<PH_GATHER>(p, l, shm); GBAR(); STAMP(sb + 10);
            run_phase<PH_MG1>(p, l, shm); GBAR(); STAMP(sb + 11);
            run_phase<PH_Q2>(p, l, shm); GBAR();
            run_phase<PH_MG2>(p, l, shm); GBAR(); STAMP(sb + 12);
#ifdef PROBE
            if (blockIdx.x == 0 && otid() == 0) {
                float* pw = (float*)(p.cnt() + 32);
                pw[0] = (float)(tsl[PROBE_A1] - tsl[PROBE_A0]) * 1e-5f; pw[1] = (float)(tsl[PROBE_B1] - tsl[PROBE_B0]) * 0.0025f;
            }
            GBAR();
#endif
            run_phase<PH_FINAL>(p, l, shm);
        }
    }
}
template <int PH> static void launch_ph(const Params& p, int layer, int grid, hipStream_t st) {
    static bool attr = false;
    if (!attr) { (void)hipFuncSetAttribute((const void*)k_ph<PH>, hipFuncAttributeMaxDynamicSharedMemorySize, LDS_BYTES); attr = true; }
    hipLaunchKernelGGL((k_ph<PH>), dim3(grid), dim3(512), LDS_BYTES, st, p, layer);
}

static size_t align_up(size_t x) { return (x + 255) & ~(size_t)255; }
extern "C" void kernel_launch(void* const* d_in, const int* in_sizes, int n_in, void* d_out, int out_size, void* d_ws, size_t ws_size, hipStream_t stream) {
    Params p{};
    for (int i = 0; i < N_IN; ++i) p.in[i] = (const float*)d_in[i];
    p.out = (float*)d_out;
    static int GRID = 0;
    if (!GRID) {
#if MEGA
        int dev = 0, cus = 0, per_cu = 0;
        (void)hipGetDevice(&dev);
        (void)hipDeviceGetAttribute(&cus, hipDeviceAttributeMultiprocessorCount, dev);
        (void)hipFuncSetAttribute((const void*)k_mega, hipFuncAttributeMaxDynamicSharedMemorySize, LDS_BYTES);
        (void)hipOccupancyMaxActiveBlocksPerMultiprocessor(&per_cu, k_mega, 512, LDS_BYTES);
        if (per_cu < 1 || cus < 1) { fprintf(stderr, "kernel_launch: occupancy query failed (%d blocks/CU, %d CUs)\n", per_cu, cus); return; }
        GRID = cus < WS_GRID ? cus : WS_GRID;
#else
        GRID = 256;
#endif
    }
    p.ws = (char*)d_ws;
    if (ws_size < WSL.need) { fprintf(stderr, "kernel_launch: workspace too small: %zu < %zu\n", ws_size, (size_t)WSL.need); return; }
#if MEGA
    (void)hipMemsetAsync((char*)d_ws + WSL.bar, 0, WSL.modv - WSL.bar, stream);
    hipLaunchKernelGGL(k_mega, dim3(GRID), dim3(512), LDS_BYTES, stream, p);
#else
    launch_ph<PH_PRO>(p, 0, GRID, stream);
    for (int l = 0; l < 2; ++l) {
        launch_ph<PH_NORM1>(p, l, GRID, stream);
        launch_ph<PH_GIN>(p, l, GRID, stream);
        launch_ph<PH_PREP>(p, l, GRID, stream);
        launch_ph<PH_GMLA>(p, l, GRID, stream);
        launch_ph<PH_ATT>(p, l, GRID, stream);
        launch_ph<PH_CPREP>(p, l, GRID, stream);
        launch_ph<PH_CHAIN>(p, l, GRID, stream);
        launch_ph<PH_HY>(p, l, GRID, stream);
        launch_ph<PH_MIXOUT>(p, l, GRID, stream);
        launch_ph<PH_GOUT>(p, l, GRID, stream);
        launch_ph<PH_NORM2>(p, l, GRID, stream);
        if (l == 0) { launch_ph<PH_F1>(p, l, GRID, stream); launch_ph<PH_F2>(p, l, GRID, stream); }
        else { launch_ph<PH_GATHER>(p, l, GRID, stream); launch_ph<PH_MG1>(p, l, GRID, stream); launch_ph<PH_MG2>(p, l, GRID, stream); launch_ph<PH_FINAL>(p, l, GRID, stream); }
    }
#endif
}
```

```cpp
#include <hip/hip_runtime.h>
#include <stdint.h>
#include <math.h>
#include <stdio.h>

#define LAS __attribute__((address_space(3)))
typedef unsigned short bf16_t;
typedef short bf16x8 __attribute__((ext_vector_type(8)));
typedef short s16x4 __attribute__((ext_vector_type(4)));
typedef float f32x4 __attribute__((ext_vector_type(4)));
typedef float f32x2 __attribute__((ext_vector_type(2)));
typedef float f32x16 __attribute__((ext_vector_type(16)));
typedef unsigned u32x4 __attribute__((ext_vector_type(4)));
typedef unsigned u32x2 __attribute__((ext_vector_type(2)));

constexpr int D_ = 2048, SEQ = 16384, LC = 256, MT = 16640, NP = 6400, DFF = 5632, NEXP = 8, DIN = 6288;
constexpr int PC_GQKV = 0, PC_GZ = 1536, PC_HY = 2048, PC_RQKV = 3584, PC_RG = 5120, PC_CQ = 5632, PC_CKV = 6144, PC_KR = 6272, PC_A = 6336, PC_B = 6344;
constexpr int MLAK = 640, MLAN = 1792;
constexpr float EPS = 1e-6f;
constexpr int MAXROWS_MOE = 2 * SEQ + NEXP * 256;
enum { I_X, I_C, I_CTX, I_CCTX, I_N1W, I_N2W, I_MODW, I_MODB, I_WIN, I_WOUT, I_GCONV, I_GALOG, I_GDT, I_GNW, I_MQN, I_MUQ, I_MKVN, I_MUKV,
       I_HCONV, I_HW1, I_HB1, I_HW2, I_HB2, I_HW3, I_HB3, I_HW4, I_HFREQ, I_HBIAS, I_FW1, I_FW3, I_FW2, I_ROUTER, I_MW1, I_MW3, I_MW2, I_FNW, N_IN };

constexpr int NCHUNK_ = MT / 64;
constexpr size_t REC_BYTES_ = 73984, HY_SCR_FLOATS_ = 2 * 2 * (size_t)16384 + (size_t)SEQ;
constexpr int WS_GRID = 256;
constexpr int WAM_F13 = 0, WAM_F2 = 2 * DFF, WAM_M13 = WAM_F2 + D_, WAM_M2 = WAM_M13 + NEXP * 2 * DFF, WAM_IN = WAM_M2 + NEXP * D_, WAM_WORDS = WAM_IN + 2 * NP;
struct WsLayout { size_t bar, cnt, wam, hs, acts, hsg, modv, xcur, hbuf, tok_r, tok_w, tok_e, tok_p, gidx, tailidx, wq_m13, wq_m2, wb_in, wb_out, wb_mla, wb_f13, wb_f2, hfilt, hsum, hfc, hsc, Pp, gqkv, ggb, rqk, mrs, krr, qkvup, go, ro, recs, hys, ocat,
                  act, wb_m13, wb_m2, hg, yb, act_moe, hyT, hyO, partG, partF, attp, actq, actq_moe, need; };
constexpr size_t ws_al(size_t x) { return (x + 255) & ~(size_t)255; }
constexpr WsLayout make_ws_layout() {
    WsLayout L{}; size_t off = 0;
    L.bar = off; off = ws_al(off + 16384); L.cnt = off; off = ws_al(off + 256);
    L.wam = off; off = ws_al(off + (size_t)WAM_WORDS * 4);
    L.hs = off; off = ws_al(off + (size_t)MT * 4); L.acts = off; off = ws_al(off + (size_t)MAXROWS_MOE * 4); L.hsg = off; off = ws_al(off + (size_t)MAXROWS_MOE * 4);
    L.modv = off; off = ws_al(off + (size_t)2 * 2 * 6 * D_ * 4);
    L.xcur = off; off = ws_al(off + (size_t)MT * D_ * 4);
    L.hbuf = off; off = ws_al(off + (size_t)MT * D_);
    L.tok_r = off; off = ws_al(off + (size_t)2 * SEQ * 4); L.tok_w = off; off = ws_al(off + (size_t)2 * SEQ * 4); L.tok_e = off; off = ws_al(off + (size_t)2 * SEQ * 4); L.tok_p = off; off = ws_al(off + (size_t)2 * SEQ * 4); L.gidx = off; off = ws_al(off + (size_t)MAXROWS_MOE * 4); L.tailidx = off; off = ws_al(off + (size_t)(MAXROWS_MOE / 256) * 8 * 4);
    L.wq_m13 = off; off = ws_al(off + (size_t)NEXP * 2 * DFF * D_); L.wq_m2 = off; off = ws_al(off + (size_t)NEXP * D_ * DFF);
    const size_t region = off;
    L.wb_in = off; off = ws_al(off + (size_t)2 * NP * D_); L.wb_out = off; off = ws_al(off + (size_t)2 * D_ * D_ * 2); L.wb_mla = off; off = ws_al(off + (size_t)2 * MLAN * MLAK * 2);
    L.wb_f13 = off; off = ws_al(off + (size_t)2 * DFF * D_); L.wb_f2 = off; off = ws_al(off + (size_t)D_ * DFF);
    L.hfilt = off; off = ws_al(off + (size_t)2 * 1024 * SEQ * 4); L.hsum = off; off = ws_al(off + (size_t)2 * 1024 * 256 * 4); L.hfc = off; off = ws_al(off + (size_t)1024 * 256 * 4); L.hsc = off; off = ws_al(off + (size_t)1024 * 4 * 4);
    const size_t arena = off;
    L.Pp = off; off = ws_al(off + (size_t)MT * NP * 2);
    L.gqkv = off; off = ws_al(off + (size_t)MT * 1536 * 2); L.ggb = off; off = ws_al(off + (size_t)MT * 16 * 4); L.rqk = off; off = ws_al(off + (size_t)MT * 1024 * 2);
    L.mrs = off; off = ws_al(off + (size_t)MT * 2 * 4); L.krr = off; off = ws_al(off + (size_t)MT * 64 * 2); L.qkvup = off; off = ws_al(off + (size_t)MT * MLAN * 2);
    L.go = off; off = ws_al(off + (size_t)2 * MT * 512 * 4); L.ro = off; off = ws_al(off + (size_t)2 * MT * 512 * 4);
    L.recs = off; off = ws_al(off + (size_t)16 * NCHUNK_ * REC_BYTES_);
    L.hys = off; off = ws_al(off + (size_t)WS_GRID * HY_SCR_FLOATS_ * 4);
    L.hyT = off; off = ws_al(off + (size_t)1536 * SEQ * 4); L.hyO = off; off = ws_al(off + (size_t)512 * SEQ * 2);
    L.attp = off; off = ws_al(off + (size_t)64 * (256 * 128 + 512) * 4);
    L.ocat = L.gqkv;
    L.partG = L.recs; L.partF = L.recs + ws_al((size_t)4 * LC * D_ * 4);
    const size_t end1 = off;
    L.act = arena;
    L.actq = L.gqkv;
    off = region;
    L.wb_m13 = L.wq_m13; L.wb_m2 = L.wq_m2;
    L.hg = off; L.yb = off; off = ws_al(off + (size_t)MAXROWS_MOE * D_ * 2);
    L.act_moe = off; off = ws_al(off + (size_t)MAXROWS_MOE * DFF * 2);
    L.actq_moe = off; off = ws_al(off + (size_t)MAXROWS_MOE * DFF);
    const size_t end2 = off;
    L.need = end1 > end2 ? end1 : end2;
    return L;
}
constexpr WsLayout WSL = make_ws_layout();
struct Params {
    const float* in[N_IN];
    float* out;
    char* ws;
    __device__ __forceinline__ unsigned* bar() const { return (unsigned*)(ws + WSL.bar); }
    __device__ __forceinline__ unsigned* cnt() const { return (unsigned*)(ws + WSL.cnt); }
    __device__ __forceinline__ unsigned* wam() const { return (unsigned*)(ws + WSL.wam); }
    __device__ __forceinline__ float* hs() const { return (float*)(ws + WSL.hs); }
    __device__ __forceinline__ float* acts() const { return (float*)(ws + WSL.acts); }
    __device__ __forceinline__ float* hsg() const { return (float*)(ws + WSL.hsg); }
    __device__ __forceinline__ float* modv() const { return (float*)(ws + WSL.modv); }
    __device__ __forceinline__ bf16_t* wb_in() const { return (bf16_t*)(ws + WSL.wb_in); }
    __device__ __forceinline__ bf16_t* wb_out() const { return (bf16_t*)(ws + WSL.wb_out); }
    __device__ __forceinline__ bf16_t* wb_mla() const { return (bf16_t*)(ws + WSL.wb_mla); }
    __device__ __forceinline__ bf16_t* wb_f13() const { return (bf16_t*)(ws + WSL.wb_f13); }
    __device__ __forceinline__ bf16_t* wb_f2() const { return (bf16_t*)(ws + WSL.wb_f2); }
    __device__ __forceinline__ bf16_t* wb_m13() const { return (bf16_t*)(ws + WSL.wb_m13); }
    __device__ __forceinline__ bf16_t* wb_m2() const { return (bf16_t*)(ws + WSL.wb_m2); }
    __device__ __forceinline__ float* hfilt() const { return (float*)(ws + WSL.hfilt); }
    __device__ __forceinline__ float* hsum() const { return (float*)(ws + WSL.hsum); }
    __device__ __forceinline__ float* hfc() const { return (float*)(ws + WSL.hfc); }
    __device__ __forceinline__ float* hsc() const { return (float*)(ws + WSL.hsc); }
    __device__ __forceinline__ float* xcur() const { return (float*)(ws + WSL.xcur); }
    __device__ __forceinline__ bf16_t* hbuf() const { return (bf16_t*)(ws + WSL.hbuf); }
    __device__ __forceinline__ bf16_t* Pp() const { return (bf16_t*)(ws + WSL.Pp); }
    __device__ __forceinline__ bf16_t* gqkv() const { return (bf16_t*)(ws + WSL.gqkv); }
    __device__ __forceinline__ float* ggb() const { return (float*)(ws + WSL.ggb); }
    __device__ __forceinline__ bf16_t* rqk() const { return (bf16_t*)(ws + WSL.rqk); }
    __device__ __forceinline__ float* mrs() const { return (float*)(ws + WSL.mrs); }
    __device__ __forceinline__ bf16_t* krr() const { return (bf16_t*)(ws + WSL.krr); }
    __device__ __forceinline__ bf16_t* qkvup() const { return (bf16_t*)(ws + WSL.qkvup); }
    __device__ __forceinline__ float* go() const { return (float*)(ws + WSL.go); }
    __device__ __forceinline__ float* ro() const { return (float*)(ws + WSL.ro); }
    __device__ __forceinline__ char* recs() const { return (char*)(ws + WSL.recs); }
    __device__ __forceinline__ float* hys() const { return (float*)(ws + WSL.hys); }
    __device__ __forceinline__ float* hyT() const { return (float*)(ws + WSL.hyT); }
    __device__ __forceinline__ bf16_t* hyO() const { return (bf16_t*)(ws + WSL.hyO); }
    __device__ __forceinline__ float* partG() const { return (float*)(ws + WSL.partG); }
    __device__ __forceinline__ float* partF() const { return (float*)(ws + WSL.partF); }
    __device__ __forceinline__ float* attp() const { return (float*)(ws + WSL.attp); }
    __device__ __forceinline__ signed char* actq() const { return (signed char*)(ws + WSL.actq); }
    __device__ __forceinline__ signed char* actq_moe() const { return (signed char*)(ws + WSL.actq_moe); }
    __device__ __forceinline__ bf16_t* ocat() const { return (bf16_t*)(ws + WSL.ocat); }
    __device__ __forceinline__ bf16_t* act() const { return (bf16_t*)(ws + WSL.act); }
    __device__ __forceinline__ bf16_t* act_moe() const { return (bf16_t*)(ws + WSL.act_moe); }
    __device__ __forceinline__ bf16_t* hg() const { return (bf16_t*)(ws + WSL.hg); }
    __device__ __forceinline__ bf16_t* yb() const { return (bf16_t*)(ws + WSL.yb); }
    __device__ __forceinline__ int* tok_r() const { return (int*)(ws + WSL.tok_r); }
    __device__ __forceinline__ float* tok_w() const { return (float*)(ws + WSL.tok_w); }
    __device__ __forceinline__ int* tok_e() const { return (int*)(ws + WSL.tok_e); }
    __device__ __forceinline__ int* tok_p() const { return (int*)(ws + WSL.tok_p); }
    __device__ __forceinline__ int* gidx() const { return (int*)(ws + WSL.gidx); }
    __device__ __forceinline__ int* tailidx() const { return (int*)(ws + WSL.tailidx); }
    __device__ __forceinline__ float* ypart() const { return (float*)(ws + WSL.wb_m13); }
};

__device__ __forceinline__ int otid() { int t = threadIdx.x; asm volatile("" : "+v"(t)); return t; }
__device__ __forceinline__ unsigned cvt_pk_bf16(float lo, float hi) { unsigned r; asm volatile("v_cvt_pk_bf16_f32 %0, %1, %2" : "=v"(r) : "v"(lo), "v"(hi)); return r; }
__device__ __forceinline__ bf16_t f2bf(float x) { return (bf16_t)(cvt_pk_bf16(x, 0.f) & 0xffffu); }
__device__ __forceinline__ float bf2f(bf16_t b) { return __uint_as_float(((unsigned)b) << 16); }
__device__ __forceinline__ float bflo(unsigned w) { return __uint_as_float(w << 16); }
__device__ __forceinline__ float bfhi(unsigned w) { return __uint_as_float(w & 0xffff0000u); }
__device__ __forceinline__ float silu_f(float x) { return x / (1.f + __expf(-x)); }
__device__ __forceinline__ float sigmoid_f(float x) { return 1.f / (1.f + __expf(-x)); }
__device__ __forceinline__ float softplus_f(float x) { return fmaxf(x, 0.f) + __logf(1.f + __expf(-fabsf(x))); }
__device__ __forceinline__ float shflx(float v, int o, int lane) { return __int_as_float(__builtin_amdgcn_ds_bpermute((lane ^ o) << 2, __float_as_int(v))); }
__device__ __forceinline__ float wave_sum(float v) {
    const int lane = otid() & 63;
#pragma unroll
    for (int o = 32; o >= 1; o >>= 1) v += shflx(v, o, lane);
    return v;
}
__device__ __forceinline__ float sum16(float v) {
    const int lane = otid() & 63;
#pragma unroll
    for (int o = 8; o >= 1; o >>= 1) v += shflx(v, o, lane);
    return v;
}
__device__ __forceinline__ void unpack8(u32x4 w, float (&f)[8]) {
    f[0] = bflo(w.x); f[1] = bfhi(w.x); f[2] = bflo(w.y); f[3] = bfhi(w.y); f[4] = bflo(w.z); f[5] = bfhi(w.z); f[6] = bflo(w.w); f[7] = bfhi(w.w);
}
__device__ __forceinline__ u32x4 pack8(const float (&f)[8]) {
    u32x4 w; w.x = cvt_pk_bf16(f[0], f[1]); w.y = cvt_pk_bf16(f[2], f[3]); w.z = cvt_pk_bf16(f[4], f[5]); w.w = cvt_pk_bf16(f[6], f[7]); return w;
}

namespace pg8 {
constexpr int BM = 256, BK = 64, HALF = 128, HTB = HALF * BK * 2, STAGE_BYTES = 8 * HTB, NXCD = 8, WGM = 4;
__host__ __device__ __forceinline__ int lds_byte(int r, int c) { const int st = (r >> 4) * 2 + (c >> 5), rr = r & 15, cc = c & 31, ob = rr * 64 + cc * 2; return st * 1024 + (ob ^ (((ob >> 9) & 1) << 5)); }
__host__ __device__ __forceinline__ void stage_rc(int b, int& R, int& C) { const int st = b / 1024, sb = b % 1024, swz = sb ^ (((sb >> 9) & 1) << 5); R = (st >> 1) * 16 + swz / 64; C = (st & 1) * 32 + (swz % 64) / 2; }
__host__ __device__ __forceinline__ int perm32(int rho) { const int n = rho >> 4, i = rho & 15; return 8 * (i >> 2) + 4 * n + (i & 3); }
struct Unit { int pm, pn, e, kt0, nt, ks, tu; };
struct Gemm { const bf16_t* A; const bf16_t* Bt; int K, lda, ldb; size_t estride; const int* gidx; };

struct StaticOrder {
    int nM, nN, nwg, G, c, ntk;
    __device__ void init(int M, int N, int G_, int c_, int K) { nM = M / BM; nN = N / BM; nwg = nM * nN; G = G_; c = c_; ntk = K / BK; }
    __device__ bool next(int i, Unit& u) const {
        const long L = (long)i * G + c; if (L >= nwg) return false;
        int wgid = (int)L; { const int q = nwg / NXCD, r = nwg % NXCD, xcd = wgid % NXCD, off = wgid / NXCD; wgid = (xcd < r ? xcd * (q + 1) : r * (q + 1) + (xcd - r) * q) + off; }
        const int nig = WGM * nN, gid = wgid / nig, fm = gid * WGM, gsz = (nM - fm) < WGM ? (nM - fm) : WGM;
        u.pm = fm + ((wgid % nig) % gsz); u.pn = (wgid % nig) / gsz; u.e = 0; u.kt0 = 0; u.nt = ntk; u.ks = -1; u.tu = 0; return true;
    }
    __device__ __forceinline__ void a_ready(const Unit&) const {}
    __device__ __forceinline__ void done(const Unit&) const {}
};
struct CtxSplitOrder {
    StaticOrder S; int ns, G, c;
    __device__ void init(int G_, int c_, int K, int NS) { S.init(SEQ, D_, G_, c_, K); ns = NS; G = G_; c = c_; }
    __device__ bool next(int i, Unit& u) const {
        const long L = (long)i * G + c;
        if (L < S.nwg) { S.next(i, u); u.pm += 1; return true; }
        const int s = (int)(L - S.nwg); if (s >= 8 * ns) return false;
        u.pm = 0; u.pn = s & 7; u.e = 0; u.ks = s >> 3; u.tu = 0; u.nt = S.ntk / ns; u.kt0 = u.ks * u.nt; return true;
    }
    __device__ __forceinline__ void a_ready(const Unit&) const {}
    __device__ __forceinline__ void done(const Unit&) const {}
};
struct GroupedOrder {
    int pb[NEXP + 1]; int ub[NEXP + 1]; int nN, nwg, G, c, ntk, nfull, ntail;
    __device__ void init(const unsigned* cnt, int N, int G_, int c_, int K, bool split_tail = false) {
        ntk = K / BK; nN = N / BM; int acc = 0, ua = 0;
#pragma unroll
        for (int e = 0; e < NEXP; ++e) { pb[e] = acc; ub[e] = ua; const int np = ((int)cnt[e] + 255) >> 8; acc += np; ua += np * nN; }
        pb[NEXP] = acc; ub[NEXP] = ua; nwg = ua; G = G_; c = c_;
        const int rem = nwg % G; ntail = (split_tail && rem > 0 && rem <= 64) ? rem : 0; nfull = nwg - ntail;
    }
    __device__ bool next(int i, Unit& u) const {
        long L = (long)i * G + c; int ks = -1, tu = 0;
        if (L >= nfull) { const long t = L - nfull; if (t >= (long)ntail * 4) return false; tu = (int)(t >> 2); ks = (int)(t & 3); L = nfull + tu; }
        int wgid = (int)L; { const int q = nwg / NXCD, r = nwg % NXCD, xcd = wgid % NXCD, off = wgid / NXCD; wgid = (xcd < r ? xcd * (q + 1) : r * (q + 1) + (xcd - r) * q) + off; }
        int e = 0;
#pragma unroll
        for (int k = 1; k < NEXP; ++k) e += (wgid >= ub[k]) ? 1 : 0;
        int ube = 0, pbe = 0, npe = 0;
#pragma unroll
        for (int k = 0; k < NEXP; ++k) if (e == k) { ube = ub[k]; pbe = pb[k]; npe = pb[k + 1] - pb[k]; }
        const int l = wgid - ube, nig = WGM * nN, gid = l / nig, fm = gid * WGM, gsz = (npe - fm) < WGM ? (npe - fm) : WGM;
        u.pm = pbe + fm + ((l % nig) % gsz); u.pn = (l % nig) / gsz; u.e = e; u.ks = ks; u.tu = tu;
        const int ntq = ntk >> 2; u.nt = ks < 0 ? ntk : ntq; u.kt0 = ks < 0 ? 0 : ks * ntq;
        return true;
    }
    __device__ __forceinline__ void a_ready(const Unit&) const {}
    __device__ __forceinline__ void done(const Unit&) const {}
};

typedef int i32x4 __attribute__((ext_vector_type(4)));
template <class Epi, class Sched, bool GATHER = false, bool I8 = false>
__device__ __forceinline__ void gemm_phase(LAS unsigned char* lds, const Gemm g, const Sched& S, const Epi& E) {
    const int tid = otid(), wid = __builtin_amdgcn_readfirstlane(tid >> 6), lane = tid & 63, wr = wid >> 2, wc = wid & 3, fr = lane & 15, fq = lane >> 4;
    unsigned voffA[2], voffB[2]; int rA[2], cA2[2];
#pragma unroll
    for (int i = 0; i < 2; ++i) { int R, C; stage_rc(tid * 16 + i * 8192, R, C); const int Rb = Epi::PERM ? ((R & ~31) + perm32(R & 31)) : R;
        voffA[i] = (unsigned)(R * g.lda + C) * 2u; voffB[i] = (unsigned)(Rb * g.ldb + C) * 2u; rA[i] = R; cA2[i] = C * 2; }
    unsigned gA[2][2], gN[2][2];
#define PG8_GIDX(dst, pm_) do { _Pragma("unroll") for (int h_ = 0; h_ < 2; ++h_) _Pragma("unroll") for (int i_ = 0; i_ < 2; ++i_) \
        dst[h_][i_] = (unsigned)g.gidx[(pm_) * BM + h_ * HALF + rA[i_]] * (unsigned)(g.lda * 2) + (unsigned)cA2[i_]; } while (0)
#define PG8_STAGE_A(bufoff, kptr, h, useN) do { if constexpr (GATHER) { _Pragma("unroll") for (int _i = 0; _i < 2; ++_i) \
        __builtin_amdgcn_global_load_lds((const unsigned*)((const char*)(kptr) + ((useN) ? gN[h][_i] : gA[h][_i])), (LAS unsigned*)(lds + (bufoff) + ldsw + _i * 8192), 16, 0, 0); } \
        else PG8_STAGE(bufoff, (kptr) + (h) * hstepA, voffA); } while (0)
    const size_t kstep = (size_t)(BK * 2);
    const size_t hstepA = (size_t)HALF * g.lda * 2, hstepB = (size_t)HALF * g.ldb * 2;
    const size_t tstepA = 2 * hstepA, tstepB = 2 * hstepB;
    const unsigned ldsw = (unsigned)wid * 1024u;
    const int aoff = lds_byte(wr * 64 + fr, fq * 8), boff = lds_byte(wc * 32 + fr, fq * 8);
#define PG8_SA(b, h) (((b) * 2 + (h)) * HTB)
#define PG8_SB(b, h) ((4 + (b) * 2 + (h)) * HTB)
#define PG8_STAGE(bufoff, gbase, voff) do { _Pragma("unroll") for (int _i = 0; _i < 2; ++_i) \
        __builtin_amdgcn_global_load_lds((const unsigned*)((const char*)(gbase) + (voff)[_i]), (LAS unsigned*)(lds + (bufoff) + ldsw + _i * 8192), 16, 0, 0); } while (0)
#define PG8_LDA(dst, b, h) do { _Pragma("unroll") for (int m = 0; m < 4; ++m) _Pragma("unroll") for (int k = 0; k < 2; ++k) dst[m][k] = *(const LAS bf16x8*)(lds + PG8_SA(b, h) + aoff + m * 2048 + k * 1024); } while (0)
#define PG8_LDB(dst, b, h) do { _Pragma("unroll") for (int n = 0; n < 2; ++n) _Pragma("unroll") for (int k = 0; k < 2; ++k) dst[n][k] = *(const LAS bf16x8*)(lds + PG8_SB(b, h) + boff + n * 2048 + k * 1024); } while (0)
#define PG8_MMA(ai, bj, At, Bt) do { __builtin_amdgcn_s_setprio(1); _Pragma("unroll") for (int m = 0; m < 4; ++m) _Pragma("unroll") for (int n = 0; n < 2; ++n) _Pragma("unroll") for (int k = 0; k < 2; ++k) \
        { if constexpr (I8) acc[ai][bj][m][n] = __builtin_bit_cast(f32x4, __builtin_amdgcn_mfma_i32_16x16x64_i8(__builtin_bit_cast(i32x4, Bt[n][k]), __builtin_bit_cast(i32x4, At[m][k]), __builtin_bit_cast(i32x4, acc[ai][bj][m][n]), 0, 0, 0)); \
          else acc[ai][bj][m][n] = __builtin_amdgcn_mfma_f32_16x16x32_bf16(Bt[n][k], At[m][k], acc[ai][bj][m][n], 0, 0, 0); } __builtin_amdgcn_s_setprio(0); } while (0)
#define PG8_WAIT_V(n) asm volatile("s_waitcnt vmcnt(" #n ")" ::: "memory")
#define PG8_WAIT_L(n) asm volatile("s_waitcnt lgkmcnt(" #n ")" ::: "memory")
#define PG8_BAR __builtin_amdgcn_s_barrier()
#define PG8_SCHED __builtin_amdgcn_sched_barrier(0)
    Unit cur, nxt; int ui = 0; typename Epi::Regs er;
    if (!S.next(0, cur)) return;
    f32x4 acc[2][2][4][2];
#pragma unroll
    for (int a = 0; a < 2; ++a)
#pragma unroll
        for (int b = 0; b < 2; ++b)
#pragma unroll
            for (int m = 0; m < 4; ++m)
#pragma unroll
                for (int n = 0; n < 2; ++n) acc[a][b][m][n] = (f32x4){0.f, 0.f, 0.f, 0.f};
    bf16x8 At[4][2], B0[2][2], B1[2][2];
    const char* cA = (const char*)g.A + (GATHER ? (size_t)0 : (size_t)cur.pm * tstepA) + (size_t)cur.kt0 * kstep; const char* cB = (const char*)g.Bt + (size_t)cur.pn * tstepB + (size_t)cur.e * g.estride * 2 + (size_t)cur.kt0 * kstep;
    S.a_ready(cur);
    if constexpr (GATHER) { PG8_GIDX(gA, cur.pm); }
    PG8_STAGE(PG8_SB(0, 0), cB, voffB); PG8_STAGE_A(PG8_SA(0, 0), cA, 0, false); PG8_STAGE(PG8_SB(0, 1), cB + hstepB, voffB); PG8_STAGE_A(PG8_SA(0, 1), cA, 1, false);
    if (wr == 1) PG8_BAR;
    PG8_WAIT_V(4); PG8_BAR;
    PG8_STAGE(PG8_SB(1, 0), cB + kstep, voffB); PG8_STAGE_A(PG8_SA(1, 0), cA + kstep, 0, false); PG8_STAGE(PG8_SB(1, 1), cB + hstepB + kstep, voffB);
    PG8_WAIT_V(6); PG8_BAR;
    for (;;) {
        const bool has_next = S.next(ui + 1, nxt);
        const char* nA = has_next ? (const char*)g.A + (GATHER ? (size_t)0 : (size_t)nxt.pm * tstepA) + (size_t)nxt.kt0 * kstep : cA;
        if constexpr (GATHER) { if (has_next) { PG8_GIDX(gN, nxt.pm); } else { _Pragma("unroll") for (int h_ = 0; h_ < 2; ++h_) _Pragma("unroll") for (int i_ = 0; i_ < 2; ++i_) gN[h_][i_] = gA[h_][i_]; } }
        const char* nB = has_next ? (const char*)g.Bt + (size_t)nxt.pn * tstepB + (size_t)nxt.e * g.estride * 2 + (size_t)nxt.kt0 * kstep : cB;
        const int nt = cur.nt;
        for (int t = 0; t < nt; t += 2) {
            const bool last = (t == nt - 2);
            const char* a1 = cA + (size_t)(t + 1) * kstep;
            const char* a2 = last ? nA : cA + (size_t)(t + 2) * kstep; const char* b2 = last ? nB : cB + (size_t)(t + 2) * kstep;
            const char* a3 = a2 + kstep; const char* b3 = b2 + kstep;
            if (last && has_next) S.a_ready(nxt);
            PG8_LDB(B0, 0, 0); PG8_SCHED; PG8_LDA(At, 0, 0); PG8_STAGE_A(PG8_SA(1, 1), a1, 1, false);
            PG8_WAIT_L(8); PG8_BAR; PG8_WAIT_L(0); PG8_MMA(0, 0, At, B0); PG8_BAR; PG8_SCHED;
            PG8_LDB(B1, 0, 1); PG8_STAGE(PG8_SB(0, 0), b2, voffB);
            PG8_BAR; PG8_WAIT_L(0); PG8_MMA(0, 1, At, B1); PG8_BAR;
            PG8_LDA(At, 0, 1); PG8_STAGE_A(PG8_SA(0, 0), a2, 0, last);
            PG8_BAR; PG8_WAIT_L(0); PG8_MMA(1, 0, At, B0); PG8_BAR; PG8_SCHED;
            PG8_STAGE(PG8_SB(0, 1), b2 + hstepB, voffB);
            PG8_WAIT_V(6); PG8_BAR; PG8_MMA(1, 1, At, B1); PG8_BAR;
            PG8_LDB(B0, 1, 0); PG8_SCHED; PG8_LDA(At, 1, 0); PG8_STAGE_A(PG8_SA(0, 1), a2, 1, last);
            PG8_WAIT_L(8); PG8_BAR; PG8_WAIT_L(0); PG8_MMA(0, 0, At, B0); PG8_BAR; PG8_SCHED;
            PG8_LDB(B1, 1, 1); PG8_STAGE(PG8_SB(1, 0), b3, voffB);
            PG8_BAR; PG8_WAIT_L(0); PG8_MMA(0, 1, At, B1); PG8_BAR;
            PG8_LDA(At, 1, 1); PG8_STAGE_A(PG8_SA(1, 0), a3, 0, last);
            PG8_BAR; PG8_WAIT_L(0); PG8_MMA(1, 0, At, B0); PG8_BAR; PG8_SCHED;
            PG8_STAGE(PG8_SB(1, 1), b3 + hstepB, voffB);
            PG8_WAIT_V(6); PG8_BAR; PG8_MMA(1, 1, At, B1); PG8_BAR;
        }
        E.pre(er, cur, wr, wc, fr, fq);
        if constexpr (I8) {
#pragma unroll
            for (int a = 0; a < 2; ++a)
#pragma unroll
                for (int b = 0; b < 2; ++b)
#pragma unroll
                    for (int m = 0; m < 4; ++m)
#pragma unroll
                        for (int n = 0; n < 2; ++n) { const i32x4 iv = __builtin_bit_cast(i32x4, acc[a][b][m][n]); acc[a][b][m][n] = (f32x4){(float)iv[0], (float)iv[1], (float)iv[2], (float)iv[3]}; }
        }
        E(acc, cur, wr, wc, fr, fq, er); S.done(cur);
        if (!has_next) break;
#pragma unroll
        for (int a = 0; a < 2; ++a)
#pragma unroll
            for (int b = 0; b < 2; ++b)
#pragma unroll
                for (int m = 0; m < 4; ++m)
#pragma unroll
                    for (int n = 0; n < 2; ++n) acc[a][b][m][n] = (f32x4){0.f, 0.f, 0.f, 0.f};
        cur = nxt; cA = nA; cB = nB; ++ui;
        if constexpr (GATHER) { _Pragma("unroll") for (int h_ = 0; h_ < 2; ++h_) _Pragma("unroll") for (int i_ = 0; i_ < 2; ++i_) gA[h_][i_] = gN[h_][i_]; }
    }
    PG8_WAIT_V(0);
    if (wr == 0) PG8_BAR;
    PG8_BAR;
#undef PG8_SA
#undef PG8_GIDX
#undef PG8_STAGE_A
#undef PG8_SB
#undef PG8_STAGE
#undef PG8_LDA
#undef PG8_LDB
#undef PG8_MMA
#undef PG8_WAIT_V
#undef PG8_WAIT_L
#undef PG8_BAR
#undef PG8_SCHED
}

struct EpiStoreBf16 {
    static constexpr bool PERM = true;
    bf16_t* O; int ldc; const float* rs; int rs_split; float* part; int* tailidx; const float* sa; const unsigned* sb;
    struct Regs { float scr[8]; f32x4 cs[2][2]; };
    __device__ __forceinline__ void pre(Regs& R, const Unit& u, int wr, int wc, int fr, int fq) const {
        const int row0 = u.pm * BM + wr * 64 + fr, col0 = u.pn * BM + wc * 32 + 8 * fq; const int sel = (u.pn >= rs_split) ? 1 : 0;
#pragma unroll
        for (int i = 0; i < 8; ++i) { const int row = row0 + (i >> 2) * HALF + (i & 3) * 16; R.scr[i] = (rs ? rs[row * 2 + sel] : 1.f) * (sa ? sa[row] : 1.f); }
#pragma unroll
        for (int bj = 0; bj < 2; ++bj) { if (sb) { const u32x4* sp = (const u32x4*)(sb + (size_t)u.e * D_ + col0 + bj * HALF); const u32x4 a = sp[0], b = sp[1];
                R.cs[bj][0] = (f32x4){__uint_as_float(a.x), __uint_as_float(a.y), __uint_as_float(a.z), __uint_as_float(a.w)} * (1.0f / 127.f);
                R.cs[bj][1] = (f32x4){__uint_as_float(b.x), __uint_as_float(b.y), __uint_as_float(b.z), __uint_as_float(b.w)} * (1.0f / 127.f); }
            else { R.cs[bj][0] = (f32x4){1.f, 1.f, 1.f, 1.f}; R.cs[bj][1] = R.cs[bj][0]; } }
    }
    __device__ __forceinline__ void operator()(const f32x4 (&acc)[2][2][4][2], const Unit& u, int wr, int wc, int fr, int fq, const Regs& R) const {
        if (u.ks >= 0) {
            float* pp = part + ((size_t)(u.tu * 4 + u.ks) * BM + wr * 64 + fr) * BM + wc * 32 + 8 * fq;
#pragma unroll
            for (int ai = 0; ai < 2; ++ai)
#pragma unroll
                for (int m = 0; m < 4; ++m)
#pragma unroll
                    for (int bj = 0; bj < 2; ++bj)
#pragma unroll
                        for (int n = 0; n < 2; ++n) *(f32x4*)(pp + (size_t)(ai * HALF + m * 16) * BM + bj * HALF + 4 * n) = acc[ai][bj][m][n];
            if (wr == 0 && wc == 0 && fr == 0 && fq == 0) tailidx[u.pm * 8 + u.pn] = u.tu;
            return;
        }
        const int row0 = u.pm * BM + wr * 64 + fr, col0 = u.pn * BM + wc * 32 + 8 * fq;
        const int sel = (u.pn >= rs_split) ? 1 : 0;
#pragma unroll
        for (int ai = 0; ai < 2; ++ai)
#pragma unroll
            for (int m = 0; m < 4; ++m) { const int row = row0 + ai * HALF + m * 16; bf16_t* rowp = O + (size_t)row * ldc + col0;
                const float sc = R.scr[ai * 4 + m];
#pragma unroll
                for (int bj = 0; bj < 2; ++bj) { f32x4 v0 = acc[ai][bj][m][0] * sc, v1 = acc[ai][bj][m][1] * sc;
                    if (sb) { v0 *= R.cs[bj][0]; v1 *= R.cs[bj][1]; }
                    u32x4 w; w.x = cvt_pk_bf16(v0[0], v0[1]); w.y = cvt_pk_bf16(v0[2], v0[3]); w.z = cvt_pk_bf16(v1[0], v1[1]); w.w = cvt_pk_bf16(v1[2], v1[3]);
                    *(u32x4*)(rowp + bj * HALF) = w; } }
    }
};
struct EpiResGate {
    static constexpr bool PERM = false;
    float* out; const float* res_ctx; const float* res_lat; const float* gate_ctx; const float* gate_lat; int rowbase; float* part;
    const float* sa; const unsigned* sb;
    struct Regs { float ra[8]; };
    __device__ __forceinline__ void pre(Regs& R, const Unit& u, int wr, int wc, int fr, int fq) const {
        const int r0 = u.pm * BM + wr * 64 + fr;
#pragma unroll
        for (int i = 0; i < 8; ++i) R.ra[i] = sa ? sa[r0 + (i >> 2) * HALF + (i & 3) * 16] : 1.f;
    }
    __device__ __forceinline__ void operator()(const f32x4 (&acc)[2][2][4][2], const Unit& u, int wr, int wc, int fr, int fq, const Regs& R) const {
        const int row0 = rowbase + u.pm * BM + wr * 64 + fr, col0 = u.pn * BM + wc * 32 + 4 * fq;
        f32x4 cs[2][2];
#pragma unroll
        for (int bj = 0; bj < 2; ++bj)
#pragma unroll
            for (int n = 0; n < 2; ++n) { if (sb) { const unsigned* sp = sb + col0 + bj * HALF + n * 16; cs[bj][n] = (f32x4){__uint_as_float(sp[0]), __uint_as_float(sp[1]), __uint_as_float(sp[2]), __uint_as_float(sp[3])} * (1.0f / 127.f); }
                else cs[bj][n] = (f32x4){1.f, 1.f, 1.f, 1.f}; }
        if (u.ks >= 0) {
            float* pp = part + ((size_t)u.ks * LC + wr * 64 + fr) * D_ + col0;
#pragma unroll
            for (int ai = 0; ai < 2; ++ai)
#pragma unroll
                for (int m = 0; m < 4; ++m)
#pragma unroll
                    for (int bj = 0; bj < 2; ++bj)
#pragma unroll
                        for (int n = 0; n < 2; ++n) *(f32x4*)(pp + (size_t)(ai * HALF + m * 16) * D_ + bj * HALF + n * 16) = acc[ai][bj][m][n] * cs[bj][n] * R.ra[ai * 4 + m];
            return;
        }
        f32x4 g4[2][2];
#pragma unroll
        for (int bj = 0; bj < 2; ++bj)
#pragma unroll
            for (int n = 0; n < 2; ++n) g4[bj][n] = *(const f32x4*)(gate_lat + col0 + bj * HALF + n * 16) * cs[bj][n];
#pragma unroll
        for (int hb = 0; hb < 4; ++hb) { f32x4 r4[2][2][2];
#pragma unroll
            for (int mm = 0; mm < 2; ++mm) { const int ai = hb >> 1, m = (hb & 1) * 2 + mm; const float* rp = res_lat + (size_t)(row0 + ai * HALF + m * 16 - LC) * D_;
#pragma unroll
                for (int bj = 0; bj < 2; ++bj)
#pragma unroll
                    for (int n = 0; n < 2; ++n) r4[mm][bj][n] = *(const f32x4*)(rp + col0 + bj * HALF + n * 16); }
#pragma unroll
            for (int mm = 0; mm < 2; ++mm) { const int ai = hb >> 1, m = (hb & 1) * 2 + mm; float* op = out + (size_t)(row0 + ai * HALF + m * 16) * D_;
#pragma unroll
                for (int bj = 0; bj < 2; ++bj)
#pragma unroll
                    for (int n = 0; n < 2; ++n) *(f32x4*)(op + col0 + bj * HALF + n * 16) = r4[mm][bj][n] + g4[bj][n] * (acc[ai][bj][m][n] * R.ra[ai * 4 + m]); } }
    }
};
struct EpiSwiGLU {
    static constexpr bool PERM = true;
    bf16_t* O; int ldc; const float* sa; const unsigned* sb; unsigned* rmax;
    struct Regs { float rav[8]; u32x4 sg[2], su[2]; };
    __device__ __forceinline__ void pre(Regs& R, const Unit& u, int wr, int wc, int fr, int fq) const {
        const int row0 = u.pm * BM + wr * 64 + fr;
#pragma unroll
        for (int i = 0; i < 8; ++i) R.rav[i] = sa ? sa[row0 + (i >> 2) * HALF + (i & 3) * 16] : 1.f;
        if (sb) { const unsigned* sp = sb + (size_t)u.e * (2 * DFF) + u.pn * BM + wc * 32 + 8 * fq;
            R.sg[0] = *(const u32x4*)sp; R.sg[1] = *(const u32x4*)(sp + 4); R.su[0] = *(const u32x4*)(sp + HALF); R.su[1] = *(const u32x4*)(sp + HALF + 4); }
    }
    __device__ __forceinline__ void operator()(const f32x4 (&acc)[2][2][4][2], const Unit& u, int wr, int wc, int fr, int fq, const Regs& R) const {
        const int row0 = u.pm * BM + wr * 64 + fr, col0 = u.pn * HALF + wc * 32 + 8 * fq;
        float sg[8], su[8];
#pragma unroll
        for (int j = 0; j < 8; ++j) { sg[j] = 1.f; su[j] = 1.f; }
        if (sb) {
#pragma unroll
            for (int j = 0; j < 8; ++j) { sg[j] = __uint_as_float(R.sg[j >> 2][j & 3]) * (1.0f / 127.f); su[j] = __uint_as_float(R.su[j >> 2][j & 3]) * (1.0f / 127.f); } }
#pragma unroll
        for (int ai = 0; ai < 2; ++ai)
#pragma unroll
            for (int m = 0; m < 4; ++m) { const int row = row0 + ai * HALF + m * 16; bf16_t* rowp = O + (size_t)row * ldc + col0;
                const float ra = R.rav[ai * 4 + m];
                float o[8];
#pragma unroll
                for (int n = 0; n < 2; ++n)
#pragma unroll
                    for (int j = 0; j < 4; ++j) { const float gte = acc[ai][0][m][n][j] * (ra * sg[n * 4 + j]), up = acc[ai][1][m][n][j] * (ra * su[n * 4 + j]); o[n * 4 + j] = gte * __builtin_amdgcn_rcpf(1.f + __expf(-gte)) * up; }
                *(u32x4*)rowp = pack8(o);
                if (rmax) { float mx = fmaxf(fmaxf(fmaxf(fabsf(o[0]), fabsf(o[1])), fmaxf(fabsf(o[2]), fabsf(o[3]))), fmaxf(fmaxf(fabsf(o[4]), fabsf(o[5])), fmaxf(fabsf(o[6]), fabsf(o[7]))));
                    const int ln = otid() & 63; mx = fmaxf(mx, shflx(mx, 16, ln)); mx = fmaxf(mx, shflx(mx, 32, ln));
                    if (fq == 0) atomicMax(rmax + row, __float_as_uint(mx)); } }
    }
};
}
#ifndef FFT_DEV_H
#define FFT_DEV_H
#ifndef FFT_HOST
#define FFT_FN __device__ __forceinline__
struct cpx { float x, y; };
FFT_FN void tw(float frac, float& c, float& s) { c = __builtin_amdgcn_cosf(frac); s = __builtin_amdgcn_sinf(frac); }
#else
#include <cmath>
#define FFT_FN static inline
struct cpx { float x, y; };
FFT_FN void tw(float frac, float& c, float& s) { c = (float)cos(6.283185307179586 * (double)frac); s = (float)sin(6.283185307179586 * (double)frac); }
#endif
#define ZP(i) ((i) + (((i) >> 6) << 2))
constexpr int FFT_N = 16384;
constexpr int FFT_ZN = FFT_N + 4 * (FFT_N / 64);

FFT_FN void bf_dif(cpx& a, cpx& b, float c, float s) {
    const float dx = a.x - b.x, dy = a.y - b.y;
    a.x += b.x; a.y += b.y;
    b.x = dx * c + dy * s; b.y = dy * c - dx * s;
}
FFT_FN void bf_dit(cpx& a, cpx& b, float c, float s) {
    const float tx = b.x * c - b.y * s, ty = b.x * s + b.y * c;
    b.x = a.x - tx; b.y = a.y - ty; a.x += tx; a.y += ty;
}
template <int K16> FFT_FN void rot16(float c0, float s0, float& c, float& s) {
    constexpr float CR[16] = {1.f, 0.9238795325112867f, 0.7071067811865476f, 0.3826834323650898f, 0.f, -0.3826834323650898f, -0.7071067811865476f, -0.9238795325112867f,
                              -1.f, -0.9238795325112867f, -0.7071067811865476f, -0.3826834323650898f, 0.f, 0.3826834323650898f, 0.7071067811865476f, 0.9238795325112867f};
    constexpr float SR[16] = {0.f, 0.3826834323650898f, 0.7071067811865476f, 0.9238795325112867f, 1.f, 0.9238795325112867f, 0.7071067811865476f, 0.3826834323650898f,
                              0.f, -0.3826834323650898f, -0.7071067811865476f, -0.9238795325112867f, -1.f, -0.9238795325112867f, -0.7071067811865476f, -0.3826834323650898f};
    constexpr float cr = CR[K16 & 15], sr = SR[K16 & 15];
    if constexpr ((K16 & 15) == 0) { c = c0; s = s0; }
    else if constexpr ((K16 & 15) == 4) { c = -s0; s = c0; }
    else if constexpr ((K16 & 15) == 8) { c = -c0; s = -s0; }
    else if constexpr ((K16 & 15) == 12) { c = s0; s = -c0; }
    else { c = c0 * cr - s0 * sr; s = s0 * cr + c0 * sr; }
}
#define FFT_BF(DIFDIT, ra, rb, K16, cb, sb) do { float _c, _s; rot16<K16>(cb, sb, _c, _s); DIFDIT(v[ra], v[rb], _c, _s); } while (0)
template <bool INV> FFT_FN void fft_pass16(cpx* Z, int g, int lm) {
    const int mp = 1 << lm, ilo = g & (mp - 1), ihi = g >> lm, base = (ihi << (lm + 4)) + ilo;
    const int zb = ZP(base), st = (lm >= 6) ? mp + (mp >> 4) : mp;
    cpx v[16];
#pragma unroll
    for (int r = 0; r < 16; ++r) v[r] = Z[zb + r * st];
#ifndef FFT_HOST
    const float th = __builtin_amdgcn_ldexpf((float)ilo, -(lm + 4));
#else
    const float th = (float)ilo / (float)(16 * mp);
#endif
    float cA, sA, cB, sB, cC, sC, cD, sD;
    tw(th, cA, sA); tw(2.f * th, cB, sB); tw(4.f * th, cC, sC); tw(8.f * th, cD, sD);
    if (!INV) {
        FFT_BF(bf_dif, 0, 8, 0, cA, sA); FFT_BF(bf_dif, 1, 9, 1, cA, sA); FFT_BF(bf_dif, 2, 10, 2, cA, sA); FFT_BF(bf_dif, 3, 11, 3, cA, sA);
        FFT_BF(bf_dif, 4, 12, 4, cA, sA); FFT_BF(bf_dif, 5, 13, 5, cA, sA); FFT_BF(bf_dif, 6, 14, 6, cA, sA); FFT_BF(bf_dif, 7, 15, 7, cA, sA);
        FFT_BF(bf_dif, 0, 4, 0, cB, sB); FFT_BF(bf_dif, 1, 5, 2, cB, sB); FFT_BF(bf_dif, 2, 6, 4, cB, sB); FFT_BF(bf_dif, 3, 7, 6, cB, sB);
        FFT_BF(bf_dif, 8, 12, 0, cB, sB); FFT_BF(bf_dif, 9, 13, 2, cB, sB); FFT_BF(bf_dif, 10, 14, 4, cB, sB); FFT_BF(bf_dif, 11, 15, 6, cB, sB);
        FFT_BF(bf_dif, 0, 2, 0, cC, sC); FFT_BF(bf_dif, 1, 3, 4, cC, sC); FFT_BF(bf_dif, 4, 6, 0, cC, sC); FFT_BF(bf_dif, 5, 7, 4, cC, sC);
        FFT_BF(bf_dif, 8, 10, 0, cC, sC); FFT_BF(bf_dif, 9, 11, 4, cC, sC); FFT_BF(bf_dif, 12, 14, 0, cC, sC); FFT_BF(bf_dif, 13, 15, 4, cC, sC);
#pragma unroll
        for (int r = 0; r < 16; r += 2) bf_dif(v[r], v[r + 1], cD, sD);
    } else {
#pragma unroll
        for (int r = 0; r < 16; r += 2) bf_dit(v[r], v[r + 1], cD, sD);
        FFT_BF(bf_dit, 0, 2, 0, cC, sC); FFT_BF(bf_dit, 1, 3, 4, cC, sC); FFT_BF(bf_dit, 4, 6, 0, cC, sC); FFT_BF(bf_dit, 5, 7, 4, cC, sC);
        FFT_BF(bf_dit, 8, 10, 0, cC, sC); FFT_BF(bf_dit, 9, 11, 4, cC, sC); FFT_BF(bf_dit, 12, 14, 0, cC, sC); FFT_BF(bf_dit, 13, 15, 4, cC, sC);
        FFT_BF(bf_dit, 0, 4, 0, cB, sB); FFT_BF(bf_dit, 1, 5, 2, cB, sB); FFT_BF(bf_dit, 2, 6, 4, cB, sB); FFT_BF(bf_dit, 3, 7, 6, cB, sB);
        FFT_BF(bf_dit, 8, 12, 0, cB, sB); FFT_BF(bf_dit, 9, 13, 2, cB, sB); FFT_BF(bf_dit, 10, 14, 4, cB, sB); FFT_BF(bf_dit, 11, 15, 6, cB, sB);
        FFT_BF(bf_dit, 0, 8, 0, cA, sA); FFT_BF(bf_dit, 1, 9, 1, cA, sA); FFT_BF(bf_dit, 2, 10, 2, cA, sA); FFT_BF(bf_dit, 3, 11, 3, cA, sA);
        FFT_BF(bf_dit, 4, 12, 4, cA, sA); FFT_BF(bf_dit, 5, 13, 5, cA, sA); FFT_BF(bf_dit, 6, 14, 6, cA, sA); FFT_BF(bf_dit, 7, 15, 7, cA, sA);
    }
#pragma unroll
    for (int r = 0; r < 16; ++r) Z[zb + r * st] = v[r];
}
template <bool INV> FFT_FN void fft_pass4(cpx* Z, int g) {
    const int base = 4 * g;
#ifndef FFT_HOST
    typedef float f4_t __attribute__((ext_vector_type(4)));
    f4_t* zv = (f4_t*)(Z + ZP(base)); const f4_t q0 = zv[0], q1 = zv[1];
    cpx a = {q0[0], q0[1]}, b = {q0[2], q0[3]}, c = {q1[0], q1[1]}, d = {q1[2], q1[3]};
#else
    cpx a = Z[ZP(base)], b = Z[ZP(base + 1)], c = Z[ZP(base + 2)], d = Z[ZP(base + 3)];
#endif
    if (!INV) {
        cpx a2 = {a.x + c.x, a.y + c.y}, c2 = {a.x - c.x, a.y - c.y};
        cpx b2 = {b.x + d.x, b.y + d.y}, t = {b.x - d.x, b.y - d.y}; cpx d2 = {t.y, -t.x};
        a = {a2.x + b2.x, a2.y + b2.y}; b = {a2.x - b2.x, a2.y - b2.y};
        c = {c2.x + d2.x, c2.y + d2.y}; d = {c2.x - d2.x, c2.y - d2.y};
    } else {
        cpx a2 = {a.x + b.x, a.y + b.y}, b2 = {a.x - b.x, a.y - b.y};
        cpx c2 = {c.x + d.x, c.y + d.y}, d2 = {c.x - d.x, c.y - d.y};
        a = {a2.x + c2.x, a2.y + c2.y}; c = {a2.x - c2.x, a2.y - c2.y};
        cpx t = {-d2.y, d2.x};
        b = {b2.x + t.x, b2.y + t.y}; d = {b2.x - t.x, b2.y - t.y};
    }
#ifndef FFT_HOST
    zv[0] = (f4_t){a.x, a.y, b.x, b.y}; zv[1] = (f4_t){c.x, c.y, d.x, d.y};
#else
    Z[ZP(base)] = a; Z[ZP(base + 1)] = b; Z[ZP(base + 2)] = c; Z[ZP(base + 3)] = d;
#endif
}
FFT_FN int rev14(int p) {
#ifndef FFT_HOST
    return (int)(__builtin_bitreverse32((unsigned)p) >> 18);
#else
    int r = 0; for (int b = 0; b < 14; ++b) r |= ((p >> b) & 1) << (13 - b); return r;
#endif
}
FFT_FN int ilog2(int q) {
#ifndef FFT_HOST
    return 31 - __builtin_clz((unsigned)q);
#else
    int b = 0; while ((1 << (b + 1)) <= q) ++b; return b;
#endif
}
FFT_FN void fft_pw_idx(int q, int& pp, int& pq) { if (q == 0) { pp = 0; pq = 1; return; } const int b = ilog2(q); pp = (2 << b) + (q - (1 << b)); pq = 3 * (2 << b) - 1 - pp; }
FFT_FN void fft_pointwise_pre(cpx* Z, const cpx HA, const cpx HB, int q) {
    if (q == 0) {
        { const cpx a = Z[ZP(0)]; Z[ZP(0)] = cpx{a.x * HA.x + a.y * HA.y, a.x * HA.y + a.y * HA.x}; }
        { const cpx a = Z[ZP(1)]; Z[ZP(1)] = cpx{a.x * HB.x - a.y * HB.y, a.x * HB.y + a.y * HB.x}; }
        return;
    }
    const int b = ilog2(q), pp = (2 << b) + (q - (1 << b)), pq = 3 * (2 << b) - 1 - pp;
    const int kk = rev14(pp);
    float wc, ws; tw((float)kk * (1.0f / (float)FFT_N), wc, ws);
    const cpx A = Z[ZP(pp)], B = Z[ZP(pq)];
    const cpx Ue = {0.5f * (A.x + B.x), 0.5f * (A.y - B.y)};
    const cpx dU = {A.x - B.x, A.y + B.y};
    const cpx Uo = {0.5f * dU.y, -0.5f * dU.x};
    const cpx He = {0.5f * (HA.x + HB.x), 0.5f * (HA.y - HB.y)};
    const cpx dH = {HA.x - HB.x, HA.y + HB.y};
    const cpx Ho = {0.5f * dH.y, -0.5f * dH.x};
    const cpx UoHo = {Uo.x * Ho.x - Uo.y * Ho.y, Uo.x * Ho.y + Uo.y * Ho.x};
    const cpx wUH = {wc * UoHo.x + ws * UoHo.y, wc * UoHo.y - ws * UoHo.x};
    const cpx Ye = {Ue.x * He.x - Ue.y * He.y + wUH.x, Ue.x * He.y + Ue.y * He.x + wUH.y};
    const cpx Yo = {Ue.x * Ho.x - Ue.y * Ho.y + Uo.x * He.x - Uo.y * He.y, Ue.x * Ho.y + Ue.y * Ho.x + Uo.x * He.y + Uo.y * He.x};
    cpx o1 = {Ye.x - Yo.y, Ye.y + Yo.x};
    cpx o2 = {Ye.x + Yo.y, -Ye.y + Yo.x};
    Z[ZP(pp)] = o1; Z[ZP(pq)] = o2;
}
FFT_FN void fft_pointwise(cpx* Z, const cpx* Zh, int q) {
    if (q == 0) {
#pragma unroll
        for (int p0 = 0; p0 < 2; ++p0) {
            const cpx a = Z[ZP(p0)], h = Zh[p0];
            const float ue = a.x, uo = a.y, he = h.x, ho = h.y, sg = p0 ? -1.f : 1.f;
            cpx o = {ue * he + sg * uo * ho, ue * ho + uo * he};
            Z[ZP(p0)] = o;
        }
        return;
    }
    const int b = ilog2(q), pp = (2 << b) + (q - (1 << b)), pq = 3 * (2 << b) - 1 - pp;
    const int kk = rev14(pp);
    float wc, ws; tw((float)kk * (1.0f / (float)FFT_N), wc, ws);
    const cpx A = Z[ZP(pp)], B = Z[ZP(pq)], HA = Zh[pp], HB = Zh[pq];
    const cpx Ue = {0.5f * (A.x + B.x), 0.5f * (A.y - B.y)};
    const cpx dU = {A.x - B.x, A.y + B.y};
    const cpx Uo = {0.5f * dU.y, -0.5f * dU.x};
    const cpx He = {0.5f * (HA.x + HB.x), 0.5f * (HA.y - HB.y)};
    const cpx dH = {HA.x - HB.x, HA.y + HB.y};
    const cpx Ho = {0.5f * dH.y, -0.5f * dH.x};
    const cpx UoHo = {Uo.x * Ho.x - Uo.y * Ho.y, Uo.x * Ho.y + Uo.y * Ho.x};
    const cpx wUH = {wc * UoHo.x + ws * UoHo.y, wc * UoHo.y - ws * UoHo.x};
    const cpx Ye = {Ue.x * He.x - Ue.y * He.y + wUH.x, Ue.x * He.y + Ue.y * He.x + wUH.y};
    const cpx Yo = {Ue.x * Ho.x - Ue.y * Ho.y + Uo.x * He.x - Uo.y * He.y, Ue.x * Ho.y + Ue.y * Ho.x + Uo.x * He.y + Uo.y * He.x};
    cpx o1 = {Ye.x - Yo.y, Ye.y + Yo.x};
    cpx o2 = {Ye.x + Yo.y, -Ye.y + Yo.x};
    Z[ZP(pp)] = o1; Z[ZP(pq)] = o2;
}
#endif
template <class F> __device__ __forceinline__ void tconv_tile(const F& f, bf16_t* dst, int K, int k0, int n0, float* tile  , int lane) {
    f32x4 v[16];
    const int n4 = (lane & 15) * 4, kr = lane >> 4;
#pragma unroll
    for (int i = 0; i < 16; ++i) v[i] = f.ld4(k0 + kr + 4 * i, n0 + n4);
#pragma unroll
    for (int i = 0; i < 16; ++i) { float* t = tile + (kr + 4 * i) * 65 + n4; t[0] = v[i][0]; t[1] = v[i][1]; t[2] = v[i][2]; t[3] = v[i][3]; }
    __builtin_amdgcn_fence(__ATOMIC_RELEASE, "wavefront"); __builtin_amdgcn_wave_barrier(); __builtin_amdgcn_fence(__ATOMIC_ACQUIRE, "wavefront");
    const int kq = (lane & 7) * 8, nr = lane >> 3;
#pragma unroll
    for (int i = 0; i < 8; ++i) { const int nn = nr + 8 * i; float o[8];
#pragma unroll
        for (int e = 0; e < 8; ++e) o[e] = tile[(kq + e) * 65 + nn];
        *(u32x4*)(dst + (size_t)(n0 + nn) * K + k0 + kq) = pack8(o); }
    __builtin_amdgcn_fence(__ATOMIC_RELEASE, "wavefront"); __builtin_amdgcn_wave_barrier(); __builtin_amdgcn_fence(__ATOMIC_ACQUIRE, "wavefront");
}
__device__ __forceinline__ int in_src_col(int n) {
    if (n < 2048) return n;
    if (n < 3584) return 2704 + (n - 2048);
    if (n < 5120) return 4240 + (n - 3584);
    if (n < 5632) return 5776 + (n - 5120);
    if (n < 6080) return 2064 + (n - 5632);
    if (n < 6144) return -1;
    if (n < 6272) return 2512 + (n - 6144);
    if (n < 6336) return 2640 + (n - 6272);
    if (n < 6344) return 2048 + (n - 6336);
    if (n < 6352) return 2056 + (n - 6344);
    return -1;
}
struct FWin { const float* src;
    __device__ __forceinline__ f32x4 ld4(int k, int n) const {
        if (n < 6336) { const int c = in_src_col(n); return c < 0 ? (f32x4){0.f, 0.f, 0.f, 0.f} : *(const f32x4*)(src + (size_t)k * DIN + c); }
        f32x4 r;
#pragma unroll
        for (int e = 0; e < 4; ++e) { const int c = in_src_col(n + e); r[e] = c < 0 ? 0.f : src[(size_t)k * DIN + c]; }
        return r; } };
struct FPlain { const float* src; int ld; __device__ __forceinline__ f32x4 ld4(int k, int n) const { return *(const f32x4*)(src + (size_t)k * ld + n); } };
struct FMla { const float *uq, *ukv, *qn, *kvn;
    __device__ __forceinline__ f32x4 ld4(int k, int n) const {
        if (n < 768) { if (k >= 448) return (f32x4){0.f, 0.f, 0.f, 0.f}; return *(const f32x4*)(uq + (size_t)k * 768 + n) * qn[k]; }
        if (k < 512) return (f32x4){0.f, 0.f, 0.f, 0.f};
        return *(const f32x4*)(ukv + (size_t)(k - 512) * 1024 + (n - 768)) * kvn[k - 512]; } };
struct FW13 { const float *w1, *w3;
    __device__ __forceinline__ f32x4 ld4(int k, int n) const { const int col = (n >> 8) * 128 + (n & 127);
        const uintptr_t d = (uintptr_t)w3 - (uintptr_t)w1; const float* b = (const float*)((uintptr_t)w1 + (((n >> 7) & 1) ? d : (uintptr_t)0));
        return *(const f32x4*)(b + (size_t)k * DFF + col); } };

constexpr int T_WIN = (NP / 64) * (D_ / 64), T_WOUT = 32 * 32, T_MLA = (MLAN / 64) * (MLAK / 64), T_F13 = (2 * DFF / 64) * 32, T_F2 = 32 * (DFF / 64);
constexpr int U_MOD = 96, U_HF = 516, U_TR = 2 * T_WOUT + 2 * T_MLA;
constexpr int XBW_OFF_ = 147456 - 16;
constexpr int U_WABS_IN = 2 * (NP / 32);
constexpr int U_TRB = (U_TR + 7) / 8;
constexpr int U_S13 = 2 * (DFF / 32), U_S2 = D_ / 16, U_SBIG = 9 * U_S2, U_SSMALL = 9 * U_S13;
constexpr int U_STREAM = U_MOD + U_SBIG + U_SSMALL + U_WABS_IN + U_TRB, U_QTOT = U_HF + U_STREAM, Q_STRIDE = 9;

__device__ __forceinline__ void pro_mod_unit(const Params& p, int u, float* lds) {
    const int tid = otid(), wid = tid >> 6, lane = tid & 63;
    const int l = u / 48, cb = u % 48, col = cb * 256 + lane * 4;
    const float* W = p.in[I_MODW] + (size_t)l * D_ * (6 * D_) + col;
    const float* c = p.in[I_C]; const float* cc = p.in[I_CCTX];
    f32x4 al = {0, 0, 0, 0}, ac = {0, 0, 0, 0};
    const int k0 = wid * 256;
#pragma unroll 16
    for (int k = k0; k < k0 + 256; ++k) {
        const f32x4 w4 = *(const f32x4*)(W + (size_t)k * (6 * D_));
        const float sl = silu_f(c[k]), sc = silu_f(cc[k]);
        al += w4 * sl; ac += w4 * sc;
    }
    f32x4* red = (f32x4*)lds;
    red[(wid * 64 + lane) * 2] = al; red[(wid * 64 + lane) * 2 + 1] = ac;
    __syncthreads();
    if (wid == 0) {
        f32x4 sl = {0, 0, 0, 0}, sc = {0, 0, 0, 0};
#pragma unroll
        for (int w = 0; w < 8; ++w) { sl += red[(w * 64 + lane) * 2]; sc += red[(w * 64 + lane) * 2 + 1]; }
        const f32x4 b4 = *(const f32x4*)(p.in[I_MODB] + (size_t)l * 6 * D_ + col);
        *(f32x4*)(p.modv() + ((size_t)l * 2 + 0) * 6 * D_ + col) = sl + b4;
        *(f32x4*)(p.modv() + ((size_t)l * 2 + 1) * 6 * D_ + col) = sc + b4;
    }
    __syncthreads();
}

__device__ __forceinline__ void pro_hfilt_unit(const Params& p, int l, int Lf, int tb, float* hout, float* hsumo, float* lds) {
    const int tid = otid(), wid = tid >> 6, lane = tid & 63;
    float* zb = lds;
    float* H1 = lds + 64 * 36;
    float* H2 = H1 + 64 * 68;
    float* tl = H2 + 64 * 68 + wid * (64 * 33);
    const int t0 = tb * 64;
    const float* w1 = p.in[I_HW1] + (size_t)l * 33 * 64; const float* b1 = p.in[I_HB1] + l * 64;
    const float* w2 = p.in[I_HW2] + (size_t)l * 64 * 64; const float* b2 = p.in[I_HB2] + l * 64;
    const float* w3 = p.in[I_HW3] + (size_t)l * 64 * 64; const float* b3 = p.in[I_HB3] + l * 64;
    const float* w4 = p.in[I_HW4] + (size_t)l * 64 * 1024; const float* fq = p.in[I_HFREQ] + l * 64;
    {
        const int tp = lane, part = wid; const float pf = (float)(t0 + tp);
        const float c0 = (float)(6.283185307179586 / (double)Lf);
#pragma unroll 1
        for (int e = part; e < 33; e += 8) {
            float v;
            if (e == 0) v = pf / (float)(Lf - 1);
            else { const int b = (e - 1) & 15; const float fr = 1e-4f + (float)b * ((15.0f - 1e-4f) / 15.0f); const float ang = (c0 * pf) * fr; v = (e <= 16) ? cosf(ang) : -sinf(ang); }
            zb[tp * 36 + e] = v;
        }
    }
    __syncthreads();
    {   const int tp = lane, j0 = wid * 8; float s[8];
#pragma unroll
        for (int jj = 0; jj < 8; ++jj) s[jj] = b1[j0 + jj];
#pragma unroll 3
        for (int e = 0; e < 33; ++e) { const float z = zb[tp * 36 + e];
#pragma unroll
            for (int jj = 0; jj < 8; ++jj) s[jj] += z * w1[e * 64 + j0 + jj]; }
#pragma unroll 1
        for (int jj = 0; jj < 8; ++jj) H1[tp * 68 + j0 + jj] = sinf(fq[j0 + jj] * s[jj]);
    }
    __syncthreads();
    {   const int tp = lane, j0 = wid * 8; float s[8];
#pragma unroll
        for (int jj = 0; jj < 8; ++jj) s[jj] = b2[j0 + jj];
#pragma unroll 4
        for (int i = 0; i < 64; ++i) { const float z = H1[tp * 68 + i];
#pragma unroll
            for (int jj = 0; jj < 8; ++jj) s[jj] += z * w2[i * 64 + j0 + jj]; }
#pragma unroll 1
        for (int jj = 0; jj < 8; ++jj) H2[tp * 68 + j0 + jj] = sinf(fq[j0 + jj] * s[jj]);
    }
    __syncthreads();
    {   const int tp = lane, j0 = wid * 8; float s[8];
#pragma unroll
        for (int jj = 0; jj < 8; ++jj) s[jj] = b3[j0 + jj];
#pragma unroll 4
        for (int i = 0; i < 64; ++i) { const float z = H2[tp * 68 + i];
#pragma unroll
            for (int jj = 0; jj < 8; ++jj) s[jj] += z * w3[i * 64 + j0 + jj]; }
        __syncthreads();
#pragma unroll 1
        for (int jj = 0; jj < 8; ++jj) H1[tp * 68 + j0 + jj] = sinf(fq[j0 + jj] * s[jj]);
    }
    __syncthreads();
    const int nblk = Lf / 64;
#pragma unroll 1
    for (int i = 0; i < 2; ++i) {
        const int cg = wid + 8 * i, c = cg * 64 + lane;
        float wreg[64];
#pragma unroll
        for (int j = 0; j < 64; ++j) wreg[j] = w4[j * 1024 + c];
        const float a0 = -120.39728043259361f, a1 = 40.546510810816436f;
        const float delta = fabsf(a0 + (float)c * ((a1 - a0) / 1023.0f));
        float asum = 0.f; const float rLf = 1.0f / (float)Lf;
#pragma unroll 1
        for (int hh = 0; hh < 2; ++hh) {
#pragma unroll 2
            for (int tq = 0; tq < 32; ++tq) { const int tp = hh * 32 + tq;
                float s = 0.f;
#pragma unroll
                for (int j4 = 0; j4 < 16; ++j4) { const f32x4 h4 = *(const f32x4*)(H1 + tp * 68 + 4 * j4);
                    s += h4[0] * wreg[4 * j4] + h4[1] * wreg[4 * j4 + 1] + h4[2] * wreg[4 * j4 + 2] + h4[3] * wreg[4 * j4 + 3]; }
                const float pf = (float)(t0 + tp), dist = fabsf(pf - (float)(Lf / 2)) * rLf;
                const float val = s * expf(-dist * delta);
                tl[lane * 33 + tq] = val; asum += fabsf(val);
            }
            __builtin_amdgcn_fence(__ATOMIC_RELEASE, "wavefront"); __builtin_amdgcn_wave_barrier(); __builtin_amdgcn_fence(__ATOMIC_ACQUIRE, "wavefront");
#pragma unroll
            for (int ps = 0; ps < 2; ++ps) { const int rr = (lane >> 1) + 32 * ps, tq0 = (lane & 1) * 16;
                float* dst = hout + (size_t)(cg * 64 + rr) * Lf + t0 + hh * 32 + tq0;
#pragma unroll
                for (int k = 0; k < 4; ++k) { f32x4 v;
#pragma unroll
                    for (int e = 0; e < 4; ++e) v[e] = tl[rr * 33 + tq0 + 4 * k + e];
                    *(f32x4*)(dst + 4 * k) = v; } }
            __builtin_amdgcn_fence(__ATOMIC_RELEASE, "wavefront"); __builtin_amdgcn_wave_barrier(); __builtin_amdgcn_fence(__ATOMIC_ACQUIRE, "wavefront");
        }
        hsumo[(size_t)c * nblk + tb] = asum;
    }
    __syncthreads();
}

template <class M> __device__ __forceinline__ void wabs_unit(const float* src, int ld, int c0, int k0, unsigned* wam, const M& map, float* lds) {
    const int tid = otid(), wid = tid >> 6, lane = tid & 63;
    const float* sp = src + (size_t)(k0 + wid * 64) * ld + c0 + lane * 4;
    f32x4 m4 = {0.f, 0.f, 0.f, 0.f};
#pragma unroll 8
    for (int k = 0; k < 64; ++k) { const f32x4 v = *(const f32x4*)(sp + (size_t)k * ld); m4 = __builtin_elementwise_max(m4, __builtin_elementwise_abs(v)); }
    f32x4* red = (f32x4*)lds; red[wid * 64 + lane] = m4;
    __syncthreads();
    if (wid == 0) {
#pragma unroll
        for (int w = 1; w < 8; ++w) m4 = __builtin_elementwise_max(m4, red[w * 64 + lane]);
#pragma unroll
        for (int e = 0; e < 4; ++e) atomicMax(wam + map(c0 + lane * 4 + e), __float_as_uint(m4[e]));
    }
    __syncthreads();
}
struct ColId { __device__ __forceinline__ int operator()(int n) const { return n; } };
struct ColWin { __device__ __forceinline__ int operator()(int n) const { return in_src_col(n); } };
template <int K, int NCH, class M, class C = ColId> __device__ __forceinline__ void strip_unit(const float* src, int ld, int n0, signed char* dst, unsigned* wam, const M& map, char* lds, const C& colmap = C()) {
    constexpr int LPR = NCH / 4, RPP = 512 / LPR, NPASS = K / RPP, KS = K + 16, CH = 8;
    static_assert(NPASS % 4 == 0 && NPASS % CH == 0 || NPASS % 4 == 0, "strip geometry");
    const int tid = otid(), wid = tid >> 6, lane = tid & 63, tr = tid / LPR, m = tid % LPR;
    const int c4 = colmap(n0 + m * 4); const bool zcol = c4 < 0;
    const float* sp = src + (size_t)(tr * 4) * ld + (c4 < 0 ? 0 : c4);
    unsigned pk[NPASS][2]; f32x4 m4 = {0.f, 0.f, 0.f, 0.f};
    constexpr int NCK = (NPASS + CH - 1) / CH;
    f32x4 v[2][CH];
#pragma unroll
    for (int j = 0; j < CH; ++j) v[0][j] = *(const f32x4*)(sp + (size_t)((j >> 2) * (4 * RPP) + (j & 3)) * ld);
#pragma unroll
    for (int ck = 0; ck < NCK; ++ck) {
        if (ck + 1 < NCK) {
#pragma unroll
            for (int j = 0; j < CH; ++j) { const int i = (ck + 1) * CH + j; if (i < NPASS) v[(ck + 1) & 1][j] = *(const f32x4*)(sp + (size_t)((i >> 2) * (4 * RPP) + (i & 3)) * ld); }
        }
        __builtin_amdgcn_sched_barrier(0);
#pragma unroll
        for (int j = 0; j < CH; ++j) { const int i = ck * CH + j; if (i < NPASS) { const f32x4 x = zcol ? (f32x4){0.f, 0.f, 0.f, 0.f} : v[ck & 1][j]; m4 = __builtin_elementwise_max(m4, __builtin_elementwise_abs(x)); pk[i][0] = cvt_pk_bf16(x[0], x[1]); pk[i][1] = cvt_pk_bf16(x[2], x[3]); } }
        __builtin_amdgcn_sched_barrier(0);
    }
    float* red = (float*)(lds + NCH * KS);
#pragma unroll
    for (int e = 0; e < 4; ++e) { float a = m4[e];
#pragma unroll
        for (int o = LPR; o < 64; o <<= 1) a = fmaxf(a, shflx(a, o, lane));
        m4[e] = a; }
    if (lane < LPR) *(f32x4*)(red + (wid * LPR + m) * 4) = m4;
    __syncthreads();
    f32x4 mx = *(const f32x4*)(red + m * 4);
#pragma unroll
    for (int w = 1; w < 8; ++w) mx = __builtin_elementwise_max(mx, *(const f32x4*)(red + (w * LPR + m) * 4));
    if (tid < LPR) {
#pragma unroll
        for (int e = 0; e < 4; ++e) wam[map(n0 + m * 4 + e)] = __float_as_uint(mx[e]); }
    float inv[4];
#pragma unroll
    for (int e = 0; e < 4; ++e) inv[e] = 127.f / fmaxf(mx[e], 1e-30f);
    {   char* wb = lds + (size_t)(m * 4) * KS + tr * 4;
#pragma unroll
        for (int g = 0; g < NPASS / 4; ++g) {
#pragma unroll
            for (int e = 0; e < 4; ++e) { unsigned acc = 0u;
#pragma unroll
                for (int q4 = 0; q4 < 4; ++q4) { const unsigned w = pk[4 * g + q4][e >> 1]; const float f = __uint_as_float((e & 1) ? (w & 0xffff0000u) : (w << 16));
                    acc |= (unsigned)((int)rintf(f * inv[e]) & 255) << (8 * q4); }
                *(unsigned*)(wb + e * KS + g * (4 * RPP)) = acc; }
        }
    }
    __syncthreads();
#pragma unroll 1
    for (int j = tid; j < NCH * (K / 16); j += 512) { const int c = j / (K / 16), ch = j % (K / 16);
        *(u32x4*)(dst + (size_t)map(n0 + c) * K + ch * 16) = *(const u32x4*)(lds + (size_t)c * KS + ch * 16); }
    __syncthreads();
}
template <class F> __device__ __forceinline__ void wabsf_unit(const F& f, int n0, int k0, unsigned* wam, float* lds) {
    const int tid = otid(), wid = tid >> 6, lane = tid & 63;
    f32x4 m4 = {0.f, 0.f, 0.f, 0.f};
#pragma unroll 8
    for (int k = 0; k < 64; ++k) { const f32x4 v = f.ld4(k0 + wid * 64 + k, n0 + lane * 4); m4 = __builtin_elementwise_max(m4, __builtin_elementwise_abs(v)); }
    f32x4* red = (f32x4*)lds; red[wid * 64 + lane] = m4;
    __syncthreads();
    if (wid == 0) {
#pragma unroll
        for (int w = 1; w < 8; ++w) m4 = __builtin_elementwise_max(m4, red[w * 64 + lane]);
#pragma unroll
        for (int e = 0; e < 4; ++e) atomicMax(wam + n0 + lane * 4 + e, __float_as_uint(m4[e]));
    }
    __syncthreads();
}
struct MapW13 { int which; __device__ __forceinline__ int operator()(int col) const { return (col >> 7) * 256 + which * 128 + (col & 127); } };
struct MapId { __device__ __forceinline__ int operator()(int col) const { return col; } };
template <class F> __device__ __forceinline__ void tconv8_tile(const F& f, signed char* dst, int K, int k0, int n0, const unsigned* wam, float* tile, int lane) {
    f32x4 v[16];
    const int n4 = (lane & 15) * 4, kr = lane >> 4;
#pragma unroll
    for (int i = 0; i < 16; ++i) v[i] = f.ld4(k0 + kr + 4 * i, n0 + n4);
#pragma unroll
    for (int i = 0; i < 16; ++i) { float* t = tile + (kr + 4 * i) * 65 + n4; t[0] = v[i][0]; t[1] = v[i][1]; t[2] = v[i][2]; t[3] = v[i][3]; }
    __builtin_amdgcn_fence(__ATOMIC_RELEASE, "wavefront"); __builtin_amdgcn_wave_barrier(); __builtin_amdgcn_fence(__ATOMIC_ACQUIRE, "wavefront");
    const int kq = (lane & 3) * 16, nr = lane >> 2;
#pragma unroll
    for (int i = 0; i < 4; ++i) { const int nn = nr + 16 * i; const float inv = 127.f / fmaxf(__uint_as_float(wam[n0 + nn]), 1e-30f);
        unsigned w[4];
#pragma unroll
        for (int g4 = 0; g4 < 4; ++g4) { unsigned acc = 0u;
#pragma unroll
            for (int e = 0; e < 4; ++e) { const int q = (int)rintf(tile[(kq + g4 * 4 + e) * 65 + nn] * inv); acc |= (unsigned)(q & 255) << (8 * e); }
            w[g4] = acc; }
        *(u32x4*)(dst + (size_t)(n0 + nn) * K + k0 + kq) = (u32x4){w[0], w[1], w[2], w[3]}; }
    __builtin_amdgcn_fence(__ATOMIC_RELEASE, "wavefront"); __builtin_amdgcn_wave_barrier(); __builtin_amdgcn_fence(__ATOMIC_ACQUIRE, "wavefront");
}
__device__ __forceinline__ void tr_unit(const Params& p, int v, float* tile, int lane) {
    if (v < 2 * T_WOUT) { const int l = v / T_WOUT, t = v % T_WOUT, nt = t / 32, kt = t % 32;
        FPlain f{p.in[I_WOUT] + (size_t)l * D_ * D_, D_}; tconv_tile(f, p.wb_out() + (size_t)l * D_ * D_, D_, kt * 64, nt * 64, tile, lane); return; }
    v -= 2 * T_WOUT;
    if (v < 2 * T_MLA) { const int l = v / T_MLA, t = v % T_MLA, nt = t / 10, kt = t % 10;
        FMla f{p.in[I_MUQ] + (size_t)l * 448 * 768, p.in[I_MUKV] + (size_t)l * 128 * 1024, p.in[I_MQN] + l * 448, p.in[I_MKVN] + l * 128};
        tconv_tile(f, p.wb_mla() + (size_t)l * MLAN * MLAK, MLAK, kt * 64, nt * 64, tile, lane); return; }
}
__device__ __forceinline__ void pro_stream_unit(const Params& p, int v, float* lds) {
    if (v < U_MOD) { pro_mod_unit(p, v, lds); return; }
    v -= U_MOD;
    if (v < U_SBIG) { const int set = v / U_S2, s = v % U_S2; MapId mp;
        const float* src = set == 0 ? p.in[I_FW2] : p.in[I_MW2] + (size_t)(set - 1) * DFF * D_;
        signed char* dst = set == 0 ? (signed char*)p.wb_f2() : (signed char*)p.wb_m2() + (size_t)(set - 1) * D_ * DFF;
        strip_unit<DFF, 16>(src, D_, s * 16, dst, p.wam() + (set == 0 ? WAM_F2 : WAM_M2 + (set - 1) * D_), mp, (char*)lds); return; }
    v -= U_SBIG;
    if (v < U_SSMALL) { const int set = v / U_S13, w = v % U_S13, which = w / (DFF / 32), s = w % (DFF / 32); MapW13 mp{which};
        const float* src = set == 0 ? p.in[which ? I_FW3 : I_FW1] : p.in[which ? I_MW3 : I_MW1] + (size_t)(set - 1) * D_ * DFF;
        signed char* dst = set == 0 ? (signed char*)p.wb_f13() : (signed char*)p.wb_m13() + (size_t)(set - 1) * 2 * DFF * D_;
        strip_unit<D_, 32>(src, DFF, s * 32, dst, p.wam() + (set == 0 ? WAM_F13 : WAM_M13 + (set - 1) * 2 * DFF), mp, (char*)lds); return; }
    v -= U_SSMALL;
    if (v < U_WABS_IN) { const int l = v / (NP / 32), s = v % (NP / 32); MapId mp; ColWin cw;
        strip_unit<D_, 32>(p.in[I_WIN] + (size_t)l * D_ * DIN, DIN, s * 32, (signed char*)p.wb_in() + (size_t)l * NP * D_, p.wam() + WAM_IN + l * NP, mp, (char*)lds, cw); return; }
    v -= U_WABS_IN;
    { const int tid = otid(), wid = tid >> 6, lane = tid & 63; float* tile = lds + wid * (64 * 68);
      if (v * 8 + wid < U_TR) tr_unit(p, v * 8 + wid, tile, lane);
      __syncthreads(); }
}
__device__ __forceinline__ void phase_prologue(const Params& p, float* lds) {
    static_assert((U_HF - 1) * Q_STRIDE < U_QTOT, "every filter unit needs a queue slot");
    unsigned* qctr = p.cnt() + 24; volatile LAS unsigned* qw = (volatile LAS unsigned*)(LAS unsigned char*)((unsigned char*)lds + XBW_OFF_ - 32);
#pragma unroll 1
    for (;;) {
        __syncthreads();
        if (otid() == 0) qw[0] = atomicAdd(qctr, 1u);
        __syncthreads();
        const int q = (int)qw[0];
        if (q >= U_QTOT) break;
        const int nf = (q + Q_STRIDE - 1) / Q_STRIDE, nfb = nf < U_HF ? nf : U_HF;
        if (q % Q_STRIDE == 0 && q / Q_STRIDE < U_HF) { const int u = q / Q_STRIDE;
            if (u < 512) { const int l = u >> 8, tb = u & 255; pro_hfilt_unit(p, l, SEQ, tb, p.hfilt() + (size_t)l * 1024 * SEQ, p.hsum() + (size_t)l * 1024 * 256, lds); }
            else pro_hfilt_unit(p, 0, LC, u - 512, p.hfc(), p.hsc(), lds); }
        else pro_stream_unit(p, q - nfb, lds);
    }
    __syncthreads();
}
__device__ __forceinline__ void f13q_unit(const Params& p, int v, float* tile, int lane) {
    const int nt = v / 32, kt = v % 32; FW13 f{p.in[I_FW1], p.in[I_FW3]}; tconv8_tile(f, (signed char*)p.wb_f13(), D_, kt * 64, nt * 64, p.wam() + WAM_F13, tile, lane);
}
__device__ __forceinline__ void f2q_unit(const Params& p, int v, float* tile, int lane) {
    const int nt = v / 88, kt = v % 88; FPlain f{p.in[I_FW2], D_}; tconv8_tile(f, (signed char*)p.wb_f2(), DFF, kt * 64, nt * 64, p.wam() + WAM_F2, tile, lane);
}
__device__ __forceinline__ void winq_unit(const Params& p, int v, float* tile, int lane) {
    const int l = v / T_WIN, t = v % T_WIN, nt = t / 32, kt = t % 32; FWin f{p.in[I_WIN] + (size_t)l * D_ * DIN};
    tconv8_tile(f, (signed char*)p.wb_in() + (size_t)l * NP * D_, D_, kt * 64, nt * 64, p.wam() + WAM_IN + l * NP, tile, lane);
}
constexpr int T_M13 = NEXP * T_F13, T_M2 = NEXP * T_F2, U_MOEW = T_M13 + T_M2;
__device__ __forceinline__ void moe_w_unit(const Params& p, int v, float* tile, int lane) {
    if (v < T_M13) { const int e = v / T_F13, t = v % T_F13, nt = t / 32, kt = t % 32;
        FW13 f{p.in[I_MW1] + (size_t)e * D_ * DFF, p.in[I_MW3] + (size_t)e * D_ * DFF};
        tconv8_tile(f, (signed char*)p.wb_m13() + (size_t)e * 2 * DFF * D_, D_, kt * 64, nt * 64, p.wam() + WAM_M13 + e * 2 * DFF, tile, lane); return; }
    v -= T_M13;
    { const int e = v / T_F2, t = v % T_F2, nt = t / 88, kt = t % 88;
      FPlain f{p.in[I_MW2] + (size_t)e * DFF * D_, D_};
      tconv8_tile(f, (signed char*)p.wb_m2() + (size_t)e * D_ * DFF, DFF, kt * 64, nt * 64, p.wam() + WAM_M2 + e * D_, tile, lane); }
}

__device__ __forceinline__ void phase_norm(const Params& p, int layer, int which, int row_lo, unsigned char* shm) {
    const int tid = otid(), wid = tid >> 6, lane = tid & 63;
    const float* nw = p.in[which == 1 ? I_N1W : I_N2W] + (size_t)layer * D_;
    const int csh = (which == 1 ? 0 : 3) * D_, csc = (which == 1 ? 1 : 4) * D_;
    const bool route = (layer == 1 && which == 2);
    unsigned* lcnt = (unsigned*)shm; unsigned* lbase = lcnt + 8; int* recE = (int*)(lcnt + 16); int* recP = recE + 128;
    int kk = 0;
    f32x4* rtl = (f32x4*)(shm + 4096);
    if (route) { if (tid < 8) lcnt[tid] = 0u;
        const float* rt0 = p.in[I_ROUTER];
#pragma unroll
        for (int it = 0; it < 8; ++it) { const int pc = tid + it * 512;
            const int c = pc >> 1, hf = pc & 1; rtl[((c & 3) * 2 + hf) * 512 + (c >> 2)] = *(const f32x4*)(rt0 + (size_t)c * NEXP + hf * 4); }
        __syncthreads(); }
    for (int r = row_lo + blockIdx.x * 8 + wid; r < MT; r += gridDim.x * 8) {
        const bool isc = r < LC;
        const float* src = (layer == 0 && which == 1) ? (isc ? p.in[I_CTX] + (size_t)r * D_ : p.in[I_X] + (size_t)(r - LC) * D_)
                         : ((layer == 0 && isc) ? p.in[I_CTX] + (size_t)r * D_ : p.xcur() + (size_t)r * D_);
        const float* mv = p.modv() + ((size_t)layer * 2 + (isc ? 1 : 0)) * 6 * D_;
        const bool fixG = isc && layer == 0 && which == 2, fixF = isc && layer == 1 && which == 1;
        f32x4 xv[8]; float ss = 0.f;
#pragma unroll
        for (int i = 0; i < 8; ++i) { const int col = (i * 64 + lane) * 4; xv[i] = *(const f32x4*)(src + col);
            if (fixG || fixF) {
                const float* pp = (fixG ? p.partG() : p.partF()) + (size_t)r * D_ + col; const int ns = fixG ? 4 : 11;
                f32x4 a = {0.f, 0.f, 0.f, 0.f};
                for (int s2 = 0; s2 < ns; ++s2) a += *(const f32x4*)(pp + (size_t)s2 * LC * D_);
                const f32x4 g4 = *(const f32x4*)(p.modv() + ((size_t)(fixG ? 0 : 0) * 2 + 1) * 6 * D_ + (fixG ? 2 : 5) * D_ + col);
                xv[i] += g4 * a;
                if (fixG) *(f32x4*)(p.xcur() + (size_t)r * D_ + col) = xv[i];
            }
            ss += xv[i][0] * xv[i][0] + xv[i][1] * xv[i][1] + xv[i][2] * xv[i][2] + xv[i][3] * xv[i][3]; }
        ss = wave_sum(ss);
        const float rstd = rsqrtf(ss * (1.0f / D_) + EPS);
        float lg[NEXP];
#pragma unroll
        for (int e = 0; e < NEXP; ++e) lg[e] = 0.f;
        float qinv = 0.f;
        {   float am = 0.f;
#pragma unroll
            for (int i = 0; i < 8; ++i) { const int col = (i * 64 + lane) * 4;
                const f32x4 w4 = *(const f32x4*)(nw + col), sh = *(const f32x4*)(mv + csh + col), sc = *(const f32x4*)(mv + csc + col);
                xv[i] = (xv[i] * rstd) * w4 * (sc + 1.0f) + sh;
                am = fmaxf(am, fmaxf(fmaxf(fabsf(xv[i][0]), fabsf(xv[i][1])), fmaxf(fabsf(xv[i][2]), fabsf(xv[i][3])))); }
#pragma unroll
            for (int o = 32; o >= 1; o >>= 1) am = fmaxf(am, shflx(am, o, lane));
            am = fmaxf(am, 1e-20f); qinv = 127.f / am;
            if (lane == 0) p.hs()[r] = am * (1.0f / 127.f);
        }
#pragma unroll
        for (int i = 0; i < 8; ++i) { const int col = (i * 64 + lane) * 4;
            const f32x4 hv = xv[i];
            {
                const int q0 = (int)rintf(hv[0] * qinv), q1 = (int)rintf(hv[1] * qinv), q2 = (int)rintf(hv[2] * qinv), q3 = (int)rintf(hv[3] * qinv);
                *(unsigned*)((char*)p.hbuf() + (size_t)r * D_ + col) = (unsigned)(q0 & 255) | ((unsigned)(q1 & 255) << 8) | ((unsigned)(q2 & 255) << 16) | ((unsigned)(q3 & 255) << 24);
            }
            if (route) { const int cg = i * 64 + lane;
#pragma unroll
                for (int j = 0; j < 4; ++j) { const f32x4 r0 = rtl[(j * 2) * 512 + cg], r1 = rtl[(j * 2 + 1) * 512 + cg];
                    lg[0] += hv[j] * r0[0]; lg[1] += hv[j] * r0[1]; lg[2] += hv[j] * r0[2]; lg[3] += hv[j] * r0[3];
                    lg[4] += hv[j] * r1[0]; lg[5] += hv[j] * r1[1]; lg[6] += hv[j] * r1[2]; lg[7] += hv[j] * r1[3]; } }
        }
        if (route && !isc) {
#pragma unroll
            for (int e = 0; e < NEXP; ++e) lg[e] = wave_sum(lg[e]);
            if (lane == 0) {
                int e0 = 0; float v0 = lg[0];
#pragma unroll
                for (int e = 1; e < NEXP; ++e) if (lg[e] > v0) { v0 = lg[e]; e0 = e; }
                int e1 = -1; float v1 = -3.0e38f;
#pragma unroll
                for (int e = 0; e < NEXP; ++e) if (e != e0 && lg[e] > v1) { v1 = lg[e]; e1 = e; }
                const float w0 = 1.f / (1.f + expf(v1 - v0)), w1 = 1.f - w0;
                const int t = r - LC;
                const int p0 = (int)__hip_atomic_fetch_add(lcnt + e0, 1u, __ATOMIC_RELAXED, __HIP_MEMORY_SCOPE_WORKGROUP), p1 = (int)__hip_atomic_fetch_add(lcnt + e1, 1u, __ATOMIC_RELAXED, __HIP_MEMORY_SCOPE_WORKGROUP);
                const int ri = (wid * 8 + (kk & 7)) * 2;
                recE[ri] = e0; recE[ri + 1] = e1; recP[ri] = p0; recP[ri + 1] = p1;
                p.tok_e()[t * 2] = e0; p.tok_e()[t * 2 + 1] = e1; p.tok_w()[t * 2] = w0; p.tok_w()[t * 2 + 1] = w1;
            }
        }
        ++kk;
    }
    if (route) {
        __syncthreads();
        if (tid < 8) lbase[tid] = atomicAdd(&p.cnt()[tid], lcnt[tid]);
        __syncthreads();
        if (tid < 128) { const int w = (tid >> 1) & 7, k = tid >> 4, s = tid & 1; const int tt = (int)blockIdx.x * 8 + w + k * (int)gridDim.x * 8;
            if (tt < SEQ && k < kk) { const int ri = (w * 8 + k) * 2 + s; p.tok_p()[tt * 2 + s] = (int)lbase[recE[ri]] + recP[ri]; } }
        __syncthreads();
    }
}

__device__ __forceinline__ void phase_prep(const Params& p, int layer) {
    const int tid = otid(), wid = tid >> 6, lane = tid & 63;
    const float* gcw = p.in[I_GCONV] + (size_t)layer * 3 * 1536;
    const float LN1E4 = 9.210340371976184f;
    for (int r = blockIdx.x * 8 + wid; r < MT; r += gridDim.x * 8) {
        const bool isc = r < LC; const int t = r - LC;
        const bool hasp = isc ? (r > 0) : (r > LC), hasn = isc ? (r < LC - 1) : (r < MT - 1);
        const bf16_t* P0 = p.Pp() + (size_t)r * NP;
        const bf16_t* Pm = hasp ? P0 - NP : P0; const bf16_t* Pn = hasn ? P0 + NP : P0;
        u32x4 gx[3][3];
#pragma unroll
        for (int i = 0; i < 3; ++i) { const int ch = i * 512 + lane * 8; gx[i][0] = *(const u32x4*)(Pm + PC_GQKV + ch); gx[i][1] = *(const u32x4*)(P0 + PC_GQKV + ch); gx[i][2] = *(const u32x4*)(Pn + PC_GQKV + ch); }
        const bf16_t gab = P0[PC_A + (lane & 7)], gbb = P0[PC_B + (lane & 7)];
        const u32x4 cqr = *(const u32x4*)(P0 + PC_CQ + (lane < 56 ? lane : 55) * 8), ckr = *(const u32x4*)(P0 + PC_CKV + (lane & 15) * 8);
        const bf16_t kr1 = P0[PC_KR + ((lane >> 4) & 1) * 32 + (lane & 15)], kr2 = P0[PC_KR + ((lane >> 4) & 1) * 32 + (lane & 15) + 16];
        bf16_t rq[8][2];
#pragma unroll
        for (int it = 0; it < 8; ++it) { const int o = (it >> 2) * 512 + (it & 3) * 128 + lane; rq[it][0] = P0[PC_RQKV + o]; rq[it][1] = P0[PC_RQKV + o + 64]; }
#pragma unroll
        for (int i = 0; i < 3; ++i) {
            const int ch = i * 512 + lane * 8;
            float x0[8], xm[8], xn[8], y[8];
            unpack8(gx[i][1], x0); unpack8(gx[i][0], xm); unpack8(gx[i][2], xn);
            const float fm = hasp ? 1.f : 0.f, fn = hasn ? 1.f : 0.f;
            float ss = 0.f;
#pragma unroll
            for (int e = 0; e < 8; ++e) { const float v = gcw[ch + e] * (xm[e] * fm) + gcw[1536 + ch + e] * x0[e] + gcw[3072 + ch + e] * (xn[e] * fn); y[e] = silu_f(v); ss += y[e] * y[e]; }
            if (i < 2) { ss = sum16(ss); const float rn = rsqrtf(ss + EPS) * (i == 0 ? 0.08838834764831845f : 1.f);
#pragma unroll
                for (int e = 0; e < 8; ++e) y[e] *= rn; }
            *(u32x4*)(p.gqkv() + (size_t)r * 1536 + ch) = pack8(y);
        }
        if (lane < 8) {
            const float a = bf2f(gab), b = bf2f(gbb);
            const float g = -expf(p.in[I_GALOG][layer * 8 + lane]) * softplus_f(a + p.in[I_GDT][layer * 8 + lane]);
            p.ggb()[(size_t)r * 16 + lane] = g; p.ggb()[(size_t)r * 16 + 8 + lane] = sigmoid_f(b);
        }
        {   float sq = 0.f, sk = 0.f;
            if (lane < 56) { float f[8]; unpack8(cqr, f);
#pragma unroll
                for (int e = 0; e < 8; ++e) sq += f[e] * f[e]; }
            if (lane < 16) { float f[8]; unpack8(ckr, f);
#pragma unroll
                for (int e = 0; e < 8; ++e) sk += f[e] * f[e]; }
            sq = wave_sum(sq); sk = wave_sum(sk);
            if (lane == 0) { p.mrs()[(size_t)r * 2] = rsqrtf(sq * (1.0f / 448.f) + EPS); p.mrs()[(size_t)r * 2 + 1] = rsqrtf(sk * (1.0f / 128.f) + EPS); }
        }
        if (lane < 32) {
            const int i = lane & 15, half = lane >> 4;
            const float x1 = bf2f(kr1), x2 = bf2f(kr2);
            float o1 = x1, o2 = x2;
            if (!isc) { const float pos = (float)(half ? (t & 63) : (t >> 6)); const float inv = expf(-(float)i * (LN1E4 / 16.f)); float s, c; sincosf(pos * inv, &s, &c);
                o1 = x1 * c - x2 * s; o2 = x2 * c + x1 * s; }
            p.krr()[(size_t)r * 64 + half * 32 + i] = f2bf(o1); p.krr()[(size_t)r * 64 + half * 32 + i + 16] = f2bf(o2);
        }
        {   float s = 0.f, c = 1.f;
            if (!isc) { const float inv = expf(-(float)lane * (LN1E4 / 64.f)); sincosf((float)t * inv, &s, &c); }
#pragma unroll
            for (int it = 0; it < 8; ++it) { const int which = it >> 2, hd = it & 3; const int o = which * 512 + hd * 128 + lane;
                const float x1 = bf2f(rq[it][0]), x2 = bf2f(rq[it][1]); const float sc = which ? 0.08838834764831845f : 1.f;
                p.rqk()[(size_t)r * 1024 + o] = f2bf((x1 * c - x2 * s) * sc); p.rqk()[(size_t)r * 1024 + o + 64] = f2bf((x2 * c + x1 * s) * sc); }
        }
    }
}
namespace att {
constexpr int NW = 8, QBLK = 32, KVBLK = 64, DK = 192, DV = 128;
constexpr float SCALE = 0.07216878364870322f;
constexpr float THR = 8.f;
constexpr int LDQ = MLAN, LDKN = MLAN, LDKR = 64, LDV = MLAN, LDO = D_;
constexpr int SHM_V = KVBLK * DV * 2, SHM_K = KVBLK * DK * 2, SHM_ATTN = 2 * SHM_V + 2 * SHM_K + NW * 64 * 4;
#define KSWZ(row, colB) ((row) * 384 + ((colB) ^ ((((row) >> 1) & 7) << 4)))
#define SBAR() __builtin_amdgcn_sched_barrier(0)
__device__ __forceinline__ int crow(int r, int hi) { return (r & 3) + 8 * (r >> 2) + 4 * hi; }
__device__ __forceinline__ void partialSM(f32x16& p0, f32x16& p1, float& m_reg, float& mn, float& alpha) {
    constexpr float C = SCALE * 1.4426950408889634f;
    float pmax = p0[0];
#pragma unroll
    for (int r = 1; r < 16; ++r) pmax = fmaxf(pmax, p0[r]);
#pragma unroll
    for (int r = 0; r < 16; ++r) pmax = fmaxf(pmax, p1[r]);
    { auto rr = __builtin_amdgcn_permlane32_swap(__float_as_uint(pmax), __float_as_uint(pmax), false, false);
      pmax = fmaxf(__uint_as_float(rr[0]), __uint_as_float(rr[1])); }
    if (__builtin_expect(__all(pmax - m_reg <= THR / SCALE), 1)) { mn = m_reg; alpha = 1.f; }
    else { mn = fmaxf(m_reg, pmax); alpha = __builtin_amdgcn_exp2f((m_reg - mn) * C); m_reg = mn; }
    const float mnC = -mn * C;
#pragma unroll
    for (int r = 0; r < 16; ++r) p0[r] = fmaf(p0[r], C, mnC);
#pragma unroll
    for (int r = 0; r < 16; ++r) p1[r] = fmaf(p1[r], C, mnC);
#pragma unroll
    for (int r = 0; r < 16; ++r) p0[r] = __builtin_amdgcn_exp2f(p0[r]);
}
__device__ __forceinline__ void finishSM(f32x16& p0, f32x16& p1, float alpha, float& l_reg, bf16x8& pa0, bf16x8& pa1, bf16x8& pa2, bf16x8& pa3) {
#pragma unroll
    for (int r = 0; r < 16; ++r) p1[r] = __builtin_amdgcn_exp2f(p1[r]);
    float ps = 0;
#pragma unroll
    for (int r = 0; r < 16; ++r) ps += p0[r];
#pragma unroll
    for (int r = 0; r < 16; ++r) ps += p1[r];
    { auto rr = __builtin_amdgcn_permlane32_swap(__float_as_uint(ps), __float_as_uint(ps), false, false);
      ps = __uint_as_float(rr[0]) + __uint_as_float(rr[1]); }
    l_reg = l_reg * alpha + ps;
#define PK4(P, BASE, OUT) do { unsigned a0 = cvt_pk_bf16(P[BASE + 0], P[BASE + 1]), a1 = cvt_pk_bf16(P[BASE + 2], P[BASE + 3]);   \
    unsigned b0 = cvt_pk_bf16(P[BASE + 4], P[BASE + 5]), b1 = cvt_pk_bf16(P[BASE + 6], P[BASE + 7]);                              \
    auto r0 = __builtin_amdgcn_permlane32_swap(a0, b0, false, false); auto r1 = __builtin_amdgcn_permlane32_swap(a1, b1, false, false); \
    u32x4 w = {r0[0], r1[0], r0[1], r1[1]}; OUT = *reinterpret_cast<bf16x8*>(&w); } while (0)
    PK4(p0, 0, pa0); PK4(p0, 8, pa1); PK4(p1, 0, pa2); PK4(p1, 8, pa3);
#undef PK4
}
__device__ __forceinline__ void qkt(f32x16& p0, f32x16& p1, const int (&ka)[4], int boff, const bf16x8* qr) {
    p0 = f32x16{}; p1 = f32x16{};
    bf16x8 kb[3][2];
#define QK_LD(D0) do { const int dl_ = (D0) & 3, dh_ = (D0) >> 2; kb[(D0) % 3][0] = *(const LAS bf16x8*)(unsigned)(ka[dl_] + (boff + dh_ * 128)); \
        kb[(D0) % 3][1] = *(const LAS bf16x8*)(unsigned)(ka[dl_] + (boff + dh_ * 128 + 32 * 384)); } while (0)
    QK_LD(0); QK_LD(1);
#pragma unroll
    for (int d0 = 0; d0 < 12; ++d0) {
        if (d0 + 2 < 12) QK_LD(d0 + 2);
        p0 = __builtin_amdgcn_mfma_f32_32x32x16_bf16(kb[d0 % 3][0], qr[d0], p0, 0, 0, 0);
        p1 = __builtin_amdgcn_mfma_f32_32x32x16_bf16(kb[d0 % 3][1], qr[d0], p1, 0, 0, 0);
    }
#undef QK_LD
}
__device__ __forceinline__ int v_st(int k, int c) { const int kk = (k & ~0xC) | ((k & 4) << 1) | ((k & 8) >> 1); return ((kk >> 3) * 4 + (c >> 5)) * 512 + ((kk & 7) * 32 + (c & 31)) * 2; }
__device__ __forceinline__ int v_rd_base(int lane) { return ((lane & 3) << 3) | (((lane >> 2) & 3) << 6) | (((lane >> 4) & 1) << 5) | (((lane >> 5) & 1) << 8); }
constexpr int v_rd_off(int d0, int ks, int half) { return d0 * 512 + ks * 4096 + half * 2048; }
template <int OFF> __device__ __forceinline__ s16x4 tr_read(int vb) {
    s16x4 r; asm volatile("ds_read_b64_tr_b16 %0, %1 offset:%2" : "=&v"(r) : "v"(vb), "i"(OFF) : "memory"); return r;
}
template <int D0> __device__ __forceinline__ void pv_one(f32x16& od, int vb, bf16x8 pa0, bf16x8 pa1, bf16x8 pa2, bf16x8 pa3) {
    const s16x4 l0 = tr_read<v_rd_off(D0, 0, 0)>(vb), h0 = tr_read<v_rd_off(D0, 0, 1)>(vb), l1 = tr_read<v_rd_off(D0, 1, 0)>(vb), h1 = tr_read<v_rd_off(D0, 1, 1)>(vb);
    const s16x4 l2 = tr_read<v_rd_off(D0, 2, 0)>(vb), h2 = tr_read<v_rd_off(D0, 2, 1)>(vb), l3 = tr_read<v_rd_off(D0, 3, 0)>(vb), h3 = tr_read<v_rd_off(D0, 3, 1)>(vb);
    asm volatile("s_waitcnt lgkmcnt(0)" ::: "memory"); SBAR();
#define PK(L, H) (bf16x8){L[0], L[1], L[2], L[3], H[0], H[1], H[2], H[3]}
    od = __builtin_amdgcn_mfma_f32_32x32x16_bf16(pa0, PK(l0, h0), od, 0, 0, 0);
    od = __builtin_amdgcn_mfma_f32_32x32x16_bf16(pa1, PK(l1, h1), od, 0, 0, 0);
    od = __builtin_amdgcn_mfma_f32_32x32x16_bf16(pa2, PK(l2, h2), od, 0, 0, 0);
    od = __builtin_amdgcn_mfma_f32_32x32x16_bf16(pa3, PK(l3, h3), od, 0, 0, 0);
#undef PK
}
__device__ __forceinline__ void pv_d0(f32x16* o, int vb, bf16x8 pa0, bf16x8 pa1, bf16x8 pa2, bf16x8 pa3) {
    pv_one<0>(o[0], vb, pa0, pa1, pa2, pa3); pv_one<1>(o[1], vb, pa0, pa1, pa2, pa3); pv_one<2>(o[2], vb, pa0, pa1, pa2, pa3); pv_one<3>(o[3], vb, pa0, pa1, pa2, pa3);
}
__device__ __forceinline__ void attn_body(const bf16_t* __restrict__ Qb, const bf16_t* __restrict__ Kn, const bf16_t* __restrict__ Kr, const bf16_t* __restrict__ Vh,
                                          bf16_t* __restrict__ Ob, int seq, int rope_t0, char* lds, float* __restrict__ Opart, float* __restrict__ MLpart) {
    const int tid = otid(), wid = tid >> 6, lane = tid & 63, r32 = lane & 31, hi = lane >> 5;
    char* V_lds = lds; char* K_lds = lds + 2 * SHM_V;
    float* ws = (float*)(lds + 2 * SHM_V + 2 * SHM_K) + wid * 64; float* li_l = ws; float* al_l = ws + 32;
    float m_reg = -1e30f, l_reg = 0; f32x16 o[4] = {}; bf16x8 qr[12];
    const bf16_t* Qw = Qb + (long)(wid * QBLK + r32) * LDQ + hi * 8;
#pragma unroll
    for (int d0 = 0; d0 < 8; ++d0) qr[d0] = *reinterpret_cast<const bf16x8*>(Qw + d0 * 16);
    {
        bf16_t* Qr = (bf16_t*)(lds + SHM_ATTN);
        bf16_t qa[16][2];
#pragma unroll
        for (int it = 0; it < 16; ++it) { const int item = tid + it * 512, row = item >> 5, pr = item & 31; const bf16_t* qp = Qb + (long)row * LDQ + 128 + (pr >> 4) * 32 + (pr & 15); qa[it][0] = qp[0]; qa[it][1] = qp[16]; }
#pragma unroll
        for (int it = 0; it < 16; ++it) { const int item = tid + it * 512, row = item >> 5, pr = item & 31, half = pr >> 4, i = pr & 15;
            const float x1 = bf2f(qa[it][0]), x2 = bf2f(qa[it][1]); float o1 = x1, o2 = x2;
            if (rope_t0 >= 0) { const int t = rope_t0 + row; const float pos = (float)(half ? (t & 63) : (t >> 6));
                const float inv = expf(-(float)i * (9.210340371976184f / 16.f)); float s, c; sincosf(pos * inv, &s, &c);
                o1 = x1 * c - x2 * s; o2 = x2 * c + x1 * s; }
            Qr[row * 64 + half * 32 + i] = f2bf(o1); Qr[row * 64 + half * 32 + i + 16] = f2bf(o2); }
        __syncthreads();
#pragma unroll
        for (int dd = 0; dd < 4; ++dd) qr[8 + dd] = *reinterpret_cast<const bf16x8*>(Qr + (wid * QBLK + r32) * 64 + dd * 16 + hi * 8);
    }
    const int sr = tid >> 4, sc = (tid & 15) * 8, vst0 = v_st(sr, sc), vst1 = v_st(32 + sr, sc);
    const int rr = tid >> 3, rc = (tid & 7) * 8;
    const int vb0 = (int)(uintptr_t)V_lds + v_rd_base(lane);
    int ka[4];
#pragma unroll
    for (int dl = 0; dl < 4; ++dl) ka[dl] = (int)(uintptr_t)K_lds + r32 * 384 + ((dl * 32 + hi * 16) ^ (((r32 >> 1) & 7) << 4));
    struct { bf16x8 vs0, vs1, ks0, ks1, kr; } sr_[1];
    const unsigned ovA = (unsigned)(sr * LDV + sc) * 2u, ovB = (unsigned)((32 + sr) * LDV + sc) * 2u, orr = (unsigned)(rr * LDKR + rc) * 2u;
#define SLOAD(i, k0) do { const char* vbp = (const char*)Vh + (size_t)(k0) * (LDV * 2); const char* kbp = (const char*)Kn + (size_t)(k0) * (LDKN * 2); const char* rbp = (const char*)Kr + (size_t)(k0) * (LDKR * 2); \
    sr_[i].vs0 = *(const bf16x8*)(vbp + ovA); sr_[i].vs1 = *(const bf16x8*)(vbp + ovB); \
    sr_[i].ks0 = *(const bf16x8*)(kbp + ovA); sr_[i].ks1 = *(const bf16x8*)(kbp + ovB); \
    sr_[i].kr = *(const bf16x8*)(rbp + orr); } while (0)
#define SWRITE(b, i) do { *(bf16x8*)(V_lds + (b) * SHM_V + vst0) = sr_[i].vs0; *(bf16x8*)(V_lds + (b) * SHM_V + vst1) = sr_[i].vs1; const int kc = sc * 2; \
    *(bf16x8*)(K_lds + (b) * SHM_K + KSWZ(sr, kc)) = sr_[i].ks0; *(bf16x8*)(K_lds + (b) * SHM_K + KSWZ(32 + sr, kc)) = sr_[i].ks1; \
    *(bf16x8*)(K_lds + (b) * SHM_K + KSWZ(rr, 256 + rc * 2)) = sr_[i].kr; } while (0)
#define SWAIT() asm volatile("s_waitcnt vmcnt(0)" ::: "memory")
#define RESC(a) do { if (__any((a) < 1.f)) { if (hi == 0) al_l[r32] = (a); asm volatile("s_waitcnt lgkmcnt(0)" ::: "memory"); \
    _Pragma("unroll") for (int d = 0; d < 4; ++d) _Pragma("unroll") for (int r = 0; r < 16; ++r) o[d][r] *= al_l[crow(r, hi)]; } } while (0)
    f32x16 pA0, pA1, pB0, pB1; float mnA, mnB, alA, alB; bf16x8 pa0, pa1, pa2, pa3; const int NT = seq / KVBLK;
    constexpr int SE = 0, SO = 0;
    SLOAD(SE, 0); asm volatile("s_waitcnt vmcnt(0)" ::: "memory"); SWRITE(0, SE); __syncthreads();
    qkt(pA0, pA1, ka, 0, qr); partialSM(pA0, pA1, m_reg, mnA, alA);
    SLOAD(SO, KVBLK);
    SWAIT(); SWRITE(1, SO); __syncthreads();
    for (int j = 1; j + 1 < NT; j += 2) {
        SBAR(); qkt(pB0, pB1, ka, SHM_K, qr);
        finishSM(pA0, pA1, alA, l_reg, pa0, pa1, pa2, pa3); SBAR();
        SLOAD(SO, (j + 1) * KVBLK); SBAR();
        pv_d0(o, vb0, pa0, pa1, pa2, pa3); partialSM(pB0, pB1, m_reg, mnB, alB);
        __syncthreads(); SWAIT(); SWRITE(0, SE);
        RESC(alB); __syncthreads();
        SBAR(); qkt(pA0, pA1, ka, 0, qr);
        finishSM(pB0, pB1, alB, l_reg, pa0, pa1, pa2, pa3); SBAR();
        SLOAD(SE, (j + 2) * KVBLK); SBAR();
        pv_d0(o, vb0 + SHM_V, pa0, pa1, pa2, pa3); partialSM(pA0, pA1, m_reg, mnA, alA);
        __syncthreads(); SWAIT(); SWRITE(1, SO);
        RESC(alA); __syncthreads();
    }
    SBAR(); qkt(pB0, pB1, ka, SHM_K, qr);
    finishSM(pA0, pA1, alA, l_reg, pa0, pa1, pa2, pa3); SBAR();
    pv_d0(o, vb0, pa0, pa1, pa2, pa3); partialSM(pB0, pB1, m_reg, mnB, alB);
    __syncthreads(); RESC(alB);
    finishSM(pB0, pB1, alB, l_reg, pa0, pa1, pa2, pa3); SBAR();
    pv_d0(o, vb0 + SHM_V, pa0, pa1, pa2, pa3);
    if (Opart != nullptr) {
        if (hi == 0) { MLpart[(wid * QBLK + r32) * 2] = m_reg; MLpart[(wid * QBLK + r32) * 2 + 1] = l_reg; }
#pragma unroll
        for (int r = 0; r < 16; ++r) { const int orow = wid * QBLK + crow(r, hi);
#pragma unroll
            for (int d0 = 0; d0 < 4; ++d0) Opart[orow * 128 + d0 * 32 + r32] = o[d0][r]; }
        __syncthreads();
        return;
    }
    if (hi == 0) li_l[r32] = l_reg; asm volatile("s_waitcnt lgkmcnt(0)" ::: "memory");
    float rli[16];
#pragma unroll
    for (int r = 0; r < 16; ++r) rli[r] = __builtin_amdgcn_rcpf(li_l[crow(r, hi)]);
    bf16_t* Ow = Ob + (long)(wid * QBLK) * LDO;
#pragma unroll
    for (int r = 0; r < 16; ++r) { const int orow = crow(r, hi);
#pragma unroll
        for (int d0 = 0; d0 < 4; ++d0) Ow[(long)orow * LDO + d0 * 32 + r32] = f2bf(o[d0][r] * rli[r]); }
    __syncthreads();
#undef SLOAD
#undef SWRITE
#undef SWAIT
#undef RESC
}
}

constexpr int ATT_SPLIT_K0[4] = {0, 4096, 8192, 12416};
constexpr size_t ATT_PART_FLOATS = 256 * 128 + 512;
__device__ __forceinline__ void attn_unit(const Params& p, int u, int sp, char* lds) {
    const bool lat = u < 256;
    const int xcd = u & 7, h = lat ? (xcd >> 1) : (u - 256), qb = (u >> 3) * 2 + (xcd & 1);
    const int row0 = lat ? LC + qb * 256 : 0;
    const int k0 = sp < 0 ? 0 : (sp == 0 ? 0 : (sp == 1 ? 4096 : (sp == 2 ? 8192 : 12416)));
    const int nk = sp < 0 ? (lat ? MT : LC) : (sp < 2 ? 4096 : 4224);
    float* part = sp < 0 ? nullptr : p.attp() + (size_t)(u * 4 + sp) * ATT_PART_FLOATS;
    att::attn_body(p.qkvup() + (size_t)row0 * MLAN + h * 192, p.qkvup() + (size_t)k0 * MLAN + 768 + h * 256, p.krr() + (size_t)k0 * 64, p.qkvup() + (size_t)k0 * MLAN + 768 + h * 256 + 128,
                   p.ocat() + (size_t)row0 * D_ + 512 + h * 128, nk, lat ? qb * 256 : -1, lds, part, part ? part + 256 * 128 : nullptr);
}
__device__ __forceinline__ void phase_attn(const Params& p, int layer, char* lds) {
    const int nunits = 256 + (layer == 0 ? 4 : 0);
#pragma unroll 1
    for (int u = blockIdx.x; u < nunits; u += gridDim.x) attn_unit(p, u, -1, lds);
}

__device__ __forceinline__ void phase_rec_naive(const Params& p, int layer, float* lds) {
    const int tid = otid();
    float* kq = lds;
    float* vv = lds + 32 * 256;
    float* ab = vv + 32 * 128;
    for (int u = blockIdx.x; u < 16; u += gridDim.x) {
        const int kind = u >> 3, dir = (u >> 2) & 1, h = u & 3;
        float S[128];
#pragma unroll
        for (int i = 0; i < 128; ++i) S[i] = 0.f;
        const float gam = 1.0f - exp2f(-(float)((dir ? 6 : 5) + 2 * h));
        float* outp = (kind == 0 ? p.go() : p.ro()) + (size_t)dir * MT * 512 + h * 128;
        for (int s0 = 0; s0 < MT; s0 += 32) {
            __syncthreads();
            {   const int tk = tid >> 4, seg = (tid & 15) * 16; const int s = s0 + tk;
                const int row = dir == 0 ? s : (s < LC ? LC - 1 - s : MT + LC - 1 - s);
                const bf16_t* src;
                if (kind == 0) src = p.gqkv() + (size_t)row * 1536 + (seg < 128 ? 512 + h * 128 + seg : h * 128 + (seg - 128));
                else           src = p.rqk() + (size_t)row * 1024 + (seg < 128 ? 512 + h * 128 + seg : h * 128 + (seg - 128));
                float f[8]; unpack8(*(const u32x4*)src, f);
#pragma unroll
                for (int e = 0; e < 8; ++e) kq[tk * 256 + seg + e] = f[e];
                unpack8(*(const u32x4*)(src + 8), f);
#pragma unroll
                for (int e = 0; e < 8; ++e) kq[tk * 256 + seg + 8 + e] = f[e];
                const int vseg = (tid & 15) * 8;
                const bf16_t* vsrc = kind == 0 ? p.gqkv() + (size_t)row * 1536 + 1024 + h * 128 + vseg : p.Pp() + (size_t)row * NP + PC_RQKV + 1024 + h * 128 + vseg;
                unpack8(*(const u32x4*)vsrc, f);
#pragma unroll
                for (int e = 0; e < 8; ++e) vv[tk * 128 + vseg + e] = f[e];
                if (tid < 32) { const int s2 = s0 + tid; const int row2 = dir == 0 ? s2 : (s2 < LC ? LC - 1 - s2 : MT + LC - 1 - s2);
                    if (kind == 0) { ab[tid * 2] = expf(p.ggb()[(size_t)row2 * 16 + dir * 4 + h]); ab[tid * 2 + 1] = p.ggb()[(size_t)row2 * 16 + 8 + dir * 4 + h]; }
                    else { ab[tid * 2] = gam; ab[tid * 2 + 1] = 1.f; } }
            }
            __syncthreads();
            if (tid < 128) {
                for (int tk = 0; tk < 32; ++tk) {
                    const f32x4* kp = (const f32x4*)(kq + tk * 256); const f32x4* qp = kp + 32;
                    const float a = ab[tk * 2], b = ab[tk * 2 + 1], v = vv[tk * 128 + tid];
                    float dv;
                    if (kind == 0) { float ks = 0.f;
#pragma unroll
                        for (int i = 0; i < 32; ++i) { const f32x4 k4 = kp[i]; ks += k4[0] * S[4 * i] + k4[1] * S[4 * i + 1] + k4[2] * S[4 * i + 2] + k4[3] * S[4 * i + 3]; }
                        dv = b * (v - a * ks); }
                    else dv = v;
                    float o = 0.f;
#pragma unroll
                    for (int i = 0; i < 32; ++i) { const f32x4 k4 = kp[i], q4 = qp[i];
                        S[4 * i] = a * S[4 * i] + k4[0] * dv; S[4 * i + 1] = a * S[4 * i + 1] + k4[1] * dv; S[4 * i + 2] = a * S[4 * i + 2] + k4[2] * dv; S[4 * i + 3] = a * S[4 * i + 3] + k4[3] * dv;
                        o += q4[0] * S[4 * i] + q4[1] * S[4 * i + 1] + q4[2] * S[4 * i + 2] + q4[3] * S[4 * i + 3]; }
                    const int s = s0 + tk; const int row = dir == 0 ? s : (s < LC ? LC - 1 - s : MT + LC - 1 - s);
                    outp[(size_t)row * 512 + tid] = o;
                }
            }
        }
        __syncthreads();
    }
}

__device__ __forceinline__ void phase_mixout(const Params& p, int layer) {
    const int tid = otid(), wid = tid >> 6, lane = tid & 63;
    const float* gnw = p.in[I_GNW] + layer * 128;
    for (int r = blockIdx.x * 8 + wid; r < MT; r += gridDim.x * 8) {
        const int idx = lane * 8;
        f32x4 ga[2][4]; u32x4 zr[2]; float gw8[8];
        { const f32x4 g0 = *(const f32x4*)(gnw + (idx & 127)), g1 = *(const f32x4*)(gnw + (idx & 127) + 4); gw8[0] = g0[0]; gw8[1] = g0[1]; gw8[2] = g0[2]; gw8[3] = g0[3]; gw8[4] = g1[0]; gw8[5] = g1[1]; gw8[6] = g1[2]; gw8[7] = g1[3]; }
#pragma unroll
        for (int kind = 0; kind < 2; ++kind) {
            const float* o0 = (kind == 0 ? p.go() : p.ro()) + (size_t)r * 512 + idx; const float* o1 = o0 + (size_t)MT * 512;
            ga[kind][0] = *(const f32x4*)o0; ga[kind][1] = *(const f32x4*)(o0 + 4); ga[kind][2] = *(const f32x4*)o1; ga[kind][3] = *(const f32x4*)(o1 + 4);
            zr[kind] = *(const u32x4*)(p.Pp() + (size_t)r * NP + (kind == 0 ? PC_GZ : PC_RG) + idx); }
        if (r >= LC && r < LC + 1024) {
            const int qb = (r - LC) >> 8, rl = (r - LC) & 255, hh = lane >> 4, col = (lane & 15) * 8;
            const int uu = (qb >> 1) * 8 + 2 * hh + (qb & 1);
            const float* pb = p.attp() + (size_t)(uu * 4) * ATT_PART_FLOATS;
            float mm[4], ll[4], M = -3.0e38f;
#pragma unroll
            for (int s4 = 0; s4 < 4; ++s4) { mm[s4] = pb[s4 * ATT_PART_FLOATS + 256 * 128 + rl * 2]; ll[s4] = pb[s4 * ATT_PART_FLOATS + 256 * 128 + rl * 2 + 1]; M = fmaxf(M, mm[s4]); }
            float acc[8] = {0.f, 0.f, 0.f, 0.f, 0.f, 0.f, 0.f, 0.f}, L = 0.f;
#pragma unroll
            for (int s4 = 0; s4 < 4; ++s4) { const float w = __builtin_amdgcn_exp2f((mm[s4] - M) * (att::SCALE * 1.4426950408889634f)); L += w * ll[s4];
                const f32x4 o0 = *(const f32x4*)(pb + s4 * ATT_PART_FLOATS + rl * 128 + col), o1 = *(const f32x4*)(pb + s4 * ATT_PART_FLOATS + rl * 128 + col + 4);
#pragma unroll
                for (int e = 0; e < 4; ++e) { acc[e] += w * o0[e]; acc[4 + e] += w * o1[e]; } }
            const float il = 1.0f / L;
#pragma unroll
            for (int e = 0; e < 8; ++e) acc[e] *= il;
            *(u32x4*)(p.ocat() + (size_t)r * D_ + 512 + hh * 128 + col) = pack8(acc);
        }
#pragma unroll
        for (int kind = 0; kind < 2; ++kind) {
            float o[8]; float ss = 0.f;
#pragma unroll
            for (int e = 0; e < 4; ++e) { o[e] = ga[kind][0][e] + ga[kind][2][e]; o[4 + e] = ga[kind][1][e] + ga[kind][3][e]; }
#pragma unroll
            for (int e = 0; e < 8; ++e) ss += o[e] * o[e];
            ss = sum16(ss);
            const float rn = rsqrtf(ss * (1.0f / 128.f) + EPS);
            float z[8]; unpack8(zr[kind], z);
            float y[8];
#pragma unroll
            for (int e = 0; e < 8; ++e) { const float w = kind == 0 ? gw8[e] : 1.f; y[e] = o[e] * rn * w * silu_f(z[e]); }
            *(u32x4*)(p.ocat() + (size_t)r * D_ + (kind == 0 ? 0 : 1536) + idx) = pack8(y);
        }
    }
}
constexpr int NCHUNK = MT / 64;
constexpr size_t REC_Q = 0, REC_KT = 16384, REC_A = 32768, REC_W = 40960, REC_U = 57344, REC_DL = 73728, REC_BYTES = 73984;
__device__ __forceinline__ int scan_row(int dir, int s) { return dir == 0 ? s : (s < LC ? LC - 1 - s : MT + LC - 1 - s); }
__device__ __forceinline__ int crow32(int r, int hi) { return (r & 3) + 8 * (r >> 2) + 4 * hi; }

constexpr int CP_LDS = 70656;
__device__ __forceinline__ void chunkprep_pair(const Params& p, int layer, int u0, char* lds0) {
    const int tid = otid(), half = tid >> 8, t = tid & 255, hw = (tid >> 6) & 3, lane = tid & 63, r32 = lane & 31, hi = lane >> 5;
    const int u = u0 + half; const bool valid = u < 16 * NCHUNK;
    const int c = valid ? (u & 15) : 0, n = valid ? (u >> 4) : 0;
    const int kind = c >> 3, dir = (c >> 2) & 1, h = c & 3;
    char* lds = lds0 + half * CP_LDS;
    char* qL = lds; char* kL = lds + 17408; char* vL = lds + 34816; float* AM = (float*)(lds + 52224); float* scv = (float*)(lds + 69632);
    float* gcL = scv; float* btL = scv + 64; float* egL = scv + 128; float* ekL = scv + 192;
    char* rec = p.recs() + ((size_t)c * NCHUNK + n) * REC_BYTES;
    if (valid) {
        const int tk = t >> 2, seg = (t & 3) * 32; const int row = scan_row(dir, n * 64 + tk);
        const bf16_t *qs, *ks, *vs;
        if (kind == 0) { const bf16_t* b = p.gqkv() + (size_t)row * 1536 + h * 128 + seg; qs = b; ks = b + 512; vs = b + 1024; }
        else { const bf16_t* b = p.rqk() + (size_t)row * 1024 + h * 128 + seg; qs = b; ks = b + 512; vs = p.Pp() + (size_t)row * NP + PC_RQKV + 1024 + h * 128 + seg; }
        u32x4 qv[4], kv[4], vv[4];
#pragma unroll
        for (int k = 0; k < 4; ++k) { qv[k] = *(const u32x4*)(qs + 8 * k); kv[k] = *(const u32x4*)(ks + 8 * k); vv[k] = *(const u32x4*)(vs + 8 * k); }
        const int lo = tk * 272 + seg * 2;
#pragma unroll
        for (int k = 0; k < 4; ++k) { *(u32x4*)(qL + lo + 16 * k) = qv[k]; *(u32x4*)(kL + lo + 16 * k) = kv[k]; *(u32x4*)(vL + lo + 16 * k) = vv[k]; }
    }
    if (hw == 0) {
        float g, b;
        if (kind == 0) { const int row = scan_row(dir, n * 64 + lane); g = p.ggb()[(size_t)row * 16 + dir * 4 + h]; b = p.ggb()[(size_t)row * 16 + 8 + dir * 4 + h]; }
        else { const int ei = dir + 2 * h; g = (ei == 0 ? -3.1748698315e-02f : (ei == 1 ? -1.5748356968e-02f : (ei == 2 ? -7.8431774610e-03f : (ei == 3 ? -3.9138993211e-03f : (ei == 4 ? -1.9550348358e-03f : (ei == 5 ? -9.7703964783e-04f : (ei == 6 ? -4.8840049811e-04f : -2.4417043217e-04f))))))); b = 1.f; }
        float gc = g;
#pragma unroll
        for (int o = 1; o < 64; o <<= 1) { const float tt = __int_as_float(__builtin_amdgcn_ds_bpermute(((lane - o) & 63) << 2, __float_as_int(gc))); if (lane >= o) gc += tt; }
        const float gl = __int_as_float(__builtin_amdgcn_readlane(__float_as_int(gc), 63));
        gcL[lane] = gc; btL[lane] = b; egL[lane] = expf(gc); ekL[lane] = expf(gl - gc);
        if (lane == 63 && valid) *(float*)(rec + REC_DL) = expf(gc);
    }
    __syncthreads();
    {   const int mi = hw >> 1, ni = hw & 1;
#pragma unroll
        for (int mat = 0; mat < 2; ++mat) {
            if (mat == 1 || kind == 0) {
                f32x16 acc = {};
                if (!(mi == 0 && ni == 1)) {
                    const char* XL = mat ? qL : kL;
#pragma unroll
                    for (int ks = 0; ks < 8; ++ks) {
                        const bf16x8 a = *(const bf16x8*)(XL + (32 * mi + r32) * 272 + (16 * ks + 8 * hi) * 2);
                        const bf16x8 b = *(const bf16x8*)(kL + (32 * ni + r32) * 272 + (16 * ks + 8 * hi) * 2);
                        acc = __builtin_amdgcn_mfma_f32_32x32x16_bf16(a, b, acc, 0, 0, 0);
                    }
                }
                const int j = 32 * ni + r32; const float gj = gcL[j];
#pragma unroll
                for (int r = 0; r < 16; ++r) { const int i = 32 * mi + crow32(r, hi);
                    const float dec = __expf(fminf(gcL[i] - gj, 0.f));
                    if (mat == 0) AM[i * 68 + j] = (j < i) ? btL[i] * acc[r] * dec : 0.f;
                    else if (valid) *(bf16_t*)(rec + REC_A + (size_t)(i * 64 + j) * 2) = f2bf((j <= i) ? acc[r] * dec : 0.f); }
            }
        }
    }
    __syncthreads();
    if (valid) {
        if (kind == 0) {
            const int cc = t & 127; const bool isw = t >= 128; const char* src = isw ? kL : vL;
            float x[64];
#pragma unroll
            for (int i = 0; i < 64; ++i) x[i] = bf2f(*(const bf16_t*)(src + i * 272 + cc * 2)) * (isw ? btL[i] * egL[i] : btL[i]);
            f32x4 ar[2][16];
#pragma unroll
            for (int i = 1; i < 64; ++i) {
                if (i == 1) { ar[1][0] = *(const f32x4*)(AM + 68); }
                if (i + 1 < 64) {
#pragma unroll
                    for (int j4 = 0; j4 < (i + 4) / 4; ++j4) ar[(i + 1) & 1][j4] = *(const f32x4*)(AM + (i + 1) * 68 + j4 * 4);
                }
                __builtin_amdgcn_sched_barrier(0);
                float a = x[i];
#pragma unroll
                for (int j4 = 0; j4 < (i + 3) / 4; ++j4) { const f32x4 a4 = ar[i & 1][j4];
                    if (4 * j4 + 0 < i) a -= a4[0] * x[4 * j4 + 0]; if (4 * j4 + 1 < i) a -= a4[1] * x[4 * j4 + 1];
                    if (4 * j4 + 2 < i) a -= a4[2] * x[4 * j4 + 2]; if (4 * j4 + 3 < i) a -= a4[3] * x[4 * j4 + 3]; }
                x[i] = a;
                __builtin_amdgcn_sched_barrier(0);
            }
            bf16_t* dstp = (bf16_t*)(rec + (isw ? REC_W : REC_U)) + cc;
#pragma unroll
            for (int i = 0; i < 64; ++i) dstp[i * 128] = f2bf(x[i]);
        } else if (t < 128) {
#pragma unroll 8
            for (int i = 0; i < 64; ++i) *(bf16_t*)(rec + REC_U + (size_t)(i * 128 + t) * 2) = *(const bf16_t*)(vL + i * 272 + t * 2);
        }
        {   const int i = t >> 2, seg = (t & 3) * 32; const float e = egL[i];
#pragma unroll
            for (int k8 = 0; k8 < 4; ++k8) { float f[8]; unpack8(*(const u32x4*)(qL + i * 272 + (seg + k8 * 8) * 2), f);
#pragma unroll
                for (int e8 = 0; e8 < 8; ++e8) f[e8] *= e;
                *(u32x4*)(rec + REC_Q + (size_t)(i * 128 + seg + k8 * 8) * 2) = pack8(f); } }
        {   const int d = t >> 1, hf = t & 1;
#pragma unroll
            for (int k8 = 0; k8 < 4; ++k8) { float f[8];
#pragma unroll
                for (int e8 = 0; e8 < 8; ++e8) { const int i = hf * 32 + k8 * 8 + e8; f[e8] = bf2f(*(const bf16_t*)(kL + i * 272 + d * 2)) * ekL[i]; }
                *(u32x4*)(rec + REC_KT + (size_t)(d * 64 + hf * 32 + k8 * 8) * 2) = pack8(f); } }
    }
    __syncthreads();
}
__device__ __forceinline__ void phase_chunkprep(const Params& p, int layer, char* lds) {
    int k = 0;
#pragma unroll 1
    for (int id = blockIdx.x; id < 8 * NCHUNK; id += gridDim.x, ++k) { const int j = ((id & 7) + 4 * (k & 1)) & 7; chunkprep_pair(p, layer, ((id >> 3) * 8 + j) * 2, lds); }
}

constexpr int CH_W = 0, CH_Q = 16896, CH_A = 33792, CH_K = 42496, CH_BUF = 59904;
constexpr int CH_U = 2 * CH_BUF, CH_DL = CH_U + 16896;
__device__ __forceinline__ bf16x8 frag_rd(const char* base, int row, int stride, int ks, int hi) {
    const char* a = base + row * stride + (16 * ks + 4 * hi) * 2;
    const u32x2 lo = *(const u32x2*)a, hi2 = *(const u32x2*)(a + 16);
    u32x4 w = {lo.x, lo.y, hi2.x, hi2.y}; return *reinterpret_cast<bf16x8*>(&w);
}
__device__ __forceinline__ bf16x8 acc_frag(const f32x16& x, int s) {
    u32x4 w = {cvt_pk_bf16(x[8 * s + 0], x[8 * s + 1]), cvt_pk_bf16(x[8 * s + 2], x[8 * s + 3]), cvt_pk_bf16(x[8 * s + 4], x[8 * s + 5]), cvt_pk_bf16(x[8 * s + 6], x[8 * s + 7])};
    return *reinterpret_cast<bf16x8*>(&w);
}
struct ChainRegs { u32x4 q[4], k[4], a[2], w[4], u[4]; float dl; };
__device__ __forceinline__ void chain_ld(ChainRegs& R, const char* rec, int t, bool gdn) {
#pragma unroll
    for (int it = 0; it < 4; ++it) R.q[it] = *(const u32x4*)(rec + REC_Q + (size_t)(t + it * 256) * 16);
#pragma unroll
    for (int it = 0; it < 4; ++it) R.k[it] = *(const u32x4*)(rec + REC_KT + (size_t)(t + it * 256) * 16);
#pragma unroll
    for (int it = 0; it < 2; ++it) R.a[it] = *(const u32x4*)(rec + REC_A + (size_t)(t + it * 256) * 16);
#pragma unroll
    for (int it = 0; it < 4; ++it) R.u[it] = *(const u32x4*)(rec + REC_U + (size_t)(t + it * 256) * 16);
    R.dl = *(const float*)(rec + REC_DL);
    if (gdn) {
#pragma unroll
        for (int it = 0; it < 4; ++it) R.w[it] = *(const u32x4*)(rec + REC_W + (size_t)(t + it * 256) * 16);
    }
}
#define CH_ST16(DST, V) do { char* d_ = (DST); *(u32x2*)d_ = (u32x2){(V).x, (V).y}; *(u32x2*)(d_ + 8) = (u32x2){(V).z, (V).w}; } while (0)
__device__ __forceinline__ void chain_st(const ChainRegs& R, char* lds, int b, int t, bool gdn) {
    char* buf = lds + b * CH_BUF;
#pragma unroll
    for (int it = 0; it < 4; ++it) { const int pc = t + it * 256; CH_ST16(buf + CH_Q + (pc >> 4) * 264 + (pc & 15) * 16, R.q[it]); }
#pragma unroll
    for (int it = 0; it < 4; ++it) { const int pc = t + it * 256; CH_ST16(buf + CH_K + (pc >> 3) * 136 + (pc & 7) * 16, R.k[it]); }
#pragma unroll
    for (int it = 0; it < 2; ++it) { const int pc = t + it * 256; CH_ST16(buf + CH_A + (pc >> 3) * 136 + (pc & 7) * 16, R.a[it]); }
#pragma unroll
    for (int it = 0; it < 4; ++it) { const int pc = t + it * 256; CH_ST16(lds + CH_U + (pc >> 4) * 264 + (pc & 15) * 16, R.u[it]); }
    if (t == 0) *(float*)(lds + CH_DL + b * 4) = R.dl;
    if (gdn) {
#pragma unroll
        for (int it = 0; it < 4; ++it) { const int pc = t + it * 256; CH_ST16(buf + CH_W + (pc >> 4) * 264 + (pc & 15) * 16, R.w[it]); }
    }
}
#define CH_BAR() do { asm volatile("s_waitcnt lgkmcnt(0)" ::: "memory"); __builtin_amdgcn_s_barrier(); asm volatile("" ::: "memory"); } while (0)
__device__ __forceinline__ void chain_unit(const Params& p, int c, char* lds) {
    const int tid = otid(), wid = tid >> 6, lane = tid & 63, r32 = lane & 31, hi = lane >> 5;
    const int kind = c >> 3, dir = (c >> 2) & 1, h = c & 3; const bool gdn = kind == 0;
    const char* rec0 = p.recs() + (size_t)c * NCHUNK * REC_BYTES;
    float* outp = (gdn ? p.go() : p.ro()) + (size_t)dir * MT * 512 + h * 128;
    const bool comp = wid < 4; const int sl = wid & 3;
    if (!comp) {
        const int t = tid - 256; ChainRegs R0, R1;
        chain_ld(R0, rec0, t, gdn); chain_st(R0, lds, 0, t, gdn);
        chain_ld(R1, rec0 + REC_BYTES, t, gdn); chain_ld(R0, rec0 + 2 * REC_BYTES, t, gdn);
        CH_BAR();
#define CH_LSTEP(R, N) do { CH_BAR(); if ((N) + 1 < NCHUNK) { chain_st(R, lds, ((N) + 1) & 1, t, gdn); if ((N) + 3 < NCHUNK) chain_ld(R, rec0 + (size_t)((N) + 3) * REC_BYTES, t, gdn); } CH_BAR(); } while (0)
#pragma unroll 1
        for (int n = 0; n < NCHUNK; n += 2) { CH_LSTEP(R1, n); CH_LSTEP(R0, n + 1); }
#undef CH_LSTEP
    } else {
        f32x16 S[4] = {};
        unsigned warm = 0u; const char* wbase = rec0 + (size_t)((wid * 3) * 64 + lane) * 128;
        CH_BAR();
#define CH_FR8(BASE, STRIDE, ROWA, ROWB, KS0) do { _Pragma("unroll") for (int k_ = 0; k_ < 4; ++k_) { fr[k_] = frag_rd(BASE, ROWA, STRIDE, (KS0) + k_, hi); fr[4 + k_] = frag_rd(BASE, ROWB, STRIDE, (KS0) + k_, hi); } \
        __builtin_amdgcn_sched_barrier(0); } while (0)
#define CH_MM8(ACC0, ACC1, B, KS0) do { _Pragma("unroll") for (int k_ = 0; k_ < 4; ++k_) { \
        ACC0 = __builtin_amdgcn_mfma_f32_32x32x16_bf16(fr[k_], B[((KS0) + k_) >> 1][((KS0) + k_) & 1], ACC0, 0, 0, 0); \
        ACC1 = __builtin_amdgcn_mfma_f32_32x32x16_bf16(fr[4 + k_], B[((KS0) + k_) >> 1][((KS0) + k_) & 1], ACC1, 0, 0, 0); } \
        __builtin_amdgcn_sched_barrier(0); } while (0)
#pragma unroll 1
        for (int n = 0; n < NCHUNK; ++n) {
            const char* buf = lds + (n & 1) * CH_BUF;
            {   const char* wp = wbase + (size_t)(n + 6 < NCHUNK ? n + 6 : NCHUNK - 1) * REC_BYTES;
                const char* wp1 = wp + 8192; const char* wp2 = wp + 16384;
                asm volatile("global_load_dword %0, %1, off\n\tglobal_load_dword %0, %2, off\n\tglobal_load_dword %0, %3, off" : "+v"(warm) : "v"(wp), "v"(wp1), "v"(wp2) : "memory"); }
            f32x16 un[2];
#pragma unroll
            for (int mt = 0; mt < 2; ++mt)
#pragma unroll
                for (int r = 0; r < 16; ++r) un[mt][r] = bf2f(*(const bf16_t*)(lds + CH_U + (32 * mt + crow32(r, hi)) * 264 + (32 * sl + r32) * 2));
            const float dl = *(const float*)(lds + CH_DL + (n & 1) * 4);
            CH_BAR();
            bf16x8 Sb[4][2], Vb[2][2], fr[8];
#pragma unroll
            for (int kt = 0; kt < 4; ++kt) { Sb[kt][0] = acc_frag(S[kt], 0); Sb[kt][1] = acc_frag(S[kt], 1); }
            {   f32x16 X0 = {}, X1 = {};
                if (gdn) {
                    CH_FR8(buf + CH_W, 264, r32, 32 + r32, 0); CH_MM8(X0, X1, Sb, 0);
                    CH_FR8(buf + CH_W, 264, r32, 32 + r32, 4); CH_MM8(X0, X1, Sb, 4);
                }
                const f32x16 v0 = un[0] - X0, v1 = un[1] - X1;
                Vb[0][0] = acc_frag(v0, 0); Vb[0][1] = acc_frag(v0, 1); Vb[1][0] = acc_frag(v1, 0); Vb[1][1] = acc_frag(v1, 1);
            }
            {   f32x16 O0 = {}, O1 = {};
                CH_FR8(buf + CH_Q, 264, r32, 32 + r32, 0); CH_MM8(O0, O1, Sb, 0);
                CH_FR8(buf + CH_Q, 264, r32, 32 + r32, 4); CH_MM8(O0, O1, Sb, 4);
                CH_FR8(buf + CH_A, 136, r32, 32 + r32, 0); CH_MM8(O0, O1, Vb, 0);
#pragma unroll
                for (int r = 0; r < 16; ++r) { const int row = scan_row(dir, n * 64 + crow32(r, hi)); outp[(size_t)row * 512 + 32 * sl + r32] = O0[r]; }
#pragma unroll
                for (int r = 0; r < 16; ++r) { const int row = scan_row(dir, n * 64 + 32 + crow32(r, hi)); outp[(size_t)row * 512 + 32 * sl + r32] = O1[r]; }
            }
            S[0] *= dl; S[1] *= dl; S[2] *= dl; S[3] *= dl;
            CH_FR8(buf + CH_K, 136, r32, 32 + r32, 0); CH_MM8(S[0], S[1], Vb, 0);
            CH_FR8(buf + CH_K, 136, 64 + r32, 96 + r32, 0); CH_MM8(S[2], S[3], Vb, 0);
            CH_BAR();
        }
#undef CH_FR8
#undef CH_MM8
        asm volatile("s_waitcnt vmcnt(0)" : "+v"(warm) :: "memory");
    }
    __syncthreads();
}
__device__ __forceinline__ void phase_chain(const Params& p, char* lds) {
#pragma unroll 1
    for (int c = blockIdx.x; c < 16; c += gridDim.x) chain_unit(p, c, lds);
}
__device__ __forceinline__ void fft_fwd(cpx* Z, int tid) {
#pragma unroll 1
    for (int pass = 0; pass < 3; ++pass) { const int lm = pass == 0 ? 10 : (pass == 1 ? 6 : 2);

#pragma unroll 1
        for (int gi = 0; gi < 2; ++gi) fft_pass16<false>(Z, tid + gi * 512, lm);
        __syncthreads(); }
#pragma unroll 1
    for (int it = 0; it < 8; ++it) fft_pass4<false>(Z, tid + it * 512);
    __syncthreads();
}
__device__ __forceinline__ void fft_inv(cpx* Z, int tid) {
#pragma unroll 1
    for (int it = 0; it < 8; ++it) fft_pass4<true>(Z, tid + it * 512);
    __syncthreads();
#pragma unroll 1
    for (int pass = 0; pass < 3; ++pass) { const int lm = pass == 0 ? 2 : (pass == 1 ? 6 : 10);

#pragma unroll 1
        for (int gi = 0; gi < 2; ++gi) fft_pass16<true>(Z, tid + gi * 512, lm);
        __syncthreads(); }
}
constexpr size_t HY_SCR_FLOATS = 2 * 2 * (size_t)FFT_N + (size_t)SEQ;
__device__ __forceinline__ void hyena_latent_unit(const Params& p, int layer, int c, char* lds) {
    cpx* Z = (cpx*)lds; const int tid = otid(), lane = tid & 63;
    float* scr = p.hys() + (size_t)blockIdx.x * HY_SCR_FLOATS;
    cpx* Zh1 = (cpx*)scr; cpx* Zh2 = Zh1 + FFT_N; float* z1s = (float*)(Zh2 + FFT_N);
    const float* vs = p.hyT() + (size_t)c * SEQ; const float* x1s = p.hyT() + (size_t)(512 + c) * SEQ; const float* x2s = p.hyT() + (size_t)(1024 + c) * SEQ;
#pragma unroll 1
    for (int f = 0; f < 2; ++f) {
        const size_t ch = (size_t)layer * 1024 + f * 512 + c;
        const float* hsrc = p.hfilt() + ch * SEQ;
        const f32x4 ps = *(const f32x4*)(p.hsum() + ch * 256 + lane * 4);
        const float tot = wave_sum((ps[0] + ps[1]) + (ps[2] + ps[3]));
        const float scale = (1.0f / (tot + EPS)) * (1.0f / (float)FFT_N);
        {   f32x2 hv[16];
#pragma unroll
            for (int it = 0; it < 16; ++it) hv[it] = *(const f32x2*)(hsrc + 2 * (tid + it * 512));
#pragma unroll
            for (int it = 0; it < 16; ++it) { const int j = tid + it * 512; Z[ZP(j)] = cpx{hv[it][0] * scale, hv[it][1] * scale}; Z[ZP(j + 8192)] = cpx{0.f, 0.f}; } }
        __syncthreads();
        fft_fwd(Z, tid);
        cpx* Zh = f ? Zh2 : Zh1;
#pragma unroll 4
        for (int it = 0; it < 32; ++it) { const int q = tid + it * 512; Zh[q] = Z[ZP(q)]; }
        __syncthreads();
    }
    const float b0 = p.in[I_HBIAS][(size_t)layer * 1024 + c], b1 = p.in[I_HBIAS][(size_t)layer * 1024 + 512 + c];
    {   f32x2 hv[16];
#pragma unroll
        for (int it = 0; it < 16; ++it) hv[it] = *(const f32x2*)(vs + 2 * (tid + it * 512));
#pragma unroll
        for (int it = 0; it < 16; ++it) { const int j = tid + it * 512; Z[ZP(j)] = cpx{hv[it][0], hv[it][1]}; Z[ZP(j + 8192)] = cpx{0.f, 0.f}; } }
    __syncthreads();
    fft_fwd(Z, tid);
    {   cpx ha[16], hb[16];
#pragma unroll
        for (int it = 0; it < 16; ++it) { int pp, pq; fft_pw_idx(tid + it * 512, pp, pq); ha[it] = Zh1[pp]; hb[it] = Zh1[pq]; }
#pragma unroll
        for (int it = 0; it < 16; ++it) fft_pointwise_pre(Z, ha[it], hb[it], tid + it * 512); }
    __syncthreads();
    fft_inv(Z, tid);
#pragma unroll 1
    for (int half = 0; half < 2; ++half) {
        f32x2 va[8], xa[8];
#pragma unroll
        for (int it = 0; it < 8; ++it) { const int j = half * 4096 + tid + it * 512; va[it] = *(const f32x2*)(vs + 2 * j); xa[it] = *(const f32x2*)(x1s + 2 * j); }
#pragma unroll
        for (int it = 0; it < 8; ++it) { const int j = half * 4096 + tid + it * 512;
            const cpx y = Z[ZP(4096 + j)];
            const f32x2 v2 = va[it], xx = xa[it];
            const f32x2 z = {xx[0] * (y.x + b0 * v2[0]), xx[1] * (y.y + b0 * v2[1])};
            *(f32x2*)(z1s + 2 * j) = z; Z[ZP(j)] = cpx{z[0], z[1]};
            if (half) Z[ZP(4096 + j)] = cpx{0.f, 0.f};
            else Z[ZP(12288 + j)] = cpx{0.f, 0.f}; }
        __syncthreads();
    }
    __syncthreads();
    fft_fwd(Z, tid);
    {   cpx ha[16], hb[16];
#pragma unroll
        for (int it = 0; it < 16; ++it) { int pp, pq; fft_pw_idx(tid + it * 512, pp, pq); ha[it] = Zh2[pp]; hb[it] = Zh2[pq]; }
#pragma unroll
        for (int it = 0; it < 16; ++it) fft_pointwise_pre(Z, ha[it], hb[it], tid + it * 512); }
    __syncthreads();
    fft_inv(Z, tid);
    f32x2 za[16], xb[16];
#pragma unroll
    for (int it = 0; it < 16; ++it) { const int j = tid + it * 512; za[it] = *(const f32x2*)(z1s + 2 * j); xb[it] = *(const f32x2*)(x2s + 2 * j); }
#pragma unroll
    for (int it = 0; it < 16; ++it) { const int j = tid + it * 512; const cpx y = Z[ZP(4096 + j)];
        const f32x2 z = za[it], x2 = xb[it];
        *(unsigned*)(p.hyO() + (size_t)c * SEQ + 2 * j) = cvt_pk_bf16(x2[0] * (y.x + b1 * z[0]), x2[1] * (y.y + b1 * z[1])); }
    __syncthreads();
}
__device__ __forceinline__ void hyena_ctx_unit(const Params& p, int c, float* lds) {
    const int tid = otid();
    float* vv = lds; float* x1 = vv + 256; float* x2 = x1 + 256; float* h1 = x2 + 256; float* h2 = h1 + 256; float* z1 = h2 + 256;
    const float* cw = p.in[I_HCONV];
    if (tid < 256) { const int t = tid;
#pragma unroll
        for (int part = 0; part < 3; ++part) {
            const float w0 = cw[part * 512 + c], w1 = cw[1536 + part * 512 + c], w2 = cw[3072 + part * 512 + c];
            const bf16_t* col = p.Pp() + PC_HY + part * 512 + c;
            const float x0 = bf2f(col[(size_t)t * NP]), xm = t > 0 ? bf2f(col[(size_t)(t - 1) * NP]) : 0.f, xn = t < LC - 1 ? bf2f(col[(size_t)(t + 1) * NP]) : 0.f;
            (part == 0 ? vv : (part == 1 ? x1 : x2))[t] = w0 * xm + w1 * x0 + w2 * xn;
        }
        const float s1 = (p.hsc()[c * 4] + p.hsc()[c * 4 + 1]) + (p.hsc()[c * 4 + 2] + p.hsc()[c * 4 + 3]);
        const float s2 = (p.hsc()[(512 + c) * 4] + p.hsc()[(512 + c) * 4 + 1]) + (p.hsc()[(512 + c) * 4 + 2] + p.hsc()[(512 + c) * 4 + 3]);
        h1[t] = p.hfc()[(size_t)c * 256 + t] / (s1 + EPS); h2[t] = p.hfc()[(size_t)(512 + c) * 256 + t] / (s2 + EPS);
    }
    __syncthreads();
    const float b0 = p.in[I_HBIAS][c], b1 = p.in[I_HBIAS][512 + c];
    if (tid < 256) { const int t = tid; float y = 0.f;
        for (int s = 0; s < 256; ++s) { const int m = t - s + 128; if (m >= 0 && m < 256) y += vv[s] * h1[m]; }
        z1[t] = x1[t] * (y + b0 * vv[t]); }
    __syncthreads();
    if (tid < 256) { const int t = tid; float y = 0.f;
        for (int s = 0; s < 256; ++s) { const int m = t - s + 128; if (m >= 0 && m < 256) y += z1[s] * h2[m]; }
        p.ocat()[(size_t)t * D_ + 1024 + c] = f2bf(x2[t] * (y + b1 * z1[t])); }
    __syncthreads();
}
__device__ __forceinline__ void phase_hyena(const Params& p, int layer, char* lds) {
    const int nunits = 512 + (layer == 0 ? 512 : 0);
    for (int u = blockIdx.x; u < nunits; u += gridDim.x) {
        if (u < 512) hyena_latent_unit(p, layer, u, lds); else hyena_ctx_unit(p, u - 512, (float*)lds);
    }
}

__device__ __forceinline__ void phase_gather(const Params& p) {
    const int tid = otid();
    int base[NEXP], cn[NEXP]; { int acc = 0;
#pragma unroll
        for (int e = 0; e < NEXP; ++e) { base[e] = acc * 256; cn[e] = (int)p.cnt()[e]; acc += (cn[e] + 255) >> 8; } }
    for (int i = blockIdx.x * 512 + tid; i < 2 * SEQ; i += gridDim.x * 512) {
        const int t = i >> 1, e = p.tok_e()[i], pos = p.tok_p()[i];
        int b = 0;
#pragma unroll
        for (int k = 0; k < NEXP; ++k) b = (e == k) ? base[k] : b;
        const int row = b + pos;
        p.gidx()[row] = LC + t; p.tok_r()[i] = row; p.hsg()[row] = p.hs()[LC + t];
    }
    for (int i = blockIdx.x * 512 + tid; i < (MAXROWS_MOE / 256) * 8; i += gridDim.x * 512) p.tailidx()[i] = -1;
    for (int i = blockIdx.x * 512 + tid; i < MAXROWS_MOE; i += gridDim.x * 512) ((unsigned*)p.acts())[i] = 0u;
    if (blockIdx.x < NEXP && tid < 256) {
        int b = 0, cc = 0;
#pragma unroll
        for (int k = 0; k < NEXP; ++k) if ((int)blockIdx.x == k) { b = base[k]; cc = cn[k]; }
        const int r = cc + tid; if (r < ((cc + 255) & ~255)) { p.gidx()[b + r] = LC; p.hsg()[b + r] = 0.f; }
    }
}
__device__ __forceinline__ void phase_final(const Params& p) {
    const int tid = otid(), wid = tid >> 6, lane = tid & 63;
    const float* g2 = p.modv() + ((size_t)1 * 2 + 0) * 6 * D_ + 5 * D_;
    const float* fw = p.in[I_FNW];
#ifdef PROBE
    const float prc = ((const float*)(p.cnt() + 32))[0], pre = ((const float*)(p.cnt() + 32))[1];
#endif
    int tn = blockIdx.x * 8 + wid;
    int r0n = p.tok_r()[tn * 2], r1n = p.tok_r()[tn * 2 + 1]; float w0n = p.tok_w()[tn * 2], w1n = p.tok_w()[tn * 2 + 1];
    for (int t = tn; t < SEQ; t += gridDim.x * 8) {
        const int r0 = r0n, r1 = r1n; const float w0 = w0n, w1 = w1n;
        tn = t + gridDim.x * 8; if (tn < SEQ) { r0n = p.tok_r()[tn * 2]; r1n = p.tok_r()[tn * 2 + 1]; w0n = p.tok_w()[tn * 2]; w1n = p.tok_w()[tn * 2 + 1]; }
        const float* xr = p.xcur() + (size_t)(LC + t) * D_;
        f32x4 xv[8]; float ss = 0.f; u32x2 ya[8], yc[8];
#pragma unroll
        for (int i = 0; i < 8; ++i) { const int col = (i * 64 + lane) * 4; ya[i] = *(const u32x2*)(p.yb() + (size_t)r0 * D_ + col); yc[i] = *(const u32x2*)(p.yb() + (size_t)r1 * D_ + col); xv[i] = *(const f32x4*)(xr + col); }
#pragma unroll
        for (int i = 0; i < 8; ++i) { const int col = (i * 64 + lane) * 4;
            const f32x4 y0 = (f32x4){bflo(ya[i].x), bfhi(ya[i].x), bflo(ya[i].y), bfhi(ya[i].y)}, y1 = (f32x4){bflo(yc[i].x), bfhi(yc[i].x), bflo(yc[i].y), bfhi(yc[i].y)};
            const f32x4 y = y0 * w0 + y1 * w1;
            xv[i] = xv[i] + *(const f32x4*)(g2 + col) * y;
            ss += xv[i][0] * xv[i][0] + xv[i][1] * xv[i][1] + xv[i][2] * xv[i][2] + xv[i][3] * xv[i][3]; }
        ss = wave_sum(ss);
        const float rstd = rsqrtf(ss * (1.0f / D_) + EPS);
        f32x4 fwv[8];
#pragma unroll
        for (int i = 0; i < 8; ++i) fwv[i] = *(const f32x4*)(fw + (i * 64 + lane) * 4);
#pragma unroll
        for (int i = 0; i < 8; ++i) { const int col = (i * 64 + lane) * 4; const f32x4 ov = (xv[i] * rstd) * fwv[i];
            *(f32x4*)(p.out + (size_t)t * D_ + col) = ov; }
    }
}

__device__ __forceinline__ void hyprep_unit(const Params& p, int layer, int u, float* tile  ) {
    const int tid = otid(); const int rb = u / 24, cg = u % 24, t0 = rb * 128, ch0 = cg * 64;
    const float* cw = p.in[I_HCONV] + (size_t)layer * 3 * 1536 + ch0;
    {   const int c8 = (tid & 7) * 8; float w0[8], w1[8], w2[8];
#pragma unroll
        for (int e = 0; e < 8; ++e) { w0[e] = cw[c8 + e]; w1[e] = cw[1536 + c8 + e]; w2[e] = cw[3072 + c8 + e]; }
        u32x4 raw[2][3];
#pragma unroll
        for (int i = 0; i < 2; ++i) { const int t = t0 + (tid >> 3) + 64 * i;
            const bf16_t* P0 = p.Pp() + (size_t)(LC + t) * NP + PC_HY + ch0 + c8;
            raw[i][1] = *(const u32x4*)P0; raw[i][0] = *(const u32x4*)(t > 0 ? P0 - NP : P0); raw[i][2] = *(const u32x4*)(t < SEQ - 1 ? P0 + NP : P0); }
#pragma unroll
        for (int i = 0; i < 2; ++i) { const int tl = (tid >> 3) + 64 * i, t = t0 + tl;
            float x0[8], xm[8], xn[8];
            unpack8(raw[i][1], x0); unpack8(raw[i][0], xm); unpack8(raw[i][2], xn);
            const float fm = t > 0 ? 1.f : 0.f, fn = t < SEQ - 1 ? 1.f : 0.f;
#pragma unroll
            for (int e = 0; e < 8; ++e) tile[tl * 65 + c8 + e] = w0[e] * (xm[e] * fm) + w1[e] * x0[e] + w2[e] * (xn[e] * fn); }
    }
    __syncthreads();
    {   const int cl = tid >> 3, tq = (tid & 7) * 16; float* dst = p.hyT() + (size_t)(ch0 + cl) * SEQ + t0 + tq;
#pragma unroll
        for (int k = 0; k < 4; ++k) { f32x4 v;
#pragma unroll
            for (int e = 0; e < 4; ++e) v[e] = tile[(tq + 4 * k + e) * 65 + cl];
            *(f32x4*)(dst + 4 * k) = v; }
    }
    __syncthreads();
}
__device__ __forceinline__ void hyout_unit(const Params& p, int u, float* tile  ) {
    const int tid = otid(); const int rb = u >> 3, cg = u & 7, t0 = rb * 128, c0 = cg * 64;
    {   const int cl = tid >> 3, tq = (tid & 7) * 16; const bf16_t* src = p.hyO() + (size_t)(c0 + cl) * SEQ + t0 + tq;
        float f[8];
        unpack8(*(const u32x4*)src, f);
#pragma unroll
        for (int e = 0; e < 8; ++e) tile[cl * 129 + tq + e] = f[e];
        unpack8(*(const u32x4*)(src + 8), f);
#pragma unroll
        for (int e = 0; e < 8; ++e) tile[cl * 129 + tq + 8 + e] = f[e];
    }
    __syncthreads();
    {   const int c8 = (tid & 7) * 8;
#pragma unroll
        for (int i = 0; i < 2; ++i) { const int tl = (tid >> 3) + 64 * i; float f[8];
#pragma unroll
            for (int e = 0; e < 8; ++e) f[e] = tile[(c8 + e) * 129 + tl];
            *(u32x4*)(p.ocat() + (size_t)(LC + t0 + tl) * D_ + 1024 + c0 + c8) = pack8(f); }
    }
    __syncthreads();
}

__device__ __forceinline__ void phase_quant(const Params& p, const bf16_t* act, signed char* actq, float* rs, int nrows) {
    const int tid = otid(), wid = tid >> 6, lane = tid & 63;
    for (int r = blockIdx.x * 8 + wid; r < nrows; r += gridDim.x * 8) {
        const float am = fmaxf(__uint_as_float(((const unsigned*)rs)[r]), 1e-20f), inv = 127.f / am;
        const bf16_t* src = act + (size_t)r * DFF; signed char* dst = actq + (size_t)r * DFF;
        u32x4 raw[11];
#pragma unroll
        for (int it = 0; it < 11; ++it) raw[it] = *(const u32x4*)(src + (it * 64 + lane) * 8);
#pragma unroll
        for (int it = 0; it < 11; ++it) { float f[8]; unpack8(raw[it], f);
            unsigned w0 = 0u, w1 = 0u;
#pragma unroll
            for (int e = 0; e < 4; ++e) { w0 |= (unsigned)((int)rintf(f[e] * inv) & 255) << (8 * e); w1 |= (unsigned)((int)rintf(f[4 + e] * inv) & 255) << (8 * e); }
            *(u32x2*)(dst + (it * 64 + lane) * 8) = (u32x2){w0, w1}; }
        __builtin_amdgcn_wave_barrier();
        if (lane == 0) rs[r] = am * (1.0f / 127.f);
    }
}
#define XB_TMO      128
#define XB_XCNT(j)  (256  + 64 * (j))
#define XB_XSUB(j)  (1280 + 64 * (j))
#define XB_XGEN(j)  (2304 + 64 * (j))
#define XB_TOP      3328
#define XB_TOPGEN   3392
#define XCD_BAR_WORDS 3456
#define XB_SPIN_CAP (1u << 26)

__device__ __forceinline__ unsigned xb_ld(unsigned* p)              { return __hip_atomic_load(p, __ATOMIC_RELAXED, __HIP_MEMORY_SCOPE_AGENT); }
__device__ __forceinline__ unsigned xb_add(unsigned* p, unsigned v) { return __hip_atomic_fetch_add(p, v, __ATOMIC_RELAXED, __HIP_MEMORY_SCOPE_AGENT); }
__device__ __forceinline__ unsigned xb_xcc_id() { return (unsigned)__builtin_amdgcn_s_getreg((3 << 11) | 20) & 0xFu; }
#define XB_SPIN(cond, bar) do { unsigned _sp = 0; while (cond) { __builtin_amdgcn_s_sleep(1); \
    if ((++_sp & 255u) == 0u) { if (xb_ld(&(bar)[XB_TMO])) break; if (_sp > XB_SPIN_CAP) { atomicAdd(&(bar)[XB_TMO], 1u); break; } } } } while (0)

struct XcdBarrier {
    unsigned* bar; unsigned x;
    volatile LAS unsigned* st;
};

__device__ __forceinline__ XcdBarrier xcd_barrier_post(unsigned* bar, volatile LAS unsigned* st) {
    XcdBarrier b; b.bar = bar; b.x = xb_xcc_id(); b.st = st;
    if (threadIdx.x == 0) (void)xb_add(&bar[XB_XCNT(b.x)], 1u);
    return b;
}
__device__ __forceinline__ void xcd_barrier_complete(unsigned* bar, unsigned x, unsigned& nloc, unsigned& nx) {
    const unsigned G = gridDim.x * gridDim.y * gridDim.z;
    unsigned sum, cnt, mine, sp = 0u;
    for (;;) {
        sum = 0u; cnt = 0u; mine = 0u;
#pragma unroll
        for (unsigned j = 0; j < 16; ++j) { const unsigned c = xb_ld(&bar[XB_XCNT(j)]); sum += c; cnt += (c > 0u) ? 1u : 0u; mine = (j == x) ? c : mine; }
        if (sum == G) break;
        __builtin_amdgcn_s_sleep(1);
        if ((++sp & 255u) == 0u) { if (xb_ld(&bar[XB_TMO])) break; if (sp > XB_SPIN_CAP) { atomicAdd(&bar[XB_TMO], 1u); break; } }
    }
    nloc = mine > 0u ? mine : 1u; nx = cnt > 0u ? cnt : 1u;
}

__device__ __forceinline__ void xcd_barrier(const XcdBarrier& b) {
    asm volatile("s_waitcnt vmcnt(0)" ::: "memory");
    __syncthreads();
    if (threadIdx.x == 0) {
        unsigned* bar = b.bar;
        __builtin_amdgcn_s_waitcnt(0);
        unsigned nloc = b.st[0], nx = b.st[1];
        if (nloc == 0u) { xcd_barrier_complete(bar, b.x, nloc, nx); b.st[0] = nloc; b.st[1] = nx; }
        const unsigned old = xb_add(&bar[XB_XSUB(b.x)], 1u);
        const unsigned gen = old / nloc;
        if (old + 1u == (gen + 1u) * nloc) {
            __builtin_amdgcn_fence(__ATOMIC_RELEASE, "agent");
            asm volatile("s_waitcnt vmcnt(0)" ::: "memory");
            const unsigned og = xb_add(&bar[XB_TOP], 1u);
            const unsigned tg = og / nx;
            if (og + 1u == (tg + 1u) * nx) xb_add(&bar[XB_TOPGEN], 1u);
            else XB_SPIN(xb_ld(&bar[XB_TOPGEN]) == tg, bar);
            __builtin_amdgcn_fence(__ATOMIC_ACQUIRE, "agent");
            xb_add(&bar[XB_XGEN(b.x)], 1u);
            asm volatile("s_waitcnt vmcnt(0)" ::: "memory");
        } else {
            XB_SPIN(xb_ld(&bar[XB_XGEN(b.x)]) == gen, bar);
            __builtin_amdgcn_fence(__ATOMIC_ACQUIRE, "agent");
            asm volatile("s_waitcnt vmcnt(0)" ::: "memory");
        }
    }
    __syncthreads();
}

enum { PH_PRO, PH_NORM1, PH_GIN, PH_PREP, PH_GMLA, PH_ATT, PH_REC, PH_CPREP, PH_CHAIN, PH_MIX3, PH_HY, PH_MIXOUT, PH_GOUT, PH_NORM2, PH_F1, PH_Q1, PH_F2, PH_GATHER, PH_MG1, PH_Q2, PH_MG2, PH_FINAL };
constexpr int LDS_BYTES = 147456;
constexpr int XBW_OFF = LDS_BYTES - 16;

template <int PH> __device__ __forceinline__ void run_phase(const Params& p, int layer, unsigned char* shm) {
    LAS unsigned char* lds3 = (LAS unsigned char*)shm;
    const int G = gridDim.x, c = blockIdx.x;
    if constexpr (PH == PH_PRO) phase_prologue(p, (float*)shm);
    else if constexpr (PH == PH_NORM1) {
        phase_norm(p, layer, 1, 0, shm);
    }
    else if constexpr (PH == PH_GIN) {
        pg8::Gemm g{p.hbuf(), p.wb_in() + (size_t)layer * NP * (D_ / 2), D_ / 2, D_ / 2, D_ / 2, 0, nullptr};
        pg8::StaticOrder S; S.init(MT, NP, G, c, D_ / 2);
        pg8::EpiStoreBf16 E{p.Pp(), NP, nullptr, 1 << 30, nullptr, nullptr, p.hs(), p.wam() + WAM_IN + layer * NP};
        pg8::gemm_phase<pg8::EpiStoreBf16, pg8::StaticOrder, false, true>(lds3, g, S, E);
    }
    else if constexpr (PH == PH_PREP) phase_prep(p, layer);
    else if constexpr (PH == PH_GMLA) {
        pg8::Gemm g{p.Pp() + PC_CQ, p.wb_mla() + (size_t)layer * MLAN * MLAK, MLAK, NP, MLAK, 0, nullptr};
        pg8::StaticOrder S; S.init(MT, MLAN, G, c, MLAK);
        pg8::EpiStoreBf16 E{p.qkvup(), MLAN, p.mrs(), 3, nullptr, nullptr, nullptr, nullptr};
        pg8::gemm_phase(lds3, g, S, E);
    }
    else if constexpr (PH == PH_ATT) phase_attn(p, layer, (char*)shm);
    else if constexpr (PH == PH_REC) phase_rec_naive(p, layer, (float*)shm);
    else if constexpr (PH == PH_CPREP) {
        phase_chunkprep(p, layer, (char*)shm);
        {
            int u0 = c, u1 = 128 * 24, us = G;
            if (G == 256) { const int n = c < 32 ? 5 : (c < 199 ? 11 : 18 + (c >= 207 ? 1 : 0));
                u0 = c < 32 ? 5 * c : (c < 199 ? 160 + 11 * (c - 32) : 1997 + 18 * (c - 199) + (c > 207 ? c - 207 : 0)); u1 = u0 + n; us = 1; }
#pragma unroll 1
            for (int u = u0; u < u1; u += us) hyprep_unit(p, layer, u, (float*)shm); }
    }
    else if constexpr (PH == PH_CHAIN) phase_chain(p, (char*)shm);
    else if constexpr (PH == PH_MIX3) {
        const int nctx = layer == 0 ? 4 : 0, nq = 64 + nctx + 512 + (layer == 0 ? 512 : 0);
        unsigned* qctr = p.cnt() + 16 + layer; volatile LAS unsigned* qw = (volatile LAS unsigned*)(LAS unsigned char*)(shm + XBW_OFF - 32);
        int code = c < 16 ? c : (c < 256 ? 16 + c : -1);
#pragma unroll 1
        for (;;) {
            if (code < 0) {
                __syncthreads();
                if (otid() == 0) qw[0] = atomicAdd(qctr, 1u);
                __syncthreads();
                const int q = (int)qw[0];
                if (q >= nq) break;
                code = q < 64 ? 1300 + q : (q < 64 + nctx ? 16 + 256 + (q - 64) : (q < 64 + nctx + 512 ? 276 + (q - 64 - nctx) : 788 + (q - 64 - nctx - 512)));
            }
            if (code < 16) chain_unit(p, code, (char*)shm);
            else if (code < 276 || code >= 1300) { const bool spl = code >= 1300; attn_unit(p, spl ? (code - 1300) >> 2 : code - 16, spl ? (code - 1300) & 3 : -1, (char*)shm); }
            else if (code < 788) hyena_latent_unit(p, layer, code - 276, (char*)shm);
            else hyena_ctx_unit(p, code - 788, (float*)shm);
            code = -1;
        }
    }
    else if constexpr (PH == PH_HY) phase_hyena(p, layer, (char*)shm);
    else if constexpr (PH == PH_MIXOUT) {
        phase_mixout(p, layer);
        __syncthreads();
#pragma unroll 1
        for (int u = c; u < 128 * 8; u += G) hyout_unit(p, u, (float*)shm);
    }
    else if constexpr (PH == PH_GOUT) {
        const float* mv = p.modv() + (size_t)layer * 2 * 6 * D_;
        if (layer == 0) {
            pg8::Gemm g{p.ocat(), p.wb_out(), D_, D_, D_, 0, nullptr};
            pg8::CtxSplitOrder S; S.init(G, c, D_, 4);
            pg8::EpiResGate E{p.xcur(), p.in[I_CTX], p.in[I_X], mv + 6 * D_ + 2 * D_, mv + 2 * D_, 0, p.partG(), nullptr, nullptr};
            pg8::gemm_phase(lds3, g, S, E);
        } else {
            pg8::Gemm g{p.ocat() + (size_t)LC * D_, p.wb_out() + (size_t)D_ * D_, D_, D_, D_, 0, nullptr};
            pg8::StaticOrder S; S.init(SEQ, D_, G, c, D_);
            pg8::EpiResGate E{p.xcur(), p.xcur(), p.xcur() + (size_t)LC * D_, mv + 6 * D_ + 2 * D_, mv + 2 * D_, LC, nullptr, nullptr, nullptr};
            pg8::gemm_phase(lds3, g, S, E);
        }
    }
    else if constexpr (PH == PH_NORM2) {
        phase_norm(p, layer, 2, layer == 0 ? 0 : LC, shm);
    }
    else if constexpr (PH == PH_F1) {
        pg8::Gemm g{p.hbuf(), p.wb_f13(), D_ / 2, D_ / 2, D_ / 2, 0, nullptr};
        pg8::StaticOrder S; S.init(MT, 2 * DFF, G, c, D_ / 2);
        pg8::EpiSwiGLU E{p.act(), DFF, p.hs(), p.wam() + WAM_F13, (unsigned*)p.acts()};
        pg8::gemm_phase<pg8::EpiSwiGLU, pg8::StaticOrder, false, true>(lds3, g, S, E);
    }
    else if constexpr (PH == PH_Q1) phase_quant(p, p.act(), p.actq(), p.acts(), MT);
    else if constexpr (PH == PH_F2) {
        const float* mv = p.modv();
        pg8::Gemm g{(const bf16_t*)p.actq(), p.wb_f2(), DFF / 2, DFF / 2, DFF / 2, 0, nullptr};
        pg8::CtxSplitOrder S; S.init(G, c, DFF / 2, 11);
        pg8::EpiResGate E{p.xcur(), p.xcur(), p.xcur() + (size_t)LC * D_, mv + 6 * D_ + 5 * D_, mv + 5 * D_, 0, p.partF(), p.acts(), p.wam() + WAM_F2};
        pg8::gemm_phase<pg8::EpiResGate, pg8::CtxSplitOrder, false, true>(lds3, g, S, E);
    }
    else if constexpr (PH == PH_GATHER) phase_gather(p);
    else if constexpr (PH == PH_MG1) {
        pg8::Gemm g{p.hbuf(), p.wb_m13(), D_ / 2, D_ / 2, D_ / 2, (size_t)2 * DFF * (D_ / 2), p.gidx()};
        pg8::GroupedOrder S; S.init(p.cnt(), 2 * DFF, G, c, D_ / 2);
        pg8::EpiSwiGLU E{p.act_moe(), DFF, p.hsg(), p.wam() + WAM_M13, (unsigned*)p.acts()};
        pg8::gemm_phase<pg8::EpiSwiGLU, pg8::GroupedOrder, true, true>(lds3, g, S, E);
    }
    else if constexpr (PH == PH_Q2) { int np = 0;
#pragma unroll
        for (int e = 0; e < NEXP; ++e) np += ((int)p.cnt()[e] + 255) >> 8;
        phase_quant(p, p.act_moe(), p.actq_moe(), p.acts(), np * 256); }
    else if constexpr (PH == PH_MG2) {
        pg8::Gemm g{(const bf16_t*)p.actq_moe(), p.wb_m2(), DFF / 2, DFF / 2, DFF / 2, (size_t)D_ * (DFF / 2), nullptr};
        pg8::GroupedOrder S; S.init(p.cnt(), D_, G, c, DFF / 2, false);
        pg8::EpiStoreBf16 E{p.yb(), D_, nullptr, 1 << 30, p.ypart(), p.tailidx(), p.acts(), p.wam() + WAM_M2};
        pg8::gemm_phase<pg8::EpiStoreBf16, pg8::GroupedOrder, false, true>(lds3, g, S, E);
    }
    else if constexpr (PH == PH_FINAL) phase_final(p);
}

#ifndef MEGA
#define MEGA 1
#endif
template <int PH> __global__ __launch_bounds__(512, 2) void k_ph(Params p, int layer) {
    extern __shared__ __attribute__((aligned(16))) unsigned char shm[];
    run_phase<PH>(p, layer, shm);
}
#ifdef PROBE
#ifndef PROBE_A0
#define PROBE_A0 0
#define PROBE_A1 1
#define PROBE_B0 0
#define PROBE_B1 1
#endif
#define STAMP(k) do { if (blockIdx.x == 0 && otid() == 0) tsl[k] = (unsigned long long)wall_clock64(); } while (0)
#else
#define STAMP(k) do {} while (0)
#endif
__global__ __launch_bounds__(512, 2) void k_mega(Params p) {
    extern __shared__ __attribute__((aligned(16))) unsigned char shm[];
    volatile LAS unsigned* xbw = (volatile LAS unsigned*)(LAS unsigned char*)(shm + XBW_OFF);
#ifdef PROBE
    volatile LAS unsigned long long* tsl = (volatile LAS unsigned long long*)(LAS unsigned char*)(shm + XBW_OFF - 512);
#endif
    if (otid() == 0) { xbw[0] = 0u; xbw[1] = 0u; xbw[2] = 0u; xbw[3] = 0u; }
    __syncthreads();
    STAMP(0);
    (void)xcd_barrier_post(p.bar(), xbw);
#define GBAR() do { XcdBarrier _b; _b.bar = p.bar(); _b.x = xb_xcc_id(); _b.st = xbw; xcd_barrier(_b); } while (0)
    run_phase<PH_PRO>(p, 0, shm); GBAR(); STAMP(1);
#pragma unroll 1
    for (int l = 0; l < 2; ++l) {
        const int sb = 2 + 16 * l; (void)sb;
        run_phase<PH_NORM1>(p, l, shm); GBAR(); STAMP(sb + 0);
        run_phase<PH_GIN>(p, l, shm); GBAR(); STAMP(sb + 1);
        run_phase<PH_PREP>(p, l, shm); GBAR(); STAMP(sb + 2);
        run_phase<PH_GMLA>(p, l, shm); __syncthreads();
        run_phase<PH_CPREP>(p, l, shm); GBAR(); STAMP(sb + 3);
        run_phase<PH_MIX3>(p, l, shm); GBAR(); STAMP(sb + 6);
        run_phase<PH_MIXOUT>(p, l, shm); GBAR(); STAMP(sb + 7);
        run_phase<PH_GOUT>(p, l, shm); GBAR(); STAMP(sb + 8);
        run_phase<PH_NORM2>(p, l, shm); GBAR(); STAMP(sb + 9);
        if (l == 0) {
            run_phase<PH_F1>(p, l, shm); GBAR(); STAMP(sb + 10);
            run_phase<PH_Q1>(p, l, shm); GBAR();
            run_phase<PH_F2>(p, l, shm); GBAR(); STAMP(sb + 11);
        } else {
            run_phase<PH_GATHER>(p, l, shm); GBAR(); STAMP(sb + 10);
            run_phase<PH_MG1>(p, l, shm); GBAR(); STAMP(sb + 11);
            run_phase<PH_Q2>(p, l, shm); GBAR();
            run_phase<PH_MG2>(p, l, shm); GBAR(); STAMP(sb + 12);
#ifdef PROBE
            if (blockIdx.x == 0 && otid() == 0) {
                float* pw = (float*)(p.cnt() + 32);
                pw[0] = (float)(tsl[PROBE_A1] - tsl[PROBE_A0]) * 1e-5f; pw[1] = (float)(tsl[PROBE_B1] - tsl[PROBE_B0]) * 0.0025f;
            }
            GBAR();
#endif
            run_phase<PH_FINAL>(p, l, shm);
        }
    }
}
template <int PH> static void launch_ph(const Params& p, int layer, int grid, hipStream_t st) {
    static bool attr = false;
    if (!attr) { (void)hipFuncSetAttribute((const void*)k_ph<PH>, hipFuncAttributeMaxDynamicSharedMemorySize, LDS_BYTES); attr = true; }
    hipLaunchKernelGGL((k_ph<PH>), dim3(grid), dim3(512), LDS_BYTES, st, p, layer);
}

static size_t align_up(size_t x) { return (x + 255) & ~(size_t)255; }
extern "C" void kernel_launch(void* const* d_in, const int* in_sizes, int n_in, void* d_out, int out_size, void* d_ws, size_t ws_size, hipStream_t stream) {
    Params p{};
    for (int i = 0; i < N_IN; ++i) p.in[i] = (const float*)d_in[i];
    p.out = (float*)d_out;
    static int GRID = 0;
    if (!GRID) {
#if MEGA
        int dev = 0, cus = 0, per_cu = 0;
        (void)hipGetDevice(&dev);
        (void)hipDeviceGetAttribute(&cus, hipDeviceAttributeMultiprocessorCount, dev);
        (void)hipFuncSetAttribute((const void*)k_mega, hipFuncAttributeMaxDynamicSharedMemorySize, LDS_BYTES);
        (void)hipOccupancyMaxActiveBlocksPerMultiprocessor(&per_cu, k_mega, 512, LDS_BYTES);
        if (per_cu < 1 || cus < 1) { fprintf(stderr, "kernel_launch: occupancy query failed (%d blocks/CU, %d CUs)\n", per_cu, cus); return; }
        GRID = cus < WS_GRID ? cus : WS_GRID;
#else
        GRID = 256;
#endif
    }
    p.ws = (char*)d_ws;
    if (ws_size < WSL.need) { fprintf(stderr, "kernel_launch: workspace too small: %zu < %zu\n", ws_size, (size_t)WSL.need); return; }
#if MEGA
    (void)hipMemsetAsync((char*)d_ws + WSL.bar, 0, WSL.modv - WSL.bar, stream);
    hipLaunchKernelGGL(k_mega, dim3(GRID), dim3(512), LDS_BYTES, stream, p);
#else
    launch_ph<PH_PRO>(p, 0, GRID, stream);
    for (int l = 0; l < 2; ++l) {
        launch_ph<PH_NORM1>(p, l, GRID, stream);
        launch_ph<PH_GIN>(p, l, GRID, stream);
        launch_ph<PH_PREP>(p, l, GRID, stream);
        launch_ph<PH_GMLA>(p, l, GRID, stream);
        launch_ph<PH_ATT>(p, l, GRID, stream);
        launch_ph<PH_CPREP>(p, l, GRID, stream);
        launch_ph<PH_CHAIN>(p, l, GRID, stream);
        launch_ph<PH_HY>(p, l, GRID, stream);
        launch_ph<PH_MIXOUT>(p, l, GRID, stream);
        launch_ph<PH_GOUT>(p, l, GRID, stream);
        launch_ph<PH_NORM2>(p, l, GRID, stream);
        if (l == 0) { launch_ph<PH_F1>(p, l, GRID, stream); launch_ph<PH_F2>(p, l, GRID, stream); }
        else { launch_ph<PH_GATHER>(p, l, GRID, stream); launch_ph<PH_MG1>(p, l, GRID, stream); launch_ph<PH_MG2>(p, l, GRID, stream); launch_ph<PH_FINAL>(p, l, GRID, stream); }
    }
#endif
}
```
